# Optimizing an MI355X kernel written in HIP

```python
import math
import jax
import jax.numpy as jnp
from jax import lax
import numpy as np

D_MODEL = 1024
BATCH = 16
SEQ = 4096
DEPTH = 4

PLE_DIM = 256
D_FF = 2816
NORM_EPS = 1e-6
NEG_INF = -1e30
NUM_BUCKETS = 32
MAX_DISTANCE = 128
A_HEADS = 4
A_HEAD_DIM = 64
A_QBLOCK = 128
B_HEADS = 8
B_GROUPS = 2
B_REP = B_HEADS // B_GROUPS
B_HEAD_DIM = 64
B_CMP_LEN = 32
B_CMP_STRIDE = 16
B_CMP_HIDDEN = 256
B_SEL_BLOCK = 64
B_SEL_TOPK = 16
B_WINDOW = 512
B_QBLOCK = 64
B_SEL_FORCE = 1e6
C_HEADS = 8
C_GROUPS = 2
C_REP = C_HEADS // C_GROUPS
C_HEAD_DIM = 64
C_WINDOW = 128
C_QBLOCK = 128

A_WIDTH = A_HEADS * 2 * A_HEAD_DIM
B_WIDTH = B_HEADS * B_HEAD_DIM
B_KV = B_GROUPS * B_HEAD_DIM
C_WIDTH = C_HEADS * C_HEAD_DIM
C_KV = C_GROUPS * C_HEAD_DIM
N_BIAS_HEADS = A_HEADS + B_HEADS + C_HEADS
IN_SPLITS = (A_WIDTH, A_WIDTH, A_WIDTH,
             B_WIDTH, B_KV, B_KV, B_KV, B_KV, B_KV, B_KV, 3 * B_HEADS,
             C_WIDTH, C_KV, C_KV,
             D_MODEL, D_MODEL, D_MODEL)
D_IN = 3 * A_WIDTH + B_WIDTH + 6 * B_KV + 3 * B_HEADS + C_WIDTH + 2 * C_KV + 3 * D_MODEL

kernel_name = "hybrid_diff_nsa_swa_macaron_trunk"


def rms_norm(x, g):
    xf = x.astype(jnp.float32)
    y = xf * lax.rsqrt(jnp.mean(xf * xf, axis=-1, keepdims=True) + NORM_EPS)
    return (y * g.astype(jnp.float32)).astype(x.dtype)


def swiglu(x, wi, wo):
    gate, up = jnp.split(x @ wi, 2, axis=-1)
    return (jax.nn.silu(gate) * up) @ wo


def split_cols(z, sizes):
    outs, start = [], 0
    for s in sizes:
        outs.append(z[..., start:start + s])
        start += s
    return outs


def rel_bucket(dist):
    n = jnp.maximum(dist, 0)
    max_exact = NUM_BUCKETS // 2
    nf = jnp.maximum(n, 1).astype(jnp.float32)
    large = max_exact + (jnp.log(nf / max_exact) / math.log(MAX_DISTANCE / max_exact)
                         * (NUM_BUCKETS - max_exact)).astype(jnp.int32)
    large = jnp.minimum(large, NUM_BUCKETS - 1)
    return jnp.where(n < max_exact, n, large)


def head_bias(table, dist):
    return jnp.moveaxis(table[rel_bucket(dist)].astype(jnp.float32), -1, 0)


def grouped_head_bias(table, dist, groups, rep):
    b = head_bias(table, dist)
    return b.reshape((groups, rep) + dist.shape)


def masked_softmax(s, mask):
    return jax.nn.softmax(jnp.where(mask, s, NEG_INF), axis=-1) * mask


def diff_attention(q, k, v, bias_table, lam, lam_init, subln_g):
    bsz, seq = q.shape[:2]
    nblk = seq // A_QBLOCK
    scale = A_HEAD_DIM ** -0.5
    qb = q.reshape(bsz, nblk, A_QBLOCK, A_HEADS, 2, A_HEAD_DIM).swapaxes(0, 1)
    kpos = jnp.arange(seq)

    def block(args):
        i, qi = args
        qpos = i * A_QBLOCK + jnp.arange(A_QBLOCK)
        dist = qpos[:, None] - kpos[None, :]
        s = jnp.einsum('bqhcd,bkhcd->bchqk', qi, k, preferred_element_type=jnp.float32) * scale
        s = s + head_bias(bias_table, dist)[None, None]
        pr = masked_softmax(s, dist >= 0)
        attn = pr[:, 0] - lam * pr[:, 1]
        return jnp.einsum('bhqk,bkhe->bqhe', attn.astype(v.dtype), v)

    o = lax.map(block, (jnp.arange(nblk), qb))
    o = o.swapaxes(0, 1).reshape(bsz, seq, A_HEADS, 2 * A_HEAD_DIM)
    o = rms_norm(o, subln_g) * (1.0 - lam_init)
    return o.reshape(bsz, seq, A_WIDTH)


def nsa_attention(q, kc, vc, ks, vs, kw, vw, gates, bias_table, cmp_pos, cmp_w1, cmp_w2):
    bsz, seq = q.shape[:2]
    scale = B_HEAD_DIM ** -0.5
    n_chunk = seq // B_CMP_STRIDE
    n_cmp = n_chunk - 1
    n_sel = seq // B_SEL_BLOCK
    top_k = min(B_SEL_TOPK, n_sel)
    nblk = seq // B_QBLOCK

    def compress(t, pos, w1, w2):
        c = t.reshape(bsz, n_chunk, B_CMP_STRIDE, B_GROUPS, B_HEAD_DIM)
        blk = jnp.concatenate([c[:, :-1], c[:, 1:]], axis=2) + pos[None, None, :, None, :]
        blk = blk.transpose(0, 1, 3, 2, 4).reshape(bsz, n_cmp, B_GROUPS, B_CMP_LEN * B_HEAD_DIM)
        return jax.nn.gelu(blk @ w1) @ w2

    k_cmp = compress(kc, cmp_pos[0], cmp_w1[0], cmp_w2[0])
    v_cmp = compress(vc, cmp_pos[1], cmp_w1[1], cmp_w2[1])
    cmp_start = jnp.arange(n_cmp) * B_CMP_STRIDE
    cmp_end = cmp_start + B_CMP_LEN - 1
    sel_start = jnp.arange(n_sel) * B_SEL_BLOCK
    overlap = ((cmp_start[:, None] < sel_start[None, :] + B_SEL_BLOCK)
               & (cmp_start[:, None] + B_CMP_LEN > sel_start[None, :])).astype(jnp.float32)
    ks_blk = ks.reshape(bsz, n_sel, B_SEL_BLOCK, B_GROUPS, B_HEAD_DIM).transpose(0, 3, 1, 2, 4)
    vs_blk = vs.reshape(bsz, n_sel, B_SEL_BLOCK, B_GROUPS, B_HEAD_DIM).transpose(0, 3, 1, 2, 4)
    kw_pad = jnp.pad(kw, ((0, 0), (B_WINDOW, 0), (0, 0), (0, 0)))
    vw_pad = jnp.pad(vw, ((0, 0), (B_WINDOW, 0), (0, 0), (0, 0)))
    tbg = bias_table.reshape(NUM_BUCKETS, B_GROUPS, B_REP).transpose(1, 0, 2)
    b_idx = jnp.arange(bsz)[:, None, None, None]
    g_idx = jnp.arange(B_GROUPS)[None, :, None, None]
    blk_id = jnp.arange(n_sel)
    qb = q.reshape(bsz, nblk, B_QBLOCK, B_GROUPS, B_REP, B_HEAD_DIM).swapaxes(0, 1)
    gb = gates.reshape(bsz, nblk, B_QBLOCK, B_GROUPS, B_REP, 3).swapaxes(0, 1)

    def block(args):
        i, qi, gi = args
        qpos = i * B_QBLOCK + jnp.arange(B_QBLOCK)
        dist_c = qpos[:, None] - cmp_end[None, :]
        s_c = jnp.einsum('bqgrd,bngd->bgrqn', qi, k_cmp, preferred_element_type=jnp.float32) * scale
        s_c = s_c + grouped_head_bias(bias_table, dist_c, B_GROUPS, B_REP)
        p_c = masked_softmax(s_c, dist_c >= 0)
        o_c = jnp.einsum('bgrqn,bngd->bqgrd', p_c.astype(v_cmp.dtype), v_cmp)
        imp = jnp.einsum('bgrqn,nm->bgqm', p_c, overlap)
        cur = qpos // B_SEL_BLOCK
        forced = (blk_id[None, :] == 0) | (blk_id[None, :] == cur[:, None]) | (blk_id[None, :] == cur[:, None] - 1)
        future = blk_id[None, :] > cur[:, None]
        imp = jnp.where(forced, B_SEL_FORCE, jnp.where(future, -B_SEL_FORCE, imp))
        _, idx = lax.top_k(imp, top_k)
        n_keys = top_k * B_SEL_BLOCK
        k_sel = ks_blk[b_idx, g_idx, idx].reshape(bsz, B_GROUPS, B_QBLOCK, n_keys, B_HEAD_DIM)
        v_sel = vs_blk[b_idx, g_idx, idx].reshape(bsz, B_GROUPS, B_QBLOCK, n_keys, B_HEAD_DIM)
        kpos_s = (idx[..., None] * B_SEL_BLOCK + jnp.arange(B_SEL_BLOCK)).reshape(bsz, B_GROUPS, B_QBLOCK, n_keys)
        dist_s = qpos[None, None, :, None] - kpos_s
        bias_s = tbg[g_idx, rel_bucket(dist_s)].astype(jnp.float32).transpose(0, 1, 4, 2, 3)
        s_s = jnp.einsum('bqgrd,bgqld->bgrql', qi, k_sel, preferred_element_type=jnp.float32) * scale + bias_s
        p_s = masked_softmax(s_s, (dist_s >= 0)[:, :, None])
        o_s = jnp.einsum('bgrql,bgqld->bqgrd', p_s.astype(v_sel.dtype), v_sel)
        start = i * B_QBLOCK
        k_win = lax.dynamic_slice_in_dim(kw_pad, start, B_WINDOW + B_QBLOCK, axis=1)
        v_win = lax.dynamic_slice_in_dim(vw_pad, start, B_WINDOW + B_QBLOCK, axis=1)
        kpos_w = start - B_WINDOW + jnp.arange(B_WINDOW + B_QBLOCK)
        dist_w = qpos[:, None] - kpos_w[None, :]
        mask_w = (dist_w >= 0) & (dist_w < B_WINDOW) & (kpos_w >= 0)[None, :]
        s_w = jnp.einsum('bqgrd,bkgd->bgrqk', qi, k_win, preferred_element_type=jnp.float32) * scale
        s_w = s_w + grouped_head_bias(bias_table, dist_w, B_GROUPS, B_REP)
        p_w = masked_softmax(s_w, mask_w)
        o_w = jnp.einsum('bgrqk,bkgd->bqgrd', p_w.astype(v_win.dtype), v_win)
        return gi[..., 0:1] * o_c + gi[..., 1:2] * o_s + gi[..., 2:3] * o_w

    o = lax.map(block, (jnp.arange(nblk), qb, gb))
    return o.swapaxes(0, 1).reshape(bsz, seq, B_WIDTH)


def swa_sink_attention(q, k, v, bias_table, sinks):
    bsz, seq = q.shape[:2]
    scale = C_HEAD_DIM ** -0.5
    nblk = seq // C_QBLOCK
    k_pad = jnp.pad(k, ((0, 0), (C_WINDOW, 0), (0, 0), (0, 0)))
    v_pad = jnp.pad(v, ((0, 0), (C_WINDOW, 0), (0, 0), (0, 0)))
    qb = q.reshape(bsz, nblk, C_QBLOCK, C_GROUPS, C_REP, C_HEAD_DIM).swapaxes(0, 1)
    sink = jnp.broadcast_to(sinks.astype(jnp.float32).reshape(C_GROUPS, C_REP, 1, 1),
                            (bsz, C_GROUPS, C_REP, C_QBLOCK, 1))

    def block(args):
        i, qi = args
        start = i * C_QBLOCK
        qpos = start + jnp.arange(C_QBLOCK)
        kb = lax.dynamic_slice_in_dim(k_pad, start, C_WINDOW + C_QBLOCK, axis=1)
        vb = lax.dynamic_slice_in_dim(v_pad, start, C_WINDOW + C_QBLOCK, axis=1)
        kpos = start - C_WINDOW + jnp.arange(C_WINDOW + C_QBLOCK)
        dist = qpos[:, None] - kpos[None, :]
        mask = (dist >= 0) & (dist < C_WINDOW) & (kpos >= 0)[None, :]
        s = jnp.einsum('bqgrd,bkgd->bgrqk', qi, kb, preferred_element_type=jnp.float32) * scale
        s = jnp.where(mask, s + grouped_head_bias(bias_table, dist, C_GROUPS, C_REP), NEG_INF)
        pr = jax.nn.softmax(jnp.concatenate([s, sink], axis=-1), axis=-1)[..., :-1]
        return jnp.einsum('bgrqk,bkgd->bqgrd', pr.astype(vb.dtype), vb)

    o = lax.map(block, (jnp.arange(nblk), qb))
    return o.swapaxes(0, 1).reshape(bsz, seq, C_WIDTH)


def setup_inputs(seed: int = 0) -> dict:
    key = jax.random.key(seed)
    ks = jax.random.split(key, 20)

    def nrm(k, shape, scale):
        return jax.random.normal(k, shape, jnp.float32) * scale

    return {
        'x': nrm(ks[0], (BATCH, SEQ, D_MODEL), 1.0),
        'p': nrm(ks[1], (DEPTH, BATCH, SEQ, PLE_DIM), 1.0),
        'norm_g': 1.0 + nrm(ks[2], (DEPTH, 4, D_MODEL), 0.05),
        'ffn1_wi': nrm(ks[3], (DEPTH, D_MODEL, 2 * D_FF), D_MODEL ** -0.5),
        'ffn1_wo': nrm(ks[4], (DEPTH, D_FF, D_MODEL), D_FF ** -0.5),
        'w_in': nrm(ks[5], (DEPTH, D_MODEL, D_IN), D_MODEL ** -0.5),
        'diff_lambda': nrm(ks[6], (DEPTH, 4, A_HEAD_DIM), 0.1),
        'diff_subln': 1.0 + nrm(ks[7], (DEPTH, 2 * A_HEAD_DIM), 0.05),
        'nsa_cmp_pos': nrm(ks[8], (DEPTH, 2, B_CMP_LEN, B_HEAD_DIM), 0.1),
        'nsa_cmp_w1': nrm(ks[9], (DEPTH, 2, B_CMP_LEN * B_HEAD_DIM, B_CMP_HIDDEN), (B_CMP_LEN * B_HEAD_DIM) ** -0.5),
        'nsa_cmp_w2': nrm(ks[10], (DEPTH, 2, B_CMP_HIDDEN, B_HEAD_DIM), B_CMP_HIDDEN ** -0.5),
        'swa_sinks': nrm(ks[11], (DEPTH, C_HEADS), 0.5),
        'w_branch': nrm(ks[12], (DEPTH, 3, A_WIDTH, D_MODEL), A_WIDTH ** -0.5),
        'w_out': nrm(ks[13], (DEPTH, D_MODEL, D_MODEL), D_MODEL ** -0.5),
        'ffn2_wi': nrm(ks[14], (DEPTH, D_MODEL, 2 * D_FF), D_MODEL ** -0.5),
        'ffn2_wo': nrm(ks[15], (DEPTH, D_FF, D_MODEL), D_FF ** -0.5),
        'w_ple': nrm(ks[16], (DEPTH, PLE_DIM, D_MODEL), PLE_DIM ** -0.5),
        'w_ple_gate': nrm(ks[17], (DEPTH, D_MODEL, D_MODEL), D_MODEL ** -0.5),
        'rel_bias': nrm(ks[18], (NUM_BUCKETS, N_BIAS_HEADS), 0.5),
        'final_norm': 1.0 + nrm(ks[19], (D_MODEL,), 0.05),
    }


def reference(x, p, norm_g, ffn1_wi, ffn1_wo, w_in, diff_lambda, diff_subln, nsa_cmp_pos,
              nsa_cmp_w1, nsa_cmp_w2, swa_sinks, w_branch, w_out, ffn2_wi, ffn2_wo,
              w_ple, w_ple_gate, rel_bias, final_norm):
    bsz, seq, _ = x.shape
    bias_a = rel_bias[:, :A_HEADS]
    bias_b = rel_bias[:, A_HEADS:A_HEADS + B_HEADS]
    bias_c = rel_bias[:, A_HEADS + B_HEADS:]
    h = x
    for i in range(DEPTH):
        h = h + 0.5 * swiglu(rms_norm(h, norm_g[i, 0]), ffn1_wi[i], ffn1_wo[i])
        n = rms_norm(h, norm_g[i, 1])
        (aq, ak, av, bq, bkc, bvc, bks, bvs, bkw, bvw, bgate,
         cq, ck, cv, ga, gb, gc) = split_cols(n @ w_in[i], IN_SPLITS)
        lam_init = 0.8 - 0.6 * math.exp(-0.3 * i)
        lp = diff_lambda[i].astype(jnp.float32)
        lam = jnp.exp(jnp.sum(lp[0] * lp[1])) - jnp.exp(jnp.sum(lp[2] * lp[3])) + lam_init
        ya = diff_attention(aq.reshape(bsz, seq, A_HEADS, 2, A_HEAD_DIM),
                            ak.reshape(bsz, seq, A_HEADS, 2, A_HEAD_DIM),
                            av.reshape(bsz, seq, A_HEADS, 2 * A_HEAD_DIM),
                            bias_a, lam, lam_init, diff_subln[i])
        kvb = lambda t: t.reshape(bsz, seq, B_GROUPS, B_HEAD_DIM)
        yb = nsa_attention(bq.reshape(bsz, seq, B_GROUPS, B_REP, B_HEAD_DIM),
                           kvb(bkc), kvb(bvc), kvb(bks), kvb(bvs), kvb(bkw), kvb(bvw),
                           jax.nn.sigmoid(bgate.reshape(bsz, seq, B_GROUPS, B_REP, 3)),
                           bias_b, nsa_cmp_pos[i], nsa_cmp_w1[i], nsa_cmp_w2[i])
        yc = swa_sink_attention(cq.reshape(bsz, seq, C_GROUPS, C_REP, C_HEAD_DIM),
                                ck.reshape(bsz, seq, C_GROUPS, C_HEAD_DIM),
                                cv.reshape(bsz, seq, C_GROUPS, C_HEAD_DIM),
                                bias_c, swa_sinks[i])
        merged = (jax.nn.sigmoid(ga) * (ya @ w_branch[i, 0])
                  + jax.nn.sigmoid(gb) * (yb @ w_branch[i, 1])
                  + jax.nn.sigmoid(gc) * (yc @ w_branch[i, 2]))
        h = h + merged @ w_out[i]
        h = h + 0.5 * swiglu(rms_norm(h, norm_g[i, 2]), ffn2_wi[i], ffn2_wo[i])
        h = h + jax.nn.sigmoid(rms_norm(h, norm_g[i, 3]) @ w_ple_gate[i]) * (p[i] @ w_ple[i])
    return rms_norm(h, final_norm)
```

```cpp
#include <hip/hip_runtime.h>
#include <hip/hip_cooperative_groups.h>
#include <cstdio>
#include <cstdint>
namespace cg = cooperative_groups;
namespace pg8 {
#define PG8_LAS __attribute__((address_space(3)))
typedef unsigned short bf16_t;
typedef short bf16x8 __attribute__((ext_vector_type(8)));
typedef float f32x4 __attribute__((ext_vector_type(4)));
typedef unsigned u32x4 __attribute__((ext_vector_type(4)));
constexpr int BM = 256, BK = 64, HALF = 128, HTB = HALF * BK * 2  , STAGE_BYTES = 8 * HTB, NXCD = 8, WGM = 8;

__host__ __device__ __forceinline__ int lds_byte(int r, int c) { const int st = (r >> 4) * 2 + (c >> 5), rr = r & 15, cc = c & 31, ob = rr * 64 + cc * 2; return st * 1024 + (ob ^ (((ob >> 9) & 1) << 5)); }
__host__ __device__ __forceinline__ void stage_rc(int b, int& R, int& C) { const int st = b / 1024, sb = b % 1024, swz = sb ^ (((sb >> 9) & 1) << 5); R = (st >> 1) * 16 + swz / 64; C = (st & 1) * 32 + (swz % 64) / 2; }
__host__ __device__ __forceinline__ int perm32(int rho) { const int n = rho >> 4, i = rho & 15; return 8 * (i >> 2) + 4 * n + (i & 3); }

struct Unit { int pm, pn; };
struct Gemm { const bf16_t* A; const bf16_t* Bt; int M, N, K, lda; };

struct StaticOrder {
    int nM, nN, nwg, G, c;
    __host__ __device__ void init(int M, int N, int G_, int c_) { nM = M / BM; nN = N / BM; nwg = nM * nN; G = G_; c = c_; }
    __host__ __device__ bool next(int i, Unit& u) const {
        const long L = (long)i * G + c; if (L >= nwg) return false;
        int wgid = (int)L; { const int q = nwg / NXCD, r = nwg % NXCD, xcd = wgid % NXCD, off = wgid / NXCD; wgid = (xcd < r ? xcd * (q + 1) : r * (q + 1) + (xcd - r) * q) + off; }
        const int nig = WGM * nN, gid = wgid / nig, fm = gid * WGM, gsz = (nM - fm) < WGM ? (nM - fm) : WGM;
        u.pm = fm + ((wgid % nig) % gsz); u.pn = (wgid % nig) / gsz; return true;
    }
    __device__ __forceinline__ void a_ready(const Unit&) const {}
    __device__ __forceinline__ void done(const Unit&) const {}
};

__device__ __forceinline__ unsigned cvt_pk_bf16(float lo, float hi) { unsigned r; asm volatile("v_cvt_pk_bf16_f32 %0, %1, %2" : "=v"(r) : "v"(lo), "v"(hi)); return r; }
typedef float f32x2 __attribute__((ext_vector_type(2)));
template <class Epi, class Sched, bool ALIGN_EPI = false, bool SP2 = false>
__device__ __forceinline__ void gemm_phase(PG8_LAS unsigned char* lds, const Gemm g, const Sched& S, const Epi& E) {
    int tid_ = threadIdx.x; asm volatile("" : "+v"(tid_)); const int tid = tid_, wid = __builtin_amdgcn_readfirstlane(tid >> 6), lane = tid & 63, wr = wid >> 2, wc = wid & 3, fr = lane & 15, fq = lane >> 4;
    const int K = g.K, nt = K / BK;
    unsigned voffA[2], voffB[2];
#pragma unroll
    for (int i = 0; i < 2; ++i) { int R, C; stage_rc(tid * 16 + i * 8192, R, C); const int Rb = Epi::PERM ? ((R & ~31) + perm32(R & 31)) : R;
        voffA[i] = (unsigned)(R * g.lda + C) * 2u; voffB[i] = (unsigned)(Rb * K + C) * 2u; }
    const size_t kstep = (size_t)(BK * 2);
    const size_t hstep = (size_t)HALF * K * 2;
    const size_t tstep = 2 * hstep; const size_t hstepA = (size_t)HALF * g.lda * 2, tstepA = 2 * hstepA;
    const unsigned ldsw = (unsigned)wid * 1024u;
    const int aoff = lds_byte(wr * 64 + fr, fq * 8), boff = lds_byte(wc * 32 + fr, fq * 8);
#define PG8_SA(b, h) (((b) * 2 + (h)) * HTB)
#define PG8_SB(b, h) ((4 + (b) * 2 + (h)) * HTB)
#define PG8_STAGE(bufoff, gbase, voff) do { _Pragma("unroll") for (int _i = 0; _i < 2; ++_i) \
        __builtin_amdgcn_global_load_lds((const unsigned*)((const char*)(gbase) + (voff)[_i]), (PG8_LAS unsigned*)(lds + (bufoff) + ldsw + _i * 8192), 16, 0, 0); } while (0)
#define PG8_LDA(dst, b, h) do { _Pragma("unroll") for (int m = 0; m < 4; ++m) _Pragma("unroll") for (int k = 0; k < 2; ++k) dst[m][k] = *(const PG8_LAS bf16x8*)(lds + PG8_SA(b, h) + aoff + m * 2048 + k * 1024); } while (0)
#define PG8_LDB(dst, b, h) do { _Pragma("unroll") for (int n = 0; n < 2; ++n) _Pragma("unroll") for (int k = 0; k < 2; ++k) dst[n][k] = *(const PG8_LAS bf16x8*)(lds + PG8_SB(b, h) + boff + n * 2048 + k * 1024); } while (0)
#define PG8_MMA(ai, bj, At, Bt) do { __builtin_amdgcn_s_setprio(1); _Pragma("unroll") for (int m = 0; m < 4; ++m) _Pragma("unroll") for (int n = 0; n < 2; ++n) _Pragma("unroll") for (int k = 0; k < 2; ++k) \
        acc[ai][bj][m][n] = __builtin_amdgcn_mfma_f32_16x16x32_bf16(Bt[n][k], At[m][k], acc[ai][bj][m][n], 0, 0, 0); __builtin_amdgcn_s_setprio(0); } while (0)
#define PG8_WAIT_V(n) asm volatile("s_waitcnt vmcnt(" #n ")" ::: "memory")
#define PG8_WAIT_L(n) asm volatile("s_waitcnt lgkmcnt(" #n ")" ::: "memory")
#define PG8_BAR __builtin_amdgcn_s_barrier()
#define PG8_SCHED __builtin_amdgcn_sched_barrier(0)
    Unit cur, nxt; int ui = 0;
    if (!S.next(0, cur)) return;
    f32x4 acc[2][2][4][2];
#pragma unroll
    for (int a = 0; a < 2; ++a)
#pragma unroll
        for (int b = 0; b < 2; ++b)
#pragma unroll
            for (int m = 0; m < 4; ++m)
#pragma unroll
                for (int n = 0; n < 2; ++n) acc[a][b][m][n] = (f32x4){0.f, 0.f, 0.f, 0.f};
    bf16x8 At[4][2], B0[2][2], B1[2][2];
    const char* cA = (const char*)g.A + (size_t)cur.pm * tstepA; const char* cB = (const char*)g.Bt + (size_t)cur.pn * tstep;
    S.a_ready(cur);
    if constexpr (SP2) {
        PG8_STAGE(PG8_SB(0, 0), cB, voffB); PG8_STAGE(PG8_SB(0, 1), cB + hstep, voffB); PG8_STAGE(PG8_SA(0, 0), cA, voffA); PG8_STAGE(PG8_SA(0, 1), cA + hstepA, voffA);
        if (wr == 1) PG8_BAR;
        PG8_WAIT_V(2); PG8_BAR;
        PG8_STAGE(PG8_SB(1, 0), cB + kstep, voffB); PG8_STAGE(PG8_SA(1, 0), cA + kstep, voffA); PG8_STAGE(PG8_SB(1, 1), cB + hstep + kstep, voffB);
        PG8_WAIT_V(6); PG8_BAR;
    } else {
        PG8_STAGE(PG8_SB(0, 0), cB, voffB); PG8_STAGE(PG8_SA(0, 0), cA, voffA); PG8_STAGE(PG8_SB(0, 1), cB + hstep, voffB); PG8_STAGE(PG8_SA(0, 1), cA + hstepA, voffA);
        if (wr == 1) PG8_BAR;
        PG8_WAIT_V(4); PG8_BAR;
        PG8_STAGE(PG8_SB(1, 0), cB + kstep, voffB); PG8_STAGE(PG8_SA(1, 0), cA + kstep, voffA); PG8_STAGE(PG8_SB(1, 1), cB + hstep + kstep, voffB);
        PG8_WAIT_V(6); PG8_BAR;
    }
    for (;;) {
        const bool has_next = S.next(ui + 1, nxt);
        const char* nA = has_next ? (const char*)g.A + (size_t)nxt.pm * tstepA : cA; const char* nB = has_next ? (const char*)g.Bt + (size_t)nxt.pn * tstep : cB;
        for (int t = 0; t < nt; t += 2) {
            const bool last = (t == nt - 2);
            const char* a1 = cA + (size_t)(t + 1) * kstep;
            const char* a2 = last ? nA : cA + (size_t)(t + 2) * kstep; const char* b2 = last ? nB : cB + (size_t)(t + 2) * kstep;
            const char* a3 = a2 + kstep; const char* b3 = b2 + kstep;
            if (last && has_next) S.a_ready(nxt);
            if constexpr (SP2) {
            PG8_LDB(B0, 0, 0); PG8_LDB(B1, 0, 1); PG8_SCHED; PG8_LDA(At, 0, 0); PG8_STAGE(PG8_SA(1, 1), a1 + hstepA, voffA);
            PG8_WAIT_V(8); PG8_WAIT_L(0); PG8_BAR; PG8_MMA(0, 0, At, B0); PG8_MMA(0, 1, At, B1); PG8_BAR; PG8_SCHED;
            PG8_LDA(At, 0, 1); PG8_STAGE(PG8_SB(0, 0), b2, voffB); PG8_STAGE(PG8_SB(0, 1), b2 + hstep, voffB); PG8_STAGE(PG8_SA(0, 0), a2, voffA);
            PG8_WAIT_V(8); PG8_WAIT_L(0); PG8_BAR; PG8_MMA(1, 0, At, B0); PG8_MMA(1, 1, At, B1); PG8_BAR; PG8_SCHED;
            PG8_LDB(B0, 1, 0); PG8_LDB(B1, 1, 1); PG8_SCHED; PG8_LDA(At, 1, 0); PG8_STAGE(PG8_SA(0, 1), a2 + hstepA, voffA);
            PG8_WAIT_V(8); PG8_WAIT_L(0); PG8_BAR; PG8_MMA(0, 0, At, B0); PG8_MMA(0, 1, At, B1); PG8_BAR; PG8_SCHED;
            PG8_LDA(At, 1, 1); PG8_STAGE(PG8_SB(1, 0), b3, voffB); PG8_STAGE(PG8_SB(1, 1), b3 + hstep, voffB); PG8_STAGE(PG8_SA(1, 0), a3, voffA);
            PG8_WAIT_V(8); PG8_WAIT_L(0); PG8_BAR; PG8_MMA(1, 0, At, B0); PG8_MMA(1, 1, At, B1); PG8_BAR; PG8_SCHED;
            } else {
            PG8_LDB(B0, 0, 0); PG8_SCHED; PG8_LDA(At, 0, 0); PG8_STAGE(PG8_SA(1, 1), a1 + hstepA, voffA);
            PG8_WAIT_L(8); PG8_BAR; PG8_WAIT_L(0); PG8_MMA(0, 0, At, B0); PG8_BAR; PG8_SCHED;
            PG8_LDB(B1, 0, 1); PG8_STAGE(PG8_SB(0, 0), b2, voffB);
            PG8_BAR; PG8_WAIT_L(0); PG8_MMA(0, 1, At, B1); PG8_BAR;
            PG8_LDA(At, 0, 1); PG8_STAGE(PG8_SA(0, 0), a2, voffA);
            PG8_BAR; PG8_WAIT_L(0); PG8_MMA(1, 0, At, B0); PG8_BAR; PG8_SCHED;
            PG8_STAGE(PG8_SB(0, 1), b2 + hstep, voffB);
            PG8_WAIT_V(6); PG8_BAR; PG8_MMA(1, 1, At, B1); PG8_BAR;
            PG8_LDB(B0, 1, 0); PG8_SCHED; PG8_LDA(At, 1, 0); PG8_STAGE(PG8_SA(0, 1), a2 + hstepA, voffA);
            PG8_WAIT_L(8); PG8_BAR; PG8_WAIT_L(0); PG8_MMA(0, 0, At, B0); PG8_BAR; PG8_SCHED;
            PG8_LDB(B1, 1, 1); PG8_STAGE(PG8_SB(1, 0), b3, voffB);
            PG8_BAR; PG8_WAIT_L(0); PG8_MMA(0, 1, At, B1); PG8_BAR;
            PG8_LDA(At, 1, 1); PG8_STAGE(PG8_SA(1, 0), a3, voffA);
            PG8_BAR; PG8_WAIT_L(0); PG8_MMA(1, 0, At, B0); PG8_BAR; PG8_SCHED;
            PG8_STAGE(PG8_SB(1, 1), b3 + hstep, voffB);
            PG8_WAIT_V(6); PG8_BAR; PG8_MMA(1, 1, At, B1); PG8_BAR;
            }
        }
        if constexpr (ALIGN_EPI) { if (wr == 0) PG8_BAR; }
        if constexpr (!Epi::AFTER_DRAIN) { E(acc, cur, wr, wc, fr, fq); S.done(cur); }
        if (!has_next) break;
#pragma unroll
        for (int a = 0; a < 2; ++a)
#pragma unroll
            for (int b = 0; b < 2; ++b)
#pragma unroll
                for (int m = 0; m < 4; ++m)
#pragma unroll
                    for (int n = 0; n < 2; ++n) acc[a][b][m][n] = (f32x4){0.f, 0.f, 0.f, 0.f};
        cur = nxt; cA = nA; cB = nB; ++ui;
        if constexpr (ALIGN_EPI) { if (wr == 1) PG8_BAR; }
    }
    PG8_WAIT_V(0);
    if constexpr (!ALIGN_EPI) { if (wr == 0) PG8_BAR; }
    PG8_BAR;
    if constexpr (Epi::AFTER_DRAIN) { E.fused(acc, cur, wr, wc, fr, fq, lds, wid, lane); S.done(cur); }
#undef PG8_SA
#undef PG8_SB
#undef PG8_STAGE
#undef PG8_LDA
#undef PG8_LDB
#undef PG8_MMA
#undef PG8_WAIT_V
#undef PG8_WAIT_L
#undef PG8_BAR
#undef PG8_SCHED
}
}

#define LAS __attribute__((address_space(3)))
using pg8::bf16_t; using pg8::bf16x8; using pg8::f32x4; using pg8::u32x4;
typedef float f32x16 __attribute__((ext_vector_type(16)));
typedef unsigned u32x2 __attribute__((ext_vector_type(2)));
typedef unsigned char uchar;
typedef float f32x2_t __attribute__((ext_vector_type(2)));
typedef __bf16 bf16x2_t __attribute__((ext_vector_type(2)));

constexpr int DM = 1024, NBATCH = 16, SEQ = 4096, DEPTH = 4, PLE = 256, DFF = 2816;
constexpr int T = NBATCH * SEQ;
constexpr int NB = 8, TC = NB * SEQ, NCHUNK = NBATCH / NB;
constexpr int DIN = 6680, DINP = 6912;
constexpr float EPS = 1e-6f, LOG2E = 1.4426950408889634f;
constexpr int NTHR = 512;

constexpr size_t W_WI1 = 0, W_WO1 = W_WI1 + (size_t)5632 * 1024, W_WIN = W_WO1 + (size_t)1024 * 2816, W_CW1 = W_WIN + (size_t)DINP * 1024,
                 W_CW2 = W_CW1 + (size_t)2 * 256 * 2048, W_WBR = W_CW2 + (size_t)2 * 256 * 256, W_WOUT = W_WBR + (size_t)3 * 1024 * 512,
                 W_WI2 = W_WOUT + (size_t)1024 * 1024, W_WO2 = W_WI2 + (size_t)5632 * 1024, W_WPE = W_WO2 + (size_t)1024 * 2816,
                 W_WPG = W_WPE + (size_t)1024 * 256, W_LAYER = W_WPG + (size_t)1024 * 1024;
static_assert(W_LAYER == 29491200, "weights");
constexpr size_t MiB = 1u << 20;
constexpr size_t WS_W = 0, WS_XN = 226 * MiB, WS_R1 = 354 * MiB, WS_Y = 782 * MiB, WS_MG = 878 * MiB, WS_CH = 942 * MiB, WS_KCMP = 946 * MiB,
                 WS_VCMP = WS_KCMP + MiB / 2, WS_CB = 947 * MiB, WS_END = 948 * MiB;
static_assert(W_LAYER * 2 * DEPTH <= WS_XN, "w");
constexpr size_t HS = 262144;
constexpr size_t ZQA = 0, ZKA = ZQA + NB * 8 * HS, ZVA = ZKA + NB * 8 * HS, ZQB = ZVA + NB * 8 * HS, ZKCI = ZQB + NB * 8 * HS, ZVCI = ZKCI + NB * 2 * HS,
                 ZKS = ZVCI + NB * 2 * HS, ZVS = ZKS + NB * 2 * HS, ZKW = ZVS + NB * 2 * HS, ZVW = ZKW + NB * 2 * HS, ZQC = ZVW + NB * 2 * HS,
                 ZKC = ZQC + NB * 8 * HS, ZVC = ZKC + NB * 2 * HS, ZSG = ZVC + NB * 2 * HS, ZBG = ZSG + (size_t)TC * 3072, ZEND = ZBG + (size_t)TC * 32 * 2;
static_assert(ZEND * 2 <= 428 * MiB, "zbuf");
static_assert((size_t)T * DFF * 2 <= 428 * MiB, "act");
constexpr size_t R1_PBF = 0, R1_E = 32 * MiB;

struct Params {
    const float* in[20];
    float* out;
    uchar* ws;
};

__device__ __forceinline__ unsigned cvtpk(float lo, float hi) { f32x2_t v = {lo, hi}; bf16x2_t b = __builtin_convertvector(v, bf16x2_t); return __builtin_bit_cast(unsigned, b); }
__device__ __forceinline__ bf16_t cvt1(float x) { return (bf16_t)(cvtpk(x, 0.f) & 0xffffu); }
__device__ __forceinline__ float bf2f(unsigned short b) { return __uint_as_float((unsigned)b << 16); }
__device__ __forceinline__ float wave_sum(float v) {
#pragma unroll
    for (int o = 1; o < 64; o <<= 1) v += __shfl_xor(v, o);
    return v;
}
__device__ __forceinline__ int opq(int v) { asm volatile("" : "+v"(v)); return v; }
__device__ __forceinline__ float sigm(float x) { return __builtin_amdgcn_rcpf(1.f + __builtin_amdgcn_exp2f(-x * LOG2E)); }
__device__ __forceinline__ float gelu_tanh(float x) { const float u = 0.7978845608028654f * (x + 0.044715f * x * x * x); const float e = __builtin_amdgcn_exp2f(-2.f * LOG2E * u); const float th = 2.f * __builtin_amdgcn_rcpf(1.f + e) - 1.f; return 0.5f * x * (1.f + th); }

typedef const pg8::f32x4 (&AccRef)[2][2][4][2];
struct EpiSwiglu {
    static constexpr bool PERM = true, AFTER_DRAIN = false;
    bf16_t* O;
    __device__ __forceinline__ void operator()(AccRef acc, const pg8::Unit& u, int wr, int wc, int fr, int fq) const {
        asm volatile("" : "+v"(fr), "+v"(fq));
        const int row0 = u.pm * 256 + wr * 64 + fr, col0 = u.pn * 128 + wc * 32 + 8 * fq;
#pragma unroll
        for (int ai = 0; ai < 2; ++ai)
#pragma unroll
            for (int m = 0; m < 4; ++m) {
                bf16_t* rp = O + (size_t)(row0 + ai * 128 + m * 16) * DFF + col0;
                float o[8];
#pragma unroll
                for (int n = 0; n < 2; ++n)
#pragma unroll
                    for (int e = 0; e < 4; ++e) { const float g = acc[ai][0][m][n][e], up = acc[ai][1][m][n][e]; o[n * 4 + e] = g * sigm(g) * up; }
                u32x4 w; w.x = cvtpk(o[0], o[1]); w.y = cvtpk(o[2], o[3]); w.z = cvtpk(o[4], o[5]); w.w = cvtpk(o[6], o[7]);
                *(u32x4*)rp = w;
                asm volatile("" ::: "memory");
            }
    }
};
struct EpiResid {
    static constexpr bool PERM = false, AFTER_DRAIN = false;
    const float* in; float* out; float alpha; int row_off;
    __device__ __forceinline__ void operator()(AccRef acc, const pg8::Unit& u, int wr, int wc, int fr, int fq) const {
        asm volatile("" : "+v"(fr), "+v"(fq));
        const int row0 = row_off + u.pm * 256 + wr * 64 + fr, col0 = u.pn * 256 + wc * 32 + 4 * fq;
#pragma unroll
        for (int ai = 0; ai < 2; ++ai)
#pragma unroll
            for (int m = 0; m < 4; ++m) {
                const size_t off = (size_t)(row0 + ai * 128 + m * 16) * DM + col0;
#pragma unroll
                for (int bj = 0; bj < 2; ++bj)
#pragma unroll
                    for (int n = 0; n < 2; ++n) { const f32x4 b = *(const f32x4*)(in + off + bj * 128 + n * 16); *(f32x4*)(out + off + bj * 128 + n * 16) = b + acc[ai][bj][m][n] * alpha; }
                asm volatile("" ::: "memory");
            }
    }
};
struct EpiPle {
    static constexpr bool PERM = false, AFTER_DRAIN = false;
    float* h; const bf16_t* E;
    __device__ __forceinline__ void operator()(AccRef acc, const pg8::Unit& u, int wr, int wc, int fr, int fq) const {
        asm volatile("" : "+v"(fr), "+v"(fq));
        const int row0 = u.pm * 256 + wr * 64 + fr, col0 = u.pn * 256 + wc * 32 + 4 * fq;
#pragma unroll
        for (int ai = 0; ai < 2; ++ai)
#pragma unroll
            for (int m = 0; m < 4; ++m) {
                const size_t off = (size_t)(row0 + ai * 128 + m * 16) * DM + col0;
#pragma unroll
                for (int bj = 0; bj < 2; ++bj)
#pragma unroll
                    for (int n = 0; n < 2; ++n) {
                        const size_t o2 = off + bj * 128 + n * 16;
                        const u32x2 ev = *(const u32x2*)(E + o2); f32x4 b = *(const f32x4*)(h + o2); const f32x4 a = acc[ai][bj][m][n];
                        b[0] += sigm(a[0]) * __uint_as_float(ev.x << 16); b[1] += sigm(a[1]) * __uint_as_float(ev.x & 0xffff0000u);
                        b[2] += sigm(a[2]) * __uint_as_float(ev.y << 16); b[3] += sigm(a[3]) * __uint_as_float(ev.y & 0xffff0000u);
                        *(f32x4*)(h + o2) = b;
                    }
                asm volatile("" ::: "memory");
            }
    }
};
template <int MODE> struct EpiBf {
    static constexpr bool PERM = true, AFTER_DRAIN = false;
    bf16_t* O; int ldc; const float* bias;
    __device__ __forceinline__ void operator()(AccRef acc, const pg8::Unit& u, int wr, int wc, int fr, int fq) const {
        asm volatile("" : "+v"(fr), "+v"(fq));
        const int row0 = u.pm * 256 + wr * 64 + fr, col0 = u.pn * 256 + wc * 32 + 8 * fq;
#pragma unroll
        for (int bj = 0; bj < 2; ++bj) {
            float bv[8];
#pragma unroll
            for (int e = 0; e < 8; ++e) bv[e] = MODE == 1 ? bias[col0 + bj * 128 + e] : 0.f;
#pragma unroll
            for (int ai = 0; ai < 2; ++ai)
#pragma unroll
                for (int m = 0; m < 4; ++m) {
                    float o[8];
#pragma unroll
                    for (int n = 0; n < 2; ++n)
#pragma unroll
                        for (int e = 0; e < 4; ++e) { float v = acc[ai][bj][m][n][e] + bv[n * 4 + e]; if (MODE == 1) v = gelu_tanh(v); o[n * 4 + e] = v; }
                    u32x4 w; w.x = cvtpk(o[0], o[1]); w.y = cvtpk(o[2], o[3]); w.z = cvtpk(o[4], o[5]); w.w = cvtpk(o[6], o[7]);
                    *(u32x4*)(O + (size_t)(row0 + ai * 128 + m * 16) * ldc + col0 + bj * 128) = w;
                    asm volatile("" ::: "memory");
                }
        }
    }
};
template <bool VT> struct EpiCmp2 {
    static constexpr bool PERM = true, AFTER_DRAIN = false;
    bf16_t* O;
    __device__ __forceinline__ void operator()(AccRef acc, const pg8::Unit& u, int wr, int wc, int fr, int fq) const {
        asm volatile("" : "+v"(fr), "+v"(fq));
        if (u.pn != 0 || wc >= 2) return;
        const int row0 = u.pm * 256 + wr * 64 + fr, d0 = wc * 32 + 8 * fq;
#pragma unroll
        for (int ai = 0; ai < 2; ++ai)
#pragma unroll
            for (int m = 0; m < 4; ++m) {
                const int row = row0 + ai * 128 + m * 16, bg = row >> 8, n = row & 255;
                float o[8];
#pragma unroll
                for (int nn = 0; nn < 2; ++nn)
#pragma unroll
                    for (int e = 0; e < 4; ++e) o[nn * 4 + e] = (n == 255) ? 0.f : acc[ai][0][m][nn][e];
                if (!VT) { u32x4 w; w.x = cvtpk(o[0], o[1]); w.y = cvtpk(o[2], o[3]); w.z = cvtpk(o[4], o[5]); w.w = cvtpk(o[6], o[7]); *(u32x4*)(O + (size_t)row * 64 + d0) = w; }
                else {
#pragma unroll
                    for (int e = 0; e < 8; ++e) O[((size_t)bg * 64 + d0 + e) * 256 + n] = cvt1(o[e]);
                }
            }
    }
};
struct EpiBranch {
    static constexpr bool PERM = true, AFTER_DRAIN = false;
    bf16_t* mg; const bf16_t* sg; int mi;
    __device__ __forceinline__ void operator()(AccRef acc, const pg8::Unit& u, int wr, int wc, int fr, int fq) const {
        asm volatile("" : "+v"(fr), "+v"(fq));
        const int row0 = u.pm * 256 + wr * 64 + fr, col0 = u.pn * 256 + wc * 32 + 8 * fq;
#pragma unroll
        for (int ai = 0; ai < 2; ++ai)
#pragma unroll
            for (int m = 0; m < 4; ++m) {
                const int row = row0 + ai * 128 + m * 16;
#pragma unroll
                for (int bj = 0; bj < 2; ++bj) {
                    const int col = col0 + bj * 128;
                    const u32x4 gv = *(const u32x4*)(sg + (size_t)row * 3072 + mi * 1024 + col);
                    u32x4 ov = (u32x4){0u, 0u, 0u, 0u};
                    if (mi != 0) ov = *(const u32x4*)(mg + (size_t)row * DM + col);
                    float o[8];
#pragma unroll
                    for (int q = 0; q < 4; ++q) {
                        const unsigned gq = gv[q], oq = ov[q];
                        const float a0 = acc[ai][bj][m][q >> 1][(q & 1) * 2], a1 = acc[ai][bj][m][q >> 1][(q & 1) * 2 + 1];
                        o[2 * q] = __uint_as_float(oq << 16) + __uint_as_float(gq << 16) * a0;
                        o[2 * q + 1] = __uint_as_float(oq & 0xffff0000u) + __uint_as_float(gq & 0xffff0000u) * a1;
                    }
                    u32x4 w; w.x = cvtpk(o[0], o[1]); w.y = cvtpk(o[2], o[3]); w.z = cvtpk(o[4], o[5]); w.w = cvtpk(o[6], o[7]);
                    *(u32x4*)(mg + (size_t)row * DM + col) = w;
                }
                asm volatile("" ::: "memory");
            }
    }
};
struct EpiZ {
    static constexpr bool PERM = true, AFTER_DRAIN = false;
    bf16_t* zb;
    __device__ __forceinline__ void operator()(AccRef acc, const pg8::Unit& u, int wr, int wc, int fr, int fq) const {
        asm volatile("" : "+v"(fr), "+v"(fq));
        const int pn = u.pn;
#pragma unroll
        for (int bj = 0; bj < 2; ++bj) {
            const int ch = 2 * bj + (wc >> 1), d0 = (wc & 1) * 32 + 8 * fq;
            size_t off = 0, bs = 8 * HS; int mode = 0;
            if (pn < 2) { off = ZQA + (size_t)(pn * 4 + ch) * HS; }
            else if (pn < 4) { off = ZKA + (size_t)((pn - 2) * 4 + ch) * HS; }
            else if (pn < 6) { off = ZVA + (size_t)((pn - 4) * 4 + ch) * HS; mode = 1; }
            else if (pn < 8) { off = ZQB + (size_t)((pn - 6) * 4 + ch) * HS; }
            else if (pn == 8) { bs = 2 * HS; off = (ch < 2) ? ZKCI + (size_t)ch * HS : ZVCI + (size_t)(ch - 2) * HS; }
            else if (pn == 9) { bs = 2 * HS; if (ch < 2) off = ZKS + (size_t)ch * HS; else { off = ZVS + (size_t)(ch - 2) * HS; mode = 1; } }
            else if (pn == 10) { bs = 2 * HS; if (ch < 2) off = ZKW + (size_t)ch * HS; else { off = ZVW + (size_t)(ch - 2) * HS; mode = 1; } }
            else if (pn < 13) { off = ZQC + (size_t)((pn - 11) * 4 + ch) * HS; }
            else if (pn == 13) { bs = 2 * HS; if (ch < 2) off = ZKC + (size_t)ch * HS; else { off = ZVC + (size_t)(ch - 2) * HS; mode = 1; } }
            else if (pn < 26) mode = 2;
            else mode = 3;
#pragma unroll
            for (int ai = 0; ai < 2; ++ai)
#pragma unroll
                for (int m = 0; m < 4; ++m) {
                    const int tl = u.pm * 256 + ai * 128 + wr * 64 + m * 16 + fr, bl = tl >> 12, s = tl & 4095;
                    float o[8];
#pragma unroll
                    for (int n = 0; n < 2; ++n)
#pragma unroll
                        for (int e = 0; e < 4; ++e) o[n * 4 + e] = acc[ai][bj][m][n][e];
                    if (mode == 0) {
                        u32x4 w; w.x = cvtpk(o[0], o[1]); w.y = cvtpk(o[2], o[3]); w.z = cvtpk(o[4], o[5]); w.w = cvtpk(o[6], o[7]);
                        *(u32x4*)(zb + off + (size_t)bl * bs + (size_t)s * 64 + d0) = w;
                    } else if (mode == 1) {
                        bf16_t* p = zb + off + (size_t)bl * bs + (size_t)d0 * 4096 + s;
#pragma unroll
                        for (int e = 0; e < 8; ++e) p[(size_t)e * 4096] = cvt1(o[e]);
                    } else if (mode == 2) {
#pragma unroll
                        for (int e = 0; e < 8; ++e) o[e] = sigm(o[e]);
                        u32x4 w; w.x = cvtpk(o[0], o[1]); w.y = cvtpk(o[2], o[3]); w.z = cvtpk(o[4], o[5]); w.w = cvtpk(o[6], o[7]);
                        *(u32x4*)(zb + ZSG + (size_t)tl * 3072 + (pn - 14) * 256 + bj * 128 + wc * 32 + 8 * fq) = w;
                    } else {
                        const int cc = bj * 128 + wc * 32 + 8 * fq;
                        if (cc < 24) {
                            float* bgp = (float*)(zb + ZBG) + (size_t)tl * 32 + cc;
                            *(f32x4*)bgp = (f32x4){sigm(o[0]), sigm(o[1]), sigm(o[2]), sigm(o[3])};
                            *(f32x4*)(bgp + 4) = (f32x4){sigm(o[4]), sigm(o[5]), sigm(o[6]), sigm(o[7])};
                        }
                    }
                    asm volatile("" ::: "memory");
                }
        }
    }
};

__device__ __forceinline__ void rms_row_bf16(const float* xrow, const float* g, bf16_t* orow, int lane) {
    const f32x4* xr = (const f32x4*)xrow + lane; f32x4 v[4]; float s = 0.f;
#pragma unroll
    for (int j = 0; j < 4; ++j) { v[j] = xr[64 * j]; s += (v[j][0] * v[j][0] + v[j][1] * v[j][1]) + (v[j][2] * v[j][2] + v[j][3] * v[j][3]); }
    const float rstd = 1.0f / sqrtf(wave_sum(s) * (1.f / DM) + EPS);
    u32x2* o8 = (u32x2*)orow + lane;
#pragma unroll
    for (int j = 0; j < 4; ++j) { const f32x4 gg = ((const f32x4*)g)[lane + 64 * j]; u32x2 w; w.x = cvtpk(v[j][0] * rstd * gg[0], v[j][1] * rstd * gg[1]); w.y = cvtpk(v[j][2] * rstd * gg[2], v[j][3] * rstd * gg[3]); o8[64 * j] = w; }
}
__device__ __forceinline__ void rms_row_f32(const float* xrow, const float* g, float* orow, int lane) {
    const f32x4* xr = (const f32x4*)xrow + lane; f32x4 v[4]; float s = 0.f;
#pragma unroll
    for (int j = 0; j < 4; ++j) { v[j] = xr[64 * j]; s += (v[j][0] * v[j][0] + v[j][1] * v[j][1]) + (v[j][2] * v[j][2] + v[j][3] * v[j][3]); }
    const float rstd = 1.0f / sqrtf(wave_sum(s) * (1.f / DM) + EPS);
#pragma unroll
    for (int j = 0; j < 4; ++j) { const f32x4 gg = ((const f32x4*)g)[lane + 64 * j]; ((f32x4*)orow)[lane + 64 * j] = (v[j] * rstd) * gg; }
}
__device__ __forceinline__ void phase_rms(const float* src, const float* g, bf16_t* dst, int gw, int ngw, int lane) {
    lane = opq(lane);
    for (int m = gw; m < T; m += ngw) rms_row_bf16(src + (size_t)m * DM, g, dst + (size_t)m * DM, lane);
}

__device__ __forceinline__ int srccol(int mode, int n) {
    if (mode == 0) return n;
    if (mode == 1) return ((n >> 7) & 1) * DFF + (n >> 8) * 128 + (n & 127);
    if (mode == 2) return n < 2816 ? n : (n < 6656 ? n + 24 : (n < 6680 ? 2816 + (n - 6656) : -1));
    return n < 64 ? n : -1;
}
__device__ __forceinline__ void conv_matrix(const float* src, int K, int ld, int Ndst, int mode, bf16_t* dst, int& base, LAS float* scr, int tid, int blk, int G) {
    tid = opq(tid);
    const int ntn = Ndst / 64, ntiles = (K / 64) * ntn;
    int start = (blk - (base % G) + G) % G;
    for (int t = start; t < ntiles; t += G) {
        const int k0 = (t / ntn) * 64, n0 = (t % ntn) * 64;
        { const int kr = tid >> 6, n = tid & 63; const int col = srccol(mode, n0 + n);
#pragma unroll
          for (int kk = 0; kk < 8; ++kk) { const int k = kr + 8 * kk; scr[k * 65 + n] = col >= 0 ? src[(size_t)(k0 + k) * ld + col] : 0.f; } }
        __syncthreads();
        { const int n = tid >> 3, ks = tid & 7; const LAS float* s = scr + (8 * ks) * 65 + n;
          u32x4 w; w.x = cvtpk(s[0], s[65]); w.y = cvtpk(s[130], s[195]); w.z = cvtpk(s[260], s[325]); w.w = cvtpk(s[390], s[455]);
          *(u32x4*)(dst + (size_t)(n0 + n) * K + k0 + 8 * ks) = w; }
        __syncthreads();
    }
    base += ntiles;
}

constexpr int KP = 144;
constexpr int L_K0 = 0, L_K1 = 9216, L_V0 = 18432, L_V1 = 36864, L_TBL = 55296, L_IMP = 57344, L_SEL = 73984, L_RED = 74496;
constexpr float SC = 0.125f * LOG2E;
constexpr float MINIT = -30000.f, MASKED = -1e30f;

__device__ __forceinline__ int t5_bucket(int n) {
    if (n < 16) return n;
    int b = 16;
    b += (n >= 19); b += (n >= 21); b += (n >= 24); b += (n >= 27); b += (n >= 31); b += (n >= 35); b += (n >= 40); b += (n >= 46);
    b += (n >= 52); b += (n >= 59); b += (n >= 67); b += (n >= 77); b += (n >= 87); b += (n >= 99); b += (n >= 113);
    return b;
}
__device__ __forceinline__ void build_tbl(LAS uchar* lds, const float* rel_bias, int col0, int nh, int tid) {
    const int hd = tid >> 7, idx = tid & 127;
    if (hd < nh && idx < 114) ((LAS float*)(lds + L_TBL))[hd * 128 + idx] = rel_bias[t5_bucket(idx) * 20 + col0 + hd] * LOG2E;
}

template <int DV> struct TileRegs { u32x4 k; u32x4 v[DV / 64]; };
template <int DV, bool HASV>
__device__ __forceinline__ void tile_gload(TileRegs<DV>& r, const bf16_t* Kg, const bf16_t* Vt, int vpitch, int kt, int tid) {
    const int row = tid >> 3, seg = tid & 7;
    r.k = *(const u32x4*)(Kg + (size_t)(kt * 64 + row) * 64 + seg * 8);
    if (HASV) {
#pragma unroll
        for (int j = 0; j < DV / 64; ++j) r.v[j] = *(const u32x4*)(Vt + (size_t)(row + 64 * j) * vpitch + kt * 64 + seg * 8);
    }
}
template <int DV, bool HASV>
__device__ __forceinline__ void tile_swrite(const TileRegs<DV>& r, LAS uchar* lds, int buf, int tid) {
    const int row = tid >> 3, seg = tid & 7;
    *(LAS u32x4*)(lds + (buf ? L_K1 : L_K0) + row * KP + seg * 16) = r.k;
    if (HASV) {
#pragma unroll
        for (int j = 0; j < DV / 64; ++j) *(LAS u32x4*)(lds + (buf ? L_V1 : L_V0) + (row + 64 * j) * KP + seg * 16) = r.v[j];
    }
}

template <int DV, bool IMPP>
__device__ __forceinline__ void attn_pass(LAS uchar* lds, const bf16_t* Kg, const bf16_t* Vt, int vpitch, int kt0, int kt1, int wave_kt_max,
                                          int qpos, int kmul, int kadd, unsigned W, const bf16x8 (&qf)[4], int tbl,
                                          unsigned long long selmask, bool use_sel, float& m, float& l, f32x16 (&acc)[DV / 32],
                                          float inv_l, int imp_row, int tid) {
    const int lane = tid & 63, n = lane & 31, hi = lane >> 5;
    TileRegs<DV> tr;
    if (kt0 >= kt1) return;
    tile_gload<DV, !IMPP>(tr, Kg, Vt, vpitch, kt0, tid);
    tile_swrite<DV, !IMPP>(tr, lds, 0, tid);
    __syncthreads();
    for (int kt = kt0; kt < kt1; ++kt) {
        const int cur = (kt - kt0) & 1;
        const bool more = kt + 1 < kt1;
        if (more) tile_gload<DV, !IMPP>(tr, Kg, Vt, vpitch, kt + 1, tid);
        if (kt <= wave_kt_max) {
            f32x16 s[2];
#pragma unroll
            for (int r = 0; r < 16; ++r) { s[0][r] = 0.f; s[1][r] = 0.f; }
            const LAS uchar* kb = lds + (cur ? L_K1 : L_K0) + n * KP + hi * 16;
#pragma unroll
            for (int ks = 0; ks < 4; ++ks) {
                const bf16x8 a0 = *(const LAS bf16x8*)(kb + ks * 32);
                const bf16x8 a1 = *(const LAS bf16x8*)(kb + 32 * KP + ks * 32);
                s[0] = __builtin_amdgcn_mfma_f32_32x32x16_bf16(a0, qf[ks], s[0], 0, 0, 0);
                s[1] = __builtin_amdgcn_mfma_f32_32x32x16_bf16(a1, qf[ks], s[1], 0, 0, 0);
            }
            const int dq = qpos - kadd - kmul * (kt * 64 + 4 * hi);
            const bool lane_ok = !use_sel || ((selmask >> kt) & 1ull);
            const unsigned Wl = lane_ok ? W : 0u;
            const LAS uchar* tb = lds + tbl;
            float mx = IMPP ? m : m;
#pragma unroll
            for (int hh = 0; hh < 2; ++hh)
#pragma unroll
                for (int r = 0; r < 16; ++r) {
                    const int kk = 32 * hh + 8 * (r >> 2) + (r & 3);
                    const int dist = dq - kmul * kk;
                    const unsigned ud = (unsigned)dist;
                    const unsigned idx = ud < 113u ? ud : 113u;
                    const float bias = *(const LAS float*)(tb + idx * 4);
                    float v = s[hh][r] * SC + bias;
                    v = (ud < Wl) ? v : MASKED;
                    s[hh][r] = v;
                    if (!IMPP) mx = fmaxf(mx, v);
                }
            if (!IMPP) {
                mx = fmaxf(mx, __shfl_xor(mx, 32));
                const float alpha = __builtin_amdgcn_exp2f(m - mx);
                m = mx;
                float ls = 0.f;
#pragma unroll
                for (int hh = 0; hh < 2; ++hh)
#pragma unroll
                    for (int r = 0; r < 16; ++r) { const float p = __builtin_amdgcn_exp2f(s[hh][r] - mx); s[hh][r] = p; ls += p; }
                l = l * alpha + ls;
#pragma unroll
                for (int dt = 0; dt < DV / 32; ++dt)
#pragma unroll
                    for (int r = 0; r < 16; ++r) acc[dt][r] *= alpha;
                const LAS uchar* vb = lds + (cur ? L_V1 : L_V0) + n * KP + hi * 8;
#pragma unroll
                for (int hh = 0; hh < 2; ++hh)
#pragma unroll
                    for (int u2 = 0; u2 < 2; ++u2) {
                        u32x4 pw;
                        pw.x = cvtpk(s[hh][8 * u2 + 0], s[hh][8 * u2 + 1]); pw.y = cvtpk(s[hh][8 * u2 + 2], s[hh][8 * u2 + 3]);
                        pw.z = cvtpk(s[hh][8 * u2 + 4], s[hh][8 * u2 + 5]); pw.w = cvtpk(s[hh][8 * u2 + 6], s[hh][8 * u2 + 7]);
                        const bf16x8 pb = __builtin_bit_cast(bf16x8, pw);
                        const int kbase = 32 * hh + 16 * u2;
#pragma unroll
                        for (int dt = 0; dt < DV / 32; ++dt) {
                            const LAS uchar* vp = vb + dt * 32 * KP + kbase * 2;
                            const u32x2 lo = *(const LAS u32x2*)vp, hi2 = *(const LAS u32x2*)(vp + 16);
                            const u32x4 vw = (u32x4){lo.x, lo.y, hi2.x, hi2.y};
                            acc[dt] = __builtin_amdgcn_mfma_f32_32x32x16_bf16(__builtin_bit_cast(bf16x8, vw), pb, acc[dt], 0, 0, 0);
                        }
                    }
            } else {
                LAS float* imp = (LAS float*)(lds + L_IMP) + imp_row * 65;
                float spill[8];
#pragma unroll
                for (int hh = 0; hh < 2; ++hh)
#pragma unroll
                    for (int gq = 0; gq < 4; ++gq) {
                        const float p0 = __builtin_amdgcn_exp2f(s[hh][4 * gq + 0] - m) * inv_l, p1 = __builtin_amdgcn_exp2f(s[hh][4 * gq + 1] - m) * inv_l;
                        const float p2 = __builtin_amdgcn_exp2f(s[hh][4 * gq + 2] - m) * inv_l, p3 = __builtin_amdgcn_exp2f(s[hh][4 * gq + 3] - m) * inv_l;
                        float mn = (p0 + p1) + (p2 + p3), sp = p3;
                        mn += __shfl_xor(mn, 8); mn += __shfl_xor(mn, 16);
                        sp += __shfl_xor(sp, 8); sp += __shfl_xor(sp, 16);
                        spill[hh * 4 + gq] = sp;
                        const int j = 16 * kt + 8 * hh + 2 * gq + hi;
                        if (n < 8) imp[j] += mn;
                    }
                __builtin_amdgcn_fence(__ATOMIC_RELEASE, "wavefront");
#pragma unroll
                for (int hh = 0; hh < 2; ++hh)
#pragma unroll
                    for (int gq = 0; gq < 4; ++gq) {
                        const int j = 16 * kt + 8 * hh + 2 * gq + hi + 1;
                        if (n < 8 && j < 64) imp[j] += spill[hh * 4 + gq];
                    }
                __builtin_amdgcn_fence(__ATOMIC_RELEASE, "wavefront");
            }
        }
        if (more) tile_swrite<DV, !IMPP>(tr, lds, cur ^ 1, tid);
        __syncthreads();
    }
}

template <int NT> __device__ __forceinline__ void acc_zero(f32x16 (&a)[NT]) {
#pragma unroll
    for (int t = 0; t < NT; ++t)
#pragma unroll
        for (int r = 0; r < 16; ++r) a[t][r] = 0.f;
}
template <int NT> __device__ __forceinline__ void acc_norm(f32x16 (&a)[NT], float l) {
    const float lt = l + __shfl_xor(l, 32);
    const float inv = lt > 0.f ? 1.f / lt : 0.f;
#pragma unroll
    for (int t = 0; t < NT; ++t)
#pragma unroll
        for (int r = 0; r < 16; ++r) a[t][r] *= inv;
}
__device__ __forceinline__ void load_q(bf16x8 (&qf)[4], const bf16_t* qrow, int hi) {
#pragma unroll
    for (int ks = 0; ks < 4; ++ks) qf[ks] = *(const bf16x8*)(qrow + 16 * ks + 8 * hi);
}

struct AttnCtx {
    const bf16_t* zb;
    bf16_t *ya, *yb, *yc;
    float* park;
    const bf16_t *kcmp, *vtcmp;
    const float *rel_bias, *lamp, *subln, *sinks;
    float lam_init;
};

__device__ __forceinline__ void attn_unit_A(LAS uchar* lds, const AttnCtx& C, int bl, int h, int qt, int tid) {
    tid = opq(tid);
    const int lane = tid & 63, n = lane & 31, hi = lane >> 5, w = __builtin_amdgcn_readfirstlane(tid >> 6);
    build_tbl(lds, C.rel_bias, h, 1, tid);
    float lam;
    { const float a = C.lamp[lane] * C.lamp[64 + lane], b = C.lamp[128 + lane] * C.lamp[192 + lane]; lam = __expf(wave_sum(a)) - __expf(wave_sum(b)) + C.lam_init; }
    const int qpos = 256 * qt + 32 * w + n;
    const int kt1 = 4 * qt + 4, wkm = 4 * qt + (w >> 1);
    const bf16_t* Vt = C.zb + ZVA + ((size_t)bl * 8 + 2 * h) * HS;
    f32x16 acc[4];
    bf16x8 qf[4];
    float m, l;
    float* prow = C.park + ((size_t)bl * 4096 + qpos) * 512 + h * 128;
#pragma unroll 1
    for (int c = 1; c >= 0; --c) {
        const size_t hoff = ((size_t)bl * 8 + 2 * h + c) * HS;
        load_q(qf, C.zb + ZQA + hoff + (size_t)qpos * 64, hi);
        acc_zero<4>(acc); m = MINIT; l = 0.f;
        attn_pass<128, false>(lds, C.zb + ZKA + hoff, Vt, 4096, 0, kt1, wkm, qpos, 1, 0, 0x7fffffffu, qf, L_TBL, 0ull, false, m, l, acc, 0.f, 0, tid);
        acc_norm<4>(acc, l);
        if (c == 1) {
#pragma unroll
            for (int t = 0; t < 4; ++t)
#pragma unroll
                for (int gq = 0; gq < 4; ++gq) *(f32x4*)(prow + 32 * t + 8 * gq + 4 * hi) = (f32x4){acc[t][4 * gq], acc[t][4 * gq + 1], acc[t][4 * gq + 2], acc[t][4 * gq + 3]};
        }
    }
    float ss = 0.f;
#pragma unroll
    for (int t = 0; t < 4; ++t)
#pragma unroll
        for (int gq = 0; gq < 4; ++gq) { const f32x4 o1 = *(const f32x4*)(prow + 32 * t + 8 * gq + 4 * hi);
#pragma unroll
            for (int e = 0; e < 4; ++e) { const float y = acc[t][4 * gq + e] - lam * o1[e]; acc[t][4 * gq + e] = y; ss += y * y; } }
    ss += __shfl_xor(ss, 32);
    const float rs = (1.0f / sqrtf(ss * (1.f / 128.f) + EPS)) * (1.f - C.lam_init);
    bf16_t* yrow = C.ya + ((size_t)bl * 4096 + qpos) * 512 + h * 128;
#pragma unroll
    for (int t = 0; t < 4; ++t)
#pragma unroll
        for (int gq = 0; gq < 4; ++gq) {
            const int d = 32 * t + 8 * gq + 4 * hi;
            const f32x4 gg = *(const f32x4*)(C.subln + d);
            u32x2 wv; wv.x = cvtpk(acc[t][4 * gq] * rs * gg[0], acc[t][4 * gq + 1] * rs * gg[1]); wv.y = cvtpk(acc[t][4 * gq + 2] * rs * gg[2], acc[t][4 * gq + 3] * rs * gg[3]);
            *(u32x2*)(yrow + d) = wv;
        }
}

__device__ __forceinline__ void attn_unit_B(LAS uchar* lds, const AttnCtx& C, int bl, int g, int i, int tid) {
    tid = opq(tid);
    const int lane = tid & 63, n = lane & 31, hi = lane >> 5, w = __builtin_amdgcn_readfirstlane(tid >> 6);
    build_tbl(lds, C.rel_bias, 4 + 4 * g, 4, tid);
    const int ql = 8 * w + (n & 7), hr = n >> 3, qpos = 64 * i + ql, head = 4 * g + hr;
    const int tbl = L_TBL + hr * 512;
    bf16x8 qf[4];
    load_q(qf, C.zb + ZQB + ((size_t)bl * 8 + head) * HS + (size_t)qpos * 64, hi);
    const size_t goff = ((size_t)bl * 2 + g) * HS;
    f32x16 ot[2], acc[2];
    float m, l;
    const size_t tok = (size_t)bl * 4096 + qpos;
    const float* bg = (const float*)(C.zb + ZBG) + tok * 32 + head * 3;
    const float g0 = bg[0], g1 = bg[1], g2 = bg[2];
    const bf16_t* Kc = C.kcmp + ((size_t)bl * 2 + g) * 256 * 64;
    const bf16_t* Vc = C.vtcmp + ((size_t)bl * 2 + g) * 64 * 256;
    const int ktc1 = ((4 * i + 2) >> 6) + 1;
    acc_zero<2>(acc); m = MINIT; l = 0.f;
    attn_pass<64, false>(lds, Kc, Vc, 256, 0, ktc1, 1 << 20, qpos, 16, 31, 0x7fffffffu, qf, tbl, 0ull, false, m, l, acc, 0.f, 0, tid);
    acc_norm<2>(acc, l);
#pragma unroll
    for (int t = 0; t < 2; ++t)
#pragma unroll
        for (int r = 0; r < 16; ++r) ot[t][r] = g0 * acc[t][r];
    {
        const float lt = l + __shfl_xor(l, 32);
        const float inv_l = lt > 0.f ? 1.f / lt : 0.f;
        LAS float* impw = (LAS float*)(lds + L_IMP) + (8 * w) * 65;
        for (int x = lane; x < 8 * 65; x += 64) impw[x] = 0.f;
        __builtin_amdgcn_fence(__ATOMIC_RELEASE, "wavefront");
        attn_pass<64, true>(lds, Kc, Vc, 256, 0, ktc1, 1 << 20, qpos, 16, 31, 0x7fffffffu, qf, tbl, 0ull, false, m, l, acc, inv_l, ql, tid);
    }
    {
        const int q = tid & 63, part = tid >> 6;
        const LAS float* row = (const LAS float*)(lds + L_IMP) + q * 65;
        float cand[8]; int rank[8];
#pragma unroll
        for (int c = 0; c < 8; ++c) { const int j = 8 * part + c; float v = row[j]; v = (j == 0 || j == i || j == i - 1) ? 1e6f : (j > i ? -1e6f : v); cand[c] = v; rank[c] = 0; }
        for (int jj = 0; jj < 64; ++jj) {
            float x = row[jj]; x = (jj == 0 || jj == i || jj == i - 1) ? 1e6f : (jj > i ? -1e6f : x);
#pragma unroll
            for (int c = 0; c < 8; ++c) { const int j = 8 * part + c; rank[c] += (x > cand[c] || (x == cand[c] && jj < j)) ? 1 : 0; }
        }
        unsigned bits = 0;
#pragma unroll
        for (int c = 0; c < 8; ++c) bits |= (rank[c] < 16 ? 1u : 0u) << c;
        ((LAS uchar*)(lds + L_SEL))[q * 8 + part] = (uchar)bits;
    }
    __syncthreads();
    unsigned long long selmask;
    { const u32x2 sm = *(const LAS u32x2*)(lds + L_SEL + ql * 8); selmask = (unsigned long long)sm.x | ((unsigned long long)sm.y << 32); }
    acc_zero<2>(acc); m = MINIT; l = 0.f;
    attn_pass<64, false>(lds, C.zb + ZKS + goff, C.zb + ZVS + goff, 4096, 0, i + 1, 1 << 20, qpos, 1, 0, 0x7fffffffu, qf, tbl, selmask, true, m, l, acc, 0.f, 0, tid);
    acc_norm<2>(acc, l);
#pragma unroll
    for (int t = 0; t < 2; ++t)
#pragma unroll
        for (int r = 0; r < 16; ++r) ot[t][r] += g1 * acc[t][r];
    acc_zero<2>(acc); m = MINIT; l = 0.f;
    attn_pass<64, false>(lds, C.zb + ZKW + goff, C.zb + ZVW + goff, 4096, i > 8 ? i - 8 : 0, i + 1, 1 << 20, qpos, 1, 0, 512u, qf, tbl, 0ull, false, m, l, acc, 0.f, 0, tid);
    acc_norm<2>(acc, l);
    bf16_t* yrow = C.yb + tok * 512 + head * 64;
#pragma unroll
    for (int t = 0; t < 2; ++t)
#pragma unroll
        for (int gq = 0; gq < 4; ++gq) {
            const int d = 32 * t + 8 * gq + 4 * hi;
            float o[4];
#pragma unroll
            for (int e = 0; e < 4; ++e) o[e] = ot[t][4 * gq + e] + g2 * acc[t][4 * gq + e];
            u32x2 wv; wv.x = cvtpk(o[0], o[1]); wv.y = cvtpk(o[2], o[3]);
            *(u32x2*)(yrow + d) = wv;
        }
}

__device__ __forceinline__ void attn_unit_C(LAS uchar* lds, const AttnCtx& C, int bl, int g, int i, int tid) {
    tid = opq(tid);
    const int lane = tid & 63, n = lane & 31, hi = lane >> 5, w = __builtin_amdgcn_readfirstlane(tid >> 6);
    build_tbl(lds, C.rel_bias, 12 + 4 * g, 4, tid);
    const int ql = 8 * w + (n & 7), hr = n >> 3, qpos = 64 * i + ql, head = 4 * g + hr;
    const int tbl = L_TBL + hr * 512;
    bf16x8 qf[4];
    load_q(qf, C.zb + ZQC + ((size_t)bl * 8 + head) * HS + (size_t)qpos * 64, hi);
    const size_t goff = ((size_t)bl * 2 + g) * HS;
    f32x16 acc[2];
    acc_zero<2>(acc);
    float m = C.sinks[head] * LOG2E, l = hi == 0 ? 1.f : 0.f;
    attn_pass<64, false>(lds, C.zb + ZKC + goff, C.zb + ZVC + goff, 4096, i > 2 ? i - 2 : 0, i + 1, 1 << 20, qpos, 1, 0, 128u, qf, tbl, 0ull, false, m, l, acc, 0.f, 0, tid);
    acc_norm<2>(acc, l);
    const size_t tok = (size_t)bl * 4096 + qpos;
    bf16_t* yrow = C.yc + tok * 512 + head * 64;
#pragma unroll
    for (int t = 0; t < 2; ++t)
#pragma unroll
        for (int gq = 0; gq < 4; ++gq) {
            const int d = 32 * t + 8 * gq + 4 * hi;
            u32x2 wv; wv.x = cvtpk(acc[t][4 * gq], acc[t][4 * gq + 1]); wv.y = cvtpk(acc[t][4 * gq + 2], acc[t][4 * gq + 3]);
            *(u32x2*)(yrow + d) = wv;
        }
}

typedef const __attribute__((address_space(4))) Params* KParPtr;
__device__ __forceinline__ KParPtr kparams() { auto p = __builtin_amdgcn_kernarg_segment_ptr(); asm volatile("" : "+s"(p)); return (KParPtr)p; }
#define KIN(i) (kparams()->in[i])
#define WS_ (kparams()->ws)
#define HOUT (kparams()->out)
#define Wb ((bf16_t*)(WS_ + WS_W))
#define XN ((bf16_t*)(WS_ + WS_XN))
#define R1 ((bf16_t*)(WS_ + WS_R1))
#define YA ((bf16_t*)(WS_ + WS_Y))
#define MG ((bf16_t*)(WS_ + WS_MG))
#define CH ((bf16_t*)(WS_ + WS_CH))
#define KCMP ((bf16_t*)(WS_ + WS_KCMP))
#define VCMP ((bf16_t*)(WS_ + WS_VCMP))
#define CB ((float*)(WS_ + WS_CB))
constexpr int LDS_BYTES = 147456;
#ifdef ONLY_EPI
#include <type_traits>
#define ONLY_OK(E) (std::is_same<E, ONLY_EPI>::value)
#else
#define ONLY_OK(E) true
#endif
#ifdef NO_GEMM
#define GEMM(EPI, e, A_, lda_, Bt_, M_, N_, K_, cshift) do { (void)(e); } while (0)
#else
#define GEMM(EPI, e, A_, lda_, Bt_, M_, N_, K_, cshift) do { pg8::Gemm g_{(const bf16_t*)(A_), (const bf16_t*)(Bt_), (M_), (N_), (K_), (lda_)}; pg8::StaticOrder S_; \
    int c_ = (int)((blk + (cshift)) % G), G_ = G; asm volatile("" : "+s"(c_), "+s"(G_)); S_.init((M_), (N_), G_, c_); if (ONLY_OK(EPI)) pg8::gemm_phase<EPI, pg8::StaticOrder, false, true>(lds, g_, S_, (e)); } while (0)
#endif

__global__ void __launch_bounds__(NTHR, 2) fwd_kernel(Params P) {
    extern __shared__ __attribute__((aligned(16))) unsigned char lds_raw[];
    LAS uchar* lds = (LAS uchar*)lds_raw;
    cg::grid_group grid = cg::this_grid();
#define DEF_IDS \
    int tid_o = threadIdx.x, G_o = gridDim.x, blk_o = blockIdx.x; asm volatile("" : "+v"(tid_o), "+s"(G_o), "+s"(blk_o)); \
    const int tid = tid_o, lane = tid & 63, wave = __builtin_amdgcn_readfirstlane(tid >> 6); \
    const int G = G_o, blk = blk_o; \
    const int vcu = (G % 8 == 0) ? (blk % 8) * (G / 8) + blk / 8 : blk; \
    const int gw = blk * 8 + wave, ngw = G * 8; (void)vcu; (void)gw; (void)ngw; (void)lane;
    {
        DEF_IDS
        LAS float* scr = (LAS float*)lds;
        int base = 0;
        for (int L = 0; L < DEPTH; ++L) {
            bf16_t* wl = Wb + (size_t)L * W_LAYER;
            conv_matrix(KIN(3) + (size_t)L * 1024 * 5632, 1024, 5632, 5632, 1, wl + W_WI1, base, scr, tid, blk, G);
            conv_matrix(KIN(4) + (size_t)L * 2816 * 1024, 2816, 1024, 1024, 0, wl + W_WO1, base, scr, tid, blk, G);
            conv_matrix(KIN(5) + (size_t)L * 1024 * DIN, 1024, DIN, DINP, 2, wl + W_WIN, base, scr, tid, blk, G);
            for (int t = 0; t < 2; ++t) conv_matrix(KIN(9) + ((size_t)L * 2 + t) * 2048 * 256, 2048, 256, 256, 0, wl + W_CW1 + (size_t)t * 256 * 2048, base, scr, tid, blk, G);
            for (int t = 0; t < 2; ++t) conv_matrix(KIN(10) + ((size_t)L * 2 + t) * 256 * 64, 256, 64, 256, 3, wl + W_CW2 + (size_t)t * 256 * 256, base, scr, tid, blk, G);
            for (int t = 0; t < 3; ++t) conv_matrix(KIN(12) + ((size_t)L * 3 + t) * 512 * 1024, 512, 1024, 1024, 0, wl + W_WBR + (size_t)t * 1024 * 512, base, scr, tid, blk, G);
            conv_matrix(KIN(13) + (size_t)L * 1024 * 1024, 1024, 1024, 1024, 0, wl + W_WOUT, base, scr, tid, blk, G);
            conv_matrix(KIN(14) + (size_t)L * 1024 * 5632, 1024, 5632, 5632, 1, wl + W_WI2, base, scr, tid, blk, G);
            conv_matrix(KIN(15) + (size_t)L * 2816 * 1024, 2816, 1024, 1024, 0, wl + W_WO2, base, scr, tid, blk, G);
            conv_matrix(KIN(16) + (size_t)L * 256 * 1024, 256, 1024, 1024, 0, wl + W_WPE, base, scr, tid, blk, G);
            conv_matrix(KIN(17) + (size_t)L * 1024 * 1024, 1024, 1024, 1024, 0, wl + W_WPG, base, scr, tid, blk, G);
        }
        for (int pr = blk; pr < DEPTH * 2; pr += G) {
            const float* pos = KIN(8) + (size_t)pr * 2048; const float* w1 = KIN(9) + (size_t)pr * 2048 * 256;
            float a[4] = {0.f, 0.f, 0.f, 0.f};
            for (int k = wave * 256; k < wave * 256 + 256; ++k) { const float pv = pos[k];
#pragma unroll
                for (int j = 0; j < 4; ++j) a[j] += pv * w1[(size_t)k * 256 + lane + 64 * j]; }
#pragma unroll
            for (int j = 0; j < 4; ++j) scr[wave * 256 + lane + 64 * j] = a[j];
            __syncthreads();
            if (tid < 256) { float s = 0.f;
#pragma unroll
                for (int ww = 0; ww < 8; ++ww) s += scr[ww * 256 + tid];
                CB[pr * 256 + tid] = s; }
            __syncthreads();
        }
        phase_rms(KIN(0), KIN(2), XN, gw, ngw, lane);
    }
    grid.sync();

#pragma unroll 1
    for (int L = 0; L < DEPTH; ++L) {
        DEF_IDS
#define wl (Wb + (size_t)L * W_LAYER)
#define ng (KIN(2) + (size_t)L * 4 * DM)
        { EpiSwiglu e{R1}; GEMM(EpiSwiglu, e, XN, 1024, wl + W_WI1, T, 5632, 1024, 0); }
        grid.sync();
        { EpiResid e{(L == 0) ? KIN(0) : (const float*)HOUT, HOUT, 0.5f, 0}; GEMM(EpiResid, e, R1, DFF, wl + W_WO1, T, 1024, DFF, 0); }
        grid.sync();
        phase_rms(HOUT, ng + DM, XN, gw, ngw, lane);
        grid.sync();
        for (int c = 0; c < NCHUNK; ++c) {
            { EpiZ e{R1}; GEMM(EpiZ, e, XN + (size_t)c * TC * DM, 1024, wl + W_WIN, TC, DINP, 1024, 0); }
            grid.sync();
            { EpiBf<1> ek{CH, 256, CB + (L * 2 + 0) * 256}; GEMM(EpiBf<1>, ek, R1 + ZKCI, 1024, wl + W_CW1, NB * 512, 256, 2048, 0);
              EpiBf<1> ev{CH + (size_t)NB * 512 * 256, 256, CB + (L * 2 + 1) * 256}; GEMM(EpiBf<1>, ev, R1 + ZVCI, 1024, wl + W_CW1 + (size_t)256 * 2048, NB * 512, 256, 2048, G / 2); }
            grid.sync();
            { EpiCmp2<false> ek{KCMP}; GEMM(EpiCmp2<false>, ek, CH, 256, wl + W_CW2, NB * 512, 256, 256, 0);
              EpiCmp2<true> ev{VCMP}; GEMM(EpiCmp2<true>, ev, CH + (size_t)NB * 512 * 256, 256, wl + W_CW2 + (size_t)256 * 256, NB * 512, 256, 256, G / 2); }
            grid.sync();
            {
                AttnCtx C;
                C.zb = R1; C.park = (float*)MG; C.ya = YA; C.yb = YA + (size_t)TC * 512; C.yc = YA + (size_t)2 * TC * 512; C.kcmp = KCMP; C.vtcmp = VCMP;
                C.rel_bias = KIN(18); C.lamp = KIN(6) + (size_t)L * 256; C.subln = KIN(7) + (size_t)L * 128; C.sinks = KIN(11) + (size_t)L * 8;
                C.lam_init = 0.8f - 0.6f * __expf(-0.3f * (float)L);
                for (int u = vcu; u < NB * 32; u += G) {
                    const int bl = u >> 5;
#ifndef NO_A
                    { const int h = (u >> 3) & 3, qp = u & 7;
#pragma unroll 1
                      for (int k = 0; k < 2; ++k) attn_unit_A(lds, C, bl, h, k ? 15 - qp : qp, tid); }
#endif
                    { const int g = (u >> 4) & 1, is = u & 15;
#ifndef NO_B
#pragma unroll 1
                      for (int k = 0; k < 4; ++k) attn_unit_B(lds, C, bl, g, (k & 1) ? (k == 1 ? 31 : 63) - is : (k == 0 ? 0 : 32) + is, tid);
#endif
#ifndef NO_C
#pragma unroll 1
                      for (int k = 0; k < 4; ++k) attn_unit_C(lds, C, bl, g, (k & 1) ? (k == 1 ? 31 : 63) - is : (k == 0 ? 0 : 32) + is, tid);
#endif
                    }
                }
            }
            grid.sync();
            for (int mi = 0; mi < 3; ++mi) {
                EpiBranch e{MG, R1 + ZSG, mi}; GEMM(EpiBranch, e, YA + (size_t)mi * TC * 512, 512, wl + W_WBR + (size_t)mi * 1024 * 512, TC, 1024, 512, 0);
                grid.sync();
            }
            { EpiResid e{HOUT, HOUT, 1.0f, c * TC}; GEMM(EpiResid, e, MG, 1024, wl + W_WOUT, TC, 1024, 1024, 0); }
            grid.sync();
        }
        phase_rms(HOUT, ng + 2 * DM, XN, gw, ngw, lane);
        grid.sync();
        { EpiSwiglu e{R1}; GEMM(EpiSwiglu, e, XN, 1024, wl + W_WI2, T, 5632, 1024, 0); }
        grid.sync();
        { EpiResid e{HOUT, HOUT, 0.5f, 0}; GEMM(EpiResid, e, R1, DFF, wl + W_WO2, T, 1024, DFF, 0); }
        grid.sync();
        phase_rms(HOUT, ng + 3 * DM, XN, gw, ngw, lane);
        {
            const f32x4* src = (const f32x4*)(KIN(1) + (size_t)L * T * PLE); u32x2* dst = (u32x2*)((uchar*)R1 + R1_PBF);
            const int tq = opq(tid);
            for (size_t idx = (size_t)blk * NTHR + tq; idx < (size_t)T * PLE / 4; idx += (size_t)G * NTHR) { const f32x4 v = src[idx]; u32x2 w; w.x = cvtpk(v[0], v[1]); w.y = cvtpk(v[2], v[3]); dst[idx] = w; }
        }
        grid.sync();
        { EpiBf<0> e{(bf16_t*)((uchar*)R1 + R1_E), 1024, nullptr}; GEMM(EpiBf<0>, e, (uchar*)R1 + R1_PBF, 256, wl + W_WPE, T, 1024, 256, 0); }
        grid.sync();
        { EpiPle e{HOUT, (const bf16_t*)((uchar*)R1 + R1_E)}; GEMM(EpiPle, e, XN, 1024, wl + W_WPG, T, 1024, 1024, 0); }
        grid.sync();
        if (L + 1 < DEPTH) { phase_rms(HOUT, KIN(2) + (size_t)(L + 1) * 4 * DM, XN, gw, ngw, lane); grid.sync(); }
    }
    { DEF_IDS const int lq = opq(lane); float* ho = HOUT; const float* fg = KIN(19); for (int m = gw; m < T; m += ngw) rms_row_f32(ho + (size_t)m * DM, fg, ho + (size_t)m * DM, lq); }
}

extern "C" void kernel_launch(void* const* d_in, const int* in_sizes, int n_in, void* d_out, int out_size, void* d_ws, size_t ws_size, hipStream_t stream) {
    static int grid = 0;
    if (grid == 0) {
        if (n_in != 20 || out_size != T * DM || ws_size < WS_END) { fprintf(stderr, "kernel_launch: unexpected shapes (n_in %d out %d ws %zu)\n", n_in, out_size, ws_size); grid = -1; return; }
        int dev = 0, cus = 0, per_cu = 0;
        hipGetDevice(&dev);
        hipDeviceGetAttribute(&cus, hipDeviceAttributeMultiprocessorCount, dev);
        if (hipFuncSetAttribute((const void*)fwd_kernel, hipFuncAttributeMaxDynamicSharedMemorySize, LDS_BYTES) != hipSuccess) { fprintf(stderr, "kernel_launch: hipFuncSetAttribute failed\n"); grid = -1; return; }
        if (hipOccupancyMaxActiveBlocksPerMultiprocessor(&per_cu, (const void*)fwd_kernel, NTHR, LDS_BYTES) != hipSuccess || per_cu < 1) { fprintf(stderr, "kernel_launch: occupancy query says %d\n", per_cu); per_cu = 1; }
        (void)hipGetLastError();
        grid = cus;
        if (grid > 256) grid = 256;
    }
    if (grid < 0) return;
    Params p{};
    for (int i = 0; i < 20; ++i) p.in[i] = (const float*)d_in[i];
    p.out = (float*)d_out; p.ws = (uchar*)d_ws;
    void* args[] = {&p};
    hipError_t e = hipLaunchCooperativeKernel((const void*)fwd_kernel, dim3(grid), dim3(NTHR), args, LDS_BYTES, stream);
    if (e != hipSuccess) fprintf(stderr, "cooperative launch failed: %s (grid %d)\n", hipGetErrorString(e), grid);
}
```

```cpp
#include <hip/hip_runtime.h>
#include <hip/hip_cooperative_groups.h>
#include <cstdio>
#include <cstdint>
namespace cg = cooperative_groups;
namespace pg8 {
#define PG8_LAS __attribute__((address_space(3)))
typedef unsigned short bf16_t;
typedef short bf16x8 __attribute__((ext_vector_type(8)));
typedef float f32x4 __attribute__((ext_vector_type(4)));
typedef unsigned u32x4 __attribute__((ext_vector_type(4)));
constexpr int BM = 256, BK = 64, HALF = 128, HTB = HALF * BK * 2  , STAGE_BYTES = 8 * HTB, NXCD = 8, WGM = 8;

__host__ __device__ __forceinline__ int lds_byte(int r, int c) { const int st = (r >> 4) * 2 + (c >> 5), rr = r & 15, cc = c & 31, ob = rr * 64 + cc * 2; return st * 1024 + (ob ^ (((ob >> 9) & 1) << 5)); }
__host__ __device__ __forceinline__ void stage_rc(int b, int& R, int& C) { const int st = b / 1024, sb = b % 1024, swz = sb ^ (((sb >> 9) & 1) << 5); R = (st >> 1) * 16 + swz / 64; C = (st & 1) * 32 + (swz % 64) / 2; }
__host__ __device__ __forceinline__ int perm32(int rho) { const int n = rho >> 4, i = rho & 15; return 8 * (i >> 2) + 4 * n + (i & 3); }

struct Unit { int pm, pn; };
struct Gemm { const bf16_t* A; const bf16_t* Bt; int M, N, K, lda; };

struct StaticOrder {
    int nM, nN, nwg, G, c;
    __host__ __device__ void init(int M, int N, int G_, int c_) { nM = M / BM; nN = N / BM; nwg = nM * nN; G = G_; c = c_; }
    __host__ __device__ bool next(int i, Unit& u) const {
        const long L = (long)i * G + c; if (L >= nwg) return false;
        int wgid = (int)L; { const int q = nwg / NXCD, r = nwg % NXCD, xcd = wgid % NXCD, off = wgid / NXCD; wgid = (xcd < r ? xcd * (q + 1) : r * (q + 1) + (xcd - r) * q) + off; }
        const int nig = WGM * nN, gid = wgid / nig, fm = gid * WGM, gsz = (nM - fm) < WGM ? (nM - fm) : WGM;
        u.pm = fm + ((wgid % nig) % gsz); u.pn = (wgid % nig) / gsz; return true;
    }
    __device__ __forceinline__ void a_ready(const Unit&) const {}
    __device__ __forceinline__ void done(const Unit&) const {}
};

__device__ __forceinline__ unsigned cvt_pk_bf16(float lo, float hi) { unsigned r; asm volatile("v_cvt_pk_bf16_f32 %0, %1, %2" : "=v"(r) : "v"(lo), "v"(hi)); return r; }
typedef float f32x2 __attribute__((ext_vector_type(2)));
template <class Epi, class Sched, bool ALIGN_EPI = false, bool SP2 = false>
__device__ __forceinline__ void gemm_phase(PG8_LAS unsigned char* lds, const Gemm g, const Sched& S, const Epi& E) {
    int tid_ = threadIdx.x; asm volatile("" : "+v"(tid_)); const int tid = tid_, wid = __builtin_amdgcn_readfirstlane(tid >> 6), lane = tid & 63, wr = wid >> 2, wc = wid & 3, fr = lane & 15, fq = lane >> 4;
    const int K = g.K, nt = K / BK;
    unsigned voffA[2], voffB[2];
#pragma unroll
    for (int i = 0; i < 2; ++i) { int R, C; stage_rc(tid * 16 + i * 8192, R, C); const int Rb = Epi::PERM ? ((R & ~31) + perm32(R & 31)) : R;
        voffA[i] = (unsigned)(R * g.lda + C) * 2u; voffB[i] = (unsigned)(Rb * K + C) * 2u; }
    const size_t kstep = (size_t)(BK * 2);
    const size_t hstep = (size_t)HALF * K * 2;
    const size_t tstep = 2 * hstep; const size_t hstepA = (size_t)HALF * g.lda * 2, tstepA = 2 * hstepA;
    const unsigned ldsw = (unsigned)wid * 1024u;
    const int aoff = lds_byte(wr * 64 + fr, fq * 8), boff = lds_byte(wc * 32 + fr, fq * 8);
#define PG8_SA(b, h) (((b) * 2 + (h)) * HTB)
#define PG8_SB(b, h) ((4 + (b) * 2 + (h)) * HTB)
#define PG8_STAGE(bufoff, gbase, voff) do { _Pragma("unroll") for (int _i = 0; _i < 2; ++_i) \
        __builtin_amdgcn_global_load_lds((const unsigned*)((const char*)(gbase) + (voff)[_i]), (PG8_LAS unsigned*)(lds + (bufoff) + ldsw + _i * 8192), 16, 0, 0); } while (0)
#define PG8_LDA(dst, b, h) do { _Pragma("unroll") for (int m = 0; m < 4; ++m) _Pragma("unroll") for (int k = 0; k < 2; ++k) dst[m][k] = *(const PG8_LAS bf16x8*)(lds + PG8_SA(b, h) + aoff + m * 2048 + k * 1024); } while (0)
#define PG8_LDB(dst, b, h) do { _Pragma("unroll") for (int n = 0; n < 2; ++n) _Pragma("unroll") for (int k = 0; k < 2; ++k) dst[n][k] = *(const PG8_LAS bf16x8*)(lds + PG8_SB(b, h) + boff + n * 2048 + k * 1024); } while (0)
#define PG8_MMA(ai, bj, At, Bt) do { __builtin_amdgcn_s_setprio(1); _Pragma("unroll") for (int m = 0; m < 4; ++m) _Pragma("unroll") for (int n = 0; n < 2; ++n) _Pragma("unroll") for (int k = 0; k < 2; ++k) \
        acc[ai][bj][m][n] = __builtin_amdgcn_mfma_f32_16x16x32_bf16(Bt[n][k], At[m][k], acc[ai][bj][m][n], 0, 0, 0); __builtin_amdgcn_s_setprio(0); } while (0)
#define PG8_WAIT_V(n) asm volatile("s_waitcnt vmcnt(" #n ")" ::: "memory")
#define PG8_WAIT_L(n) asm volatile("s_waitcnt lgkmcnt(" #n ")" ::: "memory")
#define PG8_BAR __builtin_amdgcn_s_barrier()
#define PG8_SCHED __builtin_amdgcn_sched_barrier(0)
    Unit cur, nxt; int ui = 0;
    if (!S.next(0, cur)) return;
    f32x4 acc[2][2][4][2];
#pragma unroll
    for (int a = 0; a < 2; ++a)
#pragma unroll
        for (int b = 0; b < 2; ++b)
#pragma unroll
            for (int m = 0; m < 4; ++m)
#pragma unroll
                for (int n = 0; n < 2; ++n) acc[a][b][m][n] = (f32x4){0.f, 0.f, 0.f, 0.f};
    bf16x8 At[4][2], B0[2][2], B1[2][2];
    const char* cA = (const char*)g.A + (size_t)cur.pm * tstepA; const char* cB = (const char*)g.Bt + (size_t)cur.pn * tstep;
    S.a_ready(cur);
    if constexpr (SP2) {
        PG8_STAGE(PG8_SB(0, 0), cB, voffB); PG8_STAGE(PG8_SB(0, 1), cB + hstep, voffB); PG8_STAGE(PG8_SA(0, 0), cA, voffA); PG8_STAGE(PG8_SA(0, 1), cA + hstepA, voffA);
        if (wr == 1) PG8_BAR;
        PG8_WAIT_V(2); PG8_BAR;
        PG8_STAGE(PG8_SB(1, 0), cB + kstep, voffB); PG8_STAGE(PG8_SA(1, 0), cA + kstep, voffA); PG8_STAGE(PG8_SB(1, 1), cB + hstep + kstep, voffB);
        PG8_WAIT_V(6); PG8_BAR;
    } else {
        PG8_STAGE(PG8_SB(0, 0), cB, voffB); PG8_STAGE(PG8_SA(0, 0), cA, voffA); PG8_STAGE(PG8_SB(0, 1), cB + hstep, voffB); PG8_STAGE(PG8_SA(0, 1), cA + hstepA, voffA);
        if (wr == 1) PG8_BAR;
        PG8_WAIT_V(4); PG8_BAR;
        PG8_STAGE(PG8_SB(1, 0), cB + kstep, voffB); PG8_STAGE(PG8_SA(1, 0), cA + kstep, voffA); PG8_STAGE(PG8_SB(1, 1), cB + hstep + kstep, voffB);
        PG8_WAIT_V(6); PG8_BAR;
    }
    for (;;) {
        const bool has_next = S.next(ui + 1, nxt);
        const char* nA = has_next ? (const char*)g.A + (size_t)nxt.pm * tstepA : cA; const char* nB = has_next ? (const char*)g.Bt + (size_t)nxt.pn * tstep : cB;
        for (int t = 0; t < nt; t += 2) {
            const bool last = (t == nt - 2);
            const char* a1 = cA + (size_t)(t + 1) * kstep;
            const char* a2 = last ? nA : cA + (size_t)(t + 2) * kstep; const char* b2 = last ? nB : cB + (size_t)(t + 2) * kstep;
            const char* a3 = a2 + kstep; const char* b3 = b2 + kstep;
            if (last && has_next) S.a_ready(nxt);
            if constexpr (SP2) {
            PG8_LDB(B0, 0, 0); PG8_LDB(B1, 0, 1); PG8_SCHED; PG8_LDA(At, 0, 0); PG8_STAGE(PG8_SA(1, 1), a1 + hstepA, voffA);
            PG8_WAIT_V(8); PG8_WAIT_L(0); PG8_BAR; PG8_MMA(0, 0, At, B0); PG8_MMA(0, 1, At, B1); PG8_BAR; PG8_SCHED;
            PG8_LDA(At, 0, 1); PG8_STAGE(PG8_SB(0, 0), b2, voffB); PG8_STAGE(PG8_SB(0, 1), b2 + hstep, voffB); PG8_STAGE(PG8_SA(0, 0), a2, voffA);
            PG8_WAIT_V(8); PG8_WAIT_L(0); PG8_BAR; PG8_MMA(1, 0, At, B0); PG8_MMA(1, 1, At, B1); PG8_BAR; PG8_SCHED;
            PG8_LDB(B0, 1, 0); PG8_LDB(B1, 1, 1); PG8_SCHED; PG8_LDA(At, 1, 0); PG8_STAGE(PG8_SA(0, 1), a2 + hstepA, voffA);
            PG8_WAIT_V(8); PG8_WAIT_L(0); PG8_BAR; PG8_MMA(0, 0, At, B0); PG8_MMA(0, 1, At, B1); PG8_BAR; PG8_SCHED;
            PG8_LDA(At, 1, 1); PG8_STAGE(PG8_SB(1, 0), b3, voffB); PG8_STAGE(PG8_SB(1, 1), b3 + hstep, voffB); PG8_STAGE(PG8_SA(1, 0), a3, voffA);
            PG8_WAIT_V(8); PG8_WAIT_L(0); PG8_BAR; PG8_MMA(1, 0, At, B0); PG8_MMA(1, 1, At, B1); PG8_BAR; PG8_SCHED;
            } else {
            PG8_LDB(B0, 0, 0); PG8_SCHED; PG8_LDA(At, 0, 0); PG8_STAGE(PG8_SA(1, 1), a1 + hstepA, voffA);
            PG8_WAIT_L(8); PG8_BAR; PG8_WAIT_L(0); PG8_MMA(0, 0, At, B0); PG8_BAR; PG8_SCHED;
            PG8_LDB(B1, 0, 1); PG8_STAGE(PG8_SB(0, 0), b2, voffB);
            PG8_BAR; PG8_WAIT_L(0); PG8_MMA(0, 1, At, B1); PG8_BAR;
            PG8_LDA(At, 0, 1); PG8_STAGE(PG8_SA(0, 0), a2, voffA);
            PG8_BAR; PG8_WAIT_L(0); PG8_MMA(1, 0, At, B0); PG8_BAR; PG8_SCHED;
            PG8_STAGE(PG8_SB(0, 1), b2 + hstep, voffB);
            PG8_WAIT_V(6); PG8_BAR; PG8_MMA(1, 1, At, B1); PG8_BAR;
            PG8_LDB(B0, 1, 0); PG8_SCHED; PG8_LDA(At, 1, 0); PG8_STAGE(PG8_SA(0, 1), a2 + hstepA, voffA);
            PG8_WAIT_L(8); PG8_BAR; PG8_WAIT_L(0); PG8_MMA(0, 0, At, B0); PG8_BAR; PG8_SCHED;
            PG8_LDB(B1, 1, 1); PG8_STAGE(PG8_SB(1, 0), b3, voffB);
            PG8_BAR; PG8_WAIT_L(0); PG8_MMA(0, 1, At, B1); PG8_BAR;
            PG8_LDA(At, 1, 1); PG8_STAGE(PG8_SA(1, 0), a3, voffA);
            PG8_BAR; PG8_WAIT_L(0); PG8_MMA(1, 0, At, B0); PG8_BAR; PG8_SCHED;
            PG8_STAGE(PG8_SB(1, 1), b3 + hstep, voffB);
            PG8_WAIT_V(6); PG8_BAR; PG8_MMA(1, 1, At, B1); PG8_BAR;
            }
        }
        if constexpr (ALIGN_EPI) { if (wr == 0) PG8_BAR; }
        if constexpr (!Epi::AFTER_DRAIN) { E(acc, cur, wr, wc, fr, fq); S.done(cur); }
        if (!has_next) break;
#pragma unroll
        for (int a = 0; a < 2; ++a)
#pragma unroll
            for (int b = 0; b < 2; ++b)
#pragma unroll
                for (int m = 0; m < 4; ++m)
#pragma unroll
                    for (int n = 0; n < 2; ++n) acc[a][b][m][n] = (f32x4){0.f, 0.f, 0.f, 0.f};
        cur = nxt; cA = nA; cB = nB; ++ui;
        if constexpr (ALIGN_EPI) { if (wr == 1) PG8_BAR; }
    }
    PG8_WAIT_V(0);
    if constexpr (!ALIGN_EPI) { if (wr == 0) PG8_BAR; }
    PG8_BAR;
    if constexpr (Epi::AFTER_DRAIN) { E.fused(acc, cur, wr, wc, fr, fq, lds, wid, lane); S.done(cur); }
#undef PG8_SA
#undef PG8_SB
#undef PG8_STAGE
#undef PG8_LDA
#undef PG8_LDB
#undef PG8_MMA
#undef PG8_WAIT_V
#undef PG8_WAIT_L
#undef PG8_BAR
#undef PG8_SCHED
}
}

#define LAS __attribute__((address_space(3)))
using pg8::bf16_t; using pg8::bf16x8; using pg8::f32x4; using pg8::u32x4;
typedef float f32x16 __attribute__((ext_vector_type(16)));
typedef unsigned u32x2 __attribute__((ext_vector_type(2)));
typedef unsigned char uchar;
typedef float f32x2_t __attribute__((ext_vector_type(2)));
typedef __bf16 bf16x2_t __attribute__((ext_vector_type(2)));

constexpr int DM = 1024, NBATCH = 16, SEQ = 4096, DEPTH = 4, PLE = 256, DFF = 2816;
constexpr int T = NBATCH * SEQ;
constexpr int NB = 8, TC = NB * SEQ, NCHUNK = NBATCH / NB;
constexpr int DIN = 6680, DINP = 6912;
constexpr float EPS = 1e-6f, LOG2E = 1.4426950408889634f;
constexpr int NTHR = 512;

constexpr size_t W_WI1 = 0, W_WO1 = W_WI1 + (size_t)5632 * 1024, W_WIN = W_WO1 + (size_t)1024 * 2816, W_CW1 = W_WIN + (size_t)DINP * 1024,
                 W_CW2 = W_CW1 + (size_t)2 * 256 * 2048, W_WBR = W_CW2 + (size_t)2 * 256 * 256, W_WOUT = W_WBR + (size_t)3 * 1024 * 512,
                 W_WI2 = W_WOUT + (size_t)1024 * 1024, W_WO2 = W_WI2 + (size_t)5632 * 1024, W_WPE = W_WO2 + (size_t)1024 * 2816,
                 W_WPG = W_WPE + (size_t)1024 * 256, W_LAYER = W_WPG + (size_t)1024 * 1024;
static_assert(W_LAYER == 29491200, "weights");
constexpr size_t MiB = 1u << 20;
constexpr size_t WS_W = 0, WS_XN = 226 * MiB, WS_R1 = 354 * MiB, WS_Y = 782 * MiB, WS_MG = 878 * MiB, WS_CH = 942 * MiB, WS_KCMP = 946 * MiB,
                 WS_VCMP = WS_KCMP + MiB / 2, WS_CB = 947 * MiB, WS_SSQ = 948 * MiB, WS_SSQ2 = 952 * MiB, WS_CTL = 956 * MiB, WS_END = 957 * MiB;
constexpr size_t CTL_ZERO_BYTES = 65536;
constexpr size_t WS_XN2 = WS_Y, WS_PBF = WS_Y + 128 * MiB;
static_assert(W_LAYER * 2 * DEPTH <= WS_XN, "w");
constexpr size_t HS = 262144;
constexpr size_t ZQA = 0, ZKA = ZQA + NB * 8 * HS, ZVA = ZKA + NB * 8 * HS, ZQB = ZVA + NB * 8 * HS, ZKCI = ZQB + NB * 8 * HS, ZVCI = ZKCI + NB * 2 * HS,
                 ZKS = ZVCI + NB * 2 * HS, ZVS = ZKS + NB * 2 * HS, ZKW = ZVS + NB * 2 * HS, ZVW = ZKW + NB * 2 * HS, ZQC = ZVW + NB * 2 * HS,
                 ZKC = ZQC + NB * 8 * HS, ZVC = ZKC + NB * 2 * HS, ZSG = ZVC + NB * 2 * HS, ZBG = ZSG + (size_t)TC * 3072, ZEND = ZBG + (size_t)TC * 32 * 2;
static_assert(ZEND * 2 <= 428 * MiB, "zbuf");
static_assert((size_t)T * DFF * 2 <= 428 * MiB, "act");
constexpr size_t R1_E = 0;

struct Params {
    const float* in[20];
    float* out;
    uchar* ws;
};

__device__ __forceinline__ unsigned cvtpk(float lo, float hi) { f32x2_t v = {lo, hi}; bf16x2_t b = __builtin_convertvector(v, bf16x2_t); return __builtin_bit_cast(unsigned, b); }
__device__ __forceinline__ bf16_t cvt1(float x) { return (bf16_t)(cvtpk(x, 0.f) & 0xffffu); }
__device__ __forceinline__ float bf2f(unsigned short b) { return __uint_as_float((unsigned)b << 16); }
__device__ __forceinline__ float wave_sum(float v) {
#pragma unroll
    for (int o = 1; o < 64; o <<= 1) v += __shfl_xor(v, o);
    return v;
}
__device__ __forceinline__ int opq(int v) { asm volatile("" : "+v"(v)); return v; }
__device__ __forceinline__ float sigm(float x) { return __builtin_amdgcn_rcpf(1.f + __builtin_amdgcn_exp2f(-x * LOG2E)); }
__device__ __forceinline__ float gelu_tanh(float x) { const float u = 0.7978845608028654f * (x + 0.044715f * x * x * x); const float e = __builtin_amdgcn_exp2f(-2.f * LOG2E * u); const float th = 2.f * __builtin_amdgcn_rcpf(1.f + e) - 1.f; return 0.5f * x * (1.f + th); }

typedef const __attribute__((address_space(4))) Params* KParPtr;
__device__ __forceinline__ KParPtr kparams() { auto p = __builtin_amdgcn_kernarg_segment_ptr(); asm volatile("" : "+s"(p)); return (KParPtr)p; }
#ifndef ALIGN_T
#define ALIGN_T false
#endif
#ifndef ALIGN_F
#define ALIGN_F true
#endif
#ifndef ALIGN_SW
#define ALIGN_SW true
#endif
#ifndef ALIGN_BR
#define ALIGN_BR true
#endif
#ifndef ALIGN_Z
#define ALIGN_Z true
#endif
__device__ __forceinline__ float row_rstd(const float* ssq, int row) {
    const f32x4* p = (const f32x4*)(ssq + (size_t)row * 16); const f32x4 a = p[0], b = p[1], c = p[2], d = p[3];
    const float sm = (((a[0] + a[1]) + (a[2] + a[3])) + ((b[0] + b[1]) + (b[2] + b[3]))) + (((c[0] + c[1]) + (c[2] + c[3])) + ((d[0] + d[1]) + (d[2] + d[3])));
    return 1.0f / sqrtf(sm * (1.f / 1024.f) + 1e-6f);
}
typedef const pg8::f32x4 (&AccRef)[2][2][4][2];
__device__ __forceinline__ void wave_rstd(const float* ssq, int rowbase, float (&rsl)[2]) {
    const int lane = threadIdx.x & 63;
    rsl[0] = row_rstd(ssq, rowbase + lane); rsl[1] = row_rstd(ssq, rowbase + 128 + lane);
}
struct EpiSwiglu {
    static constexpr bool PERM = true, AFTER_DRAIN = false, ALIGN = ALIGN_SW;
    bf16_t* O; const float* ssq;
    __device__ __forceinline__ void operator()(AccRef acc, const pg8::Unit& u, int wr, int wc, int fr, int fq) const {
        asm volatile("" : "+v"(fr), "+v"(fq));
        const int row0 = u.pm * 256 + wr * 64 + fr, col0 = u.pn * 128 + wc * 32 + 8 * fq;
        float rsl[2]; wave_rstd(ssq, u.pm * 256 + wr * 64, rsl);
#pragma unroll
        for (int ai = 0; ai < 2; ++ai)
#pragma unroll
            for (int m = 0; m < 4; ++m) {
                bf16_t* rp = O + (size_t)(row0 + ai * 128 + m * 16) * DFF + col0;
                const float rs = __shfl(rsl[ai], 16 * m + fr);
                float o[8];
#pragma unroll
                for (int n = 0; n < 2; ++n)
#pragma unroll
                    for (int e = 0; e < 4; ++e) { const float g = acc[ai][0][m][n][e] * rs, up = acc[ai][1][m][n][e] * rs; o[n * 4 + e] = g * sigm(g) * up; }
                u32x4 w; w.x = cvtpk(o[0], o[1]); w.y = cvtpk(o[2], o[3]); w.z = cvtpk(o[4], o[5]); w.w = cvtpk(o[6], o[7]);
                *(u32x4*)rp = w;
            }
    }
};
struct EpiResid {
    static constexpr bool PERM = false, AFTER_DRAIN = false, ALIGN = ALIGN_F;
    float alpha; int row_off; int first;
    __device__ __forceinline__ void operator()(AccRef acc, const pg8::Unit& u, int wr, int wc, int fr, int fq) const {
        asm volatile("" : "+v"(fr), "+v"(fq));
        const int row0 = row_off + u.pm * 256 + wr * 64 + fr, col0 = u.pn * 256 + wc * 32 + 4 * fq;
        float* out = kparams()->out; const float* in = first ? kparams()->in[0] : (const float*)out;
        uchar* wsb = kparams()->ws; bf16_t* hb = (bf16_t*)(wsb + WS_XN); float* ssq = (float*)(wsb + WS_SSQ);
#pragma unroll
        for (int ai = 0; ai < 2; ++ai)
#pragma unroll
            for (int m = 0; m < 4; ++m) {
                const size_t off = (size_t)(row0 + ai * 128 + m * 16) * DM + col0;
                float sq = 0.f;
#pragma unroll
                for (int bj = 0; bj < 2; ++bj)
#pragma unroll
                    for (int n = 0; n < 2; ++n) { const f32x4 b = *(const f32x4*)(in + off + bj * 128 + n * 16); const f32x4 v = b + acc[ai][bj][m][n] * alpha; *(f32x4*)(out + off + bj * 128 + n * 16) = v;
                        u32x2 w; w.x = cvtpk(v[0], v[1]); w.y = cvtpk(v[2], v[3]); *(u32x2*)(hb + off + bj * 128 + n * 16) = w; sq += (v[0] * v[0] + v[1] * v[1]) + (v[2] * v[2] + v[3] * v[3]); }
                sq += __shfl_xor(sq, 16); sq += __shfl_xor(sq, 32);
                if (fq == 0) ssq[(size_t)(row0 + ai * 128 + m * 16) * 16 + u.pn * 4 + wc] = sq;

            }
    }
};
struct EpiPle {
    static constexpr bool PERM = false, AFTER_DRAIN = false, ALIGN = ALIGN_F;
    float* h; const bf16_t* E; const float* ssq_in; bf16_t* hb; float* ssq_out;
    __device__ __forceinline__ void operator()(AccRef acc, const pg8::Unit& u, int wr, int wc, int fr, int fq) const {
        asm volatile("" : "+v"(fr), "+v"(fq));
        const int row0 = u.pm * 256 + wr * 64 + fr, col0 = u.pn * 256 + wc * 32 + 4 * fq;
        float rsl[2]; wave_rstd(ssq_in, u.pm * 256 + wr * 64, rsl);
#pragma unroll
        for (int ai = 0; ai < 2; ++ai)
#pragma unroll
            for (int m = 0; m < 4; ++m) {
                const size_t off = (size_t)(row0 + ai * 128 + m * 16) * DM + col0;
                const float rs = __shfl(rsl[ai], 16 * m + fr);
                float sq = 0.f;
#pragma unroll
                for (int bj = 0; bj < 2; ++bj)
#pragma unroll
                    for (int n = 0; n < 2; ++n) {
                        const size_t o2 = off + bj * 128 + n * 16;
                        const u32x2 ev = *(const u32x2*)(E + o2); f32x4 b = *(const f32x4*)(h + o2); const f32x4 a = acc[ai][bj][m][n];
                        b[0] += sigm(a[0] * rs) * __uint_as_float(ev.x << 16); b[1] += sigm(a[1] * rs) * __uint_as_float(ev.x & 0xffff0000u);
                        b[2] += sigm(a[2] * rs) * __uint_as_float(ev.y << 16); b[3] += sigm(a[3] * rs) * __uint_as_float(ev.y & 0xffff0000u);
                        *(f32x4*)(h + o2) = b;
                        u32x2 w; w.x = cvtpk(b[0], b[1]); w.y = cvtpk(b[2], b[3]); *(u32x2*)(hb + o2) = w; sq += (b[0] * b[0] + b[1] * b[1]) + (b[2] * b[2] + b[3] * b[3]);
                    }
                sq += __shfl_xor(sq, 16); sq += __shfl_xor(sq, 32);
                if (fq == 0) ssq_out[(size_t)(row0 + ai * 128 + m * 16) * 16 + u.pn * 4 + wc] = sq;

            }
    }
};
template <int MODE> struct EpiBf {
    static constexpr bool PERM = true, AFTER_DRAIN = false, ALIGN = ALIGN_T;
    bf16_t* O; int ldc; const float* bias;
    __device__ __forceinline__ void operator()(AccRef acc, const pg8::Unit& u, int wr, int wc, int fr, int fq) const {
        asm volatile("" : "+v"(fr), "+v"(fq));
        const int row0 = u.pm * 256 + wr * 64 + fr, col0 = u.pn * 256 + wc * 32 + 8 * fq;
#pragma unroll
        for (int bj = 0; bj < 2; ++bj) {
            float bv[8];
#pragma unroll
            for (int e = 0; e < 8; ++e) bv[e] = MODE == 1 ? bias[col0 + bj * 128 + e] : 0.f;
#pragma unroll
            for (int ai = 0; ai < 2; ++ai)
#pragma unroll
                for (int m = 0; m < 4; ++m) {
                    float o[8];
#pragma unroll
                    for (int n = 0; n < 2; ++n)
#pragma unroll
                        for (int e = 0; e < 4; ++e) { float v = acc[ai][bj][m][n][e] + bv[n * 4 + e]; if (MODE == 1) v = gelu_tanh(v); o[n * 4 + e] = v; }
                    u32x4 w; w.x = cvtpk(o[0], o[1]); w.y = cvtpk(o[2], o[3]); w.z = cvtpk(o[4], o[5]); w.w = cvtpk(o[6], o[7]);
                    *(u32x4*)(O + (size_t)(row0 + ai * 128 + m * 16) * ldc + col0 + bj * 128) = w;
                }
        }
    }
};
template <bool VT> struct EpiCmp2 {
    static constexpr bool PERM = true, AFTER_DRAIN = false, ALIGN = ALIGN_T;
    bf16_t* O;
    __device__ __forceinline__ void operator()(AccRef acc, const pg8::Unit& u, int wr, int wc, int fr, int fq) const {
        asm volatile("" : "+v"(fr), "+v"(fq));
        if (u.pn != 0 || wc >= 2) return;
        const int row0 = u.pm * 256 + wr * 64 + fr, d0 = wc * 32 + 8 * fq;
#pragma unroll
        for (int ai = 0; ai < 2; ++ai)
#pragma unroll
            for (int m = 0; m < 4; ++m) {
                const int row = row0 + ai * 128 + m * 16, bg = row >> 8, n = row & 255;
                float o[8];
#pragma unroll
                for (int nn = 0; nn < 2; ++nn)
#pragma unroll
                    for (int e = 0; e < 4; ++e) o[nn * 4 + e] = (n == 255) ? 0.f : acc[ai][0][m][nn][e];
                if (!VT) { u32x4 w; w.x = cvtpk(o[0], o[1]); w.y = cvtpk(o[2], o[3]); w.z = cvtpk(o[4], o[5]); w.w = cvtpk(o[6], o[7]); *(u32x4*)(O + (size_t)row * 64 + d0) = w; }
                else {
#pragma unroll
                    for (int e = 0; e < 8; ++e) O[((size_t)bg * 64 + d0 + e) * 256 + n] = cvt1(o[e]);
                }
            }
    }
};
struct EpiBranch {
    static constexpr bool PERM = true, AFTER_DRAIN = false, ALIGN = ALIGN_BR;
    bf16_t* mg; const bf16_t* sg; int mi;
    __device__ __forceinline__ void operator()(AccRef acc, const pg8::Unit& u, int wr, int wc, int fr, int fq) const {
        asm volatile("" : "+v"(fr), "+v"(fq));
        const int row0 = u.pm * 256 + wr * 64 + fr, col0 = u.pn * 256 + wc * 32 + 8 * fq;
#pragma unroll
        for (int ai = 0; ai < 2; ++ai)
#pragma unroll
            for (int m = 0; m < 4; ++m) {
                const int row = row0 + ai * 128 + m * 16;
#pragma unroll
                for (int bj = 0; bj < 2; ++bj) {
                    const int col = col0 + bj * 128;
                    const u32x4 gv = *(const u32x4*)(sg + (size_t)row * 3072 + mi * 1024 + col);
                    u32x4 ov = (u32x4){0u, 0u, 0u, 0u};
                    if (mi != 0) ov = *(const u32x4*)(mg + (size_t)row * DM + col);
                    float o[8];
#pragma unroll
                    for (int q = 0; q < 4; ++q) {
                        const unsigned gq = gv[q], oq = ov[q];
                        const float a0 = acc[ai][bj][m][q >> 1][(q & 1) * 2], a1 = acc[ai][bj][m][q >> 1][(q & 1) * 2 + 1];
                        o[2 * q] = __uint_as_float(oq << 16) + __uint_as_float(gq << 16) * a0;
                        o[2 * q + 1] = __uint_as_float(oq & 0xffff0000u) + __uint_as_float(gq & 0xffff0000u) * a1;
                    }
                    u32x4 w; w.x = cvtpk(o[0], o[1]); w.y = cvtpk(o[2], o[3]); w.z = cvtpk(o[4], o[5]); w.w = cvtpk(o[6], o[7]);
                    *(u32x4*)(mg + (size_t)row * DM + col) = w;
                }

            }
    }
};
struct EpiZ {
    static constexpr bool PERM = true, AFTER_DRAIN = false, ALIGN = ALIGN_Z;
    bf16_t* zb; const float* ssq;
    __device__ __forceinline__ void operator()(AccRef acc, const pg8::Unit& u, int wr, int wc, int fr, int fq) const {
        asm volatile("" : "+v"(fr), "+v"(fq));
        const int pn = u.pn;
        float rsl[2]; wave_rstd(ssq, u.pm * 256 + wr * 64, rsl);
#pragma unroll
        for (int bj = 0; bj < 2; ++bj) {
            const int ch = 2 * bj + (wc >> 1), d0 = (wc & 1) * 32 + 8 * fq;
            size_t off = 0, bs = 8 * HS; int mode = 0;
            if (pn < 2) { off = ZQA + (size_t)(pn * 4 + ch) * HS; }
            else if (pn < 4) { off = ZKA + (size_t)((pn - 2) * 4 + ch) * HS; }
            else if (pn < 6) { off = ZVA + (size_t)((pn - 4) * 4 + ch) * HS; mode = 1; }
            else if (pn < 8) { off = ZQB + (size_t)((pn - 6) * 4 + ch) * HS; }
            else if (pn == 8) { bs = 2 * HS; off = (ch < 2) ? ZKCI + (size_t)ch * HS : ZVCI + (size_t)(ch - 2) * HS; }
            else if (pn == 9) { bs = 2 * HS; if (ch < 2) off = ZKS + (size_t)ch * HS; else { off = ZVS + (size_t)(ch - 2) * HS; mode = 1; } }
            else if (pn == 10) { bs = 2 * HS; if (ch < 2) off = ZKW + (size_t)ch * HS; else { off = ZVW + (size_t)(ch - 2) * HS; mode = 1; } }
            else if (pn < 13) { off = ZQC + (size_t)((pn - 11) * 4 + ch) * HS; }
            else if (pn == 13) { bs = 2 * HS; if (ch < 2) off = ZKC + (size_t)ch * HS; else { off = ZVC + (size_t)(ch - 2) * HS; mode = 1; } }
            else if (pn < 26) mode = 2;
            else mode = 3;
#pragma unroll
            for (int ai = 0; ai < 2; ++ai)
#pragma unroll
                for (int m = 0; m < 4; ++m) {
                    const int tl = u.pm * 256 + ai * 128 + wr * 64 + m * 16 + fr, bl = tl >> 12, s = tl & 4095;
                    const float rs = __shfl(rsl[ai], 16 * m + fr);
                    float o[8];
#pragma unroll
                    for (int n = 0; n < 2; ++n)
#pragma unroll
                        for (int e = 0; e < 4; ++e) o[n * 4 + e] = acc[ai][bj][m][n][e] * rs;
                    if (mode == 0) {
                        u32x4 w; w.x = cvtpk(o[0], o[1]); w.y = cvtpk(o[2], o[3]); w.z = cvtpk(o[4], o[5]); w.w = cvtpk(o[6], o[7]);
                        *(u32x4*)(zb + off + (size_t)bl * bs + (size_t)s * 64 + d0) = w;
                    } else if (mode == 1) {
                        bf16_t* p = zb + off + (size_t)bl * bs + (size_t)d0 * 4096 + s;
#pragma unroll
                        for (int e = 0; e < 8; ++e) p[(size_t)e * 4096] = cvt1(o[e]);
                    } else if (mode == 2) {
#pragma unroll
                        for (int e = 0; e < 8; ++e) o[e] = sigm(o[e]);
                        u32x4 w; w.x = cvtpk(o[0], o[1]); w.y = cvtpk(o[2], o[3]); w.z = cvtpk(o[4], o[5]); w.w = cvtpk(o[6], o[7]);
                        *(u32x4*)(zb + ZSG + (size_t)tl * 3072 + (pn - 14) * 256 + bj * 128 + wc * 32 + 8 * fq) = w;
                    } else {
                        const int cc = bj * 128 + wc * 32 + 8 * fq;
                        if (cc < 24) {
                            float* bgp = (float*)(zb + ZBG) + (size_t)tl * 32 + cc;
                            *(f32x4*)bgp = (f32x4){sigm(o[0]), sigm(o[1]), sigm(o[2]), sigm(o[3])};
                            *(f32x4*)(bgp + 4) = (f32x4){sigm(o[4]), sigm(o[5]), sigm(o[6]), sigm(o[7])};
                        }
                    }
                }
        }
    }
};

__device__ __forceinline__ void rms_row_bf16(const float* xrow, const float* g, bf16_t* orow, int lane) {
    const f32x4* xr = (const f32x4*)xrow + lane; f32x4 v[4]; float s = 0.f;
#pragma unroll
    for (int j = 0; j < 4; ++j) { v[j] = xr[64 * j]; s += (v[j][0] * v[j][0] + v[j][1] * v[j][1]) + (v[j][2] * v[j][2] + v[j][3] * v[j][3]); }
    const float rstd = 1.0f / sqrtf(wave_sum(s) * (1.f / DM) + EPS);
    u32x2* o8 = (u32x2*)orow + lane;
#pragma unroll
    for (int j = 0; j < 4; ++j) { const f32x4 gg = ((const f32x4*)g)[lane + 64 * j]; u32x2 w; w.x = cvtpk(v[j][0] * rstd * gg[0], v[j][1] * rstd * gg[1]); w.y = cvtpk(v[j][2] * rstd * gg[2], v[j][3] * rstd * gg[3]); o8[64 * j] = w; }
}
__device__ __forceinline__ void rms_row_f32(const float* xrow, const float* g, float* orow, int lane) {
    const f32x4* xr = (const f32x4*)xrow + lane; f32x4 v[4]; float s = 0.f;
#pragma unroll
    for (int j = 0; j < 4; ++j) { v[j] = xr[64 * j]; s += (v[j][0] * v[j][0] + v[j][1] * v[j][1]) + (v[j][2] * v[j][2] + v[j][3] * v[j][3]); }
    const float rstd = 1.0f / sqrtf(wave_sum(s) * (1.f / DM) + EPS);
#pragma unroll
    for (int j = 0; j < 4; ++j) { const f32x4 gg = ((const f32x4*)g)[lane + 64 * j]; ((f32x4*)orow)[lane + 64 * j] = (v[j] * rstd) * gg; }
}
__device__ __forceinline__ void phase_prep(const float* src, bf16_t* dst, float* ssq, int gw, int ngw, int lane) {
    lane = opq(lane);
    for (int m = gw; m < T; m += ngw) {
        const f32x4* xr = (const f32x4*)(src + (size_t)m * DM) + lane; u32x2* o8 = (u32x2*)(dst + (size_t)m * DM) + lane; float s = 0.f;
#pragma unroll
        for (int j = 0; j < 4; ++j) { const f32x4 v = xr[64 * j]; s += (v[0] * v[0] + v[1] * v[1]) + (v[2] * v[2] + v[3] * v[3]); u32x2 w; w.x = cvtpk(v[0], v[1]); w.y = cvtpk(v[2], v[3]); o8[64 * j] = w; }
        s = wave_sum(s);
        if (lane < 16) ssq[(size_t)m * 16 + lane] = lane == 0 ? s : 0.f;
    }
}
__device__ __forceinline__ void phase_rms(const float* src, const float* g, bf16_t* dst, int gw, int ngw, int lane) {
    lane = opq(lane);
    for (int m = gw; m < T; m += ngw) rms_row_bf16(src + (size_t)m * DM, g, dst + (size_t)m * DM, lane);
}

__device__ __forceinline__ int srccol(int mode, int n) {
    if (mode == 0) return n;
    if (mode == 1) return ((n >> 7) & 1) * DFF + (n >> 8) * 128 + (n & 127);
    if (mode == 2) return n < 2816 ? n : (n < 6656 ? n + 24 : (n < 6680 ? 2816 + (n - 6656) : -1));
    return n < 64 ? n : -1;
}
__device__ __forceinline__ void conv_matrix(const float* src, int K, int ld, int Ndst, int mode, bf16_t* dst, int& base, LAS float* scr, int tid, int blk, int G, const float* gk = nullptr) {
    tid = opq(tid);
    const int ntn = Ndst / 64, ntiles = (K / 128) * ntn;
    int start = (blk - (base % G) + G) % G;
    for (int t = start; t < ntiles; t += G) {
        const int k0 = (t / ntn) * 128, n0 = (t % ntn) * 64;
        { const int kr = tid >> 6, n = tid & 63; const int col = srccol(mode, n0 + n);
          float v[16];
#pragma unroll
          for (int kk = 0; kk < 16; ++kk) { const int k = kr + 8 * kk; v[kk] = col >= 0 ? src[(size_t)(k0 + k) * ld + col] : 0.f; }
#pragma unroll
          for (int kk = 0; kk < 16; ++kk) { const int k = kr + 8 * kk; scr[k * 65 + n] = gk ? v[kk] * gk[k0 + k] : v[kk]; } }
        __syncthreads();
        { const int n = tid >> 3, ks = tid & 7;
#pragma unroll
          for (int h2 = 0; h2 < 2; ++h2) { const LAS float* sp = scr + (64 * h2 + 8 * ks) * 65 + n;
            u32x4 w; w.x = cvtpk(sp[0], sp[65]); w.y = cvtpk(sp[130], sp[195]); w.z = cvtpk(sp[260], sp[325]); w.w = cvtpk(sp[390], sp[455]);
            *(u32x4*)(dst + (size_t)(n0 + n) * K + k0 + 64 * h2 + 8 * ks) = w; } }
        __syncthreads();
    }
    base += ntiles;
}

constexpr int KP = 144;
constexpr int VP = 144;
constexpr int L_K0 = 0, L_K1 = 9216, L_V0 = 18432, L_V1 = 36864, L_TBL = 55296, L_IMP = 57344, L_SEL = 73984, L_RED = 74496;
constexpr float SC = 0.125f * LOG2E;
constexpr float MINIT = -10000.f, MASKED = -1e30f;

__device__ __forceinline__ int t5_bucket(int n) {
    if (n < 16) return n;
    int b = 16;
    b += (n >= 19); b += (n >= 21); b += (n >= 24); b += (n >= 27); b += (n >= 31); b += (n >= 35); b += (n >= 40); b += (n >= 46);
    b += (n >= 52); b += (n >= 59); b += (n >= 67); b += (n >= 77); b += (n >= 87); b += (n >= 99); b += (n >= 113);
    return b;
}
__device__ __forceinline__ void build_tbl(LAS uchar* lds, const float* rel_bias, int col0, int nh, int tid) {
    const int hd = tid >> 7, idx = tid & 127;
    if (hd < nh && idx < 114) ((LAS float*)(lds + L_TBL))[hd * 128 + idx] = rel_bias[t5_bucket(idx) * 20 + col0 + hd] * LOG2E;
}

template <int DV> struct TileRegs { u32x4 k; u32x4 v[DV / 64]; };
template <int DV, bool HASV>
__device__ __forceinline__ void tile_gload(TileRegs<DV>& r, const bf16_t* Kg, const bf16_t* Vt, int vpitch, int kt, int tid) {
    const int row = tid >> 3, seg = tid & 7;
    r.k = *(const u32x4*)(Kg + (size_t)(kt * 64 + row) * 64 + seg * 8);
    if (HASV) {
#pragma unroll
        for (int j = 0; j < DV / 64; ++j) r.v[j] = *(const u32x4*)(Vt + (size_t)(row + 64 * j) * vpitch + kt * 64 + seg * 8);
    }
}
template <int DV, bool HASV>
__device__ __forceinline__ void tile_swrite(const TileRegs<DV>& r, LAS uchar* lds, int buf, int tid) {
    const int row = tid >> 3, seg = tid & 7;
    *(LAS u32x4*)(lds + (buf ? L_K1 : L_K0) + row * KP + seg * 16) = r.k;
    if (HASV) {
#pragma unroll
        for (int j = 0; j < DV / 64; ++j) { LAS uchar* p = lds + (buf ? L_V1 : L_V0) + (row + 64 * j) * VP + (seg >> 1) * 32 + (seg & 1) * 8; *(LAS u32x2*)p = (u32x2){r.v[j].x, r.v[j].y}; *(LAS u32x2*)(p + 16) = (u32x2){r.v[j].z, r.v[j].w}; }
    }
}

template <int DV, bool IMPP>
__device__ __forceinline__ void attn_pass(LAS uchar* lds, const bf16_t* Kg, const bf16_t* Vt, int vpitch, int kt0, int kt1, int wave_kt_max,
                                          int qpos, int qmin_w, int qmax_w, int kmul, int kadd, unsigned W, bf16x8 (&q)[4], int tbl,
                                          unsigned long long selmask, bool use_sel, float& m, float& l, f32x16 (&acc)[DV / 32],
                                          float inv_l, int imp_row, float rel_far, int tid) {
    const int lane = tid & 63, n = lane & 31, hi = lane >> 5;
    TileRegs<DV> tr;
    if (kt0 >= kt1) return;
    float tfar = rel_far;
    asm volatile("s_waitcnt vmcnt(0)" ::: "memory");
    asm volatile("" : "+v"(q[0]), "+v"(q[1]), "+v"(q[2]), "+v"(q[3]), "+v"(tfar), "+v"(m), "+v"(l), "+v"(inv_l));
    tile_gload<DV, !IMPP>(tr, Kg, Vt, vpitch, kt0, tid);
    tile_swrite<DV, !IMPP>(tr, lds, 0, tid);
    __syncthreads();
    for (int kt = kt0; kt < kt1; ++kt) {
        const int cur = (kt - kt0) & 1;
        const bool more = kt + 1 < kt1;
        if (more) tile_gload<DV, !IMPP>(tr, Kg, Vt, vpitch, kt + 1, tid);
        if (kt <= wave_kt_max && (!use_sel || __builtin_amdgcn_ballot_w64((selmask >> kt) & 1ull) != 0ull)) {
            f32x16 s[2];
#pragma unroll
            for (int r = 0; r < 16; ++r) { s[0][r] = 0.f; s[1][r] = 0.f; }
            const LAS uchar* kb = lds + (cur ? L_K1 : L_K0) + n * KP + hi * 16;
#pragma unroll
            for (int ks = 0; ks < 4; ++ks) {
                const bf16x8 a0 = *(const LAS bf16x8*)(kb + ks * 32);
                const bf16x8 a1 = *(const LAS bf16x8*)(kb + 32 * KP + ks * 32);
                s[0] = __builtin_amdgcn_mfma_f32_32x32x16_bf16(a0, q[ks], s[0], 0, 0, 0);
                s[1] = __builtin_amdgcn_mfma_f32_32x32x16_bf16(a1, q[ks], s[1], 0, 0, 0);
            }
            const bool lane_ok = !use_sel || ((selmask >> kt) & 1ull);
            const bool fast = (qmin_w - (kmul * (64 * kt + 63) + kadd) >= 113) && ((unsigned)(qmax_w - (kmul * 64 * kt + kadd)) < W);
            if (fast) {
                const float cfar = lane_ok ? tfar - m : MASKED;
                const float scl = lane_ok ? SC : 0.f;
#pragma unroll
                for (int hh = 0; hh < 2; ++hh)
#pragma unroll
                    for (int r = 0; r < 16; ++r) s[hh][r] = s[hh][r] * scl + cfar;
            } else {
                int dq = qpos - kadd - kmul * (kt * 64 + 4 * hi);
                asm volatile("" : "+v"(dq));
                const unsigned Wl = lane_ok ? W : 0u;
                const LAS uchar* tb = lds + tbl;
#pragma unroll
                for (int hh = 0; hh < 2; ++hh)
#pragma unroll
                    for (int r = 0; r < 16; ++r) {
                        const int kk = 32 * hh + 8 * (r >> 2) + (r & 3);
                        const int dist = dq - kmul * kk;
                        const unsigned ud = (unsigned)dist;
                        const unsigned idx = ud < 113u ? ud : 113u;
                        const float bias = *(const LAS float*)(tb + idx * 4);
                        float v = s[hh][r] * SC + (bias - m);
                        v = (ud < Wl) ? v : MASKED;
                        s[hh][r] = v;
                    }
            }
            if (!IMPP) {
                float t0 = fmaxf(fmaxf(s[0][0], s[0][1]), s[0][2]), t1 = fmaxf(fmaxf(s[1][0], s[1][1]), s[1][2]);
#pragma unroll
                for (int r = 3; r < 15; r += 2) { t0 = fmaxf(fmaxf(t0, s[0][r]), s[0][r + 1]); t1 = fmaxf(fmaxf(t1, s[1][r]), s[1][r + 1]); }
                float tmax = fmaxf(fmaxf(t0, t1), fmaxf(s[0][15], s[1][15]));
                { auto rr = __builtin_amdgcn_permlane32_swap(__float_as_uint(tmax), __float_as_uint(tmax), false, false); tmax = fmaxf(__uint_as_float(rr[0]), __uint_as_float(rr[1])); }
                const bool need = tmax > 8.f;
                if (__builtin_amdgcn_ballot_w64(need) != 0ull) {
                    const float delta = need ? tmax : 0.f;
                    const float alpha = __builtin_amdgcn_exp2f(-delta);
                    m += delta; l *= alpha;
#pragma unroll
                    for (int dt = 0; dt < DV / 32; ++dt) acc[dt] = acc[dt] * alpha;
#pragma unroll
                    for (int hh = 0; hh < 2; ++hh)
#pragma unroll
                        for (int r = 0; r < 16; ++r) s[hh][r] -= delta;
                }
#pragma unroll
                for (int hh = 0; hh < 2; ++hh)
#pragma unroll
                    for (int r = 0; r < 16; ++r) s[hh][r] = __builtin_amdgcn_exp2f(s[hh][r]);
                f32x2_t ls2a = {0.f, 0.f}, ls2b = {0.f, 0.f};
#pragma unroll
                for (int r = 0; r < 16; r += 2) { ls2a += (f32x2_t){s[0][r], s[0][r + 1]}; ls2b += (f32x2_t){s[1][r], s[1][r + 1]}; }
                const float ls = (ls2a[0] + ls2a[1]) + (ls2b[0] + ls2b[1]);
                l += ls;
                const LAS uchar* vb = lds + (cur ? L_V1 : L_V0) + n * VP + hi * 16;
    #pragma unroll
                for (int hh = 0; hh < 2; ++hh)
#pragma unroll
                    for (int u2 = 0; u2 < 2; ++u2) {
                        u32x4 pw;
                        pw.x = cvtpk(s[hh][8 * u2 + 0], s[hh][8 * u2 + 1]); pw.y = cvtpk(s[hh][8 * u2 + 2], s[hh][8 * u2 + 3]);
                        pw.z = cvtpk(s[hh][8 * u2 + 4], s[hh][8 * u2 + 5]); pw.w = cvtpk(s[hh][8 * u2 + 6], s[hh][8 * u2 + 7]);
                        const bf16x8 pb = __builtin_bit_cast(bf16x8, pw);
                        const int kbase = 32 * hh + 16 * u2;
#pragma unroll
                        for (int dt = 0; dt < DV / 32; ++dt) {
                            const bf16x8 va = *(const LAS bf16x8*)(vb + dt * 32 * VP + kbase * 2);
                            acc[dt] = __builtin_amdgcn_mfma_f32_32x32x16_bf16(va, pb, acc[dt], 0, 0, 0);
                        }
                    }
                } else {
                LAS float* imp = (LAS float*)(lds + L_IMP) + imp_row * 65;
                float spill[8];
#pragma unroll
                for (int hh = 0; hh < 2; ++hh)
#pragma unroll
                    for (int gq = 0; gq < 4; ++gq) {
                        const float p0 = __builtin_amdgcn_exp2f(s[hh][4 * gq + 0]) * inv_l, p1 = __builtin_amdgcn_exp2f(s[hh][4 * gq + 1]) * inv_l;
                        const float p2 = __builtin_amdgcn_exp2f(s[hh][4 * gq + 2]) * inv_l, p3 = __builtin_amdgcn_exp2f(s[hh][4 * gq + 3]) * inv_l;
                        float mn = (p0 + p1) + (p2 + p3), sp = p3;
                        mn += __shfl_xor(mn, 8); mn += __shfl_xor(mn, 16);
                        sp += __shfl_xor(sp, 8); sp += __shfl_xor(sp, 16);
                        spill[hh * 4 + gq] = sp;
                        const int j = 16 * kt + 8 * hh + 2 * gq + hi;
                        if (n < 8) imp[j] += mn;
                    }
                __builtin_amdgcn_fence(__ATOMIC_RELEASE, "wavefront");
#pragma unroll
                for (int hh = 0; hh < 2; ++hh)
#pragma unroll
                    for (int gq = 0; gq < 4; ++gq) {
                        const int j = 16 * kt + 8 * hh + 2 * gq + hi + 1;
                        if (n < 8 && j < 64) imp[j] += spill[hh * 4 + gq];
                    }
                __builtin_amdgcn_fence(__ATOMIC_RELEASE, "wavefront");
            }
        }
        if (more) tile_swrite<DV, !IMPP>(tr, lds, cur ^ 1, tid);
        __syncthreads();
    }
}

template <int NT> __device__ __forceinline__ void acc_zero(f32x16 (&a)[NT]) {
#pragma unroll
    for (int t = 0; t < NT; ++t)
#pragma unroll
        for (int r = 0; r < 16; ++r) a[t][r] = 0.f;
}
template <int NT> __device__ __forceinline__ void acc_norm(f32x16 (&a)[NT], float l) {
    const float lt = l + __shfl_xor(l, 32);
    const float inv = lt > 0.f ? 1.f / lt : 0.f;
#pragma unroll
    for (int t = 0; t < NT; ++t)
#pragma unroll
        for (int r = 0; r < 16; ++r) a[t][r] *= inv;
}
__device__ __forceinline__ void load_q(bf16x8 (&qf)[4], const bf16_t* qrow, int hi) {
#pragma unroll
    for (int ks = 0; ks < 4; ++ks) qf[ks] = *(const bf16x8*)(qrow + 16 * ks + 8 * hi);
}

struct AttnCtx {
    const bf16_t* zb;
    bf16_t *ya, *yb, *yc;
    float* park;
    const bf16_t *kcmp, *vtcmp;
    const float *rel_bias, *lamp, *subln, *sinks;
    float lam_init;
};

__device__ __forceinline__ void attn_unit_A(LAS uchar* lds, const AttnCtx& C, int bl, int h, int qt, int tid) {
    tid = opq(tid);
    const int lane = tid & 63, n = lane & 31, hi = lane >> 5, w = __builtin_amdgcn_readfirstlane(tid >> 6);
    build_tbl(lds, C.rel_bias, h, 1, tid);
    float lam;
    { const float a = C.lamp[lane] * C.lamp[64 + lane], b = C.lamp[128 + lane] * C.lamp[192 + lane]; lam = __expf(wave_sum(a)) - __expf(wave_sum(b)) + C.lam_init; }
    const int qpos = 256 * qt + 32 * w + n;
    const float rfar = C.rel_bias[31 * 20 + h] * LOG2E;
    const int kt1 = 4 * qt + 4, wkm = 4 * qt + (w >> 1);
    const bf16_t* Vt = C.zb + ZVA + ((size_t)bl * 8 + 2 * h) * HS;
    f32x16 acc[4];
    bf16x8 qf[4];
    float m, l;
    float* prow = C.park + ((size_t)bl * 4096 + qpos) * 512 + h * 128;
#pragma unroll 1
    for (int c = 1; c >= 0; --c) {
        const size_t hoff = ((size_t)bl * 8 + 2 * h + c) * HS;
        load_q(qf, C.zb + ZQA + hoff + (size_t)qpos * 64, hi);
        acc_zero<4>(acc); m = MINIT; l = 0.f;
        attn_pass<128, false>(lds, C.zb + ZKA + hoff, Vt, 4096, 0, kt1, wkm, qpos, 256 * qt + 32 * w, 256 * qt + 32 * w + 31, 1, 0, 0x7fffffffu, qf, L_TBL, 0ull, false, m, l, acc, 0.f, 0, rfar, tid);
        acc_norm<4>(acc, l);
        if (c == 1) {
#pragma unroll
            for (int t = 0; t < 4; ++t)
#pragma unroll
                for (int gq = 0; gq < 4; ++gq) *(f32x4*)(prow + 32 * t + 8 * gq + 4 * hi) = (f32x4){acc[t][4 * gq], acc[t][4 * gq + 1], acc[t][4 * gq + 2], acc[t][4 * gq + 3]};
        }
    }
    float ss = 0.f;
#pragma unroll
    for (int t = 0; t < 4; ++t)
#pragma unroll
        for (int gq = 0; gq < 4; ++gq) { const f32x4 o1 = *(const f32x4*)(prow + 32 * t + 8 * gq + 4 * hi);
#pragma unroll
            for (int e = 0; e < 4; ++e) { const float y = acc[t][4 * gq + e] - lam * o1[e]; acc[t][4 * gq + e] = y; ss += y * y; } }
    ss += __shfl_xor(ss, 32);
    const float rs = (1.0f / sqrtf(ss * (1.f / 128.f) + EPS)) * (1.f - C.lam_init);
    bf16_t* yrow = C.ya + ((size_t)bl * 4096 + qpos) * 512 + h * 128;
#pragma unroll
    for (int t = 0; t < 4; ++t)
#pragma unroll
        for (int gq = 0; gq < 4; ++gq) {
            const int d = 32 * t + 8 * gq + 4 * hi;
            const f32x4 gg = *(const f32x4*)(C.subln + d);
            u32x2 wv; wv.x = cvtpk(acc[t][4 * gq] * rs * gg[0], acc[t][4 * gq + 1] * rs * gg[1]); wv.y = cvtpk(acc[t][4 * gq + 2] * rs * gg[2], acc[t][4 * gq + 3] * rs * gg[3]);
            *(u32x2*)(yrow + d) = wv;
        }
}

__device__ __forceinline__ void attn_unit_B(LAS uchar* lds, const AttnCtx& C, int bl, int g, int i, int tid) {
    tid = opq(tid);
    const int lane = tid & 63, n = lane & 31, hi = lane >> 5, w = __builtin_amdgcn_readfirstlane(tid >> 6);
    build_tbl(lds, C.rel_bias, 4 + 4 * g, 4, tid);
    const int ql = 8 * w + (n & 7), hr = n >> 3, qpos = 64 * i + ql, head = 4 * g + hr, qlo = 64 * i + 8 * w;
    const float rfar = C.rel_bias[31 * 20 + 4 + head] * LOG2E;
    const int tbl = L_TBL + hr * 512;
    bf16x8 qf[4];
    load_q(qf, C.zb + ZQB + ((size_t)bl * 8 + head) * HS + (size_t)qpos * 64, hi);
    const size_t goff = ((size_t)bl * 2 + g) * HS;
    f32x16 acc[2];
    LAS float* otl = (LAS float*)(lds + L_RED) + tid;
    float m, l;
    const size_t tok = (size_t)bl * 4096 + qpos;
    const float* bg = (const float*)(C.zb + ZBG) + tok * 32 + head * 3;
    const float g0 = bg[0], g1 = bg[1], g2 = bg[2];
    const bf16_t* Kc = C.kcmp + ((size_t)bl * 2 + g) * 256 * 64;
    const bf16_t* Vc = C.vtcmp + ((size_t)bl * 2 + g) * 64 * 256;
    const int ktc1 = ((4 * i + 2) >> 6) + 1;
    acc_zero<2>(acc); m = MINIT; l = 0.f;
    attn_pass<64, false>(lds, Kc, Vc, 256, 0, ktc1, 1 << 20, qpos, qlo, qlo + 7, 16, 31, 0x7fffffffu, qf, tbl, 0ull, false, m, l, acc, 0.f, 0, rfar, tid);
    acc_norm<2>(acc, l);
#pragma unroll
    for (int t = 0; t < 2; ++t)
#pragma unroll
        for (int r = 0; r < 16; ++r) otl[(t * 16 + r) * NTHR] = g0 * acc[t][r];
    unsigned long long selmask = ~0ull;
    if (i >= 16) {
    {
        const float lt = l + __shfl_xor(l, 32);
        const float inv_l = lt > 0.f ? 1.f / lt : 0.f;
        LAS float* impw = (LAS float*)(lds + L_IMP) + (8 * w) * 65;
        for (int x = lane; x < 8 * 65; x += 64) impw[x] = 0.f;
        __builtin_amdgcn_fence(__ATOMIC_RELEASE, "wavefront");
        attn_pass<64, true>(lds, Kc, Vc, 256, 0, ktc1, 1 << 20, qpos, qlo, qlo + 7, 16, 31, 0x7fffffffu, qf, tbl, 0ull, false, m, l, acc, inv_l, ql, rfar, tid);
    }
    {
        const int q = tid & 63, part = tid >> 6;
        const LAS float* row = (const LAS float*)(lds + L_IMP) + q * 65;
        float cand[8]; int rank[8];
#pragma unroll
        for (int c = 0; c < 8; ++c) { const int j = 8 * part + c; float v = row[j]; v = (j == 0 || j == i || j == i - 1) ? 1e6f : (j > i ? -1e6f : v); cand[c] = v; rank[c] = 0; }
        for (int jj = 0; jj <= i; ++jj) {
            float x = row[jj]; x = (jj == 0 || jj == i || jj == i - 1) ? 1e6f : (jj > i ? -1e6f : x);
#pragma unroll
            for (int c = 0; c < 8; ++c) { const int j = 8 * part + c; rank[c] += (x > cand[c] || (x == cand[c] && jj < j)) ? 1 : 0; }
        }
        unsigned bits = 0;
#pragma unroll
        for (int c = 0; c < 8; ++c) bits |= (rank[c] < 16 ? 1u : 0u) << c;
        ((LAS uchar*)(lds + L_SEL))[q * 8 + part] = (uchar)bits;
    }
    __syncthreads();
    { const u32x2 sm = *(const LAS u32x2*)(lds + L_SEL + ql * 8); selmask = (unsigned long long)sm.x | ((unsigned long long)sm.y << 32); }
    }
    acc_zero<2>(acc); m = MINIT; l = 0.f;
    attn_pass<64, false>(lds, C.zb + ZKS + goff, C.zb + ZVS + goff, 4096, 0, i + 1, 1 << 20, qpos, qlo, qlo + 7, 1, 0, 0x7fffffffu, qf, tbl, selmask, true, m, l, acc, 0.f, 0, rfar, tid);
    acc_norm<2>(acc, l);
#pragma unroll
    for (int t = 0; t < 2; ++t)
#pragma unroll
        for (int r = 0; r < 16; ++r) otl[(t * 16 + r) * NTHR] += g1 * acc[t][r];
    acc_zero<2>(acc); m = MINIT; l = 0.f;
    attn_pass<64, false>(lds, C.zb + ZKW + goff, C.zb + ZVW + goff, 4096, i > 8 ? i - 8 : 0, i + 1, 1 << 20, qpos, qlo, qlo + 7, 1, 0, 512u, qf, tbl, 0ull, false, m, l, acc, 0.f, 0, rfar, tid);
    acc_norm<2>(acc, l);
    bf16_t* yrow = C.yb + tok * 512 + head * 64;
#pragma unroll
    for (int t = 0; t < 2; ++t)
#pragma unroll
        for (int gq = 0; gq < 4; ++gq) {
            const int d = 32 * t + 8 * gq + 4 * hi;
            float o[4];
#pragma unroll
            for (int e = 0; e < 4; ++e) o[e] = otl[(t * 16 + 4 * gq + e) * NTHR] + g2 * acc[t][4 * gq + e];
            u32x2 wv; wv.x = cvtpk(o[0], o[1]); wv.y = cvtpk(o[2], o[3]);
            *(u32x2*)(yrow + d) = wv;
        }
}

__device__ __forceinline__ void attn_unit_C(LAS uchar* lds, const AttnCtx& C, int bl, int g, int i, int tid) {
    tid = opq(tid);
    const int lane = tid & 63, n = lane & 31, hi = lane >> 5, w = __builtin_amdgcn_readfirstlane(tid >> 6);
    build_tbl(lds, C.rel_bias, 12 + 4 * g, 4, tid);
    const int ql = 8 * w + (n & 7), hr = n >> 3, qpos = 64 * i + ql, head = 4 * g + hr, qlo = 64 * i + 8 * w;
    const float rfar = C.rel_bias[31 * 20 + 12 + head] * LOG2E;
    const int tbl = L_TBL + hr * 512;
    bf16x8 qf[4];
    load_q(qf, C.zb + ZQC + ((size_t)bl * 8 + head) * HS + (size_t)qpos * 64, hi);
    const size_t goff = ((size_t)bl * 2 + g) * HS;
    f32x16 acc[2];
    acc_zero<2>(acc);
    float m = C.sinks[head] * LOG2E, l = hi == 0 ? 1.f : 0.f;
    attn_pass<64, false>(lds, C.zb + ZKC + goff, C.zb + ZVC + goff, 4096, i > 2 ? i - 2 : 0, i + 1, 1 << 20, qpos, qlo, qlo + 7, 1, 0, 128u, qf, tbl, 0ull, false, m, l, acc, 0.f, 0, rfar, tid);
    acc_norm<2>(acc, l);
    const size_t tok = (size_t)bl * 4096 + qpos;
    bf16_t* yrow = C.yc + tok * 512 + head * 64;
#pragma unroll
    for (int t = 0; t < 2; ++t)
#pragma unroll
        for (int gq = 0; gq < 4; ++gq) {
            const int d = 32 * t + 8 * gq + 4 * hi;
            u32x2 wv; wv.x = cvtpk(acc[t][4 * gq], acc[t][4 * gq + 1]); wv.y = cvtpk(acc[t][4 * gq + 2], acc[t][4 * gq + 3]);
            *(u32x2*)(yrow + d) = wv;
        }
}

#define XB_TMO      128
#define XB_XCNT(j)  (256  + 64 * (j))
#define XB_XSUB(j)  (1280 + 64 * (j))
#define XB_XGEN(j)  (2304 + 64 * (j))
#define XB_TOP      3328
#define XB_TOPGEN   3392
#define XCD_BAR_WORDS 3456
#define XB_SPIN_CAP (1u << 18)

__device__ __forceinline__ unsigned xb_ld(unsigned* p)              { return __hip_atomic_load(p, __ATOMIC_RELAXED, __HIP_MEMORY_SCOPE_AGENT); }
__device__ __forceinline__ unsigned xb_add(unsigned* p, unsigned v) { return __hip_atomic_fetch_add(p, v, __ATOMIC_RELAXED, __HIP_MEMORY_SCOPE_AGENT); }
__device__ __forceinline__ unsigned xb_xcc_id() { return (unsigned)__builtin_amdgcn_s_getreg((3 << 11) | 20) & 0xFu; }
#define XB_SPIN(cond, bar) do { unsigned _sp = 0; while (cond) { __builtin_amdgcn_s_sleep(1); \
    if ((++_sp & 255u) == 0u) { if (xb_ld(&(bar)[XB_TMO])) break; if (_sp > XB_SPIN_CAP) { atomicAdd(&(bar)[XB_TMO], 1u); break; } } } } while (0)

struct XcdBarrier {
    unsigned* bar; unsigned x;
    volatile __attribute__((address_space(3))) unsigned* st;
};

__device__ __forceinline__ XcdBarrier xcd_barrier_post(unsigned* bar, volatile __attribute__((address_space(3))) unsigned* st) {
    XcdBarrier b; b.bar = bar; b.x = xb_xcc_id(); b.st = st;
    if (threadIdx.x == 0) (void)xb_add(&bar[XB_XCNT(b.x)], 1u);
    return b;
}
__device__ __forceinline__ void xcd_barrier_complete(unsigned* bar, unsigned x, unsigned& nloc, unsigned& nx) {
    const unsigned G = gridDim.x * gridDim.y * gridDim.z;
    unsigned sum, cnt, mine, sp = 0u;
    for (;;) {
        sum = 0u; cnt = 0u; mine = 0u;
#pragma unroll
        for (unsigned j = 0; j < 16; ++j) { const unsigned c = xb_ld(&bar[XB_XCNT(j)]); sum += c; cnt += (c > 0u) ? 1u : 0u; mine = (j == x) ? c : mine; }
        if (sum == G) break;
        __builtin_amdgcn_s_sleep(1);
        if ((++sp & 255u) == 0u) { if (xb_ld(&bar[XB_TMO])) break; if (sp > XB_SPIN_CAP) { atomicAdd(&bar[XB_TMO], 1u); break; } }
    }
    nloc = mine > 0u ? mine : 1u; nx = cnt > 0u ? cnt : 1u;
}

__device__ __forceinline__ void xcd_barrier(const XcdBarrier& b) {
    asm volatile("s_waitcnt vmcnt(0)" ::: "memory");
    __syncthreads();
    if (threadIdx.x == 0) {
        unsigned* bar = b.bar;
        __builtin_amdgcn_s_waitcnt(0);
        unsigned nloc = b.st[0], nx = b.st[1];
        if (nloc == 0u) { xcd_barrier_complete(bar, b.x, nloc, nx); b.st[0] = nloc; b.st[1] = nx; }
        const unsigned old = xb_add(&bar[XB_XSUB(b.x)], 1u);
        const unsigned gen = old / nloc;
        if (old + 1u == (gen + 1u) * nloc) {
            __builtin_amdgcn_fence(__ATOMIC_RELEASE, "agent");
            asm volatile("s_waitcnt vmcnt(0)" ::: "memory");
            const unsigned og = xb_add(&bar[XB_TOP], 1u);
            const unsigned tg = og / nx;
            if (og + 1u == (tg + 1u) * nx) xb_add(&bar[XB_TOPGEN], 1u);
            else XB_SPIN(xb_ld(&bar[XB_TOPGEN]) == tg, bar);
            __builtin_amdgcn_fence(__ATOMIC_ACQUIRE, "agent");
            xb_add(&bar[XB_XGEN(b.x)], 1u);
            asm volatile("s_waitcnt vmcnt(0)" ::: "memory");
        } else {
            XB_SPIN(xb_ld(&bar[XB_XGEN(b.x)]) == gen, bar);
            __builtin_amdgcn_fence(__ATOMIC_ACQUIRE, "agent");
            asm volatile("s_waitcnt vmcnt(0)" ::: "memory");
        }
    }
    __syncthreads();
}

#define KIN(i) (kparams()->in[i])
#define WS_ (kparams()->ws)
#define HOUT (kparams()->out)
#define Wb ((bf16_t*)(WS_ + WS_W))
#define XN ((bf16_t*)(WS_ + WS_XN))
#define R1 ((bf16_t*)(WS_ + WS_R1))
#define YA ((bf16_t*)(WS_ + WS_Y))
#define MG ((bf16_t*)(WS_ + WS_MG))
#define CH ((bf16_t*)(WS_ + WS_CH))
#define KCMP ((bf16_t*)(WS_ + WS_KCMP))
#define VCMP ((bf16_t*)(WS_ + WS_VCMP))
#define CB ((float*)(WS_ + WS_CB))
#define CONVERT_LAYER(LL, BV, GV) do { LAS float* scr_ = (LAS float*)lds; int base_ = 0; bf16_t* wl_ = Wb + (size_t)(LL) * W_LAYER; \
    conv_matrix(KIN(3) + (size_t)(LL) * 1024 * 5632, 1024, 5632, 5632, 1, wl_ + W_WI1, base_, scr_, tid, (BV), (GV), KIN(2) + (size_t)((LL) * 4 + 0) * DM); \
    conv_matrix(KIN(4) + (size_t)(LL) * 2816 * 1024, 2816, 1024, 1024, 0, wl_ + W_WO1, base_, scr_, tid, (BV), (GV)); \
    conv_matrix(KIN(5) + (size_t)(LL) * 1024 * DIN, 1024, DIN, DINP, 2, wl_ + W_WIN, base_, scr_, tid, (BV), (GV), KIN(2) + (size_t)((LL) * 4 + 1) * DM); \
    for (int t = 0; t < 2; ++t) conv_matrix(KIN(9) + ((size_t)(LL) * 2 + t) * 2048 * 256, 2048, 256, 256, 0, wl_ + W_CW1 + (size_t)t * 256 * 2048, base_, scr_, tid, (BV), (GV)); \
    for (int t = 0; t < 2; ++t) conv_matrix(KIN(10) + ((size_t)(LL) * 2 + t) * 256 * 64, 256, 64, 256, 3, wl_ + W_CW2 + (size_t)t * 256 * 256, base_, scr_, tid, (BV), (GV)); \
    for (int t = 0; t < 3; ++t) conv_matrix(KIN(12) + ((size_t)(LL) * 3 + t) * 512 * 1024, 512, 1024, 1024, 0, wl_ + W_WBR + (size_t)t * 1024 * 512, base_, scr_, tid, (BV), (GV)); \
    conv_matrix(KIN(13) + (size_t)(LL) * 1024 * 1024, 1024, 1024, 1024, 0, wl_ + W_WOUT, base_, scr_, tid, (BV), (GV)); \
    conv_matrix(KIN(14) + (size_t)(LL) * 1024 * 5632, 1024, 5632, 5632, 1, wl_ + W_WI2, base_, scr_, tid, (BV), (GV), KIN(2) + (size_t)((LL) * 4 + 2) * DM); \
    conv_matrix(KIN(15) + (size_t)(LL) * 2816 * 1024, 2816, 1024, 1024, 0, wl_ + W_WO2, base_, scr_, tid, (BV), (GV)); \
    conv_matrix(KIN(16) + (size_t)(LL) * 256 * 1024, 256, 1024, 1024, 0, wl_ + W_WPE, base_, scr_, tid, (BV), (GV)); \
    conv_matrix(KIN(17) + (size_t)(LL) * 1024 * 1024, 1024, 1024, 1024, 0, wl_ + W_WPG, base_, scr_, tid, (BV), (GV), KIN(2) + (size_t)((LL) * 4 + 3) * DM); } while (0)
#define XN2 ((bf16_t*)(WS_ + WS_XN2))
#define PBF ((bf16_t*)(WS_ + WS_PBF))
#define SSQ ((float*)(WS_ + WS_SSQ))
#define SSQ2 ((float*)(WS_ + WS_SSQ2))
constexpr int LDS_BYTES = 147456;
#ifdef ONLY_EPI
#include <type_traits>
#define ONLY_OK(E) (std::is_same<E, ONLY_EPI>::value)
#else
#define ONLY_OK(E) true
#endif
#ifdef NO_GEMM
#define GEMM(EPI, e, A_, lda_, Bt_, M_, N_, K_, cshift) do { (void)(e); } while (0)
#else
#define GEMM(EPI, e, A_, lda_, Bt_, M_, N_, K_, cshift) do { pg8::Gemm g_{(const bf16_t*)(A_), (const bf16_t*)(Bt_), (M_), (N_), (K_), (lda_)}; pg8::StaticOrder S_; \
    int c_ = (int)((blk + (cshift)) % G), G_ = G; asm volatile("" : "+s"(c_), "+s"(G_)); S_.init((M_), (N_), G_, c_); if (ONLY_OK(EPI)) pg8::gemm_phase<EPI, pg8::StaticOrder, EPI::ALIGN, true>(lds, g_, S_, (e)); } while (0)
#endif

__global__ void __launch_bounds__(NTHR, 2) fwd_kernel(Params P) {
    extern __shared__ __attribute__((aligned(16))) unsigned char lds_raw[];
    LAS uchar* lds = (LAS uchar*)lds_raw;
    cg::grid_group grid = cg::this_grid();
    volatile LAS unsigned* xst = (volatile LAS unsigned*)(lds + LDS_BYTES - 64);
    if (threadIdx.x < 2) xst[threadIdx.x] = 0u;
    __syncthreads();
    const XcdBarrier xbar = xcd_barrier_post((unsigned*)(kparams()->ws + WS_CTL), xst);
#ifndef PROBE_CLASS
#define PROBE_CLASS 0
#endif
#if PROBE_CLASS
    unsigned long long pr_acc = 0, pr_last = __builtin_amdgcn_s_memrealtime();
#define SYNC(cls) do { const unsigned long long t1_ = __builtin_amdgcn_s_memrealtime(); if ((cls) == PROBE_CLASS) pr_acc += t1_ - pr_last; if ((cls) == 6) grid.sync(); else xcd_barrier(xbar); \
    const unsigned long long t2_ = __builtin_amdgcn_s_memrealtime(); if (PROBE_CLASS == 2) pr_acc += t2_ - t1_; pr_last = t2_; } while (0)
#else
#define SYNC(cls) do { if ((cls) == 6) grid.sync(); else xcd_barrier(xbar); } while (0)
#endif
#define DEF_IDS \
    int tid_o = threadIdx.x, G_o = gridDim.x, blk_o = blockIdx.x; asm volatile("" : "+v"(tid_o), "+s"(G_o), "+s"(blk_o)); \
    const int tid = tid_o, lane = tid & 63, wave = __builtin_amdgcn_readfirstlane(tid >> 6); \
    const int G = G_o, blk = blk_o; \
    const int vcu = (G % 8 == 0) ? (blk % 8) * (G / 8) + blk / 8 : blk; \
    const int gw = blk * 8 + wave, ngw = G * 8; (void)vcu; (void)gw; (void)ngw; (void)lane;
    {
        DEF_IDS
        LAS float* scr = (LAS float*)lds;
        const bool offl0 = (G >= 64) && ((G & 1) == 0);
        for (int L = 0; L < (offl0 ? 1 : DEPTH); ++L) CONVERT_LAYER(L, blk, G);
        for (int pr = blk; pr < DEPTH * 2; pr += G) {
            const float* pos = KIN(8) + (size_t)pr * 2048; const float* w1 = KIN(9) + (size_t)pr * 2048 * 256;
            float a[4] = {0.f, 0.f, 0.f, 0.f};
            for (int k = wave * 256; k < wave * 256 + 256; ++k) { const float pv = pos[k];
#pragma unroll
                for (int j = 0; j < 4; ++j) a[j] += pv * w1[(size_t)k * 256 + lane + 64 * j]; }
#pragma unroll
            for (int j = 0; j < 4; ++j) scr[wave * 256 + lane + 64 * j] = a[j];
            __syncthreads();
            if (tid < 256) { float s = 0.f;
#pragma unroll
                for (int ww = 0; ww < 8; ++ww) s += scr[ww * 256 + tid];
                CB[pr * 256 + tid] = s; }
            __syncthreads();
        }
        phase_prep(KIN(0), XN2, SSQ2, gw, ngw, lane);
    }
    SYNC(6);

#pragma unroll 1
    for (int L = 0; L < DEPTH; ++L) {
        DEF_IDS
#define wl (Wb + (size_t)L * W_LAYER)
#define ng (KIN(2) + (size_t)L * 4 * DM)
        { EpiSwiglu e{R1, SSQ2}; GEMM(EpiSwiglu, e, XN2, 1024, wl + W_WI1, T, 5632, 1024, 0); }
        SYNC(3);
        { EpiResid e{0.5f, 0, L == 0 ? 1 : 0}; GEMM(EpiResid, e, R1, DFF, wl + W_WO1, T, 1024, DFF, 0); }
        SYNC(3);
        { EpiZ e{R1, SSQ}; GEMM(EpiZ, e, XN, 1024, wl + W_WIN, TC, DINP, 1024, 0); }
        SYNC(3);
        for (int c = 0; c < NCHUNK; ++c) {
            if (L + 1 < DEPTH && G >= 64 && (G & 1) == 0 && !(blk < 16 || (blk >= G / 2 && blk < G / 2 + 16))) {
                const int idx = blk < G / 2 ? blk - 16 : blk - 32, nidle = G - 32;
                CONVERT_LAYER(L + 1, idx + c * nidle, NCHUNK * nidle);
            }
            { EpiBf<1> ek{CH, 256, CB + (L * 2 + 0) * 256}; GEMM(EpiBf<1>, ek, R1 + ZKCI, 1024, wl + W_CW1, NB * 512, 256, 2048, 0);
              EpiBf<1> ev{CH + (size_t)NB * 512 * 256, 256, CB + (L * 2 + 1) * 256}; GEMM(EpiBf<1>, ev, R1 + ZVCI, 1024, wl + W_CW1 + (size_t)256 * 2048, NB * 512, 256, 2048, G / 2); }
            __builtin_amdgcn_fence(__ATOMIC_RELEASE, "workgroup"); __syncthreads(); __builtin_amdgcn_fence(__ATOMIC_ACQUIRE, "workgroup");
            { EpiCmp2<false> ek{KCMP}; GEMM(EpiCmp2<false>, ek, CH, 256, wl + W_CW2, NB * 512, 256, 256, 0);
              EpiCmp2<true> ev{VCMP}; GEMM(EpiCmp2<true>, ev, CH + (size_t)NB * 512 * 256, 256, wl + W_CW2 + (size_t)256 * 256, NB * 512, 256, 256, G / 2); }
            SYNC(5);
            {
                AttnCtx C;
                C.zb = R1; C.park = (float*)MG; C.ya = YA; C.yb = YA + (size_t)TC * 512; C.yc = YA + (size_t)2 * TC * 512; C.kcmp = KCMP; C.vtcmp = VCMP;
                C.rel_bias = KIN(18); C.lamp = KIN(6) + (size_t)L * 256; C.subln = KIN(7) + (size_t)L * 128; C.sinks = KIN(11) + (size_t)L * 8;
                C.lam_init = 0.8f - 0.6f * __expf(-0.3f * (float)L);
                for (int u = vcu; u < NB * 32; u += G) {
                    const int bl = u >> 5;
#ifndef NO_A
#if PROBE_CLASS == 7
                    const unsigned long long ta0_ = __builtin_amdgcn_s_memrealtime();
#endif
                    { const int h = (u >> 3) & 3, qp = u & 7;
#pragma unroll 1
                      for (int k = 0; k < 2; ++k) attn_unit_A(lds, C, bl, h, k ? 15 - qp : qp, tid); }
#if PROBE_CLASS == 7
                    pr_acc += __builtin_amdgcn_s_memrealtime() - ta0_;
#endif
#endif
                    { const int g = (u >> 4) & 1, is = u & 15;
#ifndef NO_B
#pragma unroll 1
                      for (int k = 0; k < 4; ++k) attn_unit_B(lds, C, bl, g, (k & 1) ? (k == 1 ? 31 : 63) - is : (k == 0 ? 0 : 32) + is, tid);
#endif
#ifndef NO_C
#pragma unroll 1
                      for (int k = 0; k < 4; ++k) attn_unit_C(lds, C, bl, g, (k & 1) ? (k == 1 ? 31 : 63) - is : (k == 0 ? 0 : 32) + is, tid);
#endif
                    }
                }
            }
            SYNC(1);
            for (int mi = 0; mi < 3; ++mi) {
                EpiBranch e{MG, R1 + ZSG, mi}; GEMM(EpiBranch, e, YA + (size_t)mi * TC * 512, 512, wl + W_WBR + (size_t)mi * 1024 * 512, TC, 1024, 512, 0);
            }
            SYNC(3);
            { EpiResid e{1.0f, c * TC, 0}; GEMM(EpiResid, e, MG, 1024, wl + W_WOUT, TC, 1024, 1024, 0); }
            if (c + 1 < NCHUNK) { EpiZ e{R1, SSQ + (size_t)(c + 1) * TC * 16}; GEMM(EpiZ, e, XN + (size_t)(c + 1) * TC * DM, 1024, wl + W_WIN, TC, DINP, 1024, 0); }
            SYNC(3);
        }
        {
            const f32x4* src = (const f32x4*)(KIN(1) + (size_t)L * T * PLE); u32x2* dst = (u32x2*)PBF;
            const int tq = opq(tid);
            for (size_t idx = (size_t)blk * NTHR + tq; idx < (size_t)T * PLE / 4; idx += (size_t)G * NTHR) { const f32x4 v = src[idx]; u32x2 w; w.x = cvtpk(v[0], v[1]); w.y = cvtpk(v[2], v[3]); dst[idx] = w; }
        }
        { EpiSwiglu e{R1, SSQ}; GEMM(EpiSwiglu, e, XN, 1024, wl + W_WI2, T, 5632, 1024, 0); }
        SYNC(3);
        { EpiResid e{0.5f, 0, 0}; GEMM(EpiResid, e, R1, DFF, wl + W_WO2, T, 1024, DFF, 0); }
        SYNC(3);
        { EpiBf<0> e{(bf16_t*)((uchar*)R1 + R1_E), 1024, nullptr}; GEMM(EpiBf<0>, e, PBF, 256, wl + W_WPE, T, 1024, 256, 0); }
        SYNC(3);
        { float* ho_ = HOUT; uchar* ws_ = WS_; EpiPle e{ho_, (const bf16_t*)(ws_ + WS_R1 + R1_E), (const float*)(ws_ + WS_SSQ), (bf16_t*)(ws_ + WS_XN2), (float*)(ws_ + WS_SSQ2)}; GEMM(EpiPle, e, XN, 1024, wl + W_WPG, T, 1024, 1024, 0); }
        SYNC(3);
    }
    { DEF_IDS const int lq = opq(lane); float* ho = HOUT; const float* fg = KIN(19); for (int m = gw; m < T; m += ngw) rms_row_f32(ho + (size_t)m * DM, fg, ho + (size_t)m * DM, lq); }
#if PROBE_CLASS
    if (blockIdx.x == 0) { const unsigned long long t0_ = __builtin_amdgcn_s_memrealtime(); while (__builtin_amdgcn_s_memrealtime() - t0_ < pr_acc) __builtin_amdgcn_s_sleep(20); }
#endif
}

extern "C" void kernel_launch(void* const* d_in, const int* in_sizes, int n_in, void* d_out, int out_size, void* d_ws, size_t ws_size, hipStream_t stream) {
    static int grid = 0;
    if (grid == 0) {
        if (n_in != 20 || out_size != T * DM || ws_size < WS_END) { fprintf(stderr, "kernel_launch: unexpected shapes (n_in %d out %d ws %zu)\n", n_in, out_size, ws_size); grid = -1; return; }
        int dev = 0, cus = 0, per_cu = 0;
        hipGetDevice(&dev);
        hipDeviceGetAttribute(&cus, hipDeviceAttributeMultiprocessorCount, dev);
        if (hipFuncSetAttribute((const void*)fwd_kernel, hipFuncAttributeMaxDynamicSharedMemorySize, LDS_BYTES) != hipSuccess) { fprintf(stderr, "kernel_launch: hipFuncSetAttribute failed\n"); grid = -1; return; }
        if (hipOccupancyMaxActiveBlocksPerMultiprocessor(&per_cu, (const void*)fwd_kernel, NTHR, LDS_BYTES) != hipSuccess || per_cu < 1) { fprintf(stderr, "kernel_launch: occupancy query says %d\n", per_cu); per_cu = 1; }
        (void)hipGetLastError();
        grid = cus;
        if (grid > 256) grid = 256;
    }
    if (grid < 0) return;
    if (hipMemsetAsync((char*)d_ws + WS_CTL, 0, CTL_ZERO_BYTES, stream) != hipSuccess) { fprintf(stderr, "kernel_launch: memset failed\n"); return; }
    Params p{};
    for (int i = 0; i < 20; ++i) p.in[i] = (const float*)d_in[i];
    p.out = (float*)d_out; p.ws = (uchar*)d_ws;
    void* args[] = {&p};
    hipError_t e = hipLaunchCooperativeKernel((const void*)fwd_kernel, dim3(grid), dim3(NTHR), args, LDS_BYTES, stream);
    if (e != hipSuccess) fprintf(stderr, "cooperative launch failed: %s (grid %d)\n", hipGetErrorString(e), grid);
}
```

```cpp
#include <hip/hip_runtime.h>
#include <hip/hip_cooperative_groups.h>
#include <cstdio>
#include <cstdint>
namespace cg = cooperative_groups;
namespace pg8 {
#define PG8_LAS __attribute__((address_space(3)))
typedef unsigned short bf16_t;
typedef short bf16x8 __attribute__((ext_vector_type(8)));
typedef float f32x4 __attribute__((ext_vector_type(4)));
typedef unsigned u32x4 __attribute__((ext_vector_type(4)));
constexpr int BM = 256, BK = 64, HALF = 128, HTB = HALF * BK * 2  , STAGE_BYTES = 8 * HTB, NXCD = 8, WGM = 4;

__host__ __device__ __forceinline__ int lds_byte(int r, int c) { const int st = (r >> 4) * 2 + (c >> 5), rr = r & 15, cc = c & 31, ob = rr * 64 + cc * 2; return st * 1024 + (ob ^ (((ob >> 9) & 1) << 5)); }
__host__ __device__ __forceinline__ void stage_rc(int b, int& R, int& C) { const int st = b / 1024, sb = b % 1024, swz = sb ^ (((sb >> 9) & 1) << 5); R = (st >> 1) * 16 + swz / 64; C = (st & 1) * 32 + (swz % 64) / 2; }
__host__ __device__ __forceinline__ int perm32(int rho) { const int n = rho >> 4, i = rho & 15; return 8 * (i >> 2) + 4 * n + (i & 3); }

struct Unit { int pm, pn; };
struct Gemm { const bf16_t* A; const bf16_t* Bt; int M, N, K, lda; };

struct StaticOrder {
    int nM, nN, nwg, G, c;
    __host__ __device__ void init(int M, int N, int G_, int c_) { nM = M / BM; nN = N / BM; nwg = nM * nN; G = G_; c = c_; }
    __host__ __device__ bool next(int i, Unit& u) const {
        const long L = (long)i * G + c; if (L >= nwg) return false;
        int wgid = (int)L; { const int q = nwg / NXCD, r = nwg % NXCD, xcd = wgid % NXCD, off = wgid / NXCD; wgid = (xcd < r ? xcd * (q + 1) : r * (q + 1) + (xcd - r) * q) + off; }
        const int nig = WGM * nN, gid = wgid / nig, fm = gid * WGM, gsz = (nM - fm) < WGM ? (nM - fm) : WGM;
        u.pm = fm + ((wgid % nig) % gsz); u.pn = (wgid % nig) / gsz; return true;
    }
    __device__ __forceinline__ void a_ready(const Unit&) const {}
    __device__ __forceinline__ void done(const Unit&) const {}
};

__device__ __forceinline__ unsigned cvt_pk_bf16(float lo, float hi) { unsigned r; asm volatile("v_cvt_pk_bf16_f32 %0, %1, %2" : "=v"(r) : "v"(lo), "v"(hi)); return r; }
typedef float f32x2 __attribute__((ext_vector_type(2)));
template <class Epi, class Sched, bool ALIGN_EPI = false, bool SP2 = false>
__device__ __forceinline__ void gemm_phase(PG8_LAS unsigned char* lds, const Gemm g, const Sched& S, const Epi& E) {
    int tid_ = threadIdx.x; asm volatile("" : "+v"(tid_)); const int tid = tid_, wid = __builtin_amdgcn_readfirstlane(tid >> 6), lane = tid & 63, wr = wid >> 2, wc = wid & 3, fr = lane & 15, fq = lane >> 4;
    const int K = g.K, nt = K / BK;
    unsigned voffA[2], voffB[2];
#pragma unroll
    for (int i = 0; i < 2; ++i) { int R, C; stage_rc(tid * 16 + i * 8192, R, C); const int Rb = Epi::PERM ? ((R & ~31) + perm32(R & 31)) : R;
        voffA[i] = (unsigned)(R * g.lda + C) * 2u; voffB[i] = (unsigned)(Rb * K + C) * 2u; }
    const size_t kstep = (size_t)(BK * 2);
    const size_t hstep = (size_t)HALF * K * 2;
    const size_t tstep = 2 * hstep; const size_t hstepA = (size_t)HALF * g.lda * 2, tstepA = 2 * hstepA;
    const unsigned ldsw = (unsigned)wid * 1024u;
    const int aoff = lds_byte(wr * 64 + fr, fq * 8), boff = lds_byte(wc * 32 + fr, fq * 8);
#define PG8_SA(b, h) (((b) * 2 + (h)) * HTB)
#define PG8_SB(b, h) ((4 + (b) * 2 + (h)) * HTB)
#define PG8_STAGE(bufoff, gbase, voff) do { _Pragma("unroll") for (int _i = 0; _i < 2; ++_i) \
        __builtin_amdgcn_global_load_lds((const unsigned*)((const char*)(gbase) + (voff)[_i]), (PG8_LAS unsigned*)(lds + (bufoff) + ldsw + _i * 8192), 16, 0, 0); } while (0)
#define PG8_LDA(dst, b, h) do { _Pragma("unroll") for (int m = 0; m < 4; ++m) _Pragma("unroll") for (int k = 0; k < 2; ++k) dst[m][k] = *(const PG8_LAS bf16x8*)(lds + PG8_SA(b, h) + aoff + m * 2048 + k * 1024); } while (0)
#define PG8_LDB(dst, b, h) do { _Pragma("unroll") for (int n = 0; n < 2; ++n) _Pragma("unroll") for (int k = 0; k < 2; ++k) dst[n][k] = *(const PG8_LAS bf16x8*)(lds + PG8_SB(b, h) + boff + n * 2048 + k * 1024); } while (0)
#define PG8_MMA(ai, bj, At, Bt) do { __builtin_amdgcn_s_setprio(1); _Pragma("unroll") for (int m = 0; m < 4; ++m) _Pragma("unroll") for (int n = 0; n < 2; ++n) _Pragma("unroll") for (int k = 0; k < 2; ++k) \
        acc[ai][bj][m][n] = __builtin_amdgcn_mfma_f32_16x16x32_bf16(Bt[n][k], At[m][k], acc[ai][bj][m][n], 0, 0, 0); __builtin_amdgcn_s_setprio(0); } while (0)
#define PG8_WAIT_V(n) asm volatile("s_waitcnt vmcnt(" #n ")" ::: "memory")
#define PG8_WAIT_L(n) asm volatile("s_waitcnt lgkmcnt(" #n ")" ::: "memory")
#define PG8_BAR __builtin_amdgcn_s_barrier()
#define PG8_SCHED __builtin_amdgcn_sched_barrier(0)
    Unit cur, nxt; int ui = 0;
    if (!S.next(0, cur)) return;
    f32x4 acc[2][2][4][2];
#pragma unroll
    for (int a = 0; a < 2; ++a)
#pragma unroll
        for (int b = 0; b < 2; ++b)
#pragma unroll
            for (int m = 0; m < 4; ++m)
#pragma unroll
                for (int n = 0; n < 2; ++n) acc[a][b][m][n] = (f32x4){0.f, 0.f, 0.f, 0.f};
    bf16x8 At[4][2], B0[2][2], B1[2][2];
    const char* cA = (const char*)g.A + (size_t)cur.pm * tstepA; const char* cB = (const char*)g.Bt + (size_t)cur.pn * tstep;
    S.a_ready(cur);
    if constexpr (SP2) {
        PG8_STAGE(PG8_SB(0, 0), cB, voffB); PG8_STAGE(PG8_SB(0, 1), cB + hstep, voffB); PG8_STAGE(PG8_SA(0, 0), cA, voffA); PG8_STAGE(PG8_SA(0, 1), cA + hstepA, voffA);
        if (wr == 1) PG8_BAR;
        PG8_WAIT_V(2); PG8_BAR;
        PG8_STAGE(PG8_SB(1, 0), cB + kstep, voffB); PG8_STAGE(PG8_SA(1, 0), cA + kstep, voffA); PG8_STAGE(PG8_SB(1, 1), cB + hstep + kstep, voffB);
        PG8_WAIT_V(6); PG8_BAR;
    } else {
        PG8_STAGE(PG8_SB(0, 0), cB, voffB); PG8_STAGE(PG8_SA(0, 0), cA, voffA); PG8_STAGE(PG8_SB(0, 1), cB + hstep, voffB); PG8_STAGE(PG8_SA(0, 1), cA + hstepA, voffA);
        if (wr == 1) PG8_BAR;
        PG8_WAIT_V(4); PG8_BAR;
        PG8_STAGE(PG8_SB(1, 0), cB + kstep, voffB); PG8_STAGE(PG8_SA(1, 0), cA + kstep, voffA); PG8_STAGE(PG8_SB(1, 1), cB + hstep + kstep, voffB);
        PG8_WAIT_V(6); PG8_BAR;
    }
    for (;;) {
        const bool has_next = S.next(ui + 1, nxt);
        const char* nA = has_next ? (const char*)g.A + (size_t)nxt.pm * tstepA : cA; const char* nB = has_next ? (const char*)g.Bt + (size_t)nxt.pn * tstep : cB;
        for (int t = 0; t < nt; t += 2) {
            const bool last = (t == nt - 2);
            const char* a1 = cA + (size_t)(t + 1) * kstep;
            const char* a2 = last ? nA : cA + (size_t)(t + 2) * kstep; const char* b2 = last ? nB : cB + (size_t)(t + 2) * kstep;
            const char* a3 = a2 + kstep; const char* b3 = b2 + kstep;
            if (last && has_next) S.a_ready(nxt);
            if constexpr (SP2) {
            PG8_LDB(B0, 0, 0); PG8_LDB(B1, 0, 1); PG8_SCHED; PG8_LDA(At, 0, 0); PG8_STAGE(PG8_SA(1, 1), a1 + hstepA, voffA);
            PG8_WAIT_V(8); PG8_WAIT_L(0); PG8_BAR; PG8_MMA(0, 0, At, B0); PG8_MMA(0, 1, At, B1); PG8_BAR; PG8_SCHED;
            PG8_LDA(At, 0, 1); PG8_STAGE(PG8_SB(0, 0), b2, voffB); PG8_STAGE(PG8_SB(0, 1), b2 + hstep, voffB); PG8_STAGE(PG8_SA(0, 0), a2, voffA);
            PG8_WAIT_V(8); PG8_WAIT_L(0); PG8_BAR; PG8_MMA(1, 0, At, B0); PG8_MMA(1, 1, At, B1); PG8_BAR; PG8_SCHED;
            PG8_LDB(B0, 1, 0); PG8_LDB(B1, 1, 1); PG8_SCHED; PG8_LDA(At, 1, 0); PG8_STAGE(PG8_SA(0, 1), a2 + hstepA, voffA);
            PG8_WAIT_V(8); PG8_WAIT_L(0); PG8_BAR; PG8_MMA(0, 0, At, B0); PG8_MMA(0, 1, At, B1); PG8_BAR; PG8_SCHED;
            PG8_LDA(At, 1, 1); PG8_STAGE(PG8_SB(1, 0), b3, voffB); PG8_STAGE(PG8_SB(1, 1), b3 + hstep, voffB); PG8_STAGE(PG8_SA(1, 0), a3, voffA);
            PG8_WAIT_V(8); PG8_WAIT_L(0); PG8_BAR; PG8_MMA(1, 0, At, B0); PG8_MMA(1, 1, At, B1); PG8_BAR; PG8_SCHED;
            } else {
            PG8_LDB(B0, 0, 0); PG8_SCHED; PG8_LDA(At, 0, 0); PG8_STAGE(PG8_SA(1, 1), a1 + hstepA, voffA);
            PG8_WAIT_L(8); PG8_BAR; PG8_WAIT_L(0); PG8_MMA(0, 0, At, B0); PG8_BAR; PG8_SCHED;
            PG8_LDB(B1, 0, 1); PG8_STAGE(PG8_SB(0, 0), b2, voffB);
            PG8_BAR; PG8_WAIT_L(0); PG8_MMA(0, 1, At, B1); PG8_BAR;
            PG8_LDA(At, 0, 1); PG8_STAGE(PG8_SA(0, 0), a2, voffA);
            PG8_BAR; PG8_WAIT_L(0); PG8_MMA(1, 0, At, B0); PG8_BAR; PG8_SCHED;
            PG8_STAGE(PG8_SB(0, 1), b2 + hstep, voffB);
            PG8_WAIT_V(6); PG8_BAR; PG8_MMA(1, 1, At, B1); PG8_BAR;
            PG8_LDB(B0, 1, 0); PG8_SCHED; PG8_LDA(At, 1, 0); PG8_STAGE(PG8_SA(0, 1), a2 + hstepA, voffA);
            PG8_WAIT_L(8); PG8_BAR; PG8_WAIT_L(0); PG8_MMA(0, 0, At, B0); PG8_BAR; PG8_SCHED;
            PG8_LDB(B1, 1, 1); PG8_STAGE(PG8_SB(1, 0), b3, voffB);
            PG8_BAR; PG8_WAIT_L(0); PG8_MMA(0, 1, At, B1); PG8_BAR;
            PG8_LDA(At, 1, 1); PG8_STAGE(PG8_SA(1, 0), a3, voffA);
            PG8_BAR; PG8_WAIT_L(0); PG8_MMA(1, 0, At, B0); PG8_BAR; PG8_SCHED;
            PG8_STAGE(PG8_SB(1, 1), b3 + hstep, voffB);
            PG8_WAIT_V(6); PG8_BAR; PG8_MMA(1, 1, At, B1); PG8_BAR;
            }
        }
        if constexpr (ALIGN_EPI) { if (wr == 0) PG8_BAR; }
        if constexpr (!Epi::AFTER_DRAIN) { E(acc, cur, wr, wc, fr, fq); S.done(cur); }
        if (!has_next) break;
#pragma unroll
        for (int a = 0; a < 2; ++a)
#pragma unroll
            for (int b = 0; b < 2; ++b)
#pragma unroll
                for (int m = 0; m < 4; ++m)
#pragma unroll
                    for (int n = 0; n < 2; ++n) acc[a][b][m][n] = (f32x4){0.f, 0.f, 0.f, 0.f};
        cur = nxt; cA = nA; cB = nB; ++ui;
        if constexpr (ALIGN_EPI) { if (wr == 1) PG8_BAR; }
    }
    PG8_WAIT_V(0);
    if constexpr (!ALIGN_EPI) { if (wr == 0) PG8_BAR; }
    PG8_BAR;
    if constexpr (Epi::AFTER_DRAIN) { E.fused(acc, cur, wr, wc, fr, fq, lds, wid, lane); S.done(cur); }
#undef PG8_SA
#undef PG8_SB
#undef PG8_STAGE
#undef PG8_LDA
#undef PG8_LDB
#undef PG8_MMA
#undef PG8_WAIT_V
#undef PG8_WAIT_L
#undef PG8_BAR
#undef PG8_SCHED
}
}

#define LAS __attribute__((address_space(3)))
using pg8::bf16_t; using pg8::bf16x8; using pg8::f32x4; using pg8::u32x4;
typedef float f32x16 __attribute__((ext_vector_type(16)));
typedef unsigned u32x2 __attribute__((ext_vector_type(2)));
typedef unsigned char uchar;
typedef float f32x2_t __attribute__((ext_vector_type(2)));
typedef __bf16 bf16x2_t __attribute__((ext_vector_type(2)));

constexpr int DM = 1024, NBATCH = 16, SEQ = 4096, DEPTH = 4, PLE = 256, DFF = 2816;
constexpr int T = NBATCH * SEQ;
constexpr int NB = 8, TC = NB * SEQ, NCHUNK = NBATCH / NB;
constexpr int DIN = 6680, DINP = 6912;
constexpr float EPS = 1e-6f, LOG2E = 1.4426950408889634f;
constexpr int NTHR = 512;

constexpr size_t W_WI1 = 0, W_WO1 = W_WI1 + (size_t)5632 * 1024, W_WIN = W_WO1 + (size_t)1024 * 2816, W_CW1 = W_WIN + (size_t)DINP * 1024,
                 W_CW2 = W_CW1 + (size_t)2 * 256 * 2048, W_WBR = W_CW2 + (size_t)2 * 256 * 256, W_WOUT = W_WBR + (size_t)3 * 1024 * 512,
                 W_WI2 = W_WOUT + (size_t)1024 * 1024, W_WO2 = W_WI2 + (size_t)5632 * 1024, W_WPE = W_WO2 + (size_t)1024 * 2816,
                 W_WPG = W_WPE + (size_t)1024 * 256, W_LAYER = W_WPG + (size_t)1024 * 1024;
static_assert(W_LAYER == 29491200, "weights");
constexpr size_t MiB = 1u << 20;
constexpr size_t WS_W = 0, WS_XN = 226 * MiB, WS_R1 = 354 * MiB, WS_Y = 782 * MiB, WS_MG = 878 * MiB, WS_CH = 942 * MiB, WS_KCMP = 946 * MiB,
                 WS_VCMP = WS_KCMP + MiB / 2, WS_CB = 947 * MiB, WS_SSQ = 948 * MiB, WS_SSQ2 = 952 * MiB, WS_CTL = 956 * MiB, WS_END = 957 * MiB;
constexpr size_t CTL_ZERO_BYTES = 65536;
constexpr size_t WS_XN2 = WS_Y, WS_PBF = WS_Y + 128 * MiB;
static_assert(W_LAYER * 2 * DEPTH <= WS_XN, "w");
constexpr size_t HS = 262144;
constexpr size_t ZQA = 0, ZKA = ZQA + NB * 8 * HS, ZVA = ZKA + NB * 8 * HS, ZQB = ZVA + NB * 8 * HS, ZKCI = ZQB + NB * 8 * HS, ZVCI = ZKCI + NB * 2 * HS,
                 ZKS = ZVCI + NB * 2 * HS, ZVS = ZKS + NB * 2 * HS, ZKW = ZVS + NB * 2 * HS, ZVW = ZKW + NB * 2 * HS, ZQC = ZVW + NB * 2 * HS,
                 ZKC = ZQC + NB * 8 * HS, ZVC = ZKC + NB * 2 * HS, ZSG = ZVC + NB * 2 * HS, ZBG = ZSG + (size_t)TC * 3072, ZEND = ZBG + (size_t)TC * 32 * 2;
static_assert(ZEND * 2 <= 428 * MiB, "zbuf");
static_assert((size_t)T * DFF * 2 <= 428 * MiB, "act");
constexpr size_t R1_E = 0;

struct Params {
    const float* in[20];
    float* out;
    uchar* ws;
};

__device__ __forceinline__ unsigned cvtpk(float lo, float hi) { f32x2_t v = {lo, hi}; bf16x2_t b = __builtin_convertvector(v, bf16x2_t); return __builtin_bit_cast(unsigned, b); }
__device__ __forceinline__ bf16_t cvt1(float x) { return (bf16_t)(cvtpk(x, 0.f) & 0xffffu); }
__device__ __forceinline__ float bf2f(unsigned short b) { return __uint_as_float((unsigned)b << 16); }
__device__ __forceinline__ float wave_sum(float v) {
#pragma unroll
    for (int o = 1; o < 64; o <<= 1) v += __shfl_xor(v, o);
    return v;
}
__device__ __forceinline__ int opq(int v) { asm volatile("" : "+v"(v)); return v; }
__device__ __forceinline__ float sigm(float x) { return __builtin_amdgcn_rcpf(1.f + __builtin_amdgcn_exp2f(-x * LOG2E)); }
__device__ __forceinline__ float gelu_tanh(float x) { const float u = 0.7978845608028654f * (x + 0.044715f * x * x * x); const float e = __builtin_amdgcn_exp2f(-2.f * LOG2E * u); const float th = 2.f * __builtin_amdgcn_rcpf(1.f + e) - 1.f; return 0.5f * x * (1.f + th); }

typedef const __attribute__((address_space(4))) Params* KParPtr;
__device__ __forceinline__ KParPtr kparams() { auto p = __builtin_amdgcn_kernarg_segment_ptr(); asm volatile("" : "+s"(p)); return (KParPtr)p; }
#ifndef ALIGN_T
#define ALIGN_T false
#endif
#ifndef ALIGN_F
#define ALIGN_F true
#endif
#ifndef ALIGN_SW
#define ALIGN_SW true
#endif
#ifndef ALIGN_BR
#define ALIGN_BR true
#endif
#ifndef ALIGN_Z
#define ALIGN_Z true
#endif
__device__ __forceinline__ float row_rstd(const float* ssq, int row) {
    const f32x4* p = (const f32x4*)(ssq + (size_t)row * 16); const f32x4 a = p[0], b = p[1], c = p[2], d = p[3];
    const float sm = (((a[0] + a[1]) + (a[2] + a[3])) + ((b[0] + b[1]) + (b[2] + b[3]))) + (((c[0] + c[1]) + (c[2] + c[3])) + ((d[0] + d[1]) + (d[2] + d[3])));
    return 1.0f / sqrtf(sm * (1.f / 1024.f) + 1e-6f);
}
typedef const pg8::f32x4 (&AccRef)[2][2][4][2];
__device__ __forceinline__ void wave_rstd(const float* ssq, int rowbase, float (&rsl)[2]) {
    const int lane = threadIdx.x & 63;
    rsl[0] = row_rstd(ssq, rowbase + lane); rsl[1] = row_rstd(ssq, rowbase + 128 + lane);
}
struct EpiSwiglu {
    static constexpr bool PERM = true, AFTER_DRAIN = false, ALIGN = ALIGN_SW;
    bf16_t* O; const float* ssq;
    __device__ __forceinline__ void operator()(AccRef acc, const pg8::Unit& u, int wr, int wc, int fr, int fq) const {
        asm volatile("" : "+v"(fr), "+v"(fq));
        const int row0 = u.pm * 256 + wr * 64 + fr, col0 = u.pn * 128 + wc * 32 + 8 * fq;
        float rsl[2]; wave_rstd(ssq, u.pm * 256 + wr * 64, rsl);
#pragma unroll
        for (int ai = 0; ai < 2; ++ai)
#pragma unroll
            for (int m = 0; m < 4; ++m) {
                bf16_t* rp = O + (size_t)(row0 + ai * 128 + m * 16) * DFF + col0;
                const float rs = __shfl(rsl[ai], 16 * m + fr);
                float o[8];
#pragma unroll
                for (int n = 0; n < 2; ++n)
#pragma unroll
                    for (int e = 0; e < 4; ++e) { const float g = acc[ai][0][m][n][e] * rs, up = acc[ai][1][m][n][e] * rs; o[n * 4 + e] = g * sigm(g) * up; }
                u32x4 w; w.x = cvtpk(o[0], o[1]); w.y = cvtpk(o[2], o[3]); w.z = cvtpk(o[4], o[5]); w.w = cvtpk(o[6], o[7]);
                *(u32x4*)rp = w;
            }
    }
};
struct EpiResid {
    static constexpr bool PERM = false, AFTER_DRAIN = false, ALIGN = ALIGN_F;
    float alpha; int row_off; int first;
    __device__ __forceinline__ void operator()(AccRef acc, const pg8::Unit& u, int wr, int wc, int fr, int fq) const {
        asm volatile("" : "+v"(fr), "+v"(fq));
        const int row0 = row_off + u.pm * 256 + wr * 64 + fr, col0 = u.pn * 256 + wc * 32 + 4 * fq;
        float* out = kparams()->out; const float* in = first ? kparams()->in[0] : (const float*)out;
        uchar* wsb = kparams()->ws; bf16_t* hb = (bf16_t*)(wsb + WS_XN); float* ssq = (float*)(wsb + WS_SSQ);
#pragma unroll
        for (int ai = 0; ai < 2; ++ai)
#pragma unroll
            for (int m = 0; m < 4; ++m) {
                const size_t off = (size_t)(row0 + ai * 128 + m * 16) * DM + col0;
                float sq = 0.f;
#pragma unroll
                for (int bj = 0; bj < 2; ++bj)
#pragma unroll
                    for (int n = 0; n < 2; ++n) { const f32x4 b = *(const f32x4*)(in + off + bj * 128 + n * 16); const f32x4 v = b + acc[ai][bj][m][n] * alpha; *(f32x4*)(out + off + bj * 128 + n * 16) = v;
                        u32x2 w; w.x = cvtpk(v[0], v[1]); w.y = cvtpk(v[2], v[3]); *(u32x2*)(hb + off + bj * 128 + n * 16) = w; sq += (v[0] * v[0] + v[1] * v[1]) + (v[2] * v[2] + v[3] * v[3]); }
                sq += __shfl_xor(sq, 16); sq += __shfl_xor(sq, 32);
                if (fq == 0) ssq[(size_t)(row0 + ai * 128 + m * 16) * 16 + u.pn * 4 + wc] = sq;

            }
    }
};
struct EpiPle {
    static constexpr bool PERM = false, AFTER_DRAIN = false, ALIGN = ALIGN_F;
    float* h; const bf16_t* E; const float* ssq_in; bf16_t* hb; float* ssq_out;
    __device__ __forceinline__ void operator()(AccRef acc, const pg8::Unit& u, int wr, int wc, int fr, int fq) const {
        asm volatile("" : "+v"(fr), "+v"(fq));
        const int row0 = u.pm * 256 + wr * 64 + fr, col0 = u.pn * 256 + wc * 32 + 4 * fq;
        float rsl[2]; wave_rstd(ssq_in, u.pm * 256 + wr * 64, rsl);
#pragma unroll
        for (int ai = 0; ai < 2; ++ai)
#pragma unroll
            for (int m = 0; m < 4; ++m) {
                const size_t off = (size_t)(row0 + ai * 128 + m * 16) * DM + col0;
                const float rs = __shfl(rsl[ai], 16 * m + fr);
                float sq = 0.f;
#pragma unroll
                for (int bj = 0; bj < 2; ++bj)
#pragma unroll
                    for (int n = 0; n < 2; ++n) {
                        const size_t o2 = off + bj * 128 + n * 16;
                        const u32x2 ev = *(const u32x2*)(E + o2); f32x4 b = *(const f32x4*)(h + o2); const f32x4 a = acc[ai][bj][m][n];
                        b[0] += sigm(a[0] * rs) * __uint_as_float(ev.x << 16); b[1] += sigm(a[1] * rs) * __uint_as_float(ev.x & 0xffff0000u);
                        b[2] += sigm(a[2] * rs) * __uint_as_float(ev.y << 16); b[3] += sigm(a[3] * rs) * __uint_as_float(ev.y & 0xffff0000u);
                        *(f32x4*)(h + o2) = b;
                        u32x2 w; w.x = cvtpk(b[0], b[1]); w.y = cvtpk(b[2], b[3]); *(u32x2*)(hb + o2) = w; sq += (b[0] * b[0] + b[1] * b[1]) + (b[2] * b[2] + b[3] * b[3]);
                    }
                sq += __shfl_xor(sq, 16); sq += __shfl_xor(sq, 32);
                if (fq == 0) ssq_out[(size_t)(row0 + ai * 128 + m * 16) * 16 + u.pn * 4 + wc] = sq;

            }
    }
};
template <int MODE> struct EpiBf {
    static constexpr bool PERM = true, AFTER_DRAIN = false, ALIGN = ALIGN_T;
    bf16_t* O; int ldc; const float* bias;
    __device__ __forceinline__ void operator()(AccRef acc, const pg8::Unit& u, int wr, int wc, int fr, int fq) const {
        asm volatile("" : "+v"(fr), "+v"(fq));
        const int row0 = u.pm * 256 + wr * 64 + fr, col0 = u.pn * 256 + wc * 32 + 8 * fq;
#pragma unroll
        for (int bj = 0; bj < 2; ++bj) {
            float bv[8];
#pragma unroll
            for (int e = 0; e < 8; ++e) bv[e] = MODE == 1 ? bias[col0 + bj * 128 + e] : 0.f;
#pragma unroll
            for (int ai = 0; ai < 2; ++ai)
#pragma unroll
                for (int m = 0; m < 4; ++m) {
                    float o[8];
#pragma unroll
                    for (int n = 0; n < 2; ++n)
#pragma unroll
                        for (int e = 0; e < 4; ++e) { float v = acc[ai][bj][m][n][e] + bv[n * 4 + e]; if (MODE == 1) v = gelu_tanh(v); o[n * 4 + e] = v; }
                    u32x4 w; w.x = cvtpk(o[0], o[1]); w.y = cvtpk(o[2], o[3]); w.z = cvtpk(o[4], o[5]); w.w = cvtpk(o[6], o[7]);
                    *(u32x4*)(O + (size_t)(row0 + ai * 128 + m * 16) * ldc + col0 + bj * 128) = w;
                }
        }
    }
};
template <bool VT> struct EpiCmp2 {
    static constexpr bool PERM = true, AFTER_DRAIN = false, ALIGN = ALIGN_T;
    bf16_t* O;
    __device__ __forceinline__ void operator()(AccRef acc, const pg8::Unit& u, int wr, int wc, int fr, int fq) const {
        asm volatile("" : "+v"(fr), "+v"(fq));
        if (u.pn != 0 || wc >= 2) return;
        const int row0 = u.pm * 256 + wr * 64 + fr, d0 = wc * 32 + 8 * fq;
#pragma unroll
        for (int ai = 0; ai < 2; ++ai)
#pragma unroll
            for (int m = 0; m < 4; ++m) {
                const int row = row0 + ai * 128 + m * 16, bg = row >> 8, n = row & 255;
                float o[8];
#pragma unroll
                for (int nn = 0; nn < 2; ++nn)
#pragma unroll
                    for (int e = 0; e < 4; ++e) o[nn * 4 + e] = (n == 255) ? 0.f : acc[ai][0][m][nn][e];
                if (!VT) { u32x4 w; w.x = cvtpk(o[0], o[1]); w.y = cvtpk(o[2], o[3]); w.z = cvtpk(o[4], o[5]); w.w = cvtpk(o[6], o[7]); *(u32x4*)(O + (size_t)row * 64 + d0) = w; }
                else {
#pragma unroll
                    for (int e = 0; e < 8; ++e) O[((size_t)bg * 64 + d0 + e) * 256 + n] = cvt1(o[e]);
                }
            }
    }
};
struct EpiBranch {
    static constexpr bool PERM = true, AFTER_DRAIN = false, ALIGN = ALIGN_BR;
    bf16_t* mg; const bf16_t* sg; int mi;
    __device__ __forceinline__ void operator()(AccRef acc, const pg8::Unit& u, int wr, int wc, int fr, int fq) const {
        asm volatile("" : "+v"(fr), "+v"(fq));
        const int row0 = u.pm * 256 + wr * 64 + fr, col0 = u.pn * 256 + wc * 32 + 8 * fq;
#pragma unroll
        for (int ai = 0; ai < 2; ++ai)
#pragma unroll
            for (int m = 0; m < 4; ++m) {
                const int row = row0 + ai * 128 + m * 16;
#pragma unroll
                for (int bj = 0; bj < 2; ++bj) {
                    const int col = col0 + bj * 128;
                    const u32x4 gv = *(const u32x4*)(sg + (size_t)row * 3072 + mi * 1024 + col);
                    u32x4 ov = (u32x4){0u, 0u, 0u, 0u};
                    if (mi != 0) ov = *(const u32x4*)(mg + (size_t)row * DM + col);
                    float o[8];
#pragma unroll
                    for (int q = 0; q < 4; ++q) {
                        const unsigned gq = gv[q], oq = ov[q];
                        const float a0 = acc[ai][bj][m][q >> 1][(q & 1) * 2], a1 = acc[ai][bj][m][q >> 1][(q & 1) * 2 + 1];
                        o[2 * q] = __uint_as_float(oq << 16) + __uint_as_float(gq << 16) * a0;
                        o[2 * q + 1] = __uint_as_float(oq & 0xffff0000u) + __uint_as_float(gq & 0xffff0000u) * a1;
                    }
                    u32x4 w; w.x = cvtpk(o[0], o[1]); w.y = cvtpk(o[2], o[3]); w.z = cvtpk(o[4], o[5]); w.w = cvtpk(o[6], o[7]);
                    *(u32x4*)(mg + (size_t)row * DM + col) = w;
                }

            }
    }
};
struct EpiZ {
    static constexpr bool PERM = true, AFTER_DRAIN = false, ALIGN = ALIGN_Z;
    bf16_t* zb; const float* ssq;
    __device__ __forceinline__ void operator()(AccRef acc, const pg8::Unit& u, int wr, int wc, int fr, int fq) const {
        asm volatile("" : "+v"(fr), "+v"(fq));
        const int pn = u.pn;
        float rsl[2]; wave_rstd(ssq, u.pm * 256 + wr * 64, rsl);
#pragma unroll
        for (int bj = 0; bj < 2; ++bj) {
            const int ch = 2 * bj + (wc >> 1), d0 = (wc & 1) * 32 + 8 * fq;
            size_t off = 0, bs = 8 * HS; int mode = 0;
            if (pn < 2) { off = ZQA + (size_t)(pn * 4 + ch) * HS; }
            else if (pn < 4) { off = ZKA + (size_t)((pn - 2) * 4 + ch) * HS; }
            else if (pn < 6) { off = ZVA + (size_t)((pn - 4) * 4 + ch) * HS; mode = 1; }
            else if (pn < 8) { off = ZQB + (size_t)((pn - 6) * 4 + ch) * HS; }
            else if (pn == 8) { bs = 2 * HS; off = (ch < 2) ? ZKCI + (size_t)ch * HS : ZVCI + (size_t)(ch - 2) * HS; }
            else if (pn == 9) { bs = 2 * HS; if (ch < 2) off = ZKS + (size_t)ch * HS; else { off = ZVS + (size_t)(ch - 2) * HS; mode = 1; } }
            else if (pn == 10) { bs = 2 * HS; if (ch < 2) off = ZKW + (size_t)ch * HS; else { off = ZVW + (size_t)(ch - 2) * HS; mode = 1; } }
            else if (pn < 13) { off = ZQC + (size_t)((pn - 11) * 4 + ch) * HS; }
            else if (pn == 13) { bs = 2 * HS; if (ch < 2) off = ZKC + (size_t)ch * HS; else { off = ZVC + (size_t)(ch - 2) * HS; mode = 1; } }
            else if (pn < 26) mode = 2;
            else mode = 3;
#pragma unroll
            for (int ai = 0; ai < 2; ++ai)
#pragma unroll
                for (int m = 0; m < 4; ++m) {
                    const int tl = u.pm * 256 + ai * 128 + wr * 64 + m * 16 + fr, bl = tl >> 12, s = tl & 4095;
                    const float rs = __shfl(rsl[ai], 16 * m + fr);
                    float o[8];
#pragma unroll
                    for (int n = 0; n < 2; ++n)
#pragma unroll
                        for (int e = 0; e < 4; ++e) o[n * 4 + e] = acc[ai][bj][m][n][e] * rs;
                    if (mode == 0) {
                        u32x4 w; w.x = cvtpk(o[0], o[1]); w.y = cvtpk(o[2], o[3]); w.z = cvtpk(o[4], o[5]); w.w = cvtpk(o[6], o[7]);
                        *(u32x4*)(zb + off + (size_t)bl * bs + (size_t)s * 64 + d0) = w;
                    } else if (mode == 1) {
                        bf16_t* p = zb + off + (size_t)bl * bs + (size_t)d0 * 4096 + s;
#pragma unroll
                        for (int e = 0; e < 8; ++e) p[(size_t)e * 4096] = cvt1(o[e]);
                    } else if (mode == 2) {
#pragma unroll
                        for (int e = 0; e < 8; ++e) o[e] = sigm(o[e]);
                        u32x4 w; w.x = cvtpk(o[0], o[1]); w.y = cvtpk(o[2], o[3]); w.z = cvtpk(o[4], o[5]); w.w = cvtpk(o[6], o[7]);
                        *(u32x4*)(zb + ZSG + (size_t)tl * 3072 + (pn - 14) * 256 + bj * 128 + wc * 32 + 8 * fq) = w;
                    } else {
                        const int cc = bj * 128 + wc * 32 + 8 * fq;
                        if (cc < 24) {
                            float* bgp = (float*)(zb + ZBG) + (size_t)tl * 32 + cc;
                            *(f32x4*)bgp = (f32x4){sigm(o[0]), sigm(o[1]), sigm(o[2]), sigm(o[3])};
                            *(f32x4*)(bgp + 4) = (f32x4){sigm(o[4]), sigm(o[5]), sigm(o[6]), sigm(o[7])};
                        }
                    }
                }
        }
    }
};

__device__ __forceinline__ void rms_row_bf16(const float* xrow, const float* g, bf16_t* orow, int lane) {
    const f32x4* xr = (const f32x4*)xrow + lane; f32x4 v[4]; float s = 0.f;
#pragma unroll
    for (int j = 0; j < 4; ++j) { v[j] = xr[64 * j]; s += (v[j][0] * v[j][0] + v[j][1] * v[j][1]) + (v[j][2] * v[j][2] + v[j][3] * v[j][3]); }
    const float rstd = 1.0f / sqrtf(wave_sum(s) * (1.f / DM) + EPS);
    u32x2* o8 = (u32x2*)orow + lane;
#pragma unroll
    for (int j = 0; j < 4; ++j) { const f32x4 gg = ((const f32x4*)g)[lane + 64 * j]; u32x2 w; w.x = cvtpk(v[j][0] * rstd * gg[0], v[j][1] * rstd * gg[1]); w.y = cvtpk(v[j][2] * rstd * gg[2], v[j][3] * rstd * gg[3]); o8[64 * j] = w; }
}
__device__ __forceinline__ void rms_row_f32(const float* xrow, const float* g, float* orow, int lane) {
    const f32x4* xr = (const f32x4*)xrow + lane; f32x4 v[4]; float s = 0.f;
#pragma unroll
    for (int j = 0; j < 4; ++j) { v[j] = xr[64 * j]; s += (v[j][0] * v[j][0] + v[j][1] * v[j][1]) + (v[j][2] * v[j][2] + v[j][3] * v[j][3]); }
    const float rstd = 1.0f / sqrtf(wave_sum(s) * (1.f / DM) + EPS);
#pragma unroll
    for (int j = 0; j < 4; ++j) { const f32x4 gg = ((const f32x4*)g)[lane + 64 * j]; ((f32x4*)orow)[lane + 64 * j] = (v[j] * rstd) * gg; }
}
__device__ __forceinline__ void phase_prep(const float* src, bf16_t* dst, float* ssq, int gw, int ngw, int lane) {
    lane = opq(lane);
    for (int m = gw; m < T; m += ngw) {
        const f32x4* xr = (const f32x4*)(src + (size_t)m * DM) + lane; u32x2* o8 = (u32x2*)(dst + (size_t)m * DM) + lane; float s = 0.f;
#pragma unroll
        for (int j = 0; j < 4; ++j) { const f32x4 v = xr[64 * j]; s += (v[0] * v[0] + v[1] * v[1]) + (v[2] * v[2] + v[3] * v[3]); u32x2 w; w.x = cvtpk(v[0], v[1]); w.y = cvtpk(v[2], v[3]); o8[64 * j] = w; }
        s = wave_sum(s);
        if (lane < 16) ssq[(size_t)m * 16 + lane] = lane == 0 ? s : 0.f;
    }
}
__device__ __forceinline__ void phase_rms(const float* src, const float* g, bf16_t* dst, int gw, int ngw, int lane) {
    lane = opq(lane);
    for (int m = gw; m < T; m += ngw) rms_row_bf16(src + (size_t)m * DM, g, dst + (size_t)m * DM, lane);
}

__device__ __forceinline__ int srccol(int mode, int n) {
    if (mode == 0) return n;
    if (mode == 1) return ((n >> 7) & 1) * DFF + (n >> 8) * 128 + (n & 127);
    if (mode == 2) return n < 2816 ? n : (n < 6656 ? n + 24 : (n < 6680 ? 2816 + (n - 6656) : -1));
    return n < 64 ? n : -1;
}
__device__ __forceinline__ void conv_matrix(const float* src, int K, int ld, int Ndst, int mode, bf16_t* dst, int& base, LAS float* scr, int tid, int blk, int G, const float* gk = nullptr) {
    tid = opq(tid);
    const int ntn = Ndst / 64, ntiles = (K / 128) * ntn;
    int start = (blk - (base % G) + G) % G;
    for (int t = start; t < ntiles; t += G) {
        const int k0 = (t / ntn) * 128, n0 = (t % ntn) * 64;
        { const int kr = tid >> 6, n = tid & 63; const int col = srccol(mode, n0 + n);
          float v[16];
#pragma unroll
          for (int kk = 0; kk < 16; ++kk) { const int k = kr + 8 * kk; v[kk] = col >= 0 ? src[(size_t)(k0 + k) * ld + col] : 0.f; }
#pragma unroll
          for (int kk = 0; kk < 16; ++kk) { const int k = kr + 8 * kk; scr[k * 65 + n] = gk ? v[kk] * gk[k0 + k] : v[kk]; } }
        __syncthreads();
        { const int n = tid >> 3, ks = tid & 7;
#pragma unroll
          for (int h2 = 0; h2 < 2; ++h2) { const LAS float* sp = scr + (64 * h2 + 8 * ks) * 65 + n;
            u32x4 w; w.x = cvtpk(sp[0], sp[65]); w.y = cvtpk(sp[130], sp[195]); w.z = cvtpk(sp[260], sp[325]); w.w = cvtpk(sp[390], sp[455]);
            *(u32x4*)(dst + (size_t)(n0 + n) * K + k0 + 64 * h2 + 8 * ks) = w; } }
        __syncthreads();
    }
    base += ntiles;
}

constexpr int KP = 144;
constexpr int VP = 144;
constexpr int L_K0 = 0, L_K1 = 9216, L_V0 = 18432, L_V1 = 36864, L_TBL = 55296, L_IMP = 57344, L_SEL = 73984, L_RED = 74496;
constexpr float SC = 0.125f * LOG2E;
constexpr float MINIT = -10000.f, MASKED = -1e30f;

__device__ __forceinline__ int t5_bucket(int n) {
    if (n < 16) return n;
    int b = 16;
    b += (n >= 19); b += (n >= 21); b += (n >= 24); b += (n >= 27); b += (n >= 31); b += (n >= 35); b += (n >= 40); b += (n >= 46);
    b += (n >= 52); b += (n >= 59); b += (n >= 67); b += (n >= 77); b += (n >= 87); b += (n >= 99); b += (n >= 113);
    return b;
}
__device__ __forceinline__ void build_tbl(LAS uchar* lds, const float* rel_bias, int col0, int nh, int tid) {
    const int hd = tid >> 7, idx = tid & 127;
    if (hd < nh && idx < 114) ((LAS float*)(lds + L_TBL))[hd * 128 + idx] = rel_bias[t5_bucket(idx) * 20 + col0 + hd] * LOG2E;
}

template <int DV> struct TileRegs { u32x4 k; u32x4 v[DV / 64]; };
template <int DV, bool HASV>
__device__ __forceinline__ void tile_gload(TileRegs<DV>& r, const bf16_t* Kg, const bf16_t* Vt, int vpitch, int kt, int tid) {
    const int row = tid >> 3, seg = tid & 7;
    r.k = *(const u32x4*)(Kg + (size_t)(kt * 64 + row) * 64 + seg * 8);
    if (HASV) {
#pragma unroll
        for (int j = 0; j < DV / 64; ++j) r.v[j] = *(const u32x4*)(Vt + (size_t)(row + 64 * j) * vpitch + kt * 64 + seg * 8);
    }
}
template <int DV, bool HASV>
__device__ __forceinline__ void tile_swrite(const TileRegs<DV>& r, LAS uchar* lds, int buf, int tid) {
    const int row = tid >> 3, seg = tid & 7;
    *(LAS u32x4*)(lds + (buf ? L_K1 : L_K0) + row * KP + seg * 16) = r.k;
    if (HASV) {
#pragma unroll
        for (int j = 0; j < DV / 64; ++j) { LAS uchar* p = lds + (buf ? L_V1 : L_V0) + (row + 64 * j) * VP + (seg >> 1) * 32 + (seg & 1) * 8; *(LAS u32x2*)p = (u32x2){r.v[j].x, r.v[j].y}; *(LAS u32x2*)(p + 16) = (u32x2){r.v[j].z, r.v[j].w}; }
    }
}

template <int DV, bool IMPP>
__device__ __forceinline__ void attn_pass(LAS uchar* lds, const bf16_t* Kg, const bf16_t* Vt, int vpitch, int kt0, int kt1, int wave_kt_max,
                                          int qpos, int qmin_w, int qmax_w, int kmul, int kadd, unsigned W, bf16x8 (&q)[4], int tbl,
                                          unsigned long long selmask, bool use_sel, float& m, float& l, f32x16 (&acc)[DV / 32],
                                          float inv_l, int imp_row, float rel_far, int tid) {
    const int lane = tid & 63, n = lane & 31, hi = lane >> 5;
    TileRegs<DV> tr;
    if (kt0 >= kt1) return;
    float tfar = rel_far;
    asm volatile("s_waitcnt vmcnt(0)" ::: "memory");
    asm volatile("" : "+v"(q[0]), "+v"(q[1]), "+v"(q[2]), "+v"(q[3]), "+v"(tfar), "+v"(m), "+v"(l), "+v"(inv_l));
    tile_gload<DV, !IMPP>(tr, Kg, Vt, vpitch, kt0, tid);
    tile_swrite<DV, !IMPP>(tr, lds, 0, tid);
    __syncthreads();
    for (int kt = kt0; kt < kt1; ++kt) {
        const int cur = (kt - kt0) & 1;
        const bool more = kt + 1 < kt1;
        if (more) tile_gload<DV, !IMPP>(tr, Kg, Vt, vpitch, kt + 1, tid);
        if (kt <= wave_kt_max && (!use_sel || __builtin_amdgcn_ballot_w64((selmask >> kt) & 1ull) != 0ull)) {
            f32x16 s[2];
#pragma unroll
            for (int r = 0; r < 16; ++r) { s[0][r] = 0.f; s[1][r] = 0.f; }
            const LAS uchar* kb = lds + (cur ? L_K1 : L_K0) + n * KP + hi * 16;
#pragma unroll
            for (int ks = 0; ks < 4; ++ks) {
                const bf16x8 a0 = *(const LAS bf16x8*)(kb + ks * 32);
                const bf16x8 a1 = *(const LAS bf16x8*)(kb + 32 * KP + ks * 32);
                s[0] = __builtin_amdgcn_mfma_f32_32x32x16_bf16(a0, q[ks], s[0], 0, 0, 0);
                s[1] = __builtin_amdgcn_mfma_f32_32x32x16_bf16(a1, q[ks], s[1], 0, 0, 0);
            }
            const bool lane_ok = !use_sel || ((selmask >> kt) & 1ull);
            const bool fast = (qmin_w - (kmul * (64 * kt + 63) + kadd) >= 113) && ((unsigned)(qmax_w - (kmul * 64 * kt + kadd)) < W);
            if (fast) {
                const float cfar = lane_ok ? tfar - m : MASKED;
                const float scl = lane_ok ? SC : 0.f;
#pragma unroll
                for (int hh = 0; hh < 2; ++hh)
#pragma unroll
                    for (int r = 0; r < 16; ++r) s[hh][r] = s[hh][r] * scl + cfar;
            } else {
                int dq = qpos - kadd - kmul * (kt * 64 + 4 * hi);
                asm volatile("" : "+v"(dq));
                const unsigned Wl = lane_ok ? W : 0u;
                const LAS uchar* tb = lds + tbl;
#pragma unroll
                for (int hh = 0; hh < 2; ++hh)
#pragma unroll
                    for (int r = 0; r < 16; ++r) {
                        const int kk = 32 * hh + 8 * (r >> 2) + (r & 3);
                        const int dist = dq - kmul * kk;
                        const unsigned ud = (unsigned)dist;
                        const unsigned idx = ud < 113u ? ud : 113u;
                        const float bias = *(const LAS float*)(tb + idx * 4);
                        float v = s[hh][r] * SC + (bias - m);
                        v = (ud < Wl) ? v : MASKED;
                        s[hh][r] = v;
                    }
            }
            if (!IMPP) {
                float t0 = fmaxf(fmaxf(s[0][0], s[0][1]), s[0][2]), t1 = fmaxf(fmaxf(s[1][0], s[1][1]), s[1][2]);
#pragma unroll
                for (int r = 3; r < 15; r += 2) { t0 = fmaxf(fmaxf(t0, s[0][r]), s[0][r + 1]); t1 = fmaxf(fmaxf(t1, s[1][r]), s[1][r + 1]); }
                float tmax = fmaxf(fmaxf(t0, t1), fmaxf(s[0][15], s[1][15]));
                { auto rr = __builtin_amdgcn_permlane32_swap(__float_as_uint(tmax), __float_as_uint(tmax), false, false); tmax = fmaxf(__uint_as_float(rr[0]), __uint_as_float(rr[1])); }
                const bool need = tmax > 8.f;
                if (__builtin_amdgcn_ballot_w64(need) != 0ull) {
                    const float delta = need ? tmax : 0.f;
                    const float alpha = __builtin_amdgcn_exp2f(-delta);
                    m += delta; l *= alpha;
#pragma unroll
                    for (int dt = 0; dt < DV / 32; ++dt) acc[dt] = acc[dt] * alpha;
#pragma unroll
                    for (int hh = 0; hh < 2; ++hh)
#pragma unroll
                        for (int r = 0; r < 16; ++r) s[hh][r] -= delta;
                }
#pragma unroll
                for (int hh = 0; hh < 2; ++hh)
#pragma unroll
                    for (int r = 0; r < 16; ++r) s[hh][r] = __builtin_amdgcn_exp2f(s[hh][r]);
                f32x2_t ls2a = {0.f, 0.f}, ls2b = {0.f, 0.f};
#pragma unroll
                for (int r = 0; r < 16; r += 2) { ls2a += (f32x2_t){s[0][r], s[0][r + 1]}; ls2b += (f32x2_t){s[1][r], s[1][r + 1]}; }
                const float ls = (ls2a[0] + ls2a[1]) + (ls2b[0] + ls2b[1]);
                l += ls;
                const LAS uchar* vb = lds + (cur ? L_V1 : L_V0) + n * VP + hi * 16;
    #pragma unroll
                for (int hh = 0; hh < 2; ++hh)
#pragma unroll
                    for (int u2 = 0; u2 < 2; ++u2) {
                        u32x4 pw;
                        pw.x = cvtpk(s[hh][8 * u2 + 0], s[hh][8 * u2 + 1]); pw.y = cvtpk(s[hh][8 * u2 + 2], s[hh][8 * u2 + 3]);
                        pw.z = cvtpk(s[hh][8 * u2 + 4], s[hh][8 * u2 + 5]); pw.w = cvtpk(s[hh][8 * u2 + 6], s[hh][8 * u2 + 7]);
                        const bf16x8 pb = __builtin_bit_cast(bf16x8, pw);
                        const int kbase = 32 * hh + 16 * u2;
#pragma unroll
                        for (int dt = 0; dt < DV / 32; ++dt) {
                            const bf16x8 va = *(const LAS bf16x8*)(vb + dt * 32 * VP + kbase * 2);
                            acc[dt] = __builtin_amdgcn_mfma_f32_32x32x16_bf16(va, pb, acc[dt], 0, 0, 0);
                        }
                    }
                } else {
                LAS float* imp = (LAS float*)(lds + L_IMP) + imp_row * 65;
                float spill[8];
#pragma unroll
                for (int hh = 0; hh < 2; ++hh)
#pragma unroll
                    for (int gq = 0; gq < 4; ++gq) {
                        const float p0 = __builtin_amdgcn_exp2f(s[hh][4 * gq + 0]) * inv_l, p1 = __builtin_amdgcn_exp2f(s[hh][4 * gq + 1]) * inv_l;
                        const float p2 = __builtin_amdgcn_exp2f(s[hh][4 * gq + 2]) * inv_l, p3 = __builtin_amdgcn_exp2f(s[hh][4 * gq + 3]) * inv_l;
                        float mn = (p0 + p1) + (p2 + p3), sp = p3;
                        mn += __shfl_xor(mn, 8); mn += __shfl_xor(mn, 16);
                        sp += __shfl_xor(sp, 8); sp += __shfl_xor(sp, 16);
                        spill[hh * 4 + gq] = sp;
                        const int j = 16 * kt + 8 * hh + 2 * gq + hi;
                        if (n < 8) imp[j] += mn;
                    }
                __builtin_amdgcn_fence(__ATOMIC_RELEASE, "wavefront");
#pragma unroll
                for (int hh = 0; hh < 2; ++hh)
#pragma unroll
                    for (int gq = 0; gq < 4; ++gq) {
                        const int j = 16 * kt + 8 * hh + 2 * gq + hi + 1;
                        if (n < 8 && j < 64) imp[j] += spill[hh * 4 + gq];
                    }
                __builtin_amdgcn_fence(__ATOMIC_RELEASE, "wavefront");
            }
        }
        if (more) tile_swrite<DV, !IMPP>(tr, lds, cur ^ 1, tid);
        __syncthreads();
    }
}

template <int NT> __device__ __forceinline__ void acc_zero(f32x16 (&a)[NT]) {
#pragma unroll
    for (int t = 0; t < NT; ++t)
#pragma unroll
        for (int r = 0; r < 16; ++r) a[t][r] = 0.f;
}
template <int NT> __device__ __forceinline__ void acc_norm(f32x16 (&a)[NT], float l) {
    const float lt = l + __shfl_xor(l, 32);
    const float inv = lt > 0.f ? 1.f / lt : 0.f;
#pragma unroll
    for (int t = 0; t < NT; ++t)
#pragma unroll
        for (int r = 0; r < 16; ++r) a[t][r] *= inv;
}
__device__ __forceinline__ void load_q(bf16x8 (&qf)[4], const bf16_t* qrow, int hi) {
#pragma unroll
    for (int ks = 0; ks < 4; ++ks) qf[ks] = *(const bf16x8*)(qrow + 16 * ks + 8 * hi);
}

struct AttnCtx {
    const bf16_t* zb;
    bf16_t *ya, *yb, *yc;
    float* park;
    const bf16_t *kcmp, *vtcmp;
    const float *rel_bias, *lamp, *subln, *sinks;
    float lam_init;
};

__device__ __forceinline__ void attn_unit_A(LAS uchar* lds, const AttnCtx& C, int bl, int h, int qt, int tid) {
    tid = opq(tid);
    const int lane = tid & 63, n = lane & 31, hi = lane >> 5, w = __builtin_amdgcn_readfirstlane(tid >> 6);
    build_tbl(lds, C.rel_bias, h, 1, tid);
    float lam;
    { const float a = C.lamp[lane] * C.lamp[64 + lane], b = C.lamp[128 + lane] * C.lamp[192 + lane]; lam = __expf(wave_sum(a)) - __expf(wave_sum(b)) + C.lam_init; }
    const int qpos = 256 * qt + 32 * w + n;
    const float rfar = C.rel_bias[31 * 20 + h] * LOG2E;
    const int kt1 = 4 * qt + 4, wkm = 4 * qt + (w >> 1);
    const bf16_t* Vt = C.zb + ZVA + ((size_t)bl * 8 + 2 * h) * HS;
    f32x16 acc[4];
    bf16x8 qf[4];
    float m, l;
    float* prow = C.park + ((size_t)bl * 4096 + qpos) * 512 + h * 128;
#pragma unroll 1
    for (int c = 1; c >= 0; --c) {
        const size_t hoff = ((size_t)bl * 8 + 2 * h + c) * HS;
        load_q(qf, C.zb + ZQA + hoff + (size_t)qpos * 64, hi);
        acc_zero<4>(acc); m = MINIT; l = 0.f;
        attn_pass<128, false>(lds, C.zb + ZKA + hoff, Vt, 4096, 0, kt1, wkm, qpos, 256 * qt + 32 * w, 256 * qt + 32 * w + 31, 1, 0, 0x7fffffffu, qf, L_TBL, 0ull, false, m, l, acc, 0.f, 0, rfar, tid);
        acc_norm<4>(acc, l);
        if (c == 1) {
#pragma unroll
            for (int t = 0; t < 4; ++t)
#pragma unroll
                for (int gq = 0; gq < 4; ++gq) *(f32x4*)(prow + 32 * t + 8 * gq + 4 * hi) = (f32x4){acc[t][4 * gq], acc[t][4 * gq + 1], acc[t][4 * gq + 2], acc[t][4 * gq + 3]};
        }
    }
    float ss = 0.f;
#pragma unroll
    for (int t = 0; t < 4; ++t)
#pragma unroll
        for (int gq = 0; gq < 4; ++gq) { const f32x4 o1 = *(const f32x4*)(prow + 32 * t + 8 * gq + 4 * hi);
#pragma unroll
            for (int e = 0; e < 4; ++e) { const float y = acc[t][4 * gq + e] - lam * o1[e]; acc[t][4 * gq + e] = y; ss += y * y; } }
    ss += __shfl_xor(ss, 32);
    const float rs = (1.0f / sqrtf(ss * (1.f / 128.f) + EPS)) * (1.f - C.lam_init);
    bf16_t* yrow = C.ya + ((size_t)bl * 4096 + qpos) * 512 + h * 128;
#pragma unroll
    for (int t = 0; t < 4; ++t)
#pragma unroll
        for (int gq = 0; gq < 4; ++gq) {
            const int d = 32 * t + 8 * gq + 4 * hi;
            const f32x4 gg = *(const f32x4*)(C.subln + d);
            u32x2 wv; wv.x = cvtpk(acc[t][4 * gq] * rs * gg[0], acc[t][4 * gq + 1] * rs * gg[1]); wv.y = cvtpk(acc[t][4 * gq + 2] * rs * gg[2], acc[t][4 * gq + 3] * rs * gg[3]);
            *(u32x2*)(yrow + d) = wv;
        }
}

__device__ __forceinline__ void attn_unit_B(LAS uchar* lds, const AttnCtx& C, int bl, int g, int i, int tid) {
    tid = opq(tid);
    const int lane = tid & 63, n = lane & 31, hi = lane >> 5, w = __builtin_amdgcn_readfirstlane(tid >> 6);
    build_tbl(lds, C.rel_bias, 4 + 4 * g, 4, tid);
    const int ql = 8 * w + (n & 7), hr = n >> 3, qpos = 64 * i + ql, head = 4 * g + hr, qlo = 64 * i + 8 * w;
    const float rfar = C.rel_bias[31 * 20 + 4 + head] * LOG2E;
    const int tbl = L_TBL + hr * 512;
    bf16x8 qf[4];
    load_q(qf, C.zb + ZQB + ((size_t)bl * 8 + head) * HS + (size_t)qpos * 64, hi);
    const size_t goff = ((size_t)bl * 2 + g) * HS;
    f32x16 acc[2];
    LAS float* otl = (LAS float*)(lds + L_RED) + tid;
    float m, l;
    const size_t tok = (size_t)bl * 4096 + qpos;
    const float* bg = (const float*)(C.zb + ZBG) + tok * 32 + head * 3;
    const float g0 = bg[0], g1 = bg[1], g2 = bg[2];
    const bf16_t* Kc = C.kcmp + ((size_t)bl * 2 + g) * 256 * 64;
    const bf16_t* Vc = C.vtcmp + ((size_t)bl * 2 + g) * 64 * 256;
    const int ktc1 = ((4 * i + 2) >> 6) + 1;
    acc_zero<2>(acc); m = MINIT; l = 0.f;
    attn_pass<64, false>(lds, Kc, Vc, 256, 0, ktc1, 1 << 20, qpos, qlo, qlo + 7, 16, 31, 0x7fffffffu, qf, tbl, 0ull, false, m, l, acc, 0.f, 0, rfar, tid);
    acc_norm<2>(acc, l);
#pragma unroll
    for (int t = 0; t < 2; ++t)
#pragma unroll
        for (int r = 0; r < 16; ++r) otl[(t * 16 + r) * NTHR] = g0 * acc[t][r];
    unsigned long long selmask = ~0ull;
    if (i >= 16) {
    {
        const float lt = l + __shfl_xor(l, 32);
        const float inv_l = lt > 0.f ? 1.f / lt : 0.f;
        LAS float* impw = (LAS float*)(lds + L_IMP) + (8 * w) * 65;
        for (int x = lane; x < 8 * 65; x += 64) impw[x] = 0.f;
        __builtin_amdgcn_fence(__ATOMIC_RELEASE, "wavefront");
        attn_pass<64, true>(lds, Kc, Vc, 256, 0, ktc1, 1 << 20, qpos, qlo, qlo + 7, 16, 31, 0x7fffffffu, qf, tbl, 0ull, false, m, l, acc, inv_l, ql, rfar, tid);
    }
    {
        const int q = tid & 63, part = tid >> 6;
        const LAS float* row = (const LAS float*)(lds + L_IMP) + q * 65;
        float cand[8]; int rank[8];
#pragma unroll
        for (int c = 0; c < 8; ++c) { const int j = 8 * part + c; float v = row[j]; v = (j == 0 || j == i || j == i - 1) ? 1e6f : (j > i ? -1e6f : v); cand[c] = v; rank[c] = 0; }
        for (int jj = 0; jj <= i; ++jj) {
            float x = row[jj]; x = (jj == 0 || jj == i || jj == i - 1) ? 1e6f : (jj > i ? -1e6f : x);
#pragma unroll
            for (int c = 0; c < 8; ++c) { const int j = 8 * part + c; rank[c] += (x > cand[c] || (x == cand[c] && jj < j)) ? 1 : 0; }
        }
        unsigned bits = 0;
#pragma unroll
        for (int c = 0; c < 8; ++c) bits |= (rank[c] < 16 ? 1u : 0u) << c;
        ((LAS uchar*)(lds + L_SEL))[q * 8 + part] = (uchar)bits;
    }
    __syncthreads();
    { const u32x2 sm = *(const LAS u32x2*)(lds + L_SEL + ql * 8); selmask = (unsigned long long)sm.x | ((unsigned long long)sm.y << 32); }
    }
    acc_zero<2>(acc); m = MINIT; l = 0.f;
    attn_pass<64, false>(lds, C.zb + ZKS + goff, C.zb + ZVS + goff, 4096, 0, i + 1, 1 << 20, qpos, qlo, qlo + 7, 1, 0, 0x7fffffffu, qf, tbl, selmask, true, m, l, acc, 0.f, 0, rfar, tid);
    acc_norm<2>(acc, l);
#pragma unroll
    for (int t = 0; t < 2; ++t)
#pragma unroll
        for (int r = 0; r < 16; ++r) otl[(t * 16 + r) * NTHR] += g1 * acc[t][r];
    acc_zero<2>(acc); m = MINIT; l = 0.f;
    attn_pass<64, false>(lds, C.zb + ZKW + goff, C.zb + ZVW + goff, 4096, i > 8 ? i - 8 : 0, i + 1, 1 << 20, qpos, qlo, qlo + 7, 1, 0, 512u, qf, tbl, 0ull, false, m, l, acc, 0.f, 0, rfar, tid);
    acc_norm<2>(acc, l);
    bf16_t* yrow = C.yb + tok * 512 + head * 64;
#pragma unroll
    for (int t = 0; t < 2; ++t)
#pragma unroll
        for (int gq = 0; gq < 4; ++gq) {
            const int d = 32 * t + 8 * gq + 4 * hi;
            float o[4];
#pragma unroll
            for (int e = 0; e < 4; ++e) o[e] = otl[(t * 16 + 4 * gq + e) * NTHR] + g2 * acc[t][4 * gq + e];
            u32x2 wv; wv.x = cvtpk(o[0], o[1]); wv.y = cvtpk(o[2], o[3]);
            *(u32x2*)(yrow + d) = wv;
        }
}

__device__ __forceinline__ void attn_unit_C(LAS uchar* lds, const AttnCtx& C, int bl, int g, int i, int tid) {
    tid = opq(tid);
    const int lane = tid & 63, n = lane & 31, hi = lane >> 5, w = __builtin_amdgcn_readfirstlane(tid >> 6);
    build_tbl(lds, C.rel_bias, 12 + 4 * g, 4, tid);
    const int ql = 8 * w + (n & 7), hr = n >> 3, qpos = 64 * i + ql, head = 4 * g + hr, qlo = 64 * i + 8 * w;
    const float rfar = C.rel_bias[31 * 20 + 12 + head] * LOG2E;
    const int tbl = L_TBL + hr * 512;
    bf16x8 qf[4];
    load_q(qf, C.zb + ZQC + ((size_t)bl * 8 + head) * HS + (size_t)qpos * 64, hi);
    const size_t goff = ((size_t)bl * 2 + g) * HS;
    f32x16 acc[2];
    acc_zero<2>(acc);
    float m = C.sinks[head] * LOG2E, l = hi == 0 ? 1.f : 0.f;
    attn_pass<64, false>(lds, C.zb + ZKC + goff, C.zb + ZVC + goff, 4096, i > 2 ? i - 2 : 0, i + 1, 1 << 20, qpos, qlo, qlo + 7, 1, 0, 128u, qf, tbl, 0ull, false, m, l, acc, 0.f, 0, rfar, tid);
    acc_norm<2>(acc, l);
    const size_t tok = (size_t)bl * 4096 + qpos;
    bf16_t* yrow = C.yc + tok * 512 + head * 64;
#pragma unroll
    for (int t = 0; t < 2; ++t)
#pragma unroll
        for (int gq = 0; gq < 4; ++gq) {
            const int d = 32 * t + 8 * gq + 4 * hi;
            u32x2 wv; wv.x = cvtpk(acc[t][4 * gq], acc[t][4 * gq + 1]); wv.y = cvtpk(acc[t][4 * gq + 2], acc[t][4 * gq + 3]);
            *(u32x2*)(yrow + d) = wv;
        }
}

#define XB_TMO      128
#define XB_XCNT(j)  (256  + 64 * (j))
#define XB_XSUB(j)  (1280 + 64 * (j))
#define XB_XGEN(j)  (2304 + 64 * (j))
#define XB_TOP      3328
#define XB_TOPGEN   3392
#define XCD_BAR_WORDS 3456
#define XB_SPIN_CAP (1u << 18)

__device__ __forceinline__ unsigned xb_ld(unsigned* p)              { return __hip_atomic_load(p, __ATOMIC_RELAXED, __HIP_MEMORY_SCOPE_AGENT); }
__device__ __forceinline__ unsigned xb_add(unsigned* p, unsigned v) { return __hip_atomic_fetch_add(p, v, __ATOMIC_RELAXED, __HIP_MEMORY_SCOPE_AGENT); }
__device__ __forceinline__ unsigned xb_xcc_id() { return (unsigned)__builtin_amdgcn_s_getreg((3 << 11) | 20) & 0xFu; }
#define XB_SPIN(cond, bar) do { unsigned _sp = 0; while (cond) { __builtin_amdgcn_s_sleep(1); \
    if ((++_sp & 255u) == 0u) { if (xb_ld(&(bar)[XB_TMO])) break; if (_sp > XB_SPIN_CAP) { atomicAdd(&(bar)[XB_TMO], 1u); break; } } } } while (0)

struct XcdBarrier {
    unsigned* bar; unsigned x;
    volatile __attribute__((address_space(3))) unsigned* st;
};

__device__ __forceinline__ XcdBarrier xcd_barrier_post(unsigned* bar, volatile __attribute__((address_space(3))) unsigned* st) {
    XcdBarrier b; b.bar = bar; b.x = xb_xcc_id(); b.st = st;
    if (threadIdx.x == 0) (void)xb_add(&bar[XB_XCNT(b.x)], 1u);
    return b;
}
__device__ __forceinline__ void xcd_barrier_complete(unsigned* bar, unsigned x, unsigned& nloc, unsigned& nx) {
    const unsigned G = gridDim.x * gridDim.y * gridDim.z;
    unsigned sum, cnt, mine, sp = 0u;
    for (;;) {
        sum = 0u; cnt = 0u; mine = 0u;
#pragma unroll
        for (unsigned j = 0; j < 16; ++j) { const unsigned c = xb_ld(&bar[XB_XCNT(j)]); sum += c; cnt += (c > 0u) ? 1u : 0u; mine = (j == x) ? c : mine; }
        if (sum == G) break;
        __builtin_amdgcn_s_sleep(1);
        if ((++sp & 255u) == 0u) { if (xb_ld(&bar[XB_TMO])) break; if (sp > XB_SPIN_CAP) { atomicAdd(&bar[XB_TMO], 1u); break; } }
    }
    nloc = mine > 0u ? mine : 1u; nx = cnt > 0u ? cnt : 1u;
}

__device__ __forceinline__ void xcd_barrier(const XcdBarrier& b) {
    asm volatile("s_waitcnt vmcnt(0)" ::: "memory");
    __syncthreads();
    if (threadIdx.x == 0) {
        unsigned* bar = b.bar;
        __builtin_amdgcn_s_waitcnt(0);
        unsigned nloc = b.st[0], nx = b.st[1];
        if (nloc == 0u) { xcd_barrier_complete(bar, b.x, nloc, nx); b.st[0] = nloc; b.st[1] = nx; }
        const unsigned old = xb_add(&bar[XB_XSUB(b.x)], 1u);
        const unsigned gen = old / nloc;
        if (old + 1u == (gen + 1u) * nloc) {
            __builtin_amdgcn_fence(__ATOMIC_RELEASE, "agent");
            asm volatile("s_waitcnt vmcnt(0)" ::: "memory");
            const unsigned og = xb_add(&bar[XB_TOP], 1u);
            const unsigned tg = og / nx;
            if (og + 1u == (tg + 1u) * nx) xb_add(&bar[XB_TOPGEN], 1u);
            else XB_SPIN(xb_ld(&bar[XB_TOPGEN]) == tg, bar);
            __builtin_amdgcn_fence(__ATOMIC_ACQUIRE, "agent");
            xb_add(&bar[XB_XGEN(b.x)], 1u);
            asm volatile("s_waitcnt vmcnt(0)" ::: "memory");
        } else {
            XB_SPIN(xb_ld(&bar[XB_XGEN(b.x)]) == gen, bar);
            __builtin_amdgcn_fence(__ATOMIC_ACQUIRE, "agent");
            asm volatile("s_waitcnt vmcnt(0)" ::: "memory");
        }
    }
    __syncthreads();
}

#define KIN(i) (kparams()->in[i])
#define WS_ (kparams()->ws)
#define HOUT (kparams()->out)
#define Wb ((bf16_t*)(WS_ + WS_W))
#define XN ((bf16_t*)(WS_ + WS_XN))
#define R1 ((bf16_t*)(WS_ + WS_R1))
#define YA ((bf16_t*)(WS_ + WS_Y))
#define MG ((bf16_t*)(WS_ + WS_MG))
#define CH ((bf16_t*)(WS_ + WS_CH))
#define KCMP ((bf16_t*)(WS_ + WS_KCMP))
#define VCMP ((bf16_t*)(WS_ + WS_VCMP))
#define CB ((float*)(WS_ + WS_CB))
#define XN2 ((bf16_t*)(WS_ + WS_XN2))
#define PBF ((bf16_t*)(WS_ + WS_PBF))
#define SSQ ((float*)(WS_ + WS_SSQ))
#define SSQ2 ((float*)(WS_ + WS_SSQ2))
constexpr int LDS_BYTES = 147456;
#ifdef ONLY_EPI
#include <type_traits>
#define ONLY_OK(E) (std::is_same<E, ONLY_EPI>::value)
#else
#define ONLY_OK(E) true
#endif
#ifdef NO_GEMM
#define GEMM(EPI, e, A_, lda_, Bt_, M_, N_, K_, cshift) do { (void)(e); } while (0)
#else
#define GEMM(EPI, e, A_, lda_, Bt_, M_, N_, K_, cshift) do { pg8::Gemm g_{(const bf16_t*)(A_), (const bf16_t*)(Bt_), (M_), (N_), (K_), (lda_)}; pg8::StaticOrder S_; \
    int c_ = (int)((blk + (cshift)) % G), G_ = G; asm volatile("" : "+s"(c_), "+s"(G_)); S_.init((M_), (N_), G_, c_); if (ONLY_OK(EPI)) pg8::gemm_phase<EPI, pg8::StaticOrder, EPI::ALIGN, true>(lds, g_, S_, (e)); } while (0)
#endif

__global__ void __launch_bounds__(NTHR, 2) fwd_kernel(Params P) {
    extern __shared__ __attribute__((aligned(16))) unsigned char lds_raw[];
    LAS uchar* lds = (LAS uchar*)lds_raw;
    cg::grid_group grid = cg::this_grid();
    volatile LAS unsigned* xst = (volatile LAS unsigned*)(lds + LDS_BYTES - 64);
    if (threadIdx.x < 2) xst[threadIdx.x] = 0u;
    __syncthreads();
    const XcdBarrier xbar = xcd_barrier_post((unsigned*)(kparams()->ws + WS_CTL), xst);
#ifndef PROBE_CLASS
#define PROBE_CLASS 0
#endif
#if PROBE_CLASS
    unsigned long long pr_acc = 0, pr_last = __builtin_amdgcn_s_memrealtime();
#define SYNC(cls) do { const unsigned long long t1_ = __builtin_amdgcn_s_memrealtime(); if ((cls) == PROBE_CLASS) pr_acc += t1_ - pr_last; if ((cls) == 6) grid.sync(); else xcd_barrier(xbar); \
    const unsigned long long t2_ = __builtin_amdgcn_s_memrealtime(); if (PROBE_CLASS == 2) pr_acc += t2_ - t1_; pr_last = t2_; } while (0)
#else
#define SYNC(cls) do { if ((cls) == 6) grid.sync(); else xcd_barrier(xbar); } while (0)
#endif
#define DEF_IDS \
    int tid_o = threadIdx.x, G_o = gridDim.x, blk_o = blockIdx.x; asm volatile("" : "+v"(tid_o), "+s"(G_o), "+s"(blk_o)); \
    const int tid = tid_o, lane = tid & 63, wave = __builtin_amdgcn_readfirstlane(tid >> 6); \
    const int G = G_o, blk = blk_o; \
    const int vcu = (G % 8 == 0) ? (blk % 8) * (G / 8) + blk / 8 : blk; \
    const int gw = blk * 8 + wave, ngw = G * 8; (void)vcu; (void)gw; (void)ngw; (void)lane;
    {
        DEF_IDS
        LAS float* scr = (LAS float*)lds;
        int base = 0;
        for (int L = 0; L < DEPTH; ++L) {
            bf16_t* wl = Wb + (size_t)L * W_LAYER;
            conv_matrix(KIN(3) + (size_t)L * 1024 * 5632, 1024, 5632, 5632, 1, wl + W_WI1, base, scr, tid, blk, G, KIN(2) + (size_t)(L * 4 + 0) * DM);
            conv_matrix(KIN(4) + (size_t)L * 2816 * 1024, 2816, 1024, 1024, 0, wl + W_WO1, base, scr, tid, blk, G);
            conv_matrix(KIN(5) + (size_t)L * 1024 * DIN, 1024, DIN, DINP, 2, wl + W_WIN, base, scr, tid, blk, G, KIN(2) + (size_t)(L * 4 + 1) * DM);
            for (int t = 0; t < 2; ++t) conv_matrix(KIN(9) + ((size_t)L * 2 + t) * 2048 * 256, 2048, 256, 256, 0, wl + W_CW1 + (size_t)t * 256 * 2048, base, scr, tid, blk, G);
            for (int t = 0; t < 2; ++t) conv_matrix(KIN(10) + ((size_t)L * 2 + t) * 256 * 64, 256, 64, 256, 3, wl + W_CW2 + (size_t)t * 256 * 256, base, scr, tid, blk, G);
            for (int t = 0; t < 3; ++t) conv_matrix(KIN(12) + ((size_t)L * 3 + t) * 512 * 1024, 512, 1024, 1024, 0, wl + W_WBR + (size_t)t * 1024 * 512, base, scr, tid, blk, G);
            conv_matrix(KIN(13) + (size_t)L * 1024 * 1024, 1024, 1024, 1024, 0, wl + W_WOUT, base, scr, tid, blk, G);
            conv_matrix(KIN(14) + (size_t)L * 1024 * 5632, 1024, 5632, 5632, 1, wl + W_WI2, base, scr, tid, blk, G, KIN(2) + (size_t)(L * 4 + 2) * DM);
            conv_matrix(KIN(15) + (size_t)L * 2816 * 1024, 2816, 1024, 1024, 0, wl + W_WO2, base, scr, tid, blk, G);
            conv_matrix(KIN(16) + (size_t)L * 256 * 1024, 256, 1024, 1024, 0, wl + W_WPE, base, scr, tid, blk, G);
            conv_matrix(KIN(17) + (size_t)L * 1024 * 1024, 1024, 1024, 1024, 0, wl + W_WPG, base, scr, tid, blk, G, KIN(2) + (size_t)(L * 4 + 3) * DM);
        }
        for (int pr = blk; pr < DEPTH * 2; pr += G) {
            const float* pos = KIN(8) + (size_t)pr * 2048; const float* w1 = KIN(9) + (size_t)pr * 2048 * 256;
            float a[4] = {0.f, 0.f, 0.f, 0.f};
            for (int k = wave * 256; k < wave * 256 + 256; ++k) { const float pv = pos[k];
#pragma unroll
                for (int j = 0; j < 4; ++j) a[j] += pv * w1[(size_t)k * 256 + lane + 64 * j]; }
#pragma unroll
            for (int j = 0; j < 4; ++j) scr[wave * 256 + lane + 64 * j] = a[j];
            __syncthreads();
            if (tid < 256) { float s = 0.f;
#pragma unroll
                for (int ww = 0; ww < 8; ++ww) s += scr[ww * 256 + tid];
                CB[pr * 256 + tid] = s; }
            __syncthreads();
        }
        phase_prep(KIN(0), XN2, SSQ2, gw, ngw, lane);
    }
    SYNC(6);

#pragma unroll 1
    for (int L = 0; L < DEPTH; ++L) {
        DEF_IDS
#define wl (Wb + (size_t)L * W_LAYER)
#define ng (KIN(2) + (size_t)L * 4 * DM)
        { EpiSwiglu e{R1, SSQ2}; GEMM(EpiSwiglu, e, XN2, 1024, wl + W_WI1, T, 5632, 1024, 0); }
        SYNC(3);
        { EpiResid e{0.5f, 0, L == 0 ? 1 : 0}; GEMM(EpiResid, e, R1, DFF, wl + W_WO1, T, 1024, DFF, 0); }
        SYNC(3);
        { EpiZ e{R1, SSQ}; GEMM(EpiZ, e, XN, 1024, wl + W_WIN, TC, DINP, 1024, 0); }
        SYNC(3);
        for (int c = 0; c < NCHUNK; ++c) {
            { EpiBf<1> ek{CH, 256, CB + (L * 2 + 0) * 256}; GEMM(EpiBf<1>, ek, R1 + ZKCI, 1024, wl + W_CW1, NB * 512, 256, 2048, 0);
              EpiBf<1> ev{CH + (size_t)NB * 512 * 256, 256, CB + (L * 2 + 1) * 256}; GEMM(EpiBf<1>, ev, R1 + ZVCI, 1024, wl + W_CW1 + (size_t)256 * 2048, NB * 512, 256, 2048, G / 2); }
            __builtin_amdgcn_fence(__ATOMIC_RELEASE, "workgroup"); __syncthreads(); __builtin_amdgcn_fence(__ATOMIC_ACQUIRE, "workgroup");
            { EpiCmp2<false> ek{KCMP}; GEMM(EpiCmp2<false>, ek, CH, 256, wl + W_CW2, NB * 512, 256, 256, 0);
              EpiCmp2<true> ev{VCMP}; GEMM(EpiCmp2<true>, ev, CH + (size_t)NB * 512 * 256, 256, wl + W_CW2 + (size_t)256 * 256, NB * 512, 256, 256, G / 2); }
            SYNC(5);
            {
                AttnCtx C;
                C.zb = R1; C.park = (float*)MG; C.ya = YA; C.yb = YA + (size_t)TC * 512; C.yc = YA + (size_t)2 * TC * 512; C.kcmp = KCMP; C.vtcmp = VCMP;
                C.rel_bias = KIN(18); C.lamp = KIN(6) + (size_t)L * 256; C.subln = KIN(7) + (size_t)L * 128; C.sinks = KIN(11) + (size_t)L * 8;
                C.lam_init = 0.8f - 0.6f * __expf(-0.3f * (float)L);
                for (int u = vcu; u < NB * 32; u += G) {
                    const int bl = u >> 5;
#ifndef NO_A
#if PROBE_CLASS == 7
                    const unsigned long long ta0_ = __builtin_amdgcn_s_memrealtime();
#endif
                    { const int h = (u >> 3) & 3, qp = u & 7;
#pragma unroll 1
                      for (int k = 0; k < 2; ++k) attn_unit_A(lds, C, bl, h, k ? 15 - qp : qp, tid); }
#if PROBE_CLASS == 7
                    pr_acc += __builtin_amdgcn_s_memrealtime() - ta0_;
#endif
#endif
                    { const int g = (u >> 4) & 1, is = u & 15;
#ifndef NO_B
#pragma unroll 1
                      for (int k = 0; k < 4; ++k) attn_unit_B(lds, C, bl, g, (k & 1) ? (k == 1 ? 31 : 63) - is : (k == 0 ? 0 : 32) + is, tid);
#endif
#ifndef NO_C
#pragma unroll 1
                      for (int k = 0; k < 4; ++k) attn_unit_C(lds, C, bl, g, (k & 1) ? (k == 1 ? 31 : 63) - is : (k == 0 ? 0 : 32) + is, tid);
#endif
                    }
                }
            }
            SYNC(1);
            for (int mi = 0; mi < 3; ++mi) {
                EpiBranch e{MG, R1 + ZSG, mi}; GEMM(EpiBranch, e, YA + (size_t)mi * TC * 512, 512, wl + W_WBR + (size_t)mi * 1024 * 512, TC, 1024, 512, 0);
            }
            SYNC(3);
            { EpiResid e{1.0f, c * TC, 0}; GEMM(EpiResid, e, MG, 1024, wl + W_WOUT, TC, 1024, 1024, 0); }
            if (c + 1 < NCHUNK) { EpiZ e{R1, SSQ + (size_t)(c + 1) * TC * 16}; GEMM(EpiZ, e, XN + (size_t)(c + 1) * TC * DM, 1024, wl + W_WIN, TC, DINP, 1024, 0); }
            SYNC(3);
        }
        {
            const f32x4* src = (const f32x4*)(KIN(1) + (size_t)L * T * PLE); u32x2* dst = (u32x2*)PBF;
            const int tq = opq(tid);
            for (size_t idx = (size_t)blk * NTHR + tq; idx < (size_t)T * PLE / 4; idx += (size_t)G * NTHR) { const f32x4 v = src[idx]; u32x2 w; w.x = cvtpk(v[0], v[1]); w.y = cvtpk(v[2], v[3]); dst[idx] = w; }
        }
        { EpiSwiglu e{R1, SSQ}; GEMM(EpiSwiglu, e, XN, 1024, wl + W_WI2, T, 5632, 1024, 0); }
        SYNC(3);
        { EpiResid e{0.5f, 0, 0}; GEMM(EpiResid, e, R1, DFF, wl + W_WO2, T, 1024, DFF, 0); }
        SYNC(3);
        { EpiBf<0> e{(bf16_t*)((uchar*)R1 + R1_E), 1024, nullptr}; GEMM(EpiBf<0>, e, PBF, 256, wl + W_WPE, T, 1024, 256, 0); }
        SYNC(3);
        { float* ho_ = HOUT; uchar* ws_ = WS_; EpiPle e{ho_, (const bf16_t*)(ws_ + WS_R1 + R1_E), (const float*)(ws_ + WS_SSQ), (bf16_t*)(ws_ + WS_XN2), (float*)(ws_ + WS_SSQ2)}; GEMM(EpiPle, e, XN, 1024, wl + W_WPG, T, 1024, 1024, 0); }
        SYNC(3);
    }
    { DEF_IDS const int lq = opq(lane); float* ho = HOUT; const float* fg = KIN(19); for (int m = gw; m < T; m += ngw) rms_row_f32(ho + (size_t)m * DM, fg, ho + (size_t)m * DM, lq); }
#if PROBE_CLASS
    if (blockIdx.x == 0) { const unsigned long long t0_ = __builtin_amdgcn_s_memrealtime(); while (__builtin_amdgcn_s_memrealtime() - t0_ < pr_acc) __builtin_amdgcn_s_sleep(20); }
#endif
}

extern "C" void kernel_launch(void* const* d_in, const int* in_sizes, int n_in, void* d_out, int out_size, void* d_ws, size_t ws_size, hipStream_t stream) {
    static int grid = 0;
    if (grid == 0) {
        if (n_in != 20 || out_size != T * DM || ws_size < WS_END) { fprintf(stderr, "kernel_launch: unexpected shapes (n_in %d out %d ws %zu)\n", n_in, out_size, ws_size); grid = -1; return; }
        int dev = 0, cus = 0, per_cu = 0;
        hipGetDevice(&dev);
        hipDeviceGetAttribute(&cus, hipDeviceAttributeMultiprocessorCount, dev);
        if (hipFuncSetAttribute((const void*)fwd_kernel, hipFuncAttributeMaxDynamicSharedMemorySize, LDS_BYTES) != hipSuccess) { fprintf(stderr, "kernel_launch: hipFuncSetAttribute failed\n"); grid = -1; return; }
        if (hipOccupancyMaxActiveBlocksPerMultiprocessor(&per_cu, (const void*)fwd_kernel, NTHR, LDS_BYTES) != hipSuccess || per_cu < 1) { fprintf(stderr, "kernel_launch: occupancy query says %d\n", per_cu); per_cu = 1; }
        (void)hipGetLastError();
        grid = cus;
        if (grid > 256) grid = 256;
    }
    if (grid < 0) return;
    if (hipMemsetAsync((char*)d_ws + WS_CTL, 0, CTL_ZERO_BYTES, stream) != hipSuccess) { fprintf(stderr, "kernel_launch: memset failed\n"); return; }
    Params p{};
    for (int i = 0; i < 20; ++i) p.in[i] = (const float*)d_in[i];
    p.out = (float*)d_out; p.ws = (uchar*)d_ws;
    void* args[] = {&p};
    hipError_t e = hipLaunchCooperativeKernel((const void*)fwd_kernel, dim3(grid), dim3(NTHR), args, LDS_BYTES, stream);
    if (e != hipSuccess) fprintf(stderr, "cooperative launch failed: %s (grid %d)\n", hipGetErrorString(e), grid);
}
```

```cpp
#include <hip/hip_runtime.h>
#include <hip/hip_cooperative_groups.h>
#include <cstdio>
#include <cstdint>
namespace cg = cooperative_groups;
namespace pg8 {
#define PG8_LAS __attribute__((address_space(3)))
typedef unsigned short bf16_t;
typedef short bf16x8 __attribute__((ext_vector_type(8)));
typedef float f32x4 __attribute__((ext_vector_type(4)));
typedef unsigned u32x4 __attribute__((ext_vector_type(4)));
constexpr int BM = 256, BK = 64, HALF = 128, HTB = HALF * BK * 2  , STAGE_BYTES = 8 * HTB, NXCD = 8, WGM = 4;

__host__ __device__ __forceinline__ int lds_byte(int r, int c) { const int st = (r >> 4) * 2 + (c >> 5), rr = r & 15, cc = c & 31, ob = rr * 64 + cc * 2; return st * 1024 + (ob ^ (((ob >> 9) & 1) << 5)); }
__host__ __device__ __forceinline__ void stage_rc(int b, int& R, int& C) { const int st = b / 1024, sb = b % 1024, swz = sb ^ (((sb >> 9) & 1) << 5); R = (st >> 1) * 16 + swz / 64; C = (st & 1) * 32 + (swz % 64) / 2; }
__host__ __device__ __forceinline__ int perm32(int rho) { const int n = rho >> 4, i = rho & 15; return 8 * (i >> 2) + 4 * n + (i & 3); }

struct Unit { int pm, pn; };
struct Gemm { const bf16_t* A; const bf16_t* Bt; int M, N, K, lda; };

struct StaticOrder {
    int nM, nN, nwg, G, c;
    __host__ __device__ void init(int M, int N, int G_, int c_) { nM = M / BM; nN = N / BM; nwg = nM * nN; G = G_; c = c_; }
    __host__ __device__ bool next(int i, Unit& u) const {
        const long L = (long)i * G + c; if (L >= nwg) return false;
        int wgid = (int)L; { const int q = nwg / NXCD, r = nwg % NXCD, xcd = wgid % NXCD, off = wgid / NXCD; wgid = (xcd < r ? xcd * (q + 1) : r * (q + 1) + (xcd - r) * q) + off; }
        const int nig = WGM * nN, gid = wgid / nig, fm = gid * WGM, gsz = (nM - fm) < WGM ? (nM - fm) : WGM;
        u.pm = fm + ((wgid % nig) % gsz); u.pn = (wgid % nig) / gsz; return true;
    }
    __device__ __forceinline__ void a_ready(const Unit&) const {}
    __device__ __forceinline__ void done(const Unit&) const {}
};

__device__ __forceinline__ unsigned cvt_pk_bf16(float lo, float hi) { unsigned r; asm volatile("v_cvt_pk_bf16_f32 %0, %1, %2" : "=v"(r) : "v"(lo), "v"(hi)); return r; }
typedef float f32x2 __attribute__((ext_vector_type(2)));
template <class Epi, class Sched, bool ALIGN_EPI = false, bool SP2 = false>
__device__ __forceinline__ void gemm_phase(PG8_LAS unsigned char* lds, const Gemm g, const Sched& S, const Epi& E) {
    int tid_ = threadIdx.x; asm volatile("" : "+v"(tid_)); const int tid = tid_, wid = __builtin_amdgcn_readfirstlane(tid >> 6), lane = tid & 63, wr = wid >> 2, wc = wid & 3, fr = lane & 15, fq = lane >> 4;
    const int K = g.K, nt = K / BK;
    unsigned voffA[2], voffB[2];
#pragma unroll
    for (int i = 0; i < 2; ++i) { int R, C; stage_rc(tid * 16 + i * 8192, R, C); const int Rb = Epi::PERM ? ((R & ~31) + perm32(R & 31)) : R;
        voffA[i] = (unsigned)(R * g.lda + C) * 2u; voffB[i] = (unsigned)(Rb * K + C) * 2u; }
    const size_t kstep = (size_t)(BK * 2);
    const size_t hstep = (size_t)HALF * K * 2;
    const size_t tstep = 2 * hstep; const size_t hstepA = (size_t)HALF * g.lda * 2, tstepA = 2 * hstepA;
    const unsigned ldsw = (unsigned)wid * 1024u;
    const int aoff = lds_byte(wr * 64 + fr, fq * 8), boff = lds_byte(wc * 32 + fr, fq * 8);
#define PG8_SA(b, h) (((b) * 2 + (h)) * HTB)
#define PG8_SB(b, h) ((4 + (b) * 2 + (h)) * HTB)
#define PG8_STAGE(bufoff, gbase, voff) do { _Pragma("unroll") for (int _i = 0; _i < 2; ++_i) \
        __builtin_amdgcn_global_load_lds((const unsigned*)((const char*)(gbase) + (voff)[_i]), (PG8_LAS unsigned*)(lds + (bufoff) + ldsw + _i * 8192), 16, 0, 0); } while (0)
#define PG8_LDA(dst, b, h) do { _Pragma("unroll") for (int m = 0; m < 4; ++m) _Pragma("unroll") for (int k = 0; k < 2; ++k) dst[m][k] = *(const PG8_LAS bf16x8*)(lds + PG8_SA(b, h) + aoff + m * 2048 + k * 1024); } while (0)
#define PG8_LDB(dst, b, h) do { _Pragma("unroll") for (int n = 0; n < 2; ++n) _Pragma("unroll") for (int k = 0; k < 2; ++k) dst[n][k] = *(const PG8_LAS bf16x8*)(lds + PG8_SB(b, h) + boff + n * 2048 + k * 1024); } while (0)
#define PG8_MMA(ai, bj, At, Bt) do { __builtin_amdgcn_s_setprio(1); _Pragma("unroll") for (int m = 0; m < 4; ++m) _Pragma("unroll") for (int n = 0; n < 2; ++n) _Pragma("unroll") for (int k = 0; k < 2; ++k) \
        acc[ai][bj][m][n] = __builtin_amdgcn_mfma_f32_16x16x32_bf16(Bt[n][k], At[m][k], acc[ai][bj][m][n], 0, 0, 0); __builtin_amdgcn_s_setprio(0); } while (0)
#define PG8_WAIT_V(n) asm volatile("s_waitcnt vmcnt(" #n ")" ::: "memory")
#define PG8_WAIT_L(n) asm volatile("s_waitcnt lgkmcnt(" #n ")" ::: "memory")
#define PG8_BAR __builtin_amdgcn_s_barrier()
#define PG8_SCHED __builtin_amdgcn_sched_barrier(0)
    Unit cur, nxt; int ui = 0;
    if (!S.next(0, cur)) return;
    f32x4 acc[2][2][4][2];
#pragma unroll
    for (int a = 0; a < 2; ++a)
#pragma unroll
        for (int b = 0; b < 2; ++b)
#pragma unroll
            for (int m = 0; m < 4; ++m)
#pragma unroll
                for (int n = 0; n < 2; ++n) acc[a][b][m][n] = (f32x4){0.f, 0.f, 0.f, 0.f};
    bf16x8 At[4][2], B0[2][2], B1[2][2];
    const char* cA = (const char*)g.A + (size_t)cur.pm * tstepA; const char* cB = (const char*)g.Bt + (size_t)cur.pn * tstep;
    S.a_ready(cur);
    if constexpr (SP2) {
        PG8_STAGE(PG8_SB(0, 0), cB, voffB); PG8_STAGE(PG8_SB(0, 1), cB + hstep, voffB); PG8_STAGE(PG8_SA(0, 0), cA, voffA); PG8_STAGE(PG8_SA(0, 1), cA + hstepA, voffA);
        if (wr == 1) PG8_BAR;
        PG8_WAIT_V(2); PG8_BAR;
        PG8_STAGE(PG8_SB(1, 0), cB + kstep, voffB); PG8_STAGE(PG8_SA(1, 0), cA + kstep, voffA); PG8_STAGE(PG8_SB(1, 1), cB + hstep + kstep, voffB);
        PG8_WAIT_V(6); PG8_BAR;
    } else {
        PG8_STAGE(PG8_SB(0, 0), cB, voffB); PG8_STAGE(PG8_SA(0, 0), cA, voffA); PG8_STAGE(PG8_SB(0, 1), cB + hstep, voffB); PG8_STAGE(PG8_SA(0, 1), cA + hstepA, voffA);
        if (wr == 1) PG8_BAR;
        PG8_WAIT_V(4); PG8_BAR;
        PG8_STAGE(PG8_SB(1, 0), cB + kstep, voffB); PG8_STAGE(PG8_SA(1, 0), cA + kstep, voffA); PG8_STAGE(PG8_SB(1, 1), cB + hstep + kstep, voffB);
        PG8_WAIT_V(6); PG8_BAR;
    }
    for (;;) {
        const bool has_next = S.next(ui + 1, nxt);
        const char* nA = has_next ? (const char*)g.A + (size_t)nxt.pm * tstepA : cA; const char* nB = has_next ? (const char*)g.Bt + (size_t)nxt.pn * tstep : cB;
        for (int t = 0; t < nt; t += 2) {
            const bool last = (t == nt - 2);
            const char* a1 = cA + (size_t)(t + 1) * kstep;
            const char* a2 = last ? nA : cA + (size_t)(t + 2) * kstep; const char* b2 = last ? nB : cB + (size_t)(t + 2) * kstep;
            const char* a3 = a2 + kstep; const char* b3 = b2 + kstep;
            if (last && has_next) S.a_ready(nxt);
            if constexpr (SP2) {
            PG8_LDB(B0, 0, 0); PG8_LDB(B1, 0, 1); PG8_SCHED; PG8_LDA(At, 0, 0); PG8_STAGE(PG8_SA(1, 1), a1 + hstepA, voffA);
            PG8_WAIT_V(8); PG8_WAIT_L(0); PG8_BAR; PG8_MMA(0, 0, At, B0); PG8_MMA(0, 1, At, B1); PG8_BAR; PG8_SCHED;
            PG8_LDA(At, 0, 1); PG8_STAGE(PG8_SB(0, 0), b2, voffB); PG8_STAGE(PG8_SB(0, 1), b2 + hstep, voffB); PG8_STAGE(PG8_SA(0, 0), a2, voffA);
            PG8_WAIT_V(8); PG8_WAIT_L(0); PG8_BAR; PG8_MMA(1, 0, At, B0); PG8_MMA(1, 1, At, B1); PG8_BAR; PG8_SCHED;
            PG8_LDB(B0, 1, 0); PG8_LDB(B1, 1, 1); PG8_SCHED; PG8_LDA(At, 1, 0); PG8_STAGE(PG8_SA(0, 1), a2 + hstepA, voffA);
            PG8_WAIT_V(8); PG8_WAIT_L(0); PG8_BAR; PG8_MMA(0, 0, At, B0); PG8_MMA(0, 1, At, B1); PG8_BAR; PG8_SCHED;
            PG8_LDA(At, 1, 1); PG8_STAGE(PG8_SB(1, 0), b3, voffB); PG8_STAGE(PG8_SB(1, 1), b3 + hstep, voffB); PG8_STAGE(PG8_SA(1, 0), a3, voffA);
            PG8_WAIT_V(8); PG8_WAIT_L(0); PG8_BAR; PG8_MMA(1, 0, At, B0); PG8_MMA(1, 1, At, B1); PG8_BAR; PG8_SCHED;
            } else {
            PG8_LDB(B0, 0, 0); PG8_SCHED; PG8_LDA(At, 0, 0); PG8_STAGE(PG8_SA(1, 1), a1 + hstepA, voffA);
            PG8_WAIT_L(8); PG8_BAR; PG8_WAIT_L(0); PG8_MMA(0, 0, At, B0); PG8_BAR; PG8_SCHED;
            PG8_LDB(B1, 0, 1); PG8_STAGE(PG8_SB(0, 0), b2, voffB);
            PG8_BAR; PG8_WAIT_L(0); PG8_MMA(0, 1, At, B1); PG8_BAR;
            PG8_LDA(At, 0, 1); PG8_STAGE(PG8_SA(0, 0), a2, voffA);
            PG8_BAR; PG8_WAIT_L(0); PG8_MMA(1, 0, At, B0); PG8_BAR; PG8_SCHED;
            PG8_STAGE(PG8_SB(0, 1), b2 + hstep, voffB);
            PG8_WAIT_V(6); PG8_BAR; PG8_MMA(1, 1, At, B1); PG8_BAR;
            PG8_LDB(B0, 1, 0); PG8_SCHED; PG8_LDA(At, 1, 0); PG8_STAGE(PG8_SA(0, 1), a2 + hstepA, voffA);
            PG8_WAIT_L(8); PG8_BAR; PG8_WAIT_L(0); PG8_MMA(0, 0, At, B0); PG8_BAR; PG8_SCHED;
            PG8_LDB(B1, 1, 1); PG8_STAGE(PG8_SB(1, 0), b3, voffB);
            PG8_BAR; PG8_WAIT_L(0); PG8_MMA(0, 1, At, B1); PG8_BAR;
            PG8_LDA(At, 1, 1); PG8_STAGE(PG8_SA(1, 0), a3, voffA);
            PG8_BAR; PG8_WAIT_L(0); PG8_MMA(1, 0, At, B0); PG8_BAR; PG8_SCHED;
            PG8_STAGE(PG8_SB(1, 1), b3 + hstep, voffB);
            PG8_WAIT_V(6); PG8_BAR; PG8_MMA(1, 1, At, B1); PG8_BAR;
            }
        }
        if constexpr (ALIGN_EPI) { if (wr == 0) PG8_BAR; }
        if constexpr (!Epi::AFTER_DRAIN) { E(acc, cur, wr, wc, fr, fq); S.done(cur); }
        if (!has_next) break;
#pragma unroll
        for (int a = 0; a < 2; ++a)
#pragma unroll
            for (int b = 0; b < 2; ++b)
#pragma unroll
                for (int m = 0; m < 4; ++m)
#pragma unroll
                    for (int n = 0; n < 2; ++n) acc[a][b][m][n] = (f32x4){0.f, 0.f, 0.f, 0.f};
        cur = nxt; cA = nA; cB = nB; ++ui;
        if constexpr (ALIGN_EPI) { if (wr == 1) PG8_BAR; }
    }
    PG8_WAIT_V(0);
    if constexpr (!ALIGN_EPI) { if (wr == 0) PG8_BAR; }
    PG8_BAR;
    if constexpr (Epi::AFTER_DRAIN) { E.fused(acc, cur, wr, wc, fr, fq, lds, wid, lane); S.done(cur); }
#undef PG8_SA
#undef PG8_SB
#undef PG8_STAGE
#undef PG8_LDA
#undef PG8_LDB
#undef PG8_MMA
#undef PG8_WAIT_V
#undef PG8_WAIT_L
#undef PG8_BAR
#undef PG8_SCHED
}
}

#define LAS __attribute__((address_space(3)))
using pg8::bf16_t; using pg8::bf16x8; using pg8::f32x4; using pg8::u32x4;
typedef float f32x16 __attribute__((ext_vector_type(16)));
typedef unsigned u32x2 __attribute__((ext_vector_type(2)));
typedef unsigned char uchar;
typedef float f32x2_t __attribute__((ext_vector_type(2)));
typedef __bf16 bf16x2_t __attribute__((ext_vector_type(2)));

constexpr int DM = 1024, NBATCH = 16, SEQ = 4096, DEPTH = 4, PLE = 256, DFF = 2816;
constexpr int T = NBATCH * SEQ;
constexpr int NB = 8, TC = NB * SEQ, NCHUNK = NBATCH / NB;
constexpr int DIN = 6680, DINP = 6912;
constexpr float EPS = 1e-6f, LOG2E = 1.4426950408889634f;
constexpr int NTHR = 512;

constexpr size_t W_WI1 = 0, W_WO1 = W_WI1 + (size_t)5632 * 1024, W_WIN = W_WO1 + (size_t)1024 * 2816, W_CW1 = W_WIN + (size_t)DINP * 1024,
                 W_CW2 = W_CW1 + (size_t)2 * 256 * 2048, W_WBR = W_CW2 + (size_t)2 * 256 * 256, W_WOUT = W_WBR + (size_t)3 * 1024 * 512,
                 W_WI2 = W_WOUT + (size_t)1024 * 1024, W_WO2 = W_WI2 + (size_t)5632 * 1024, W_WPE = W_WO2 + (size_t)1024 * 2816,
                 W_WPG = W_WPE + (size_t)1024 * 256, W_LAYER = W_WPG + (size_t)1024 * 1024;
static_assert(W_LAYER == 29491200, "weights");
constexpr size_t MiB = 1u << 20;
constexpr size_t WS_W = 0, WS_XN = 226 * MiB, WS_R1 = 354 * MiB, WS_Y = 782 * MiB, WS_MG = 878 * MiB, WS_CH = 942 * MiB, WS_KCMP = 946 * MiB,
                 WS_VCMP = WS_KCMP + MiB / 2, WS_CB = 947 * MiB, WS_SSQ = 948 * MiB, WS_SSQ2 = 952 * MiB, WS_CTL = 956 * MiB, WS_END = 957 * MiB;
constexpr size_t CTL_ZERO_BYTES = 65536;
constexpr size_t WS_XN2 = WS_Y, WS_PBF = WS_Y + 128 * MiB;
static_assert(W_LAYER * 2 * DEPTH <= WS_XN, "w");
constexpr size_t HS = 262144;
constexpr size_t ZQA = 0, ZKA = ZQA + NB * 8 * HS, ZVA = ZKA + NB * 8 * HS, ZQB = ZVA + NB * 8 * HS, ZKCI = ZQB + NB * 8 * HS, ZVCI = ZKCI + NB * 2 * HS,
                 ZKS = ZVCI + NB * 2 * HS, ZVS = ZKS + NB * 2 * HS, ZKW = ZVS + NB * 2 * HS, ZVW = ZKW + NB * 2 * HS, ZQC = ZVW + NB * 2 * HS,
                 ZKC = ZQC + NB * 8 * HS, ZVC = ZKC + NB * 2 * HS, ZSG = ZVC + NB * 2 * HS, ZBG = ZSG + (size_t)TC * 3072, ZEND = ZBG + (size_t)TC * 32 * 2;
static_assert(ZEND * 2 <= 428 * MiB, "zbuf");
static_assert((size_t)T * DFF * 2 <= 428 * MiB, "act");
constexpr size_t R1_E = 0;

struct Params {
    const float* in[20];
    float* out;
    uchar* ws;
};

__device__ __forceinline__ unsigned cvtpk(float lo, float hi) { f32x2_t v = {lo, hi}; bf16x2_t b = __builtin_convertvector(v, bf16x2_t); return __builtin_bit_cast(unsigned, b); }
__device__ __forceinline__ bf16_t cvt1(float x) { return (bf16_t)(cvtpk(x, 0.f) & 0xffffu); }
__device__ __forceinline__ float bf2f(unsigned short b) { return __uint_as_float((unsigned)b << 16); }
__device__ __forceinline__ float wave_sum(float v) {
#pragma unroll
    for (int o = 1; o < 64; o <<= 1) v += __shfl_xor(v, o);
    return v;
}
__device__ __forceinline__ int opq(int v) { asm volatile("" : "+v"(v)); return v; }
__device__ __forceinline__ float sigm(float x) { return __builtin_amdgcn_rcpf(1.f + __builtin_amdgcn_exp2f(-x * LOG2E)); }
__device__ __forceinline__ float gelu_tanh(float x) { const float u = 0.7978845608028654f * (x + 0.044715f * x * x * x); const float e = __builtin_amdgcn_exp2f(-2.f * LOG2E * u); const float th = 2.f * __builtin_amdgcn_rcpf(1.f + e) - 1.f; return 0.5f * x * (1.f + th); }

typedef const __attribute__((address_space(4))) Params* KParPtr;
__device__ __forceinline__ KParPtr kparams() { auto p = __builtin_amdgcn_kernarg_segment_ptr(); asm volatile("" : "+s"(p)); return (KParPtr)p; }
#ifndef ALIGN_T
#define ALIGN_T false
#endif
#ifndef ALIGN_F
#define ALIGN_F true
#endif
#ifndef ALIGN_SW
#define ALIGN_SW true
#endif
#ifndef ALIGN_BR
#define ALIGN_BR true
#endif
#ifndef ALIGN_Z
#define ALIGN_Z true
#endif
__device__ __forceinline__ float row_rstd(const float* ssq, int row) {
    const f32x4* p = (const f32x4*)(ssq + (size_t)row * 16); const f32x4 a = p[0], b = p[1], c = p[2], d = p[3];
    const float sm = (((a[0] + a[1]) + (a[2] + a[3])) + ((b[0] + b[1]) + (b[2] + b[3]))) + (((c[0] + c[1]) + (c[2] + c[3])) + ((d[0] + d[1]) + (d[2] + d[3])));
    return 1.0f / sqrtf(sm * (1.f / 1024.f) + 1e-6f);
}
typedef const pg8::f32x4 (&AccRef)[2][2][4][2];
__device__ __forceinline__ void wave_rstd(const float* ssq, int rowbase, float (&rsl)[2]) {
    const int lane = threadIdx.x & 63;
    rsl[0] = row_rstd(ssq, rowbase + lane); rsl[1] = row_rstd(ssq, rowbase + 128 + lane);
}
struct EpiSwiglu {
    static constexpr bool PERM = true, AFTER_DRAIN = false, ALIGN = ALIGN_SW;
    bf16_t* O; const float* ssq;
    __device__ __forceinline__ void operator()(AccRef acc, const pg8::Unit& u, int wr, int wc, int fr, int fq) const {
        asm volatile("" : "+v"(fr), "+v"(fq));
        const int row0 = u.pm * 256 + wr * 64 + fr, col0 = u.pn * 128 + wc * 32 + 8 * fq;
        float rsl[2]; wave_rstd(ssq, u.pm * 256 + wr * 64, rsl);
#pragma unroll
        for (int ai = 0; ai < 2; ++ai)
#pragma unroll
            for (int m = 0; m < 4; ++m) {
                bf16_t* rp = O + (size_t)(row0 + ai * 128 + m * 16) * DFF + col0;
                const float rs = __shfl(rsl[ai], 16 * m + fr);
                float o[8];
#pragma unroll
                for (int n = 0; n < 2; ++n)
#pragma unroll
                    for (int e = 0; e < 4; ++e) { const float g = acc[ai][0][m][n][e] * rs, up = acc[ai][1][m][n][e] * rs; o[n * 4 + e] = g * sigm(g) * up; }
                u32x4 w; w.x = cvtpk(o[0], o[1]); w.y = cvtpk(o[2], o[3]); w.z = cvtpk(o[4], o[5]); w.w = cvtpk(o[6], o[7]);
                *(u32x4*)rp = w;
            }
    }
};
struct EpiResid {
    static constexpr bool PERM = false, AFTER_DRAIN = false, ALIGN = ALIGN_F;
    float alpha; int row_off; int first;
    __device__ __forceinline__ void operator()(AccRef acc, const pg8::Unit& u, int wr, int wc, int fr, int fq) const {
        asm volatile("" : "+v"(fr), "+v"(fq));
        const int row0 = row_off + u.pm * 256 + wr * 64 + fr, col0 = u.pn * 256 + wc * 32 + 4 * fq;
        float* out = kparams()->out; const float* in = first ? kparams()->in[0] : (const float*)out;
        uchar* wsb = kparams()->ws; bf16_t* hb = (bf16_t*)(wsb + WS_XN); float* ssq = (float*)(wsb + WS_SSQ);
#pragma unroll
        for (int ai = 0; ai < 2; ++ai)
#pragma unroll
            for (int m = 0; m < 4; ++m) {
                const size_t off = (size_t)(row0 + ai * 128 + m * 16) * DM + col0;
                float sq = 0.f;
#pragma unroll
                for (int bj = 0; bj < 2; ++bj)
#pragma unroll
                    for (int n = 0; n < 2; ++n) { const f32x4 b = *(const f32x4*)(in + off + bj * 128 + n * 16); const f32x4 v = b + acc[ai][bj][m][n] * alpha; *(f32x4*)(out + off + bj * 128 + n * 16) = v;
                        u32x2 w; w.x = cvtpk(v[0], v[1]); w.y = cvtpk(v[2], v[3]); *(u32x2*)(hb + off + bj * 128 + n * 16) = w; sq += (v[0] * v[0] + v[1] * v[1]) + (v[2] * v[2] + v[3] * v[3]); }
                sq += __shfl_xor(sq, 16); sq += __shfl_xor(sq, 32);
                if (fq == 0) ssq[(size_t)(row0 + ai * 128 + m * 16) * 16 + u.pn * 4 + wc] = sq;

            }
    }
};
struct EpiPle {
    static constexpr bool PERM = false, AFTER_DRAIN = false, ALIGN = ALIGN_F;
    float* h; const bf16_t* E; const float* ssq_in; bf16_t* hb; float* ssq_out;
    __device__ __forceinline__ void operator()(AccRef acc, const pg8::Unit& u, int wr, int wc, int fr, int fq) const {
        asm volatile("" : "+v"(fr), "+v"(fq));
        const int row0 = u.pm * 256 + wr * 64 + fr, col0 = u.pn * 256 + wc * 32 + 4 * fq;
        float rsl[2]; wave_rstd(ssq_in, u.pm * 256 + wr * 64, rsl);
#pragma unroll
        for (int ai = 0; ai < 2; ++ai)
#pragma unroll
            for (int m = 0; m < 4; ++m) {
                const size_t off = (size_t)(row0 + ai * 128 + m * 16) * DM + col0;
                const float rs = __shfl(rsl[ai], 16 * m + fr);
                float sq = 0.f;
#pragma unroll
                for (int bj = 0; bj < 2; ++bj)
#pragma unroll
                    for (int n = 0; n < 2; ++n) {
                        const size_t o2 = off + bj * 128 + n * 16;
                        const u32x2 ev = *(const u32x2*)(E + o2); f32x4 b = *(const f32x4*)(h + o2); const f32x4 a = acc[ai][bj][m][n];
                        b[0] += sigm(a[0] * rs) * __uint_as_float(ev.x << 16); b[1] += sigm(a[1] * rs) * __uint_as_float(ev.x & 0xffff0000u);
                        b[2] += sigm(a[2] * rs) * __uint_as_float(ev.y << 16); b[3] += sigm(a[3] * rs) * __uint_as_float(ev.y & 0xffff0000u);
                        *(f32x4*)(h + o2) = b;
                        u32x2 w; w.x = cvtpk(b[0], b[1]); w.y = cvtpk(b[2], b[3]); *(u32x2*)(hb + o2) = w; sq += (b[0] * b[0] + b[1] * b[1]) + (b[2] * b[2] + b[3] * b[3]);
                    }
                sq += __shfl_xor(sq, 16); sq += __shfl_xor(sq, 32);
                if (fq == 0) ssq_out[(size_t)(row0 + ai * 128 + m * 16) * 16 + u.pn * 4 + wc] = sq;

            }
    }
};
template <int MODE> struct EpiBf {
    static constexpr bool PERM = true, AFTER_DRAIN = false, ALIGN = ALIGN_T;
    bf16_t* O; int ldc; const float* bias;
    __device__ __forceinline__ void operator()(AccRef acc, const pg8::Unit& u, int wr, int wc, int fr, int fq) const {
        asm volatile("" : "+v"(fr), "+v"(fq));
        const int row0 = u.pm * 256 + wr * 64 + fr, col0 = u.pn * 256 + wc * 32 + 8 * fq;
#pragma unroll
        for (int bj = 0; bj < 2; ++bj) {
            float bv[8];
#pragma unroll
            for (int e = 0; e < 8; ++e) bv[e] = MODE == 1 ? bias[col0 + bj * 128 + e] : 0.f;
#pragma unroll
            for (int ai = 0; ai < 2; ++ai)
#pragma unroll
                for (int m = 0; m < 4; ++m) {
                    float o[8];
#pragma unroll
                    for (int n = 0; n < 2; ++n)
#pragma unroll
                        for (int e = 0; e < 4; ++e) { float v = acc[ai][bj][m][n][e] + bv[n * 4 + e]; if (MODE == 1) v = gelu_tanh(v); o[n * 4 + e] = v; }
                    u32x4 w; w.x = cvtpk(o[0], o[1]); w.y = cvtpk(o[2], o[3]); w.z = cvtpk(o[4], o[5]); w.w = cvtpk(o[6], o[7]);
                    *(u32x4*)(O + (size_t)(row0 + ai * 128 + m * 16) * ldc + col0 + bj * 128) = w;
                }
        }
    }
};
template <bool VT> struct EpiCmp2 {
    static constexpr bool PERM = true, AFTER_DRAIN = false, ALIGN = ALIGN_T;
    bf16_t* O;
    __device__ __forceinline__ void operator()(AccRef acc, const pg8::Unit& u, int wr, int wc, int fr, int fq) const {
        asm volatile("" : "+v"(fr), "+v"(fq));
        if (u.pn != 0 || wc >= 2) return;
        const int row0 = u.pm * 256 + wr * 64 + fr, d0 = wc * 32 + 8 * fq;
#pragma unroll
        for (int ai = 0; ai < 2; ++ai)
#pragma unroll
            for (int m = 0; m < 4; ++m) {
                const int row = row0 + ai * 128 + m * 16, bg = row >> 8, n = row & 255;
                float o[8];
#pragma unroll
                for (int nn = 0; nn < 2; ++nn)
#pragma unroll
                    for (int e = 0; e < 4; ++e) o[nn * 4 + e] = (n == 255) ? 0.f : acc[ai][0][m][nn][e];
                if (!VT) { u32x4 w; w.x = cvtpk(o[0], o[1]); w.y = cvtpk(o[2], o[3]); w.z = cvtpk(o[4], o[5]); w.w = cvtpk(o[6], o[7]); *(u32x4*)(O + (size_t)row * 64 + d0) = w; }
                else {
#pragma unroll
                    for (int e = 0; e < 8; ++e) O[((size_t)bg * 64 + d0 + e) * 256 + n] = cvt1(o[e]);
                }
            }
    }
};
struct EpiBranch {
    static constexpr bool PERM = true, AFTER_DRAIN = false, ALIGN = ALIGN_BR;
    bf16_t* mg; const bf16_t* sg; int mi;
    __device__ __forceinline__ void operator()(AccRef acc, const pg8::Unit& u, int wr, int wc, int fr, int fq) const {
        asm volatile("" : "+v"(fr), "+v"(fq));
        const int row0 = u.pm * 256 + wr * 64 + fr, col0 = u.pn * 256 + wc * 32 + 8 * fq;
#pragma unroll
        for (int ai = 0; ai < 2; ++ai)
#pragma unroll
            for (int m = 0; m < 4; ++m) {
                const int row = row0 + ai * 128 + m * 16;
#pragma unroll
                for (int bj = 0; bj < 2; ++bj) {
                    const int col = col0 + bj * 128;
                    const u32x4 gv = *(const u32x4*)(sg + (size_t)row * 3072 + mi * 1024 + col);
                    u32x4 ov = (u32x4){0u, 0u, 0u, 0u};
                    if (mi != 0) ov = *(const u32x4*)(mg + (size_t)row * DM + col);
                    float o[8];
#pragma unroll
                    for (int q = 0; q < 4; ++q) {
                        const unsigned gq = gv[q], oq = ov[q];
                        const float a0 = acc[ai][bj][m][q >> 1][(q & 1) * 2], a1 = acc[ai][bj][m][q >> 1][(q & 1) * 2 + 1];
                        o[2 * q] = __uint_as_float(oq << 16) + __uint_as_float(gq << 16) * a0;
                        o[2 * q + 1] = __uint_as_float(oq & 0xffff0000u) + __uint_as_float(gq & 0xffff0000u) * a1;
                    }
                    u32x4 w; w.x = cvtpk(o[0], o[1]); w.y = cvtpk(o[2], o[3]); w.z = cvtpk(o[4], o[5]); w.w = cvtpk(o[6], o[7]);
                    *(u32x4*)(mg + (size_t)row * DM + col) = w;
                }

            }
    }
};
struct EpiZ {
    static constexpr bool PERM = true, AFTER_DRAIN = false, ALIGN = ALIGN_Z;
    bf16_t* zb; const float* ssq; int pn_off;
    __device__ __forceinline__ void operator()(AccRef acc, const pg8::Unit& u, int wr, int wc, int fr, int fq) const {
        asm volatile("" : "+v"(fr), "+v"(fq));
        const int pn = u.pn + pn_off;
        float rsl[2]; wave_rstd(ssq, u.pm * 256 + wr * 64, rsl);
#pragma unroll
        for (int bj = 0; bj < 2; ++bj) {
            const int ch = 2 * bj + (wc >> 1), d0 = (wc & 1) * 32 + 8 * fq;
            size_t off = 0, bs = 8 * HS; int mode = 0;
            if (pn < 2) { off = ZQA + (size_t)(pn * 4 + ch) * HS; }
            else if (pn < 4) { off = ZKA + (size_t)((pn - 2) * 4 + ch) * HS; }
            else if (pn < 6) { off = ZVA + (size_t)((pn - 4) * 4 + ch) * HS; mode = 1; }
            else if (pn < 8) { off = ZQB + (size_t)((pn - 6) * 4 + ch) * HS; }
            else if (pn == 8) { bs = 2 * HS; off = (ch < 2) ? ZKCI + (size_t)ch * HS : ZVCI + (size_t)(ch - 2) * HS; }
            else if (pn == 9) { bs = 2 * HS; if (ch < 2) off = ZKS + (size_t)ch * HS; else { off = ZVS + (size_t)(ch - 2) * HS; mode = 1; } }
            else if (pn == 10) { bs = 2 * HS; if (ch < 2) off = ZKW + (size_t)ch * HS; else { off = ZVW + (size_t)(ch - 2) * HS; mode = 1; } }
            else if (pn < 13) { off = ZQC + (size_t)((pn - 11) * 4 + ch) * HS; }
            else if (pn == 13) { bs = 2 * HS; if (ch < 2) off = ZKC + (size_t)ch * HS; else { off = ZVC + (size_t)(ch - 2) * HS; mode = 1; } }
            else if (pn < 26) mode = 2;
            else mode = 3;
#pragma unroll
            for (int ai = 0; ai < 2; ++ai)
#pragma unroll
                for (int m = 0; m < 4; ++m) {
                    const int tl = u.pm * 256 + ai * 128 + wr * 64 + m * 16 + fr, bl = tl >> 12, s = tl & 4095;
                    const float rs = __shfl(rsl[ai], 16 * m + fr);
                    float o[8];
#pragma unroll
                    for (int n = 0; n < 2; ++n)
#pragma unroll
                        for (int e = 0; e < 4; ++e) o[n * 4 + e] = acc[ai][bj][m][n][e] * rs;
                    if (mode == 0) {
                        u32x4 w; w.x = cvtpk(o[0], o[1]); w.y = cvtpk(o[2], o[3]); w.z = cvtpk(o[4], o[5]); w.w = cvtpk(o[6], o[7]);
                        *(u32x4*)(zb + off + (size_t)bl * bs + (size_t)s * 64 + d0) = w;
                    } else if (mode == 1) {
                        bf16_t* p = zb + off + (size_t)bl * bs + (size_t)d0 * 4096 + s;
#pragma unroll
                        for (int e = 0; e < 8; ++e) p[(size_t)e * 4096] = cvt1(o[e]);
                    } else if (mode == 2) {
#pragma unroll
                        for (int e = 0; e < 8; ++e) o[e] = sigm(o[e]);
                        u32x4 w; w.x = cvtpk(o[0], o[1]); w.y = cvtpk(o[2], o[3]); w.z = cvtpk(o[4], o[5]); w.w = cvtpk(o[6], o[7]);
                        *(u32x4*)(zb + ZSG + (size_t)tl * 3072 + (pn - 14) * 256 + bj * 128 + wc * 32 + 8 * fq) = w;
                    } else {
                        const int cc = bj * 128 + wc * 32 + 8 * fq;
                        if (cc < 24) {
                            float* bgp = (float*)(zb + ZBG) + (size_t)tl * 32 + cc;
                            *(f32x4*)bgp = (f32x4){sigm(o[0]), sigm(o[1]), sigm(o[2]), sigm(o[3])};
                            *(f32x4*)(bgp + 4) = (f32x4){sigm(o[4]), sigm(o[5]), sigm(o[6]), sigm(o[7])};
                        }
                    }
                }
        }
    }
};

__device__ __forceinline__ void rms_row_bf16(const float* xrow, const float* g, bf16_t* orow, int lane) {
    const f32x4* xr = (const f32x4*)xrow + lane; f32x4 v[4]; float s = 0.f;
#pragma unroll
    for (int j = 0; j < 4; ++j) { v[j] = xr[64 * j]; s += (v[j][0] * v[j][0] + v[j][1] * v[j][1]) + (v[j][2] * v[j][2] + v[j][3] * v[j][3]); }
    const float rstd = 1.0f / sqrtf(wave_sum(s) * (1.f / DM) + EPS);
    u32x2* o8 = (u32x2*)orow + lane;
#pragma unroll
    for (int j = 0; j < 4; ++j) { const f32x4 gg = ((const f32x4*)g)[lane + 64 * j]; u32x2 w; w.x = cvtpk(v[j][0] * rstd * gg[0], v[j][1] * rstd * gg[1]); w.y = cvtpk(v[j][2] * rstd * gg[2], v[j][3] * rstd * gg[3]); o8[64 * j] = w; }
}
__device__ __forceinline__ void rms_row_f32(const float* xrow, const float* g, float* orow, int lane) {
    const f32x4* xr = (const f32x4*)xrow + lane; f32x4 v[4]; float s = 0.f;
#pragma unroll
    for (int j = 0; j < 4; ++j) { v[j] = xr[64 * j]; s += (v[j][0] * v[j][0] + v[j][1] * v[j][1]) + (v[j][2] * v[j][2] + v[j][3] * v[j][3]); }
    const float rstd = 1.0f / sqrtf(wave_sum(s) * (1.f / DM) + EPS);
#pragma unroll
    for (int j = 0; j < 4; ++j) { const f32x4 gg = ((const f32x4*)g)[lane + 64 * j]; ((f32x4*)orow)[lane + 64 * j] = (v[j] * rstd) * gg; }
}
__device__ __forceinline__ void phase_prep(const float* src, bf16_t* dst, float* ssq, int gw, int ngw, int lane) {
    lane = opq(lane);
    for (int m = gw; m < T; m += ngw) {
        const f32x4* xr = (const f32x4*)(src + (size_t)m * DM) + lane; u32x2* o8 = (u32x2*)(dst + (size_t)m * DM) + lane; float s = 0.f;
#pragma unroll
        for (int j = 0; j < 4; ++j) { const f32x4 v = xr[64 * j]; s += (v[0] * v[0] + v[1] * v[1]) + (v[2] * v[2] + v[3] * v[3]); u32x2 w; w.x = cvtpk(v[0], v[1]); w.y = cvtpk(v[2], v[3]); o8[64 * j] = w; }
        s = wave_sum(s);
        if (lane < 16) ssq[(size_t)m * 16 + lane] = lane == 0 ? s : 0.f;
    }
}
__device__ __forceinline__ void phase_rms(const float* src, const float* g, bf16_t* dst, int gw, int ngw, int lane) {
    lane = opq(lane);
    for (int m = gw; m < T; m += ngw) rms_row_bf16(src + (size_t)m * DM, g, dst + (size_t)m * DM, lane);
}

__device__ __forceinline__ int srccol(int mode, int n) {
    if (mode == 0) return n;
    if (mode == 1) return ((n >> 7) & 1) * DFF + (n >> 8) * 128 + (n & 127);
    if (mode == 2) return n < 2816 ? n : (n < 6656 ? n + 24 : (n < 6680 ? 2816 + (n - 6656) : -1));
    return n < 64 ? n : -1;
}
__device__ __forceinline__ void conv_matrix(const float* src, int K, int ld, int Ndst, int mode, bf16_t* dst, int& base, LAS float* scr, int tid, int blk, int G, const float* gk = nullptr) {
    tid = opq(tid);
    const int ntn = Ndst / 64, ntiles = (K / 128) * ntn;
    int start = (blk - (base % G) + G) % G;
    for (int t = start; t < ntiles; t += G) {
        const int k0 = (t / ntn) * 128, n0 = (t % ntn) * 64;
        { const int kr = tid >> 6, n = tid & 63; const int col = srccol(mode, n0 + n);
          float v[16];
#pragma unroll
          for (int kk = 0; kk < 16; ++kk) { const int k = kr + 8 * kk; v[kk] = col >= 0 ? src[(size_t)(k0 + k) * ld + col] : 0.f; }
#pragma unroll
          for (int kk = 0; kk < 16; ++kk) { const int k = kr + 8 * kk; scr[k * 65 + n] = gk ? v[kk] * gk[k0 + k] : v[kk]; } }
        __syncthreads();
        { const int n = tid >> 3, ks = tid & 7;
#pragma unroll
          for (int h2 = 0; h2 < 2; ++h2) { const LAS float* sp = scr + (64 * h2 + 8 * ks) * 65 + n;
            u32x4 w; w.x = cvtpk(sp[0], sp[65]); w.y = cvtpk(sp[130], sp[195]); w.z = cvtpk(sp[260], sp[325]); w.w = cvtpk(sp[390], sp[455]);
            *(u32x4*)(dst + (size_t)(n0 + n) * K + k0 + 64 * h2 + 8 * ks) = w; } }
        __syncthreads();
    }
    base += ntiles;
}

constexpr int KP = 144;
constexpr int VP = 144;
constexpr int L_K0 = 0, L_K1 = 9216, L_V0 = 18432, L_V1 = 36864, L_TBL = 55296, L_IMP = 57344, L_SEL = 73984, L_RED = 74496;
constexpr float SC = 0.125f * LOG2E;
constexpr float MINIT = -10000.f, MASKED = -1e30f;

__device__ __forceinline__ int t5_bucket(int n) {
    if (n < 16) return n;
    int b = 16;
    b += (n >= 19); b += (n >= 21); b += (n >= 24); b += (n >= 27); b += (n >= 31); b += (n >= 35); b += (n >= 40); b += (n >= 46);
    b += (n >= 52); b += (n >= 59); b += (n >= 67); b += (n >= 77); b += (n >= 87); b += (n >= 99); b += (n >= 113);
    return b;
}
__device__ __forceinline__ void build_tbl(LAS uchar* lds, const float* rel_bias, int col0, int nh, int tid) {
    const int hd = tid >> 7, idx = tid & 127;
    if (hd < nh && idx < 114) ((LAS float*)(lds + L_TBL))[hd * 128 + idx] = rel_bias[t5_bucket(idx) * 20 + col0 + hd] * LOG2E;
}

template <int DV> struct TileRegs { u32x4 k; u32x4 v[DV / 64]; };
template <int DV, bool HASV>
__device__ __forceinline__ void tile_gload(TileRegs<DV>& r, const bf16_t* Kg, const bf16_t* Vt, int vpitch, int kt, int tid) {
    const int row = tid >> 3, seg = tid & 7;
    r.k = *(const u32x4*)(Kg + (size_t)(kt * 64 + row) * 64 + seg * 8);
    if (HASV) {
#pragma unroll
        for (int j = 0; j < DV / 64; ++j) r.v[j] = *(const u32x4*)(Vt + (size_t)(row + 64 * j) * vpitch + kt * 64 + seg * 8);
    }
}
template <int DV, bool HASV>
__device__ __forceinline__ void tile_swrite(const TileRegs<DV>& r, LAS uchar* lds, int buf, int tid) {
    const int row = tid >> 3, seg = tid & 7;
    *(LAS u32x4*)(lds + (buf ? L_K1 : L_K0) + row * KP + seg * 16) = r.k;
    if (HASV) {
#pragma unroll
        for (int j = 0; j < DV / 64; ++j) { LAS uchar* p = lds + (buf ? L_V1 : L_V0) + (row + 64 * j) * VP + (seg >> 1) * 32 + (seg & 1) * 8; *(LAS u32x2*)p = (u32x2){r.v[j].x, r.v[j].y}; *(LAS u32x2*)(p + 16) = (u32x2){r.v[j].z, r.v[j].w}; }
    }
}

template <int DV, bool IMPP>
__device__ __forceinline__ void attn_pass(LAS uchar* lds, const bf16_t* Kg, const bf16_t* Vt, int vpitch, int kt0, int kt1, int wave_kt_max,
                                          int qpos, int qmin_w, int qmax_w, int kmul, int kadd, unsigned W, bf16x8 (&q)[4], int tbl,
                                          unsigned long long selmask, bool use_sel, float& m, float& l, f32x16 (&acc)[DV / 32],
                                          float inv_l, int imp_row, float rel_far, int tid) {
    const int lane = tid & 63, n = lane & 31, hi = lane >> 5;
    TileRegs<DV> tr;
    if (kt0 >= kt1) return;
    float tfar = rel_far;
    asm volatile("s_waitcnt vmcnt(0)" ::: "memory");
    asm volatile("" : "+v"(q[0]), "+v"(q[1]), "+v"(q[2]), "+v"(q[3]), "+v"(tfar), "+v"(m), "+v"(l), "+v"(inv_l));
    tile_gload<DV, !IMPP>(tr, Kg, Vt, vpitch, kt0, tid);
    tile_swrite<DV, !IMPP>(tr, lds, 0, tid);
    __syncthreads();
    for (int kt = kt0; kt < kt1; ++kt) {
        const int cur = (kt - kt0) & 1;
        const bool more = kt + 1 < kt1;
        if (more) tile_gload<DV, !IMPP>(tr, Kg, Vt, vpitch, kt + 1, tid);
        if (kt <= wave_kt_max && (!use_sel || __builtin_amdgcn_ballot_w64((selmask >> kt) & 1ull) != 0ull)) {
            f32x16 s[2];
#pragma unroll
            for (int r = 0; r < 16; ++r) { s[0][r] = 0.f; s[1][r] = 0.f; }
            const LAS uchar* kb = lds + (cur ? L_K1 : L_K0) + n * KP + hi * 16;
#pragma unroll
            for (int ks = 0; ks < 4; ++ks) {
                const bf16x8 a0 = *(const LAS bf16x8*)(kb + ks * 32);
                const bf16x8 a1 = *(const LAS bf16x8*)(kb + 32 * KP + ks * 32);
                s[0] = __builtin_amdgcn_mfma_f32_32x32x16_bf16(a0, q[ks], s[0], 0, 0, 0);
                s[1] = __builtin_amdgcn_mfma_f32_32x32x16_bf16(a1, q[ks], s[1], 0, 0, 0);
            }
            const bool lane_ok = !use_sel || ((selmask >> kt) & 1ull);
            const bool fast = (qmin_w - (kmul * (64 * kt + 63) + kadd) >= 113) && ((unsigned)(qmax_w - (kmul * 64 * kt + kadd)) < W);
            if (fast) {
                const float cfar = lane_ok ? tfar - m : MASKED;
                const float scl = lane_ok ? SC : 0.f;
#pragma unroll
                for (int hh = 0; hh < 2; ++hh)
#pragma unroll
                    for (int r = 0; r < 16; ++r) s[hh][r] = s[hh][r] * scl + cfar;
            } else {
                int dq = qpos - kadd - kmul * (kt * 64 + 4 * hi);
                asm volatile("" : "+v"(dq));
                const unsigned Wl = lane_ok ? W : 0u;
                const LAS uchar* tb = lds + tbl;
#pragma unroll
                for (int hh = 0; hh < 2; ++hh)
#pragma unroll
                    for (int r = 0; r < 16; ++r) {
                        const int kk = 32 * hh + 8 * (r >> 2) + (r & 3);
                        const int dist = dq - kmul * kk;
                        const unsigned ud = (unsigned)dist;
                        const unsigned idx = ud < 113u ? ud : 113u;
                        const float bias = *(const LAS float*)(tb + idx * 4);
                        float v = s[hh][r] * SC + (bias - m);
                        v = (ud < Wl) ? v : MASKED;
                        s[hh][r] = v;
                    }
            }
            if (!IMPP) {
                float t0 = fmaxf(fmaxf(s[0][0], s[0][1]), s[0][2]), t1 = fmaxf(fmaxf(s[1][0], s[1][1]), s[1][2]);
#pragma unroll
                for (int r = 3; r < 15; r += 2) { t0 = fmaxf(fmaxf(t0, s[0][r]), s[0][r + 1]); t1 = fmaxf(fmaxf(t1, s[1][r]), s[1][r + 1]); }
                float tmax = fmaxf(fmaxf(t0, t1), fmaxf(s[0][15], s[1][15]));
                { auto rr = __builtin_amdgcn_permlane32_swap(__float_as_uint(tmax), __float_as_uint(tmax), false, false); tmax = fmaxf(__uint_as_float(rr[0]), __uint_as_float(rr[1])); }
                const bool need = tmax > 8.f;
                if (__builtin_amdgcn_ballot_w64(need) != 0ull) {
                    const float delta = need ? tmax : 0.f;
                    const float alpha = __builtin_amdgcn_exp2f(-delta);
                    m += delta; l *= alpha;
#pragma unroll
                    for (int dt = 0; dt < DV / 32; ++dt) acc[dt] = acc[dt] * alpha;
#pragma unroll
                    for (int hh = 0; hh < 2; ++hh)
#pragma unroll
                        for (int r = 0; r < 16; ++r) s[hh][r] -= delta;
                }
#pragma unroll
                for (int hh = 0; hh < 2; ++hh)
#pragma unroll
                    for (int r = 0; r < 16; ++r) s[hh][r] = __builtin_amdgcn_exp2f(s[hh][r]);
                f32x2_t ls2a = {0.f, 0.f}, ls2b = {0.f, 0.f};
#pragma unroll
                for (int r = 0; r < 16; r += 2) { ls2a += (f32x2_t){s[0][r], s[0][r + 1]}; ls2b += (f32x2_t){s[1][r], s[1][r + 1]}; }
                const float ls = (ls2a[0] + ls2a[1]) + (ls2b[0] + ls2b[1]);
                l += ls;
                const LAS uchar* vb = lds + (cur ? L_V1 : L_V0) + n * VP + hi * 16;
    #pragma unroll
                for (int hh = 0; hh < 2; ++hh)
#pragma unroll
                    for (int u2 = 0; u2 < 2; ++u2) {
                        u32x4 pw;
                        pw.x = cvtpk(s[hh][8 * u2 + 0], s[hh][8 * u2 + 1]); pw.y = cvtpk(s[hh][8 * u2 + 2], s[hh][8 * u2 + 3]);
                        pw.z = cvtpk(s[hh][8 * u2 + 4], s[hh][8 * u2 + 5]); pw.w = cvtpk(s[hh][8 * u2 + 6], s[hh][8 * u2 + 7]);
                        const bf16x8 pb = __builtin_bit_cast(bf16x8, pw);
                        const int kbase = 32 * hh + 16 * u2;
#pragma unroll
                        for (int dt = 0; dt < DV / 32; ++dt) {
                            const bf16x8 va = *(const LAS bf16x8*)(vb + dt * 32 * VP + kbase * 2);
                            acc[dt] = __builtin_amdgcn_mfma_f32_32x32x16_bf16(va, pb, acc[dt], 0, 0, 0);
                        }
                    }
                } else {
                LAS float* imp = (LAS float*)(lds + L_IMP) + imp_row * 65;
                float spill[8];
#pragma unroll
                for (int hh = 0; hh < 2; ++hh)
#pragma unroll
                    for (int gq = 0; gq < 4; ++gq) {
                        const float p0 = __builtin_amdgcn_exp2f(s[hh][4 * gq + 0]) * inv_l, p1 = __builtin_amdgcn_exp2f(s[hh][4 * gq + 1]) * inv_l;
                        const float p2 = __builtin_amdgcn_exp2f(s[hh][4 * gq + 2]) * inv_l, p3 = __builtin_amdgcn_exp2f(s[hh][4 * gq + 3]) * inv_l;
                        float mn = (p0 + p1) + (p2 + p3), sp = p3;
                        mn += __shfl_xor(mn, 8); mn += __shfl_xor(mn, 16);
                        sp += __shfl_xor(sp, 8); sp += __shfl_xor(sp, 16);
                        spill[hh * 4 + gq] = sp;
                        const int j = 16 * kt + 8 * hh + 2 * gq + hi;
                        if (n < 8) imp[j] += mn;
                    }
                __builtin_amdgcn_fence(__ATOMIC_RELEASE, "wavefront");
#pragma unroll
                for (int hh = 0; hh < 2; ++hh)
#pragma unroll
                    for (int gq = 0; gq < 4; ++gq) {
                        const int j = 16 * kt + 8 * hh + 2 * gq + hi + 1;
                        if (n < 8 && j < 64) imp[j] += spill[hh * 4 + gq];
                    }
                __builtin_amdgcn_fence(__ATOMIC_RELEASE, "wavefront");
            }
        }
        if (more) tile_swrite<DV, !IMPP>(tr, lds, cur ^ 1, tid);
        __syncthreads();
    }
}

template <int NT> __device__ __forceinline__ void acc_zero(f32x16 (&a)[NT]) {
#pragma unroll
    for (int t = 0; t < NT; ++t)
#pragma unroll
        for (int r = 0; r < 16; ++r) a[t][r] = 0.f;
}
template <int NT> __device__ __forceinline__ void acc_norm(f32x16 (&a)[NT], float l) {
    const float lt = l + __shfl_xor(l, 32);
    const float inv = lt > 0.f ? 1.f / lt : 0.f;
#pragma unroll
    for (int t = 0; t < NT; ++t)
#pragma unroll
        for (int r = 0; r < 16; ++r) a[t][r] *= inv;
}
__device__ __forceinline__ void load_q(bf16x8 (&qf)[4], const bf16_t* qrow, int hi) {
#pragma unroll
    for (int ks = 0; ks < 4; ++ks) qf[ks] = *(const bf16x8*)(qrow + 16 * ks + 8 * hi);
}

struct AttnCtx {
    const bf16_t* zb;
    bf16_t *ya, *yb, *yc;
    float* park;
    const bf16_t *kcmp, *vtcmp;
    const float *rel_bias, *lamp, *subln, *sinks;
    float lam_init;
};

__device__ __forceinline__ void attn_unit_A(LAS uchar* lds, const AttnCtx& C, int bl, int h, int qt, int tid) {
    tid = opq(tid);
    const int lane = tid & 63, n = lane & 31, hi = lane >> 5, w = __builtin_amdgcn_readfirstlane(tid >> 6);
    build_tbl(lds, C.rel_bias, h, 1, tid);
    float lam;
    { const float a = C.lamp[lane] * C.lamp[64 + lane], b = C.lamp[128 + lane] * C.lamp[192 + lane]; lam = __expf(wave_sum(a)) - __expf(wave_sum(b)) + C.lam_init; }
    const int qpos = 256 * qt + 32 * w + n;
    const float rfar = C.rel_bias[31 * 20 + h] * LOG2E;
    const int kt1 = 4 * qt + 4, wkm = 4 * qt + (w >> 1);
    const bf16_t* Vt = C.zb + ZVA + ((size_t)bl * 8 + 2 * h) * HS;
    f32x16 acc[4];
    bf16x8 qf[4];
    float m, l;
    float* prow = C.park + ((size_t)bl * 4096 + qpos) * 512 + h * 128;
#pragma unroll 1
    for (int c = 1; c >= 0; --c) {
        const size_t hoff = ((size_t)bl * 8 + 2 * h + c) * HS;
        load_q(qf, C.zb + ZQA + hoff + (size_t)qpos * 64, hi);
        acc_zero<4>(acc); m = MINIT; l = 0.f;
        attn_pass<128, false>(lds, C.zb + ZKA + hoff, Vt, 4096, 0, kt1, wkm, qpos, 256 * qt + 32 * w, 256 * qt + 32 * w + 31, 1, 0, 0x7fffffffu, qf, L_TBL, 0ull, false, m, l, acc, 0.f, 0, rfar, tid);
        acc_norm<4>(acc, l);
        if (c == 1) {
#pragma unroll
            for (int t = 0; t < 4; ++t)
#pragma unroll
                for (int gq = 0; gq < 4; ++gq) *(f32x4*)(prow + 32 * t + 8 * gq + 4 * hi) = (f32x4){acc[t][4 * gq], acc[t][4 * gq + 1], acc[t][4 * gq + 2], acc[t][4 * gq + 3]};
        }
    }
    float ss = 0.f;
#pragma unroll
    for (int t = 0; t < 4; ++t)
#pragma unroll
        for (int gq = 0; gq < 4; ++gq) { const f32x4 o1 = *(const f32x4*)(prow + 32 * t + 8 * gq + 4 * hi);
#pragma unroll
            for (int e = 0; e < 4; ++e) { const float y = acc[t][4 * gq + e] - lam * o1[e]; acc[t][4 * gq + e] = y; ss += y * y; } }
    ss += __shfl_xor(ss, 32);
    const float rs = (1.0f / sqrtf(ss * (1.f / 128.f) + EPS)) * (1.f - C.lam_init);
    bf16_t* yrow = C.ya + ((size_t)bl * 4096 + qpos) * 512 + h * 128;
#pragma unroll
    for (int t = 0; t < 4; ++t)
#pragma unroll
        for (int gq = 0; gq < 4; ++gq) {
            const int d = 32 * t + 8 * gq + 4 * hi;
            const f32x4 gg = *(const f32x4*)(C.subln + d);
            u32x2 wv; wv.x = cvtpk(acc[t][4 * gq] * rs * gg[0], acc[t][4 * gq + 1] * rs * gg[1]); wv.y = cvtpk(acc[t][4 * gq + 2] * rs * gg[2], acc[t][4 * gq + 3] * rs * gg[3]);
            *(u32x2*)(yrow + d) = wv;
        }
}

__device__ __forceinline__ void attn_unit_B(LAS uchar* lds, const AttnCtx& C, int bl, int g, int i, int tid) {
    tid = opq(tid);
    const int lane = tid & 63, n = lane & 31, hi = lane >> 5, w = __builtin_amdgcn_readfirstlane(tid >> 6);
    build_tbl(lds, C.rel_bias, 4 + 4 * g, 4, tid);
    const int ql = 8 * w + (n & 7), hr = n >> 3, qpos = 64 * i + ql, head = 4 * g + hr, qlo = 64 * i + 8 * w;
    const float rfar = C.rel_bias[31 * 20 + 4 + head] * LOG2E;
    const int tbl = L_TBL + hr * 512;
    bf16x8 qf[4];
    load_q(qf, C.zb + ZQB + ((size_t)bl * 8 + head) * HS + (size_t)qpos * 64, hi);
    const size_t goff = ((size_t)bl * 2 + g) * HS;
    f32x16 acc[2];
    LAS float* otl = (LAS float*)(lds + L_RED) + tid;
    float m, l;
    const size_t tok = (size_t)bl * 4096 + qpos;
    const float* bg = (const float*)(C.zb + ZBG) + tok * 32 + head * 3;
    const float g0 = bg[0], g1 = bg[1], g2 = bg[2];
    const bf16_t* Kc = C.kcmp + ((size_t)bl * 2 + g) * 256 * 64;
    const bf16_t* Vc = C.vtcmp + ((size_t)bl * 2 + g) * 64 * 256;
    const int ktc1 = ((4 * i + 2) >> 6) + 1;
    acc_zero<2>(acc); m = MINIT; l = 0.f;
    attn_pass<64, false>(lds, Kc, Vc, 256, 0, ktc1, 1 << 20, qpos, qlo, qlo + 7, 16, 31, 0x7fffffffu, qf, tbl, 0ull, false, m, l, acc, 0.f, 0, rfar, tid);
    acc_norm<2>(acc, l);
#pragma unroll
    for (int t = 0; t < 2; ++t)
#pragma unroll
        for (int r = 0; r < 16; ++r) otl[(t * 16 + r) * NTHR] = g0 * acc[t][r];
    unsigned long long selmask = ~0ull;
    if (i >= 16) {
    {
        const float lt = l + __shfl_xor(l, 32);
        const float inv_l = lt > 0.f ? 1.f / lt : 0.f;
        LAS float* impw = (LAS float*)(lds + L_IMP) + (8 * w) * 65;
        for (int x = lane; x < 8 * 65; x += 64) impw[x] = 0.f;
        __builtin_amdgcn_fence(__ATOMIC_RELEASE, "wavefront");
        attn_pass<64, true>(lds, Kc, Vc, 256, 0, ktc1, 1 << 20, qpos, qlo, qlo + 7, 16, 31, 0x7fffffffu, qf, tbl, 0ull, false, m, l, acc, inv_l, ql, rfar, tid);
    }
    {
        const int q = tid & 63, part = tid >> 6;
        const LAS float* row = (const LAS float*)(lds + L_IMP) + q * 65;
        float cand[8]; int rank[8];
#pragma unroll
        for (int c = 0; c < 8; ++c) { const int j = 8 * part + c; float v = row[j]; v = (j == 0 || j == i || j == i - 1) ? 1e6f : (j > i ? -1e6f : v); cand[c] = v; rank[c] = 0; }
        for (int jj = 0; jj <= i; ++jj) {
            float x = row[jj]; x = (jj == 0 || jj == i || jj == i - 1) ? 1e6f : (jj > i ? -1e6f : x);
#pragma unroll
            for (int c = 0; c < 8; ++c) { const int j = 8 * part + c; rank[c] += (x > cand[c] || (x == cand[c] && jj < j)) ? 1 : 0; }
        }
        unsigned bits = 0;
#pragma unroll
        for (int c = 0; c < 8; ++c) bits |= (rank[c] < 16 ? 1u : 0u) << c;
        ((LAS uchar*)(lds + L_SEL))[q * 8 + part] = (uchar)bits;
    }
    __syncthreads();
    { const u32x2 sm = *(const LAS u32x2*)(lds + L_SEL + ql * 8); selmask = (unsigned long long)sm.x | ((unsigned long long)sm.y << 32); }
    }
    acc_zero<2>(acc); m = MINIT; l = 0.f;
    attn_pass<64, false>(lds, C.zb + ZKS + goff, C.zb + ZVS + goff, 4096, 0, i + 1, 1 << 20, qpos, qlo, qlo + 7, 1, 0, 0x7fffffffu, qf, tbl, selmask, true, m, l, acc, 0.f, 0, rfar, tid);
    acc_norm<2>(acc, l);
#pragma unroll
    for (int t = 0; t < 2; ++t)
#pragma unroll
        for (int r = 0; r < 16; ++r) otl[(t * 16 + r) * NTHR] += g1 * acc[t][r];
    acc_zero<2>(acc); m = MINIT; l = 0.f;
    attn_pass<64, false>(lds, C.zb + ZKW + goff, C.zb + ZVW + goff, 4096, i > 8 ? i - 8 : 0, i + 1, 1 << 20, qpos, qlo, qlo + 7, 1, 0, 512u, qf, tbl, 0ull, false, m, l, acc, 0.f, 0, rfar, tid);
    acc_norm<2>(acc, l);
    bf16_t* yrow = C.yb + tok * 512 + head * 64;
#pragma unroll
    for (int t = 0; t < 2; ++t)
#pragma unroll
        for (int gq = 0; gq < 4; ++gq) {
            const int d = 32 * t + 8 * gq + 4 * hi;
            float o[4];
#pragma unroll
            for (int e = 0; e < 4; ++e) o[e] = otl[(t * 16 + 4 * gq + e) * NTHR] + g2 * acc[t][4 * gq + e];
            u32x2 wv; wv.x = cvtpk(o[0], o[1]); wv.y = cvtpk(o[2], o[3]);
            *(u32x2*)(yrow + d) = wv;
        }
}

__device__ __forceinline__ void attn_unit_C(LAS uchar* lds, const AttnCtx& C, int bl, int g, int i, int tid) {
    tid = opq(tid);
    const int lane = tid & 63, n = lane & 31, hi = lane >> 5, w = __builtin_amdgcn_readfirstlane(tid >> 6);
    build_tbl(lds, C.rel_bias, 12 + 4 * g, 4, tid);
    const int ql = 8 * w + (n & 7), hr = n >> 3, qpos = 64 * i + ql, head = 4 * g + hr, qlo = 64 * i + 8 * w;
    const float rfar = C.rel_bias[31 * 20 + 12 + head] * LOG2E;
    const int tbl = L_TBL + hr * 512;
    bf16x8 qf[4];
    load_q(qf, C.zb + ZQC + ((size_t)bl * 8 + head) * HS + (size_t)qpos * 64, hi);
    const size_t goff = ((size_t)bl * 2 + g) * HS;
    f32x16 acc[2];
    acc_zero<2>(acc);
    float m = C.sinks[head] * LOG2E, l = hi == 0 ? 1.f : 0.f;
    attn_pass<64, false>(lds, C.zb + ZKC + goff, C.zb + ZVC + goff, 4096, i > 2 ? i - 2 : 0, i + 1, 1 << 20, qpos, qlo, qlo + 7, 1, 0, 128u, qf, tbl, 0ull, false, m, l, acc, 0.f, 0, rfar, tid);
    acc_norm<2>(acc, l);
    const size_t tok = (size_t)bl * 4096 + qpos;
    bf16_t* yrow = C.yc + tok * 512 + head * 64;
#pragma unroll
    for (int t = 0; t < 2; ++t)
#pragma unroll
        for (int gq = 0; gq < 4; ++gq) {
            const int d = 32 * t + 8 * gq + 4 * hi;
            u32x2 wv; wv.x = cvtpk(acc[t][4 * gq], acc[t][4 * gq + 1]); wv.y = cvtpk(acc[t][4 * gq + 2], acc[t][4 * gq + 3]);
            *(u32x2*)(yrow + d) = wv;
        }
}

#define XB_TMO      128
#define XB_XCNT(j)  (256  + 64 * (j))
#define XB_XSUB(j)  (1280 + 64 * (j))
#define XB_XGEN(j)  (2304 + 64 * (j))
#define XB_TOP      3328
#define XB_TOPGEN   3392
#define XCD_BAR_WORDS 3456
#define XB_SPIN_CAP (1u << 18)

__device__ __forceinline__ unsigned xb_ld(unsigned* p)              { return __hip_atomic_load(p, __ATOMIC_RELAXED, __HIP_MEMORY_SCOPE_AGENT); }
__device__ __forceinline__ unsigned xb_add(unsigned* p, unsigned v) { return __hip_atomic_fetch_add(p, v, __ATOMIC_RELAXED, __HIP_MEMORY_SCOPE_AGENT); }
__device__ __forceinline__ unsigned xb_xcc_id() { return (unsigned)__builtin_amdgcn_s_getreg((3 << 11) | 20) & 0xFu; }
#define XB_SPIN(cond, bar) do { unsigned _sp = 0; while (cond) { __builtin_amdgcn_s_sleep(1); \
    if ((++_sp & 255u) == 0u) { if (xb_ld(&(bar)[XB_TMO])) break; if (_sp > XB_SPIN_CAP) { atomicAdd(&(bar)[XB_TMO], 1u); break; } } } } while (0)

struct XcdBarrier {
    unsigned* bar; unsigned x;
    volatile __attribute__((address_space(3))) unsigned* st;
};

__device__ __forceinline__ XcdBarrier xcd_barrier_post(unsigned* bar, volatile __attribute__((address_space(3))) unsigned* st) {
    XcdBarrier b; b.bar = bar; b.x = xb_xcc_id(); b.st = st;
    if (threadIdx.x == 0) (void)xb_add(&bar[XB_XCNT(b.x)], 1u);
    return b;
}
__device__ __forceinline__ void xcd_barrier_complete(unsigned* bar, unsigned x, unsigned& nloc, unsigned& nx) {
    const unsigned G = gridDim.x * gridDim.y * gridDim.z;
    unsigned sum, cnt, mine, sp = 0u;
    for (;;) {
        sum = 0u; cnt = 0u; mine = 0u;
#pragma unroll
        for (unsigned j = 0; j < 16; ++j) { const unsigned c = xb_ld(&bar[XB_XCNT(j)]); sum += c; cnt += (c > 0u) ? 1u : 0u; mine = (j == x) ? c : mine; }
        if (sum == G) break;
        __builtin_amdgcn_s_sleep(1);
        if ((++sp & 255u) == 0u) { if (xb_ld(&bar[XB_TMO])) break; if (sp > XB_SPIN_CAP) { atomicAdd(&bar[XB_TMO], 1u); break; } }
    }
    nloc = mine > 0u ? mine : 1u; nx = cnt > 0u ? cnt : 1u;
}

__device__ __forceinline__ void xcd_barrier(const XcdBarrier& b) {
    asm volatile("s_waitcnt vmcnt(0)" ::: "memory");
    __syncthreads();
    if (threadIdx.x == 0) {
        unsigned* bar = b.bar;
        __builtin_amdgcn_s_waitcnt(0);
        unsigned nloc = b.st[0], nx = b.st[1];
        if (nloc == 0u) { xcd_barrier_complete(bar, b.x, nloc, nx); b.st[0] = nloc; b.st[1] = nx; }
        const unsigned old = xb_add(&bar[XB_XSUB(b.x)], 1u);
        const unsigned gen = old / nloc;
        if (old + 1u == (gen + 1u) * nloc) {
            __builtin_amdgcn_fence(__ATOMIC_RELEASE, "agent");
            asm volatile("s_waitcnt vmcnt(0)" ::: "memory");
            const unsigned og = xb_add(&bar[XB_TOP], 1u);
            const unsigned tg = og / nx;
            if (og + 1u == (tg + 1u) * nx) xb_add(&bar[XB_TOPGEN], 1u);
            else XB_SPIN(xb_ld(&bar[XB_TOPGEN]) == tg, bar);
            __builtin_amdgcn_fence(__ATOMIC_ACQUIRE, "agent");
            xb_add(&bar[XB_XGEN(b.x)], 1u);
            asm volatile("s_waitcnt vmcnt(0)" ::: "memory");
        } else {
            XB_SPIN(xb_ld(&bar[XB_XGEN(b.x)]) == gen, bar);
            __builtin_amdgcn_fence(__ATOMIC_ACQUIRE, "agent");
            asm volatile("s_waitcnt vmcnt(0)" ::: "memory");
        }
    }
    __syncthreads();
}

#define KIN(i) (kparams()->in[i])
#define WS_ (kparams()->ws)
#define HOUT (kparams()->out)
#define Wb ((bf16_t*)(WS_ + WS_W))
#define XN ((bf16_t*)(WS_ + WS_XN))
#define R1 ((bf16_t*)(WS_ + WS_R1))
#define YA ((bf16_t*)(WS_ + WS_Y))
#define MG ((bf16_t*)(WS_ + WS_MG))
#define CH ((bf16_t*)(WS_ + WS_CH))
#define KCMP ((bf16_t*)(WS_ + WS_KCMP))
#define VCMP ((bf16_t*)(WS_ + WS_VCMP))
#define CB ((float*)(WS_ + WS_CB))
#define XN2 ((bf16_t*)(WS_ + WS_XN2))
#define PBF ((bf16_t*)(WS_ + WS_PBF))
#define SSQ ((float*)(WS_ + WS_SSQ))
#define SSQ2 ((float*)(WS_ + WS_SSQ2))
constexpr int LDS_BYTES = 147456;
#ifdef ONLY_EPI
#include <type_traits>
#define ONLY_OK(E) (std::is_same<E, ONLY_EPI>::value)
#else
#define ONLY_OK(E) true
#endif
#ifdef NO_GEMM
#define GEMM(EPI, e, A_, lda_, Bt_, M_, N_, K_, cshift) do { (void)(e); } while (0)
#else
#define GEMM(EPI, e, A_, lda_, Bt_, M_, N_, K_, cshift) do { pg8::Gemm g_{(const bf16_t*)(A_), (const bf16_t*)(Bt_), (M_), (N_), (K_), (lda_)}; pg8::StaticOrder S_; \
    int c_ = (int)((blk + (cshift)) % G), G_ = G; asm volatile("" : "+s"(c_), "+s"(G_)); S_.init((M_), (N_), G_, c_); if (ONLY_OK(EPI)) pg8::gemm_phase<EPI, pg8::StaticOrder, EPI::ALIGN, true>(lds, g_, S_, (e)); } while (0)
#endif
#ifdef NO_GEMM
#define GEMM_X(EPI, e, A_, lda_, Bt_, M_, N_, K_, cidx, gsz) do { (void)(e); } while (0)
#else
#define GEMM_X(EPI, e, A_, lda_, Bt_, M_, N_, K_, cidx, gsz) do { pg8::Gemm g_{(const bf16_t*)(A_), (const bf16_t*)(Bt_), (M_), (N_), (K_), (lda_)}; pg8::StaticOrder S_; \
    int c_ = (int)(cidx), G_ = (int)(gsz); asm volatile("" : "+s"(c_), "+s"(G_)); S_.init((M_), (N_), G_, c_); if (ONLY_OK(EPI)) pg8::gemm_phase<EPI, pg8::StaticOrder, EPI::ALIGN, true>(lds, g_, S_, (e)); } while (0)
#endif

__global__ void __launch_bounds__(NTHR, 2) fwd_kernel(Params P) {
    extern __shared__ __attribute__((aligned(16))) unsigned char lds_raw[];
    LAS uchar* lds = (LAS uchar*)lds_raw;
    cg::grid_group grid = cg::this_grid();
    volatile LAS unsigned* xst = (volatile LAS unsigned*)(lds + LDS_BYTES - 64);
    if (threadIdx.x < 2) xst[threadIdx.x] = 0u;
    __syncthreads();
    const XcdBarrier xbar = xcd_barrier_post((unsigned*)(kparams()->ws + WS_CTL), xst);
#ifndef PROBE_CLASS
#define PROBE_CLASS 0
#endif
#if PROBE_CLASS
    unsigned long long pr_acc = 0, pr_last = __builtin_amdgcn_s_memrealtime();
#define SYNC(cls) do { const unsigned long long t1_ = __builtin_amdgcn_s_memrealtime(); if ((cls) == PROBE_CLASS) pr_acc += t1_ - pr_last; if ((cls) == 6) grid.sync(); else xcd_barrier(xbar); \
    const unsigned long long t2_ = __builtin_amdgcn_s_memrealtime(); if (PROBE_CLASS == 2) pr_acc += t2_ - t1_; pr_last = t2_; } while (0)
#else
#define SYNC(cls) do { if ((cls) == 6) grid.sync(); else xcd_barrier(xbar); } while (0)
#endif
#define DEF_IDS \
    int tid_o = threadIdx.x, G_o = gridDim.x, blk_o = blockIdx.x; asm volatile("" : "+v"(tid_o), "+s"(G_o), "+s"(blk_o)); \
    const int tid = tid_o, lane = tid & 63, wave = __builtin_amdgcn_readfirstlane(tid >> 6); \
    const int G = G_o, blk = blk_o; \
    const int vcu = (G % 8 == 0) ? (blk % 8) * (G / 8) + blk / 8 : blk; \
    const int gw = blk * 8 + wave, ngw = G * 8; (void)vcu; (void)gw; (void)ngw; (void)lane;
    {
        DEF_IDS
        LAS float* scr = (LAS float*)lds;
        int base = 0;
        for (int L = 0; L < DEPTH; ++L) {
            bf16_t* wl = Wb + (size_t)L * W_LAYER;
            conv_matrix(KIN(3) + (size_t)L * 1024 * 5632, 1024, 5632, 5632, 1, wl + W_WI1, base, scr, tid, blk, G, KIN(2) + (size_t)(L * 4 + 0) * DM);
            conv_matrix(KIN(4) + (size_t)L * 2816 * 1024, 2816, 1024, 1024, 0, wl + W_WO1, base, scr, tid, blk, G);
            conv_matrix(KIN(5) + (size_t)L * 1024 * DIN, 1024, DIN, DINP, 2, wl + W_WIN, base, scr, tid, blk, G, KIN(2) + (size_t)(L * 4 + 1) * DM);
            for (int t = 0; t < 2; ++t) conv_matrix(KIN(9) + ((size_t)L * 2 + t) * 2048 * 256, 2048, 256, 256, 0, wl + W_CW1 + (size_t)t * 256 * 2048, base, scr, tid, blk, G);
            for (int t = 0; t < 2; ++t) conv_matrix(KIN(10) + ((size_t)L * 2 + t) * 256 * 64, 256, 64, 256, 3, wl + W_CW2 + (size_t)t * 256 * 256, base, scr, tid, blk, G);
            for (int t = 0; t < 3; ++t) conv_matrix(KIN(12) + ((size_t)L * 3 + t) * 512 * 1024, 512, 1024, 1024, 0, wl + W_WBR + (size_t)t * 1024 * 512, base, scr, tid, blk, G);
            conv_matrix(KIN(13) + (size_t)L * 1024 * 1024, 1024, 1024, 1024, 0, wl + W_WOUT, base, scr, tid, blk, G);
            conv_matrix(KIN(14) + (size_t)L * 1024 * 5632, 1024, 5632, 5632, 1, wl + W_WI2, base, scr, tid, blk, G, KIN(2) + (size_t)(L * 4 + 2) * DM);
            conv_matrix(KIN(15) + (size_t)L * 2816 * 1024, 2816, 1024, 1024, 0, wl + W_WO2, base, scr, tid, blk, G);
            conv_matrix(KIN(16) + (size_t)L * 256 * 1024, 256, 1024, 1024, 0, wl + W_WPE, base, scr, tid, blk, G);
            conv_matrix(KIN(17) + (size_t)L * 1024 * 1024, 1024, 1024, 1024, 0, wl + W_WPG, base, scr, tid, blk, G, KIN(2) + (size_t)(L * 4 + 3) * DM);
        }
        for (int pr = blk; pr < DEPTH * 2; pr += G) {
            const float* pos = KIN(8) + (size_t)pr * 2048; const float* w1 = KIN(9) + (size_t)pr * 2048 * 256;
            float a[4] = {0.f, 0.f, 0.f, 0.f};
            for (int k = wave * 256; k < wave * 256 + 256; ++k) { const float pv = pos[k];
#pragma unroll
                for (int j = 0; j < 4; ++j) a[j] += pv * w1[(size_t)k * 256 + lane + 64 * j]; }
#pragma unroll
            for (int j = 0; j < 4; ++j) scr[wave * 256 + lane + 64 * j] = a[j];
            __syncthreads();
            if (tid < 256) { float s = 0.f;
#pragma unroll
                for (int ww = 0; ww < 8; ++ww) s += scr[ww * 256 + tid];
                CB[pr * 256 + tid] = s; }
            __syncthreads();
        }
        phase_prep(KIN(0), XN2, SSQ2, gw, ngw, lane);
    }
    SYNC(6);

#pragma unroll 1
    for (int L = 0; L < DEPTH; ++L) {
        DEF_IDS
#define wl (Wb + (size_t)L * W_LAYER)
#define ng (KIN(2) + (size_t)L * 4 * DM)
        { EpiSwiglu e{R1, SSQ2}; GEMM(EpiSwiglu, e, XN2, 1024, wl + W_WI1, T, 5632, 1024, 0); }
        SYNC(3);
        { EpiResid e{0.5f, 0, L == 0 ? 1 : 0}; GEMM(EpiResid, e, R1, DFF, wl + W_WO1, T, 1024, DFF, 0); }
        SYNC(3);
        { EpiZ e{R1, SSQ, 0}; GEMM(EpiZ, e, XN, 1024, wl + W_WIN, TC, DINP - 256, 1024, 0); }
        SYNC(3);
        for (int c = 0; c < NCHUNK; ++c) {
            {
                const bool offl = (G >= 64) && ((G & 1) == 0), has_cmp = blk < 16 || (blk >= G / 2 && blk < G / 2 + 16);
                EpiZ e{R1, SSQ + (size_t)c * TC * 16, 26};
                if (!offl) GEMM(EpiZ, e, XN + (size_t)c * TC * DM, 1024, wl + W_WIN + (size_t)(DINP - 256) * 1024, TC, 256, 1024, 0);
                else if (!has_cmp) GEMM_X(EpiZ, e, XN + (size_t)c * TC * DM, 1024, wl + W_WIN + (size_t)(DINP - 256) * 1024, TC, 256, 1024, blk < G / 2 ? blk - 16 : blk - 32, G - 32);
            }
            { EpiBf<1> ek{CH, 256, CB + (L * 2 + 0) * 256}; GEMM(EpiBf<1>, ek, R1 + ZKCI, 1024, wl + W_CW1, NB * 512, 256, 2048, 0);
              EpiBf<1> ev{CH + (size_t)NB * 512 * 256, 256, CB + (L * 2 + 1) * 256}; GEMM(EpiBf<1>, ev, R1 + ZVCI, 1024, wl + W_CW1 + (size_t)256 * 2048, NB * 512, 256, 2048, G / 2); }
            __builtin_amdgcn_fence(__ATOMIC_RELEASE, "workgroup"); __syncthreads(); __builtin_amdgcn_fence(__ATOMIC_ACQUIRE, "workgroup");
            { EpiCmp2<false> ek{KCMP}; GEMM(EpiCmp2<false>, ek, CH, 256, wl + W_CW2, NB * 512, 256, 256, 0);
              EpiCmp2<true> ev{VCMP}; GEMM(EpiCmp2<true>, ev, CH + (size_t)NB * 512 * 256, 256, wl + W_CW2 + (size_t)256 * 256, NB * 512, 256, 256, G / 2); }
            SYNC(5);
            {
                AttnCtx C;
                C.zb = R1; C.park = (float*)MG; C.ya = YA; C.yb = YA + (size_t)TC * 512; C.yc = YA + (size_t)2 * TC * 512; C.kcmp = KCMP; C.vtcmp = VCMP;
                C.rel_bias = KIN(18); C.lamp = KIN(6) + (size_t)L * 256; C.subln = KIN(7) + (size_t)L * 128; C.sinks = KIN(11) + (size_t)L * 8;
                C.lam_init = 0.8f - 0.6f * __expf(-0.3f * (float)L);
                for (int u = vcu; u < NB * 32; u += G) {
                    const int bl = u >> 5;
#ifndef NO_A
#if PROBE_CLASS == 7
                    const unsigned long long ta0_ = __builtin_amdgcn_s_memrealtime();
#endif
                    { const int h = (u >> 3) & 3, qp = u & 7;
#pragma unroll 1
                      for (int k = 0; k < 2; ++k) attn_unit_A(lds, C, bl, h, k ? 15 - qp : qp, tid); }
#if PROBE_CLASS == 7
                    pr_acc += __builtin_amdgcn_s_memrealtime() - ta0_;
#endif
#endif
                    { const int g = (u >> 4) & 1, is = u & 15;
#ifndef NO_B
#pragma unroll 1
                      for (int k = 0; k < 4; ++k) attn_unit_B(lds, C, bl, g, (k & 1) ? (k == 1 ? 31 : 63) - is : (k == 0 ? 0 : 32) + is, tid);
#endif
#ifndef NO_C
#pragma unroll 1
                      for (int k = 0; k < 4; ++k) attn_unit_C(lds, C, bl, g, (k & 1) ? (k == 1 ? 31 : 63) - is : (k == 0 ? 0 : 32) + is, tid);
#endif
                    }
                }
            }
            SYNC(1);
            for (int mi = 0; mi < 3; ++mi) {
                EpiBranch e{MG, R1 + ZSG, mi}; GEMM(EpiBranch, e, YA + (size_t)mi * TC * 512, 512, wl + W_WBR + (size_t)mi * 1024 * 512, TC, 1024, 512, 0);
            }
            SYNC(3);
            { EpiResid e{1.0f, c * TC, 0}; GEMM(EpiResid, e, MG, 1024, wl + W_WOUT, TC, 1024, 1024, 0); }
            if (c + 1 < NCHUNK) { EpiZ e{R1, SSQ + (size_t)(c + 1) * TC * 16, 0}; GEMM(EpiZ, e, XN + (size_t)(c + 1) * TC * DM, 1024, wl + W_WIN, TC, DINP - 256, 1024, 0); }
            SYNC(3);
        }
        {
            const f32x4* src = (const f32x4*)(KIN(1) + (size_t)L * T * PLE); u32x2* dst = (u32x2*)PBF;
            const int tq = opq(tid);
            for (size_t idx = (size_t)blk * NTHR + tq; idx < (size_t)T * PLE / 4; idx += (size_t)G * NTHR) { const f32x4 v = src[idx]; u32x2 w; w.x = cvtpk(v[0], v[1]); w.y = cvtpk(v[2], v[3]); dst[idx] = w; }
        }
        { EpiSwiglu e{R1, SSQ}; GEMM(EpiSwiglu, e, XN, 1024, wl + W_WI2, T, 5632, 1024, 0); }
        SYNC(3);
        { EpiResid e{0.5f, 0, 0}; GEMM(EpiResid, e, R1, DFF, wl + W_WO2, T, 1024, DFF, 0); }
        SYNC(3);
        { EpiBf<0> e{(bf16_t*)((uchar*)R1 + R1_E), 1024, nullptr}; GEMM(EpiBf<0>, e, PBF, 256, wl + W_WPE, T, 1024, 256, 0); }
        SYNC(3);
        { float* ho_ = HOUT; uchar* ws_ = WS_; EpiPle e{ho_, (const bf16_t*)(ws_ + WS_R1 + R1_E), (const float*)(ws_ + WS_SSQ), (bf16_t*)(ws_ + WS_XN2), (float*)(ws_ + WS_SSQ2)}; GEMM(EpiPle, e, XN, 1024, wl + W_WPG, T, 1024, 1024, 0); }
        SYNC(3);
    }
    { DEF_IDS const int lq = opq(lane); float* ho = HOUT; const float* fg = KIN(19); for (int m = gw; m < T; m += ngw) rms_row_f32(ho + (size_t)m * DM, fg, ho + (size_t)m * DM, lq); }
#if PROBE_CLASS
    if (blockIdx.x == 0) { const unsigned long long t0_ = __builtin_amdgcn_s_memrealtime(); while (__builtin_amdgcn_s_memrealtime() - t0_ < pr_acc) __builtin_amdgcn_s_sleep(20); }
#endif
}

extern "C" void kernel_launch(void* const* d_in, const int* in_sizes, int n_in, void* d_out, int out_size, void* d_ws, size_t ws_size, hipStream_t stream) {
    static int grid = 0;
    if (grid == 0) {
        if (n_in != 20 || out_size != T * DM || ws_size < WS_END) { fprintf(stderr, "kernel_launch: unexpected shapes (n_in %d out %d ws %zu)\n", n_in, out_size, ws_size); grid = -1; return; }
        int dev = 0, cus = 0, per_cu = 0;
        hipGetDevice(&dev);
        hipDeviceGetAttribute(&cus, hipDeviceAttributeMultiprocessorCount, dev);
        if (hipFuncSetAttribute((const void*)fwd_kernel, hipFuncAttributeMaxDynamicSharedMemorySize, LDS_BYTES) != hipSuccess) { fprintf(stderr, "kernel_launch: hipFuncSetAttribute failed\n"); grid = -1; return; }
        if (hipOccupancyMaxActiveBlocksPerMultiprocessor(&per_cu, (const void*)fwd_kernel, NTHR, LDS_BYTES) != hipSuccess || per_cu < 1) { fprintf(stderr, "kernel_launch: occupancy query says %d\n", per_cu); per_cu = 1; }
        (void)hipGetLastError();
        grid = cus;
        if (grid > 256) grid = 256;
    }
    if (grid < 0) return;
    if (hipMemsetAsync((char*)d_ws + WS_CTL, 0, CTL_ZERO_BYTES, stream) != hipSuccess) { fprintf(stderr, "kernel_launch: memset failed\n"); return; }
    Params p{};
    for (int i = 0; i < 20; ++i) p.in[i] = (const float*)d_in[i];
    p.out = (float*)d_out; p.ws = (uchar*)d_ws;
    void* args[] = {&p};
    hipError_t e = hipLaunchCooperativeKernel((const void*)fwd_kernel, dim3(grid), dim3(NTHR), args, LDS_BYTES, stream);
    if (e != hipSuccess) fprintf(stderr, "cooperative launch failed: %s (grid %d)\n", hipGetErrorString(e), grid);
}
```

```cpp
#include <hip/hip_runtime.h>
#include <hip/hip_cooperative_groups.h>
#include <cstdio>
#include <cstdint>
namespace cg = cooperative_groups;
namespace pg8 {
#define PG8_LAS __attribute__((address_space(3)))
typedef unsigned short bf16_t;
typedef short bf16x8 __attribute__((ext_vector_type(8)));
typedef float f32x4 __attribute__((ext_vector_type(4)));
typedef unsigned u32x4 __attribute__((ext_vector_type(4)));
constexpr int BM = 256, BK = 64, HALF = 128, HTB = HALF * BK * 2  , STAGE_BYTES = 8 * HTB, NXCD = 8, WGM = 4;

__host__ __device__ __forceinline__ int lds_byte(int r, int c) { const int st = (r >> 4) * 2 + (c >> 5), rr = r & 15, cc = c & 31, ob = rr * 64 + cc * 2; return st * 1024 + (ob ^ (((ob >> 9) & 1) << 5)); }
__host__ __device__ __forceinline__ void stage_rc(int b, int& R, int& C) { const int st = b / 1024, sb = b % 1024, swz = sb ^ (((sb >> 9) & 1) << 5); R = (st >> 1) * 16 + swz / 64; C = (st & 1) * 32 + (swz % 64) / 2; }
__host__ __device__ __forceinline__ int perm32(int rho) { const int n = rho >> 4, i = rho & 15; return 8 * (i >> 2) + 4 * n + (i & 3); }

struct Unit { int pm, pn; };
struct Gemm { const bf16_t* A; const bf16_t* Bt; int M, N, K, lda; };

struct StaticOrder {
    int nM, nN, nwg, G, c;
    __host__ __device__ void init(int M, int N, int G_, int c_) { nM = M / BM; nN = N / BM; nwg = nM * nN; G = G_; c = c_; }
    __host__ __device__ bool next(int i, Unit& u) const {
        const long L = (long)i * G + c; if (L >= nwg) return false;
        int wgid = (int)L; { const int q = nwg / NXCD, r = nwg % NXCD, xcd = wgid % NXCD, off = wgid / NXCD; wgid = (xcd < r ? xcd * (q + 1) : r * (q + 1) + (xcd - r) * q) + off; }
        const int nig = WGM * nN, gid = wgid / nig, fm = gid * WGM, gsz = (nM - fm) < WGM ? (nM - fm) : WGM;
        u.pm = fm + ((wgid % nig) % gsz); u.pn = (wgid % nig) / gsz; return true;
    }
    __device__ __forceinline__ void a_ready(const Unit&) const {}
    __device__ __forceinline__ void done(const Unit&) const {}
};

__device__ __forceinline__ unsigned cvt_pk_bf16(float lo, float hi) { unsigned r; asm volatile("v_cvt_pk_bf16_f32 %0, %1, %2" : "=v"(r) : "v"(lo), "v"(hi)); return r; }
typedef float f32x2 __attribute__((ext_vector_type(2)));
template <class Epi, class Sched, bool ALIGN_EPI = false, bool SP2 = false>
__device__ __forceinline__ void gemm_phase(PG8_LAS unsigned char* lds, const Gemm g, const Sched& S, const Epi& E) {
    int tid_ = threadIdx.x; asm volatile("" : "+v"(tid_)); const int tid = tid_, wid = __builtin_amdgcn_readfirstlane(tid >> 6), lane = tid & 63, wr = wid >> 2, wc = wid & 3, fr = lane & 15, fq = lane >> 4;
    const int K = g.K, nt = K / BK;
    unsigned voffA[2], voffB[2];
#pragma unroll
    for (int i = 0; i < 2; ++i) { int R, C; stage_rc(tid * 16 + i * 8192, R, C); const int Rb = Epi::PERM ? ((R & ~31) + perm32(R & 31)) : R;
        voffA[i] = (unsigned)(R * g.lda + C) * 2u; voffB[i] = (unsigned)(Rb * K + C) * 2u; }
    const size_t kstep = (size_t)(BK * 2);
    const size_t hstep = (size_t)HALF * K * 2;
    const size_t tstep = 2 * hstep; const size_t hstepA = (size_t)HALF * g.lda * 2, tstepA = 2 * hstepA;
    const unsigned ldsw = (unsigned)wid * 1024u;
    const int aoff = lds_byte(wr * 64 + fr, fq * 8), boff = lds_byte(wc * 32 + fr, fq * 8);
#define PG8_SA(b, h) (((b) * 2 + (h)) * HTB)
#define PG8_SB(b, h) ((4 + (b) * 2 + (h)) * HTB)
#define PG8_STAGE(bufoff, gbase, voff) do { _Pragma("unroll") for (int _i = 0; _i < 2; ++_i) \
        __builtin_amdgcn_global_load_lds((const unsigned*)((const char*)(gbase) + (voff)[_i]), (PG8_LAS unsigned*)(lds + (bufoff) + ldsw + _i * 8192), 16, 0, 0); } while (0)
#define PG8_LDA(dst, b, h) do { _Pragma("unroll") for (int m = 0; m < 4; ++m) _Pragma("unroll") for (int k = 0; k < 2; ++k) dst[m][k] = *(const PG8_LAS bf16x8*)(lds + PG8_SA(b, h) + aoff + m * 2048 + k * 1024); } while (0)
#define PG8_LDB(dst, b, h) do { _Pragma("unroll") for (int n = 0; n < 2; ++n) _Pragma("unroll") for (int k = 0; k < 2; ++k) dst[n][k] = *(const PG8_LAS bf16x8*)(lds + PG8_SB(b, h) + boff + n * 2048 + k * 1024); } while (0)
#define PG8_MMA(ai, bj, At, Bt) do { __builtin_amdgcn_s_setprio(1); _Pragma("unroll") for (int m = 0; m < 4; ++m) _Pragma("unroll") for (int n = 0; n < 2; ++n) _Pragma("unroll") for (int k = 0; k < 2; ++k) \
        acc[ai][bj][m][n] = __builtin_amdgcn_mfma_f32_16x16x32_bf16(Bt[n][k], At[m][k], acc[ai][bj][m][n], 0, 0, 0); __builtin_amdgcn_s_setprio(0); } while (0)
#define PG8_WAIT_V(n) asm volatile("s_waitcnt vmcnt(" #n ")" ::: "memory")
#define PG8_WAIT_L(n) asm volatile("s_waitcnt lgkmcnt(" #n ")" ::: "memory")
#define PG8_BAR __builtin_amdgcn_s_barrier()
#define PG8_SCHED __builtin_amdgcn_sched_barrier(0)
    Unit cur, nxt; int ui = 0;
    if (!S.next(0, cur)) return;
    f32x4 acc[2][2][4][2];
#pragma unroll
    for (int a = 0; a < 2; ++a)
#pragma unroll
        for (int b = 0; b < 2; ++b)
#pragma unroll
            for (int m = 0; m < 4; ++m)
#pragma unroll
                for (int n = 0; n < 2; ++n) acc[a][b][m][n] = (f32x4){0.f, 0.f, 0.f, 0.f};
    bf16x8 At[4][2], B0[2][2], B1[2][2];
    const char* cA = (const char*)g.A + (size_t)cur.pm * tstepA; const char* cB = (const char*)g.Bt + (size_t)cur.pn * tstep;
    S.a_ready(cur);
    if constexpr (SP2) {
        PG8_STAGE(PG8_SB(0, 0), cB, voffB); PG8_STAGE(PG8_SB(0, 1), cB + hstep, voffB); PG8_STAGE(PG8_SA(0, 0), cA, voffA); PG8_STAGE(PG8_SA(0, 1), cA + hstepA, voffA);
        if (wr == 1) PG8_BAR;
        PG8_WAIT_V(2); PG8_BAR;
        PG8_STAGE(PG8_SB(1, 0), cB + kstep, voffB); PG8_STAGE(PG8_SA(1, 0), cA + kstep, voffA); PG8_STAGE(PG8_SB(1, 1), cB + hstep + kstep, voffB);
        PG8_WAIT_V(6); PG8_BAR;
    } else {
        PG8_STAGE(PG8_SB(0, 0), cB, voffB); PG8_STAGE(PG8_SA(0, 0), cA, voffA); PG8_STAGE(PG8_SB(0, 1), cB + hstep, voffB); PG8_STAGE(PG8_SA(0, 1), cA + hstepA, voffA);
        if (wr == 1) PG8_BAR;
        PG8_WAIT_V(4); PG8_BAR;
        PG8_STAGE(PG8_SB(1, 0), cB + kstep, voffB); PG8_STAGE(PG8_SA(1, 0), cA + kstep, voffA); PG8_STAGE(PG8_SB(1, 1), cB + hstep + kstep, voffB);
        PG8_WAIT_V(6); PG8_BAR;
    }
    for (;;) {
        const bool has_next = S.next(ui + 1, nxt);
        const char* nA = has_next ? (const char*)g.A + (size_t)nxt.pm * tstepA : cA; const char* nB = has_next ? (const char*)g.Bt + (size_t)nxt.pn * tstep : cB;
        for (int t = 0; t < nt; t += 2) {
            const bool last = (t == nt - 2);
            const char* a1 = cA + (size_t)(t + 1) * kstep;
            const char* a2 = last ? nA : cA + (size_t)(t + 2) * kstep; const char* b2 = last ? nB : cB + (size_t)(t + 2) * kstep;
            const char* a3 = a2 + kstep; const char* b3 = b2 + kstep;
            if (last && has_next) S.a_ready(nxt);
            if constexpr (SP2) {
            PG8_LDB(B0, 0, 0); PG8_LDB(B1, 0, 1); PG8_SCHED; PG8_LDA(At, 0, 0); PG8_STAGE(PG8_SA(1, 1), a1 + hstepA, voffA);
            PG8_WAIT_V(8); PG8_WAIT_L(0); PG8_BAR; PG8_MMA(0, 0, At, B0); PG8_MMA(0, 1, At, B1); PG8_BAR; PG8_SCHED;
            PG8_LDA(At, 0, 1); PG8_STAGE(PG8_SB(0, 0), b2, voffB); PG8_STAGE(PG8_SB(0, 1), b2 + hstep, voffB); PG8_STAGE(PG8_SA(0, 0), a2, voffA);
            PG8_WAIT_V(8); PG8_WAIT_L(0); PG8_BAR; PG8_MMA(1, 0, At, B0); PG8_MMA(1, 1, At, B1); PG8_BAR; PG8_SCHED;
            PG8_LDB(B0, 1, 0); PG8_LDB(B1, 1, 1); PG8_SCHED; PG8_LDA(At, 1, 0); PG8_STAGE(PG8_SA(0, 1), a2 + hstepA, voffA);
            PG8_WAIT_V(8); PG8_WAIT_L(0); PG8_BAR; PG8_MMA(0, 0, At, B0); PG8_MMA(0, 1, At, B1); PG8_BAR; PG8_SCHED;
            PG8_LDA(At, 1, 1); PG8_STAGE(PG8_SB(1, 0), b3, voffB); PG8_STAGE(PG8_SB(1, 1), b3 + hstep, voffB); PG8_STAGE(PG8_SA(1, 0), a3, voffA);
            PG8_WAIT_V(8); PG8_WAIT_L(0); PG8_BAR; PG8_MMA(1, 0, At, B0); PG8_MMA(1, 1, At, B1); PG8_BAR; PG8_SCHED;
            } else {
            PG8_LDB(B0, 0, 0); PG8_SCHED; PG8_LDA(At, 0, 0); PG8_STAGE(PG8_SA(1, 1), a1 + hstepA, voffA);
            PG8_WAIT_L(8); PG8_BAR; PG8_WAIT_L(0); PG8_MMA(0, 0, At, B0); PG8_BAR; PG8_SCHED;
            PG8_LDB(B1, 0, 1); PG8_STAGE(PG8_SB(0, 0), b2, voffB);
            PG8_BAR; PG8_WAIT_L(0); PG8_MMA(0, 1, At, B1); PG8_BAR;
            PG8_LDA(At, 0, 1); PG8_STAGE(PG8_SA(0, 0), a2, voffA);
            PG8_BAR; PG8_WAIT_L(0); PG8_MMA(1, 0, At, B0); PG8_BAR; PG8_SCHED;
            PG8_STAGE(PG8_SB(0, 1), b2 + hstep, voffB);
            PG8_WAIT_V(6); PG8_BAR; PG8_MMA(1, 1, At, B1); PG8_BAR;
            PG8_LDB(B0, 1, 0); PG8_SCHED; PG8_LDA(At, 1, 0); PG8_STAGE(PG8_SA(0, 1), a2 + hstepA, voffA);
            PG8_WAIT_L(8); PG8_BAR; PG8_WAIT_L(0); PG8_MMA(0, 0, At, B0); PG8_BAR; PG8_SCHED;
            PG8_LDB(B1, 1, 1); PG8_STAGE(PG8_SB(1, 0), b3, voffB);
            PG8_BAR; PG8_WAIT_L(0); PG8_MMA(0, 1, At, B1); PG8_BAR;
            PG8_LDA(At, 1, 1); PG8_STAGE(PG8_SA(1, 0), a3, voffA);
            PG8_BAR; PG8_WAIT_L(0); PG8_MMA(1, 0, At, B0); PG8_BAR; PG8_SCHED;
            PG8_STAGE(PG8_SB(1, 1), b3 + hstep, voffB);
            PG8_WAIT_V(6); PG8_BAR; PG8_MMA(1, 1, At, B1); PG8_BAR;
            }
        }
        if constexpr (ALIGN_EPI) { if (wr == 0) PG8_BAR; }
        if constexpr (!Epi::AFTER_DRAIN) { E(acc, cur, wr, wc, fr, fq); S.done(cur); }
        if (!has_next) break;
#pragma unroll
        for (int a = 0; a < 2; ++a)
#pragma unroll
            for (int b = 0; b < 2; ++b)
#pragma unroll
                for (int m = 0; m < 4; ++m)
#pragma unroll
                    for (int n = 0; n < 2; ++n) acc[a][b][m][n] = (f32x4){0.f, 0.f, 0.f, 0.f};
        cur = nxt; cA = nA; cB = nB; ++ui;
        if constexpr (ALIGN_EPI) { if (wr == 1) PG8_BAR; }
    }
    PG8_WAIT_V(0);
    if constexpr (!ALIGN_EPI) { if (wr == 0) PG8_BAR; }
    PG8_BAR;
    if constexpr (Epi::AFTER_DRAIN) { E.fused(acc, cur, wr, wc, fr, fq, lds, wid, lane); S.done(cur); }
#undef PG8_SA
#undef PG8_SB
#undef PG8_STAGE
#undef PG8_LDA
#undef PG8_LDB
#undef PG8_MMA
#undef PG8_WAIT_V
#undef PG8_WAIT_L
#undef PG8_BAR
#undef PG8_SCHED
}
}

#define LAS __attribute__((address_space(3)))
using pg8::bf16_t; using pg8::bf16x8; using pg8::f32x4; using pg8::u32x4;
typedef float f32x16 __attribute__((ext_vector_type(16)));
typedef unsigned u32x2 __attribute__((ext_vector_type(2)));
typedef unsigned char uchar;
typedef float f32x2_t __attribute__((ext_vector_type(2)));
typedef __bf16 bf16x2_t __attribute__((ext_vector_type(2)));

constexpr int DM = 1024, NBATCH = 16, SEQ = 4096, DEPTH = 4, PLE = 256, DFF = 2816;
constexpr int T = NBATCH * SEQ;
constexpr int NB = 8, TC = NB * SEQ, NCHUNK = NBATCH / NB;
constexpr int DIN = 6680, DINP = 6912;
constexpr float EPS = 1e-6f, LOG2E = 1.4426950408889634f;
constexpr int NTHR = 512;

constexpr size_t W_WI1 = 0, W_WO1 = W_WI1 + (size_t)5632 * 1024, W_WIN = W_WO1 + (size_t)1024 * 2816, W_CW1 = W_WIN + (size_t)DINP * 1024,
                 W_CW2 = W_CW1 + (size_t)2 * 256 * 2048, W_WBR = W_CW2 + (size_t)2 * 256 * 256, W_WOUT = W_WBR + (size_t)3 * 1024 * 512,
                 W_WI2 = W_WOUT + (size_t)1024 * 1024, W_WO2 = W_WI2 + (size_t)5632 * 1024, W_WPE = W_WO2 + (size_t)1024 * 2816,
                 W_WPG = W_WPE + (size_t)1024 * 256, W_LAYER = W_WPG + (size_t)1024 * 1024;
static_assert(W_LAYER == 29491200, "weights");
constexpr size_t MiB = 1u << 20;
constexpr size_t WS_W = 0, WS_XN = 226 * MiB, WS_R1 = 354 * MiB, WS_Y = 782 * MiB, WS_MG = 878 * MiB, WS_CH = 942 * MiB, WS_KCMP = 946 * MiB,
                 WS_VCMP = WS_KCMP + MiB / 2, WS_CB = 947 * MiB, WS_SSQ = 948 * MiB, WS_SSQ2 = 952 * MiB, WS_CTL = 956 * MiB, WS_END = 957 * MiB;
constexpr size_t CTL_ZERO_BYTES = 65536;
constexpr size_t WS_XN2 = WS_Y, WS_PBF = WS_Y + 128 * MiB;
static_assert(W_LAYER * 2 * DEPTH <= WS_XN, "w");
constexpr size_t HS = 262144;
constexpr size_t ZQA = 0, ZKA = ZQA + NB * 8 * HS, ZVA = ZKA + NB * 8 * HS, ZQB = ZVA + NB * 8 * HS, ZKCI = ZQB + NB * 8 * HS, ZVCI = ZKCI + NB * 2 * HS,
                 ZKS = ZVCI + NB * 2 * HS, ZVS = ZKS + NB * 2 * HS, ZKW = ZVS + NB * 2 * HS, ZVW = ZKW + NB * 2 * HS, ZQC = ZVW + NB * 2 * HS,
                 ZKC = ZQC + NB * 8 * HS, ZVC = ZKC + NB * 2 * HS, ZSG = ZVC + NB * 2 * HS, ZBG = ZSG + (size_t)TC * 3072, ZEND = ZBG + (size_t)TC * 32 * 2;
static_assert(ZEND * 2 <= 428 * MiB, "zbuf");
static_assert((size_t)T * DFF * 2 <= 428 * MiB, "act");
constexpr size_t R1_E = 0;

struct Params {
    const float* in[20];
    float* out;
    uchar* ws;
};

__device__ __forceinline__ unsigned cvtpk(float lo, float hi) { f32x2_t v = {lo, hi}; bf16x2_t b = __builtin_convertvector(v, bf16x2_t); return __builtin_bit_cast(unsigned, b); }
__device__ __forceinline__ bf16_t cvt1(float x) { return (bf16_t)(cvtpk(x, 0.f) & 0xffffu); }
__device__ __forceinline__ float bf2f(unsigned short b) { return __uint_as_float((unsigned)b << 16); }
__device__ __forceinline__ float wave_sum(float v) {
#pragma unroll
    for (int o = 1; o < 64; o <<= 1) v += __shfl_xor(v, o);
    return v;
}
__device__ __forceinline__ int opq(int v) { asm volatile("" : "+v"(v)); return v; }
__device__ __forceinline__ float sigm(float x) { return __builtin_amdgcn_rcpf(1.f + __builtin_amdgcn_exp2f(-x * LOG2E)); }
__device__ __forceinline__ float gelu_tanh(float x) { const float u = 0.7978845608028654f * (x + 0.044715f * x * x * x); const float e = __builtin_amdgcn_exp2f(-2.f * LOG2E * u); const float th = 2.f * __builtin_amdgcn_rcpf(1.f + e) - 1.f; return 0.5f * x * (1.f + th); }

typedef const __attribute__((address_space(4))) Params* KParPtr;
__device__ __forceinline__ KParPtr kparams() { auto p = __builtin_amdgcn_kernarg_segment_ptr(); asm volatile("" : "+s"(p)); return (KParPtr)p; }
#ifndef ALIGN_T
#define ALIGN_T false
#endif
#ifndef ALIGN_F
#define ALIGN_F true
#endif
#ifndef ALIGN_SW
#define ALIGN_SW true
#endif
#ifndef ALIGN_BR
#define ALIGN_BR true
#endif
#ifndef ALIGN_Z
#define ALIGN_Z true
#endif
__device__ __forceinline__ float row_rstd(const float* ssq, int row) {
    const f32x4* p = (const f32x4*)(ssq + (size_t)row * 16); const f32x4 a = p[0], b = p[1], c = p[2], d = p[3];
    const float sm = (((a[0] + a[1]) + (a[2] + a[3])) + ((b[0] + b[1]) + (b[2] + b[3]))) + (((c[0] + c[1]) + (c[2] + c[3])) + ((d[0] + d[1]) + (d[2] + d[3])));
    return 1.0f / sqrtf(sm * (1.f / 1024.f) + 1e-6f);
}
typedef const pg8::f32x4 (&AccRef)[2][2][4][2];
__device__ __forceinline__ void wave_rstd(const float* ssq, int rowbase, float (&rsl)[2]) {
    const int lane = threadIdx.x & 63;
    rsl[0] = row_rstd(ssq, rowbase + lane); rsl[1] = row_rstd(ssq, rowbase + 128 + lane);
}
struct EpiSwiglu {
    static constexpr bool PERM = true, AFTER_DRAIN = false, ALIGN = ALIGN_SW;
    bf16_t* O; const float* ssq;
    __device__ __forceinline__ void operator()(AccRef acc, const pg8::Unit& u, int wr, int wc, int fr, int fq) const {
        asm volatile("" : "+v"(fr), "+v"(fq));
        const int row0 = u.pm * 256 + wr * 64 + fr, col0 = u.pn * 128 + wc * 32 + 8 * fq;
        float rsl[2]; wave_rstd(ssq, u.pm * 256 + wr * 64, rsl);
#pragma unroll
        for (int ai = 0; ai < 2; ++ai)
#pragma unroll
            for (int m = 0; m < 4; ++m) {
                bf16_t* rp = O + (size_t)(row0 + ai * 128 + m * 16) * DFF + col0;
                const float rs = __shfl(rsl[ai], 16 * m + fr);
                float o[8];
#pragma unroll
                for (int n = 0; n < 2; ++n)
#pragma unroll
                    for (int e = 0; e < 4; ++e) { const float g = acc[ai][0][m][n][e] * rs, up = acc[ai][1][m][n][e] * rs; o[n * 4 + e] = g * sigm(g) * up; }
                u32x4 w; w.x = cvtpk(o[0], o[1]); w.y = cvtpk(o[2], o[3]); w.z = cvtpk(o[4], o[5]); w.w = cvtpk(o[6], o[7]);
                *(u32x4*)rp = w;
            }
    }
};
struct EpiResid {
    static constexpr bool PERM = false, AFTER_DRAIN = false, ALIGN = ALIGN_F;
    float alpha; int row_off; int hsrc;
    __device__ __forceinline__ void operator()(AccRef acc, const pg8::Unit& u, int wr, int wc, int fr, int fq) const {
        asm volatile("" : "+v"(fr), "+v"(fq));
        const int row0 = row_off + u.pm * 256 + wr * 64 + fr, col0 = u.pn * 256 + wc * 32 + 4 * fq;
        const float* xin = kparams()->in[0];
        uchar* wsb = kparams()->ws; bf16_t* hb = (bf16_t*)(wsb + WS_XN); float* ssq = (float*)(wsb + WS_SSQ);
        const bf16_t* hin = (const bf16_t*)(wsb + (hsrc == 1 ? WS_XN2 : WS_XN));
#pragma unroll
        for (int ai = 0; ai < 2; ++ai)
#pragma unroll
            for (int m = 0; m < 4; ++m) {
                const size_t off = (size_t)(row0 + ai * 128 + m * 16) * DM + col0;
                float sq = 0.f;
#pragma unroll
                for (int bj = 0; bj < 2; ++bj)
#pragma unroll
                    for (int n = 0; n < 2; ++n) { f32x4 b;
                        if (hsrc == 0) b = *(const f32x4*)(xin + off + bj * 128 + n * 16);
                        else { const u32x2 hv = *(const u32x2*)(hin + off + bj * 128 + n * 16); b = (f32x4){__uint_as_float(hv.x << 16), __uint_as_float(hv.x & 0xffff0000u), __uint_as_float(hv.y << 16), __uint_as_float(hv.y & 0xffff0000u)}; }
                        const f32x4 v = b + acc[ai][bj][m][n] * alpha;
                        u32x2 w; w.x = cvtpk(v[0], v[1]); w.y = cvtpk(v[2], v[3]); *(u32x2*)(hb + off + bj * 128 + n * 16) = w; sq += (v[0] * v[0] + v[1] * v[1]) + (v[2] * v[2] + v[3] * v[3]); }
                sq += __shfl_xor(sq, 16); sq += __shfl_xor(sq, 32);
                if (fq == 0) ssq[(size_t)(row0 + ai * 128 + m * 16) * 16 + u.pn * 4 + wc] = sq;

            }
    }
};
struct EpiPle {
    static constexpr bool PERM = false, AFTER_DRAIN = false, ALIGN = ALIGN_F;
    const bf16_t* hin; const bf16_t* E; const float* ssq_in; bf16_t* hb; float* ssq_out;
    __device__ __forceinline__ void operator()(AccRef acc, const pg8::Unit& u, int wr, int wc, int fr, int fq) const {
        asm volatile("" : "+v"(fr), "+v"(fq));
        const int row0 = u.pm * 256 + wr * 64 + fr, col0 = u.pn * 256 + wc * 32 + 4 * fq;
        float rsl[2]; wave_rstd(ssq_in, u.pm * 256 + wr * 64, rsl);
#pragma unroll
        for (int ai = 0; ai < 2; ++ai)
#pragma unroll
            for (int m = 0; m < 4; ++m) {
                const size_t off = (size_t)(row0 + ai * 128 + m * 16) * DM + col0;
                const float rs = __shfl(rsl[ai], 16 * m + fr);
                float sq = 0.f;
#pragma unroll
                for (int bj = 0; bj < 2; ++bj)
#pragma unroll
                    for (int n = 0; n < 2; ++n) {
                        const size_t o2 = off + bj * 128 + n * 16;
                        const u32x2 ev = *(const u32x2*)(E + o2); const u32x2 hv = *(const u32x2*)(hin + o2); f32x4 b = (f32x4){__uint_as_float(hv.x << 16), __uint_as_float(hv.x & 0xffff0000u), __uint_as_float(hv.y << 16), __uint_as_float(hv.y & 0xffff0000u)}; const f32x4 a = acc[ai][bj][m][n];
                        b[0] += sigm(a[0] * rs) * __uint_as_float(ev.x << 16); b[1] += sigm(a[1] * rs) * __uint_as_float(ev.x & 0xffff0000u);
                        b[2] += sigm(a[2] * rs) * __uint_as_float(ev.y << 16); b[3] += sigm(a[3] * rs) * __uint_as_float(ev.y & 0xffff0000u);
                        u32x2 w; w.x = cvtpk(b[0], b[1]); w.y = cvtpk(b[2], b[3]); *(u32x2*)(hb + o2) = w; sq += (b[0] * b[0] + b[1] * b[1]) + (b[2] * b[2] + b[3] * b[3]);
                    }
                sq += __shfl_xor(sq, 16); sq += __shfl_xor(sq, 32);
                if (fq == 0) ssq_out[(size_t)(row0 + ai * 128 + m * 16) * 16 + u.pn * 4 + wc] = sq;

            }
    }
};
template <int MODE> struct EpiBf {
    static constexpr bool PERM = true, AFTER_DRAIN = false, ALIGN = ALIGN_T;
    bf16_t* O; int ldc; const float* bias;
    __device__ __forceinline__ void operator()(AccRef acc, const pg8::Unit& u, int wr, int wc, int fr, int fq) const {
        asm volatile("" : "+v"(fr), "+v"(fq));
        const int row0 = u.pm * 256 + wr * 64 + fr, col0 = u.pn * 256 + wc * 32 + 8 * fq;
#pragma unroll
        for (int bj = 0; bj < 2; ++bj) {
            float bv[8];
#pragma unroll
            for (int e = 0; e < 8; ++e) bv[e] = MODE == 1 ? bias[col0 + bj * 128 + e] : 0.f;
#pragma unroll
            for (int ai = 0; ai < 2; ++ai)
#pragma unroll
                for (int m = 0; m < 4; ++m) {
                    float o[8];
#pragma unroll
                    for (int n = 0; n < 2; ++n)
#pragma unroll
                        for (int e = 0; e < 4; ++e) { float v = acc[ai][bj][m][n][e] + bv[n * 4 + e]; if (MODE == 1) v = gelu_tanh(v); o[n * 4 + e] = v; }
                    u32x4 w; w.x = cvtpk(o[0], o[1]); w.y = cvtpk(o[2], o[3]); w.z = cvtpk(o[4], o[5]); w.w = cvtpk(o[6], o[7]);
                    *(u32x4*)(O + (size_t)(row0 + ai * 128 + m * 16) * ldc + col0 + bj * 128) = w;
                }
        }
    }
};
template <bool VT> struct EpiCmp2 {
    static constexpr bool PERM = true, AFTER_DRAIN = false, ALIGN = ALIGN_T;
    bf16_t* O;
    __device__ __forceinline__ void operator()(AccRef acc, const pg8::Unit& u, int wr, int wc, int fr, int fq) const {
        asm volatile("" : "+v"(fr), "+v"(fq));
        if (u.pn != 0 || wc >= 2) return;
        const int row0 = u.pm * 256 + wr * 64 + fr, d0 = wc * 32 + 8 * fq;
#pragma unroll
        for (int ai = 0; ai < 2; ++ai)
#pragma unroll
            for (int m = 0; m < 4; ++m) {
                const int row = row0 + ai * 128 + m * 16, bg = row >> 8, n = row & 255;
                float o[8];
#pragma unroll
                for (int nn = 0; nn < 2; ++nn)
#pragma unroll
                    for (int e = 0; e < 4; ++e) o[nn * 4 + e] = (n == 255) ? 0.f : acc[ai][0][m][nn][e];
                if (!VT) { u32x4 w; w.x = cvtpk(o[0], o[1]); w.y = cvtpk(o[2], o[3]); w.z = cvtpk(o[4], o[5]); w.w = cvtpk(o[6], o[7]); *(u32x4*)(O + (size_t)row * 64 + d0) = w; }
                else {
#pragma unroll
                    for (int e = 0; e < 8; ++e) O[((size_t)bg * 64 + d0 + e) * 256 + n] = cvt1(o[e]);
                }
            }
    }
};
struct EpiBranch {
    static constexpr bool PERM = true, AFTER_DRAIN = false, ALIGN = ALIGN_BR;
    bf16_t* mg; const bf16_t* sg; int mi;
    __device__ __forceinline__ void operator()(AccRef acc, const pg8::Unit& u, int wr, int wc, int fr, int fq) const {
        asm volatile("" : "+v"(fr), "+v"(fq));
        const int row0 = u.pm * 256 + wr * 64 + fr, col0 = u.pn * 256 + wc * 32 + 8 * fq;
#pragma unroll
        for (int ai = 0; ai < 2; ++ai)
#pragma unroll
            for (int m = 0; m < 4; ++m) {
                const int row = row0 + ai * 128 + m * 16;
#pragma unroll
                for (int bj = 0; bj < 2; ++bj) {
                    const int col = col0 + bj * 128;
                    const u32x4 gv = *(const u32x4*)(sg + (size_t)row * 3072 + mi * 1024 + col);
                    u32x4 ov = (u32x4){0u, 0u, 0u, 0u};
                    if (mi != 0) ov = *(const u32x4*)(mg + (size_t)row * DM + col);
                    float o[8];
#pragma unroll
                    for (int q = 0; q < 4; ++q) {
                        const unsigned gq = gv[q], oq = ov[q];
                        const float a0 = acc[ai][bj][m][q >> 1][(q & 1) * 2], a1 = acc[ai][bj][m][q >> 1][(q & 1) * 2 + 1];
                        o[2 * q] = __uint_as_float(oq << 16) + __uint_as_float(gq << 16) * a0;
                        o[2 * q + 1] = __uint_as_float(oq & 0xffff0000u) + __uint_as_float(gq & 0xffff0000u) * a1;
                    }
                    u32x4 w; w.x = cvtpk(o[0], o[1]); w.y = cvtpk(o[2], o[3]); w.z = cvtpk(o[4], o[5]); w.w = cvtpk(o[6], o[7]);
                    *(u32x4*)(mg + (size_t)row * DM + col) = w;
                }

            }
    }
};
struct EpiZ {
    static constexpr bool PERM = true, AFTER_DRAIN = false, ALIGN = ALIGN_Z;
    bf16_t* zb; const float* ssq; int pn_off;
    __device__ __forceinline__ void operator()(AccRef acc, const pg8::Unit& u, int wr, int wc, int fr, int fq) const {
        asm volatile("" : "+v"(fr), "+v"(fq));
        const int pn = u.pn + pn_off;
        float rsl[2]; wave_rstd(ssq, u.pm * 256 + wr * 64, rsl);
#pragma unroll
        for (int bj = 0; bj < 2; ++bj) {
            const int ch = 2 * bj + (wc >> 1), d0 = (wc & 1) * 32 + 8 * fq;
            size_t off = 0, bs = 8 * HS; int mode = 0;
            if (pn < 2) { off = ZQA + (size_t)(pn * 4 + ch) * HS; }
            else if (pn < 4) { off = ZKA + (size_t)((pn - 2) * 4 + ch) * HS; }
            else if (pn < 6) { off = ZVA + (size_t)((pn - 4) * 4 + ch) * HS; mode = 1; }
            else if (pn < 8) { off = ZQB + (size_t)((pn - 6) * 4 + ch) * HS; }
            else if (pn == 8) { bs = 2 * HS; off = (ch < 2) ? ZKCI + (size_t)ch * HS : ZVCI + (size_t)(ch - 2) * HS; }
            else if (pn == 9) { bs = 2 * HS; if (ch < 2) off = ZKS + (size_t)ch * HS; else { off = ZVS + (size_t)(ch - 2) * HS; mode = 1; } }
            else if (pn == 10) { bs = 2 * HS; if (ch < 2) off = ZKW + (size_t)ch * HS; else { off = ZVW + (size_t)(ch - 2) * HS; mode = 1; } }
            else if (pn < 13) { off = ZQC + (size_t)((pn - 11) * 4 + ch) * HS; }
            else if (pn == 13) { bs = 2 * HS; if (ch < 2) off = ZKC + (size_t)ch * HS; else { off = ZVC + (size_t)(ch - 2) * HS; mode = 1; } }
            else if (pn < 26) mode = 2;
            else mode = 3;
#pragma unroll
            for (int ai = 0; ai < 2; ++ai)
#pragma unroll
                for (int m = 0; m < 4; ++m) {
                    const int tl = u.pm * 256 + ai * 128 + wr * 64 + m * 16 + fr, bl = tl >> 12, s = tl & 4095;
                    const float rs = __shfl(rsl[ai], 16 * m + fr);
                    float o[8];
#pragma unroll
                    for (int n = 0; n < 2; ++n)
#pragma unroll
                        for (int e = 0; e < 4; ++e) o[n * 4 + e] = acc[ai][bj][m][n][e] * rs;
                    if (mode == 0) {
                        u32x4 w; w.x = cvtpk(o[0], o[1]); w.y = cvtpk(o[2], o[3]); w.z = cvtpk(o[4], o[5]); w.w = cvtpk(o[6], o[7]);
                        *(u32x4*)(zb + off + (size_t)bl * bs + (size_t)s * 64 + d0) = w;
                    } else if (mode == 1) {
                        bf16_t* p = zb + off + (size_t)bl * bs + (size_t)d0 * 4096 + s;
#pragma unroll
                        for (int e = 0; e < 8; ++e) p[(size_t)e * 4096] = cvt1(o[e]);
                    } else if (mode == 2) {
#pragma unroll
                        for (int e = 0; e < 8; ++e) o[e] = sigm(o[e]);
                        u32x4 w; w.x = cvtpk(o[0], o[1]); w.y = cvtpk(o[2], o[3]); w.z = cvtpk(o[4], o[5]); w.w = cvtpk(o[6], o[7]);
                        *(u32x4*)(zb + ZSG + (size_t)tl * 3072 + (pn - 14) * 256 + bj * 128 + wc * 32 + 8 * fq) = w;
                    } else {
                        const int cc = bj * 128 + wc * 32 + 8 * fq;
                        if (cc < 24) {
                            float* bgp = (float*)(zb + ZBG) + (size_t)tl * 32 + cc;
                            *(f32x4*)bgp = (f32x4){sigm(o[0]), sigm(o[1]), sigm(o[2]), sigm(o[3])};
                            *(f32x4*)(bgp + 4) = (f32x4){sigm(o[4]), sigm(o[5]), sigm(o[6]), sigm(o[7])};
                        }
                    }
                }
        }
    }
};

__device__ __forceinline__ void rms_row_bf16(const float* xrow, const float* g, bf16_t* orow, int lane) {
    const f32x4* xr = (const f32x4*)xrow + lane; f32x4 v[4]; float s = 0.f;
#pragma unroll
    for (int j = 0; j < 4; ++j) { v[j] = xr[64 * j]; s += (v[j][0] * v[j][0] + v[j][1] * v[j][1]) + (v[j][2] * v[j][2] + v[j][3] * v[j][3]); }
    const float rstd = 1.0f / sqrtf(wave_sum(s) * (1.f / DM) + EPS);
    u32x2* o8 = (u32x2*)orow + lane;
#pragma unroll
    for (int j = 0; j < 4; ++j) { const f32x4 gg = ((const f32x4*)g)[lane + 64 * j]; u32x2 w; w.x = cvtpk(v[j][0] * rstd * gg[0], v[j][1] * rstd * gg[1]); w.y = cvtpk(v[j][2] * rstd * gg[2], v[j][3] * rstd * gg[3]); o8[64 * j] = w; }
}
__device__ __forceinline__ void rms_row_f32(const float* xrow, const float* g, float* orow, int lane) {
    const f32x4* xr = (const f32x4*)xrow + lane; f32x4 v[4]; float s = 0.f;
#pragma unroll
    for (int j = 0; j < 4; ++j) { v[j] = xr[64 * j]; s += (v[j][0] * v[j][0] + v[j][1] * v[j][1]) + (v[j][2] * v[j][2] + v[j][3] * v[j][3]); }
    const float rstd = 1.0f / sqrtf(wave_sum(s) * (1.f / DM) + EPS);
#pragma unroll
    for (int j = 0; j < 4; ++j) { const f32x4 gg = ((const f32x4*)g)[lane + 64 * j]; ((f32x4*)orow)[lane + 64 * j] = (v[j] * rstd) * gg; }
}
__device__ __forceinline__ void rms_row_bf16in_f32(const bf16_t* xrow, const float* g, float* orow, int lane) {
    const u32x2* xr = (const u32x2*)xrow + lane; f32x4 v[4]; float s = 0.f;
#pragma unroll
    for (int j = 0; j < 4; ++j) { const u32x2 hv = xr[64 * j]; v[j] = (f32x4){__uint_as_float(hv.x << 16), __uint_as_float(hv.x & 0xffff0000u), __uint_as_float(hv.y << 16), __uint_as_float(hv.y & 0xffff0000u)};
        s += (v[j][0] * v[j][0] + v[j][1] * v[j][1]) + (v[j][2] * v[j][2] + v[j][3] * v[j][3]); }
    const float rstd = 1.0f / sqrtf(wave_sum(s) * (1.f / DM) + EPS);
#pragma unroll
    for (int j = 0; j < 4; ++j) { const f32x4 gg = ((const f32x4*)g)[lane + 64 * j]; ((f32x4*)orow)[lane + 64 * j] = (v[j] * rstd) * gg; }
}
__device__ __forceinline__ void phase_prep(const float* src, bf16_t* dst, float* ssq, int gw, int ngw, int lane) {
    lane = opq(lane);
    for (int m = gw; m < T; m += ngw) {
        const f32x4* xr = (const f32x4*)(src + (size_t)m * DM) + lane; u32x2* o8 = (u32x2*)(dst + (size_t)m * DM) + lane; float s = 0.f;
#pragma unroll
        for (int j = 0; j < 4; ++j) { const f32x4 v = xr[64 * j]; s += (v[0] * v[0] + v[1] * v[1]) + (v[2] * v[2] + v[3] * v[3]); u32x2 w; w.x = cvtpk(v[0], v[1]); w.y = cvtpk(v[2], v[3]); o8[64 * j] = w; }
        s = wave_sum(s);
        if (lane < 16) ssq[(size_t)m * 16 + lane] = lane == 0 ? s : 0.f;
    }
}
__device__ __forceinline__ void phase_rms(const float* src, const float* g, bf16_t* dst, int gw, int ngw, int lane) {
    lane = opq(lane);
    for (int m = gw; m < T; m += ngw) rms_row_bf16(src + (size_t)m * DM, g, dst + (size_t)m * DM, lane);
}

__device__ __forceinline__ int srccol(int mode, int n) {
    if (mode == 0) return n;
    if (mode == 1) return ((n >> 7) & 1) * DFF + (n >> 8) * 128 + (n & 127);
    if (mode == 2) return n < 2816 ? n : (n < 6656 ? n + 24 : (n < 6680 ? 2816 + (n - 6656) : -1));
    return n < 64 ? n : -1;
}
__device__ __forceinline__ void conv_matrix(const float* src, int K, int ld, int Ndst, int mode, bf16_t* dst, int& base, LAS float* scr, int tid, int blk, int G, const float* gk = nullptr) {
    tid = opq(tid);
    const int ntn = Ndst / 64, ntiles = (K / 128) * ntn;
    int start = (blk - (base % G) + G) % G;
    for (int t = start; t < ntiles; t += G) {
        const int k0 = (t / ntn) * 128, n0 = (t % ntn) * 64;
        { const int kr = tid >> 6, n = tid & 63; const int col = srccol(mode, n0 + n);
          float v[16];
#pragma unroll
          for (int kk = 0; kk < 16; ++kk) { const int k = kr + 8 * kk; v[kk] = col >= 0 ? src[(size_t)(k0 + k) * ld + col] : 0.f; }
#pragma unroll
          for (int kk = 0; kk < 16; ++kk) { const int k = kr + 8 * kk; scr[k * 65 + n] = gk ? v[kk] * gk[k0 + k] : v[kk]; } }
        __syncthreads();
        { const int n = tid >> 3, ks = tid & 7;
#pragma unroll
          for (int h2 = 0; h2 < 2; ++h2) { const LAS float* sp = scr + (64 * h2 + 8 * ks) * 65 + n;
            u32x4 w; w.x = cvtpk(sp[0], sp[65]); w.y = cvtpk(sp[130], sp[195]); w.z = cvtpk(sp[260], sp[325]); w.w = cvtpk(sp[390], sp[455]);
            *(u32x4*)(dst + (size_t)(n0 + n) * K + k0 + 64 * h2 + 8 * ks) = w; } }
        __syncthreads();
    }
    base += ntiles;
}

constexpr int KP = 144;
constexpr int VP = 144;
constexpr int L_K0 = 0, L_K1 = 9216, L_V0 = 18432, L_V1 = 36864, L_TBL = 55296, L_IMP = 57344, L_SEL = 73984, L_RED = 74496;
constexpr float SC = 0.125f * LOG2E;
constexpr float MINIT = -10000.f, MASKED = -1e30f;

__device__ __forceinline__ int t5_bucket(int n) {
    if (n < 16) return n;
    int b = 16;
    b += (n >= 19); b += (n >= 21); b += (n >= 24); b += (n >= 27); b += (n >= 31); b += (n >= 35); b += (n >= 40); b += (n >= 46);
    b += (n >= 52); b += (n >= 59); b += (n >= 67); b += (n >= 77); b += (n >= 87); b += (n >= 99); b += (n >= 113);
    return b;
}
__device__ __forceinline__ void build_tbl(LAS uchar* lds, const float* rel_bias, int col0, int nh, int tid) {
    const int hd = tid >> 7, idx = tid & 127;
    if (hd < nh && idx < 114) ((LAS float*)(lds + L_TBL))[hd * 128 + idx] = rel_bias[t5_bucket(idx) * 20 + col0 + hd] * LOG2E;
}

template <int DV> struct TileRegs { u32x4 k; u32x4 v[DV / 64]; };
template <int DV, bool HASV>
__device__ __forceinline__ void tile_gload(TileRegs<DV>& r, const bf16_t* Kg, const bf16_t* Vt, int vpitch, int kt, int tid) {
    const int row = tid >> 3, seg = tid & 7;
    r.k = *(const u32x4*)(Kg + (size_t)(kt * 64 + row) * 64 + seg * 8);
    if (HASV) {
#pragma unroll
        for (int j = 0; j < DV / 64; ++j) r.v[j] = *(const u32x4*)(Vt + (size_t)(row + 64 * j) * vpitch + kt * 64 + seg * 8);
    }
}
template <int DV, bool HASV>
__device__ __forceinline__ void tile_swrite(const TileRegs<DV>& r, LAS uchar* lds, int buf, int tid) {
    const int row = tid >> 3, seg = tid & 7;
    *(LAS u32x4*)(lds + (buf ? L_K1 : L_K0) + row * KP + seg * 16) = r.k;
    if (HASV) {
#pragma unroll
        for (int j = 0; j < DV / 64; ++j) { LAS uchar* p = lds + (buf ? L_V1 : L_V0) + (row + 64 * j) * VP + (seg >> 1) * 32 + (seg & 1) * 8; *(LAS u32x2*)p = (u32x2){r.v[j].x, r.v[j].y}; *(LAS u32x2*)(p + 16) = (u32x2){r.v[j].z, r.v[j].w}; }
    }
}

template <int DV, bool IMPP>
__device__ __forceinline__ void attn_pass(LAS uchar* lds, const bf16_t* Kg, const bf16_t* Vt, int vpitch, int kt0, int kt1, int wave_kt_max,
                                          int qpos, int qmin_w, int qmax_w, int kmul, int kadd, unsigned W, bf16x8 (&q)[4], int tbl,
                                          unsigned long long selmask, bool use_sel, float& m, float& l, f32x16 (&acc)[DV / 32],
                                          float inv_l, int imp_row, float rel_far, int tid) {
    const int lane = tid & 63, n = lane & 31, hi = lane >> 5;
    TileRegs<DV> tr;
    if (kt0 >= kt1) return;
    float tfar = rel_far;
    asm volatile("s_waitcnt vmcnt(0)" ::: "memory");
    asm volatile("" : "+v"(q[0]), "+v"(q[1]), "+v"(q[2]), "+v"(q[3]), "+v"(tfar), "+v"(m), "+v"(l), "+v"(inv_l));
    tile_gload<DV, !IMPP>(tr, Kg, Vt, vpitch, kt0, tid);
    tile_swrite<DV, !IMPP>(tr, lds, 0, tid);
    __syncthreads();
    for (int kt = kt0; kt < kt1; ++kt) {
        const int cur = (kt - kt0) & 1;
        const bool more = kt + 1 < kt1;
        if (more) tile_gload<DV, !IMPP>(tr, Kg, Vt, vpitch, kt + 1, tid);
        if (kt <= wave_kt_max && (!use_sel || __builtin_amdgcn_ballot_w64((selmask >> kt) & 1ull) != 0ull)) {
            f32x16 s[2];
#pragma unroll
            for (int r = 0; r < 16; ++r) { s[0][r] = 0.f; s[1][r] = 0.f; }
            const LAS uchar* kb = lds + (cur ? L_K1 : L_K0) + n * KP + hi * 16;
#pragma unroll
            for (int ks = 0; ks < 4; ++ks) {
                const bf16x8 a0 = *(const LAS bf16x8*)(kb + ks * 32);
                const bf16x8 a1 = *(const LAS bf16x8*)(kb + 32 * KP + ks * 32);
                s[0] = __builtin_amdgcn_mfma_f32_32x32x16_bf16(a0, q[ks], s[0], 0, 0, 0);
                s[1] = __builtin_amdgcn_mfma_f32_32x32x16_bf16(a1, q[ks], s[1], 0, 0, 0);
            }
            const bool lane_ok = !use_sel || ((selmask >> kt) & 1ull);
            const bool fast = (qmin_w - (kmul * (64 * kt + 63) + kadd) >= 113) && ((unsigned)(qmax_w - (kmul * 64 * kt + kadd)) < W);
            if (fast) {
                const float cfar = lane_ok ? tfar - m : MASKED;
                const float scl = lane_ok ? SC : 0.f;
#pragma unroll
                for (int hh = 0; hh < 2; ++hh)
#pragma unroll
                    for (int r = 0; r < 16; ++r) s[hh][r] = s[hh][r] * scl + cfar;
            } else {
                int dq = qpos - kadd - kmul * (kt * 64 + 4 * hi);
                asm volatile("" : "+v"(dq));
                const unsigned Wl = lane_ok ? W : 0u;
                const LAS uchar* tb = lds + tbl;
#pragma unroll
                for (int hh = 0; hh < 2; ++hh)
#pragma unroll
                    for (int r = 0; r < 16; ++r) {
                        const int kk = 32 * hh + 8 * (r >> 2) + (r & 3);
                        const int dist = dq - kmul * kk;
                        const unsigned ud = (unsigned)dist;
                        const unsigned idx = ud < 113u ? ud : 113u;
                        const float bias = *(const LAS float*)(tb + idx * 4);
                        float v = s[hh][r] * SC + (bias - m);
                        v = (ud < Wl) ? v : MASKED;
                        s[hh][r] = v;
                    }
            }
            if (!IMPP) {
                float t0 = fmaxf(fmaxf(s[0][0], s[0][1]), s[0][2]), t1 = fmaxf(fmaxf(s[1][0], s[1][1]), s[1][2]);
#pragma unroll
                for (int r = 3; r < 15; r += 2) { t0 = fmaxf(fmaxf(t0, s[0][r]), s[0][r + 1]); t1 = fmaxf(fmaxf(t1, s[1][r]), s[1][r + 1]); }
                float tmax = fmaxf(fmaxf(t0, t1), fmaxf(s[0][15], s[1][15]));
                { auto rr = __builtin_amdgcn_permlane32_swap(__float_as_uint(tmax), __float_as_uint(tmax), false, false); tmax = fmaxf(__uint_as_float(rr[0]), __uint_as_float(rr[1])); }
                const bool need = tmax > 8.f;
                if (__builtin_amdgcn_ballot_w64(need) != 0ull) {
                    const float delta = need ? tmax : 0.f;
                    const float alpha = __builtin_amdgcn_exp2f(-delta);
                    m += delta; l *= alpha;
#pragma unroll
                    for (int dt = 0; dt < DV / 32; ++dt) acc[dt] = acc[dt] * alpha;
#pragma unroll
                    for (int hh = 0; hh < 2; ++hh)
#pragma unroll
                        for (int r = 0; r < 16; ++r) s[hh][r] -= delta;
                }
#pragma unroll
                for (int hh = 0; hh < 2; ++hh)
#pragma unroll
                    for (int r = 0; r < 16; ++r) s[hh][r] = __builtin_amdgcn_exp2f(s[hh][r]);
                f32x2_t ls2a = {0.f, 0.f}, ls2b = {0.f, 0.f};
#pragma unroll
                for (int r = 0; r < 16; r += 2) { ls2a += (f32x2_t){s[0][r], s[0][r + 1]}; ls2b += (f32x2_t){s[1][r], s[1][r + 1]}; }
                const float ls = (ls2a[0] + ls2a[1]) + (ls2b[0] + ls2b[1]);
                l += ls;
                const LAS uchar* vb = lds + (cur ? L_V1 : L_V0) + n * VP + hi * 16;
    #pragma unroll
                for (int hh = 0; hh < 2; ++hh)
#pragma unroll
                    for (int u2 = 0; u2 < 2; ++u2) {
                        u32x4 pw;
                        pw.x = cvtpk(s[hh][8 * u2 + 0], s[hh][8 * u2 + 1]); pw.y = cvtpk(s[hh][8 * u2 + 2], s[hh][8 * u2 + 3]);
                        pw.z = cvtpk(s[hh][8 * u2 + 4], s[hh][8 * u2 + 5]); pw.w = cvtpk(s[hh][8 * u2 + 6], s[hh][8 * u2 + 7]);
                        const bf16x8 pb = __builtin_bit_cast(bf16x8, pw);
                        const int kbase = 32 * hh + 16 * u2;
#pragma unroll
                        for (int dt = 0; dt < DV / 32; ++dt) {
                            const bf16x8 va = *(const LAS bf16x8*)(vb + dt * 32 * VP + kbase * 2);
                            acc[dt] = __builtin_amdgcn_mfma_f32_32x32x16_bf16(va, pb, acc[dt], 0, 0, 0);
                        }
                    }
                } else {
                LAS float* imp = (LAS float*)(lds + L_IMP) + imp_row * 65;
                float spill[8];
#pragma unroll
                for (int hh = 0; hh < 2; ++hh)
#pragma unroll
                    for (int gq = 0; gq < 4; ++gq) {
                        const float p0 = __builtin_amdgcn_exp2f(s[hh][4 * gq + 0]) * inv_l, p1 = __builtin_amdgcn_exp2f(s[hh][4 * gq + 1]) * inv_l;
                        const float p2 = __builtin_amdgcn_exp2f(s[hh][4 * gq + 2]) * inv_l, p3 = __builtin_amdgcn_exp2f(s[hh][4 * gq + 3]) * inv_l;
                        float mn = (p0 + p1) + (p2 + p3), sp = p3;
                        mn += __shfl_xor(mn, 8); mn += __shfl_xor(mn, 16);
                        sp += __shfl_xor(sp, 8); sp += __shfl_xor(sp, 16);
                        spill[hh * 4 + gq] = sp;
                        const int j = 16 * kt + 8 * hh + 2 * gq + hi;
                        if (n < 8) imp[j] += mn;
                    }
                __builtin_amdgcn_fence(__ATOMIC_RELEASE, "wavefront");
#pragma unroll
                for (int hh = 0; hh < 2; ++hh)
#pragma unroll
                    for (int gq = 0; gq < 4; ++gq) {
                        const int j = 16 * kt + 8 * hh + 2 * gq + hi + 1;
                        if (n < 8 && j < 64) imp[j] += spill[hh * 4 + gq];
                    }
                __builtin_amdgcn_fence(__ATOMIC_RELEASE, "wavefront");
            }
        }
        if (more) tile_swrite<DV, !IMPP>(tr, lds, cur ^ 1, tid);
        __syncthreads();
    }
}

template <int NT> __device__ __forceinline__ void acc_zero(f32x16 (&a)[NT]) {
#pragma unroll
    for (int t = 0; t < NT; ++t)
#pragma unroll
        for (int r = 0; r < 16; ++r) a[t][r] = 0.f;
}
template <int NT> __device__ __forceinline__ void acc_norm(f32x16 (&a)[NT], float l) {
    const float lt = l + __shfl_xor(l, 32);
    const float inv = lt > 0.f ? 1.f / lt : 0.f;
#pragma unroll
    for (int t = 0; t < NT; ++t)
#pragma unroll
        for (int r = 0; r < 16; ++r) a[t][r] *= inv;
}
__device__ __forceinline__ void load_q(bf16x8 (&qf)[4], const bf16_t* qrow, int hi) {
#pragma unroll
    for (int ks = 0; ks < 4; ++ks) qf[ks] = *(const bf16x8*)(qrow + 16 * ks + 8 * hi);
}

struct AttnCtx {
    const bf16_t* zb;
    bf16_t *ya, *yb, *yc;
    float* park;
    const bf16_t *kcmp, *vtcmp;
    const float *rel_bias, *lamp, *subln, *sinks;
    float lam_init;
};

__device__ __forceinline__ void attn_unit_A(LAS uchar* lds, const AttnCtx& C, int bl, int h, int qt, int tid) {
    tid = opq(tid);
    const int lane = tid & 63, n = lane & 31, hi = lane >> 5, w = __builtin_amdgcn_readfirstlane(tid >> 6);
    build_tbl(lds, C.rel_bias, h, 1, tid);
    float lam;
    { const float a = C.lamp[lane] * C.lamp[64 + lane], b = C.lamp[128 + lane] * C.lamp[192 + lane]; lam = __expf(wave_sum(a)) - __expf(wave_sum(b)) + C.lam_init; }
    const int qpos = 256 * qt + 32 * w + n;
    const float rfar = C.rel_bias[31 * 20 + h] * LOG2E;
    const int kt1 = 4 * qt + 4, wkm = 4 * qt + (w >> 1);
    const bf16_t* Vt = C.zb + ZVA + ((size_t)bl * 8 + 2 * h) * HS;
    f32x16 acc[4];
    bf16x8 qf[4];
    float m, l;
    float* prow = C.park + ((size_t)bl * 4096 + qpos) * 512 + h * 128;
#pragma unroll 1
    for (int c = 1; c >= 0; --c) {
        const size_t hoff = ((size_t)bl * 8 + 2 * h + c) * HS;
        load_q(qf, C.zb + ZQA + hoff + (size_t)qpos * 64, hi);
        acc_zero<4>(acc); m = MINIT; l = 0.f;
        attn_pass<128, false>(lds, C.zb + ZKA + hoff, Vt, 4096, 0, kt1, wkm, qpos, 256 * qt + 32 * w, 256 * qt + 32 * w + 31, 1, 0, 0x7fffffffu, qf, L_TBL, 0ull, false, m, l, acc, 0.f, 0, rfar, tid);
        acc_norm<4>(acc, l);
        if (c == 1) {
#pragma unroll
            for (int t = 0; t < 4; ++t)
#pragma unroll
                for (int gq = 0; gq < 4; ++gq) *(f32x4*)(prow + 32 * t + 8 * gq + 4 * hi) = (f32x4){acc[t][4 * gq], acc[t][4 * gq + 1], acc[t][4 * gq + 2], acc[t][4 * gq + 3]};
        }
    }
    float ss = 0.f;
#pragma unroll
    for (int t = 0; t < 4; ++t)
#pragma unroll
        for (int gq = 0; gq < 4; ++gq) { const f32x4 o1 = *(const f32x4*)(prow + 32 * t + 8 * gq + 4 * hi);
#pragma unroll
            for (int e = 0; e < 4; ++e) { const float y = acc[t][4 * gq + e] - lam * o1[e]; acc[t][4 * gq + e] = y; ss += y * y; } }
    ss += __shfl_xor(ss, 32);
    const float rs = (1.0f / sqrtf(ss * (1.f / 128.f) + EPS)) * (1.f - C.lam_init);
    bf16_t* yrow = C.ya + ((size_t)bl * 4096 + qpos) * 512 + h * 128;
#pragma unroll
    for (int t = 0; t < 4; ++t)
#pragma unroll
        for (int gq = 0; gq < 4; ++gq) {
            const int d = 32 * t + 8 * gq + 4 * hi;
            const f32x4 gg = *(const f32x4*)(C.subln + d);
            u32x2 wv; wv.x = cvtpk(acc[t][4 * gq] * rs * gg[0], acc[t][4 * gq + 1] * rs * gg[1]); wv.y = cvtpk(acc[t][4 * gq + 2] * rs * gg[2], acc[t][4 * gq + 3] * rs * gg[3]);
            *(u32x2*)(yrow + d) = wv;
        }
}

__device__ __forceinline__ void attn_unit_B(LAS uchar* lds, const AttnCtx& C, int bl, int g, int i, int tid) {
    tid = opq(tid);
    const int lane = tid & 63, n = lane & 31, hi = lane >> 5, w = __builtin_amdgcn_readfirstlane(tid >> 6);
    build_tbl(lds, C.rel_bias, 4 + 4 * g, 4, tid);
    const int ql = 8 * w + (n & 7), hr = n >> 3, qpos = 64 * i + ql, head = 4 * g + hr, qlo = 64 * i + 8 * w;
    const float rfar = C.rel_bias[31 * 20 + 4 + head] * LOG2E;
    const int tbl = L_TBL + hr * 512;
    bf16x8 qf[4];
    load_q(qf, C.zb + ZQB + ((size_t)bl * 8 + head) * HS + (size_t)qpos * 64, hi);
    const size_t goff = ((size_t)bl * 2 + g) * HS;
    f32x16 acc[2];
    LAS float* otl = (LAS float*)(lds + L_RED) + tid;
    float m, l;
    const size_t tok = (size_t)bl * 4096 + qpos;
    const float* bg = (const float*)(C.zb + ZBG) + tok * 32 + head * 3;
    const float g0 = bg[0], g1 = bg[1], g2 = bg[2];
    const bf16_t* Kc = C.kcmp + ((size_t)bl * 2 + g) * 256 * 64;
    const bf16_t* Vc = C.vtcmp + ((size_t)bl * 2 + g) * 64 * 256;
    const int ktc1 = ((4 * i + 2) >> 6) + 1;
    acc_zero<2>(acc); m = MINIT; l = 0.f;
    attn_pass<64, false>(lds, Kc, Vc, 256, 0, ktc1, 1 << 20, qpos, qlo, qlo + 7, 16, 31, 0x7fffffffu, qf, tbl, 0ull, false, m, l, acc, 0.f, 0, rfar, tid);
    acc_norm<2>(acc, l);
#pragma unroll
    for (int t = 0; t < 2; ++t)
#pragma unroll
        for (int r = 0; r < 16; ++r) otl[(t * 16 + r) * NTHR] = g0 * acc[t][r];
    unsigned long long selmask = ~0ull;
    if (i >= 16) {
    {
        const float lt = l + __shfl_xor(l, 32);
        const float inv_l = lt > 0.f ? 1.f / lt : 0.f;
        LAS float* impw = (LAS float*)(lds + L_IMP) + (8 * w) * 65;
        for (int x = lane; x < 8 * 65; x += 64) impw[x] = 0.f;
        __builtin_amdgcn_fence(__ATOMIC_RELEASE, "wavefront");
        attn_pass<64, true>(lds, Kc, Vc, 256, 0, ktc1, 1 << 20, qpos, qlo, qlo + 7, 16, 31, 0x7fffffffu, qf, tbl, 0ull, false, m, l, acc, inv_l, ql, rfar, tid);
    }
    {
        const int q = tid & 63, part = tid >> 6;
        const LAS float* row = (const LAS float*)(lds + L_IMP) + q * 65;
        float cand[8]; int rank[8];
#pragma unroll
        for (int c = 0; c < 8; ++c) { const int j = 8 * part + c; float v = row[j]; v = (j == 0 || j == i || j == i - 1) ? 1e6f : (j > i ? -1e6f : v); cand[c] = v; rank[c] = 0; }
        for (int jj = 0; jj <= i; ++jj) {
            float x = row[jj]; x = (jj == 0 || jj == i || jj == i - 1) ? 1e6f : (jj > i ? -1e6f : x);
#pragma unroll
            for (int c = 0; c < 8; ++c) { const int j = 8 * part + c; rank[c] += (x > cand[c] || (x == cand[c] && jj < j)) ? 1 : 0; }
        }
        unsigned bits = 0;
#pragma unroll
        for (int c = 0; c < 8; ++c) bits |= (rank[c] < 16 ? 1u : 0u) << c;
        ((LAS uchar*)(lds + L_SEL))[q * 8 + part] = (uchar)bits;
    }
    __syncthreads();
    { const u32x2 sm = *(const LAS u32x2*)(lds + L_SEL + ql * 8); selmask = (unsigned long long)sm.x | ((unsigned long long)sm.y << 32); }
    }
    acc_zero<2>(acc); m = MINIT; l = 0.f;
    attn_pass<64, false>(lds, C.zb + ZKS + goff, C.zb + ZVS + goff, 4096, 0, i + 1, 1 << 20, qpos, qlo, qlo + 7, 1, 0, 0x7fffffffu, qf, tbl, selmask, true, m, l, acc, 0.f, 0, rfar, tid);
    acc_norm<2>(acc, l);
#pragma unroll
    for (int t = 0; t < 2; ++t)
#pragma unroll
        for (int r = 0; r < 16; ++r) otl[(t * 16 + r) * NTHR] += g1 * acc[t][r];
    acc_zero<2>(acc); m = MINIT; l = 0.f;
    attn_pass<64, false>(lds, C.zb + ZKW + goff, C.zb + ZVW + goff, 4096, i > 8 ? i - 8 : 0, i + 1, 1 << 20, qpos, qlo, qlo + 7, 1, 0, 512u, qf, tbl, 0ull, false, m, l, acc, 0.f, 0, rfar, tid);
    acc_norm<2>(acc, l);
    bf16_t* yrow = C.yb + tok * 512 + head * 64;
#pragma unroll
    for (int t = 0; t < 2; ++t)
#pragma unroll
        for (int gq = 0; gq < 4; ++gq) {
            const int d = 32 * t + 8 * gq + 4 * hi;
            float o[4];
#pragma unroll
            for (int e = 0; e < 4; ++e) o[e] = otl[(t * 16 + 4 * gq + e) * NTHR] + g2 * acc[t][4 * gq + e];
            u32x2 wv; wv.x = cvtpk(o[0], o[1]); wv.y = cvtpk(o[2], o[3]);
            *(u32x2*)(yrow + d) = wv;
        }
}

__device__ __forceinline__ void attn_unit_C(LAS uchar* lds, const AttnCtx& C, int bl, int g, int i, int tid) {
    tid = opq(tid);
    const int lane = tid & 63, n = lane & 31, hi = lane >> 5, w = __builtin_amdgcn_readfirstlane(tid >> 6);
    build_tbl(lds, C.rel_bias, 12 + 4 * g, 4, tid);
    const int ql = 8 * w + (n & 7), hr = n >> 3, qpos = 64 * i + ql, head = 4 * g + hr, qlo = 64 * i + 8 * w;
    const float rfar = C.rel_bias[31 * 20 + 12 + head] * LOG2E;
    const int tbl = L_TBL + hr * 512;
    bf16x8 qf[4];
    load_q(qf, C.zb + ZQC + ((size_t)bl * 8 + head) * HS + (size_t)qpos * 64, hi);
    const size_t goff = ((size_t)bl * 2 + g) * HS;
    f32x16 acc[2];
    acc_zero<2>(acc);
    float m = C.sinks[head] * LOG2E, l = hi == 0 ? 1.f : 0.f;
    attn_pass<64, false>(lds, C.zb + ZKC + goff, C.zb + ZVC + goff, 4096, i > 2 ? i - 2 : 0, i + 1, 1 << 20, qpos, qlo, qlo + 7, 1, 0, 128u, qf, tbl, 0ull, false, m, l, acc, 0.f, 0, rfar, tid);
    acc_norm<2>(acc, l);
    const size_t tok = (size_t)bl * 4096 + qpos;
    bf16_t* yrow = C.yc + tok * 512 + head * 64;
#pragma unroll
    for (int t = 0; t < 2; ++t)
#pragma unroll
        for (int gq = 0; gq < 4; ++gq) {
            const int d = 32 * t + 8 * gq + 4 * hi;
            u32x2 wv; wv.x = cvtpk(acc[t][4 * gq], acc[t][4 * gq + 1]); wv.y = cvtpk(acc[t][4 * gq + 2], acc[t][4 * gq + 3]);
            *(u32x2*)(yrow + d) = wv;
        }
}

#define XB_TMO      128
#define XB_XCNT(j)  (256  + 64 * (j))
#define XB_XSUB(j)  (1280 + 64 * (j))
#define XB_XGEN(j)  (2304 + 64 * (j))
#define XB_TOP      3328
#define XB_TOPGEN   3392
#define XCD_BAR_WORDS 3456
#define XB_SPIN_CAP (1u << 18)

__device__ __forceinline__ unsigned xb_ld(unsigned* p)              { return __hip_atomic_load(p, __ATOMIC_RELAXED, __HIP_MEMORY_SCOPE_AGENT); }
__device__ __forceinline__ unsigned xb_add(unsigned* p, unsigned v) { return __hip_atomic_fetch_add(p, v, __ATOMIC_RELAXED, __HIP_MEMORY_SCOPE_AGENT); }
__device__ __forceinline__ unsigned xb_xcc_id() { return (unsigned)__builtin_amdgcn_s_getreg((3 << 11) | 20) & 0xFu; }
#define XB_SPIN(cond, bar) do { unsigned _sp = 0; while (cond) { __builtin_amdgcn_s_sleep(1); \
    if ((++_sp & 255u) == 0u) { if (xb_ld(&(bar)[XB_TMO])) break; if (_sp > XB_SPIN_CAP) { atomicAdd(&(bar)[XB_TMO], 1u); break; } } } } while (0)

struct XcdBarrier {
    unsigned* bar; unsigned x;
    volatile __attribute__((address_space(3))) unsigned* st;
};

__device__ __forceinline__ XcdBarrier xcd_barrier_post(unsigned* bar, volatile __attribute__((address_space(3))) unsigned* st) {
    XcdBarrier b; b.bar = bar; b.x = xb_xcc_id(); b.st = st;
    if (threadIdx.x == 0) (void)xb_add(&bar[XB_XCNT(b.x)], 1u);
    return b;
}
__device__ __forceinline__ void xcd_barrier_complete(unsigned* bar, unsigned x, unsigned& nloc, unsigned& nx) {
    const unsigned G = gridDim.x * gridDim.y * gridDim.z;
    unsigned sum, cnt, mine, sp = 0u;
    for (;;) {
        sum = 0u; cnt = 0u; mine = 0u;
#pragma unroll
        for (unsigned j = 0; j < 16; ++j) { const unsigned c = xb_ld(&bar[XB_XCNT(j)]); sum += c; cnt += (c > 0u) ? 1u : 0u; mine = (j == x) ? c : mine; }
        if (sum == G) break;
        __builtin_amdgcn_s_sleep(1);
        if ((++sp & 255u) == 0u) { if (xb_ld(&bar[XB_TMO])) break; if (sp > XB_SPIN_CAP) { atomicAdd(&bar[XB_TMO], 1u); break; } }
    }
    nloc = mine > 0u ? mine : 1u; nx = cnt > 0u ? cnt : 1u;
}

__device__ __forceinline__ void xcd_barrier(const XcdBarrier& b) {
    asm volatile("s_waitcnt vmcnt(0)" ::: "memory");
    __syncthreads();
    if (threadIdx.x == 0) {
        unsigned* bar = b.bar;
        __builtin_amdgcn_s_waitcnt(0);
        unsigned nloc = b.st[0], nx = b.st[1];
        if (nloc == 0u) { xcd_barrier_complete(bar, b.x, nloc, nx); b.st[0] = nloc; b.st[1] = nx; }
        const unsigned old = xb_add(&bar[XB_XSUB(b.x)], 1u);
        const unsigned gen = old / nloc;
        if (old + 1u == (gen + 1u) * nloc) {
            __builtin_amdgcn_fence(__ATOMIC_RELEASE, "agent");
            asm volatile("s_waitcnt vmcnt(0)" ::: "memory");
            const unsigned og = xb_add(&bar[XB_TOP], 1u);
            const unsigned tg = og / nx;
            if (og + 1u == (tg + 1u) * nx) xb_add(&bar[XB_TOPGEN], 1u);
            else XB_SPIN(xb_ld(&bar[XB_TOPGEN]) == tg, bar);
            __builtin_amdgcn_fence(__ATOMIC_ACQUIRE, "agent");
            xb_add(&bar[XB_XGEN(b.x)], 1u);
            asm volatile("s_waitcnt vmcnt(0)" ::: "memory");
        } else {
            XB_SPIN(xb_ld(&bar[XB_XGEN(b.x)]) == gen, bar);
            __builtin_amdgcn_fence(__ATOMIC_ACQUIRE, "agent");
            asm volatile("s_waitcnt vmcnt(0)" ::: "memory");
        }
    }
    __syncthreads();
}

#define KIN(i) (kparams()->in[i])
#define WS_ (kparams()->ws)
#define HOUT (kparams()->out)
#define Wb ((bf16_t*)(WS_ + WS_W))
#define XN ((bf16_t*)(WS_ + WS_XN))
#define R1 ((bf16_t*)(WS_ + WS_R1))
#define YA ((bf16_t*)(WS_ + WS_Y))
#define MG ((bf16_t*)(WS_ + WS_MG))
#define CH ((bf16_t*)(WS_ + WS_CH))
#define KCMP ((bf16_t*)(WS_ + WS_KCMP))
#define VCMP ((bf16_t*)(WS_ + WS_VCMP))
#define CB ((float*)(WS_ + WS_CB))
#define XN2 ((bf16_t*)(WS_ + WS_XN2))
#define PBF ((bf16_t*)(WS_ + WS_PBF))
#define SSQ ((float*)(WS_ + WS_SSQ))
#define SSQ2 ((float*)(WS_ + WS_SSQ2))
constexpr int LDS_BYTES = 147456;
#ifdef ONLY_EPI
#include <type_traits>
#define ONLY_OK(E) (std::is_same<E, ONLY_EPI>::value)
#else
#define ONLY_OK(E) true
#endif
#ifdef NO_GEMM
#define GEMM(EPI, e, A_, lda_, Bt_, M_, N_, K_, cshift) do { (void)(e); } while (0)
#else
#define GEMM(EPI, e, A_, lda_, Bt_, M_, N_, K_, cshift) do { pg8::Gemm g_{(const bf16_t*)(A_), (const bf16_t*)(Bt_), (M_), (N_), (K_), (lda_)}; pg8::StaticOrder S_; \
    int c_ = (int)((blk + (cshift)) % G), G_ = G; asm volatile("" : "+s"(c_), "+s"(G_)); S_.init((M_), (N_), G_, c_); if (ONLY_OK(EPI)) pg8::gemm_phase<EPI, pg8::StaticOrder, EPI::ALIGN, true>(lds, g_, S_, (e)); } while (0)
#endif
#ifdef NO_GEMM
#define GEMM_X(EPI, e, A_, lda_, Bt_, M_, N_, K_, cidx, gsz) do { (void)(e); } while (0)
#else
#define GEMM_X(EPI, e, A_, lda_, Bt_, M_, N_, K_, cidx, gsz) do { pg8::Gemm g_{(const bf16_t*)(A_), (const bf16_t*)(Bt_), (M_), (N_), (K_), (lda_)}; pg8::StaticOrder S_; \
    int c_ = (int)(cidx), G_ = (int)(gsz); asm volatile("" : "+s"(c_), "+s"(G_)); S_.init((M_), (N_), G_, c_); if (ONLY_OK(EPI)) pg8::gemm_phase<EPI, pg8::StaticOrder, EPI::ALIGN, true>(lds, g_, S_, (e)); } while (0)
#endif

__global__ void __launch_bounds__(NTHR, 2) fwd_kernel(Params P) {
    extern __shared__ __attribute__((aligned(16))) unsigned char lds_raw[];
    LAS uchar* lds = (LAS uchar*)lds_raw;
    cg::grid_group grid = cg::this_grid();
    volatile LAS unsigned* xst = (volatile LAS unsigned*)(lds + LDS_BYTES - 64);
    if (threadIdx.x < 2) xst[threadIdx.x] = 0u;
    __syncthreads();
    const XcdBarrier xbar = xcd_barrier_post((unsigned*)(kparams()->ws + WS_CTL), xst);
#ifndef PROBE_CLASS
#define PROBE_CLASS 0
#endif
#if PROBE_CLASS
    unsigned long long pr_acc = 0, pr_last = __builtin_amdgcn_s_memrealtime();
#define SYNC(cls) do { const unsigned long long t1_ = __builtin_amdgcn_s_memrealtime(); if ((cls) == PROBE_CLASS) pr_acc += t1_ - pr_last; if ((cls) == 6) grid.sync(); else xcd_barrier(xbar); \
    const unsigned long long t2_ = __builtin_amdgcn_s_memrealtime(); if (PROBE_CLASS == 2) pr_acc += t2_ - t1_; pr_last = t2_; } while (0)
#else
#define SYNC(cls) do { if ((cls) == 6) grid.sync(); else xcd_barrier(xbar); } while (0)
#endif
#define DEF_IDS \
    int tid_o = threadIdx.x, G_o = gridDim.x, blk_o = blockIdx.x; asm volatile("" : "+v"(tid_o), "+s"(G_o), "+s"(blk_o)); \
    const int tid = tid_o, lane = tid & 63, wave = __builtin_amdgcn_readfirstlane(tid >> 6); \
    const int G = G_o, blk = blk_o; \
    const int vcu = (G % 8 == 0) ? (blk % 8) * (G / 8) + blk / 8 : blk; \
    const int gw = blk * 8 + wave, ngw = G * 8; (void)vcu; (void)gw; (void)ngw; (void)lane;
    {
        DEF_IDS
        LAS float* scr = (LAS float*)lds;
        int base = 0;
        for (int L = 0; L < DEPTH; ++L) {
            bf16_t* wl = Wb + (size_t)L * W_LAYER;
            conv_matrix(KIN(3) + (size_t)L * 1024 * 5632, 1024, 5632, 5632, 1, wl + W_WI1, base, scr, tid, blk, G, KIN(2) + (size_t)(L * 4 + 0) * DM);
            conv_matrix(KIN(4) + (size_t)L * 2816 * 1024, 2816, 1024, 1024, 0, wl + W_WO1, base, scr, tid, blk, G);
            conv_matrix(KIN(5) + (size_t)L * 1024 * DIN, 1024, DIN, DINP, 2, wl + W_WIN, base, scr, tid, blk, G, KIN(2) + (size_t)(L * 4 + 1) * DM);
            for (int t = 0; t < 2; ++t) conv_matrix(KIN(9) + ((size_t)L * 2 + t) * 2048 * 256, 2048, 256, 256, 0, wl + W_CW1 + (size_t)t * 256 * 2048, base, scr, tid, blk, G);
            for (int t = 0; t < 2; ++t) conv_matrix(KIN(10) + ((size_t)L * 2 + t) * 256 * 64, 256, 64, 256, 3, wl + W_CW2 + (size_t)t * 256 * 256, base, scr, tid, blk, G);
            for (int t = 0; t < 3; ++t) conv_matrix(KIN(12) + ((size_t)L * 3 + t) * 512 * 1024, 512, 1024, 1024, 0, wl + W_WBR + (size_t)t * 1024 * 512, base, scr, tid, blk, G);
            conv_matrix(KIN(13) + (size_t)L * 1024 * 1024, 1024, 1024, 1024, 0, wl + W_WOUT, base, scr, tid, blk, G);
            conv_matrix(KIN(14) + (size_t)L * 1024 * 5632, 1024, 5632, 5632, 1, wl + W_WI2, base, scr, tid, blk, G, KIN(2) + (size_t)(L * 4 + 2) * DM);
            conv_matrix(KIN(15) + (size_t)L * 2816 * 1024, 2816, 1024, 1024, 0, wl + W_WO2, base, scr, tid, blk, G);
            conv_matrix(KIN(16) + (size_t)L * 256 * 1024, 256, 1024, 1024, 0, wl + W_WPE, base, scr, tid, blk, G);
            conv_matrix(KIN(17) + (size_t)L * 1024 * 1024, 1024, 1024, 1024, 0, wl + W_WPG, base, scr, tid, blk, G, KIN(2) + (size_t)(L * 4 + 3) * DM);
        }
        for (int pr = blk; pr < DEPTH * 2; pr += G) {
            const float* pos = KIN(8) + (size_t)pr * 2048; const float* w1 = KIN(9) + (size_t)pr * 2048 * 256;
            float a[4] = {0.f, 0.f, 0.f, 0.f};
            for (int k = wave * 256; k < wave * 256 + 256; ++k) { const float pv = pos[k];
#pragma unroll
                for (int j = 0; j < 4; ++j) a[j] += pv * w1[(size_t)k * 256 + lane + 64 * j]; }
#pragma unroll
            for (int j = 0; j < 4; ++j) scr[wave * 256 + lane + 64 * j] = a[j];
            __syncthreads();
            if (tid < 256) { float s = 0.f;
#pragma unroll
                for (int ww = 0; ww < 8; ++ww) s += scr[ww * 256 + tid];
                CB[pr * 256 + tid] = s; }
            __syncthreads();
        }
        phase_prep(KIN(0), XN2, SSQ2, gw, ngw, lane);
    }
    SYNC(6);

#pragma unroll 1
    for (int L = 0; L < DEPTH; ++L) {
        DEF_IDS
#define wl (Wb + (size_t)L * W_LAYER)
#define ng (KIN(2) + (size_t)L * 4 * DM)
        { EpiSwiglu e{R1, SSQ2}; GEMM(EpiSwiglu, e, XN2, 1024, wl + W_WI1, T, 5632, 1024, 0); }
        SYNC(3);
        { EpiResid e{0.5f, 0, L == 0 ? 0 : 1}; GEMM(EpiResid, e, R1, DFF, wl + W_WO1, T, 1024, DFF, 0); }
        SYNC(3);
        { EpiZ e{R1, SSQ, 0}; GEMM(EpiZ, e, XN, 1024, wl + W_WIN, TC, DINP - 256, 1024, 0); }
        SYNC(3);
        for (int c = 0; c < NCHUNK; ++c) {
            {
                const bool offl = (G >= 64) && ((G & 1) == 0), has_cmp = blk < 16 || (blk >= G / 2 && blk < G / 2 + 16);
                EpiZ e{R1, SSQ + (size_t)c * TC * 16, 26};
                if (!offl) GEMM(EpiZ, e, XN + (size_t)c * TC * DM, 1024, wl + W_WIN + (size_t)(DINP - 256) * 1024, TC, 256, 1024, 0);
                else if (!has_cmp) GEMM_X(EpiZ, e, XN + (size_t)c * TC * DM, 1024, wl + W_WIN + (size_t)(DINP - 256) * 1024, TC, 256, 1024, blk < G / 2 ? blk - 16 : blk - 32, G - 32);
            }
            { EpiBf<1> ek{CH, 256, CB + (L * 2 + 0) * 256}; GEMM(EpiBf<1>, ek, R1 + ZKCI, 1024, wl + W_CW1, NB * 512, 256, 2048, 0);
              EpiBf<1> ev{CH + (size_t)NB * 512 * 256, 256, CB + (L * 2 + 1) * 256}; GEMM(EpiBf<1>, ev, R1 + ZVCI, 1024, wl + W_CW1 + (size_t)256 * 2048, NB * 512, 256, 2048, G / 2); }
            __builtin_amdgcn_fence(__ATOMIC_RELEASE, "workgroup"); __syncthreads(); __builtin_amdgcn_fence(__ATOMIC_ACQUIRE, "workgroup");
            { EpiCmp2<false> ek{KCMP}; GEMM(EpiCmp2<false>, ek, CH, 256, wl + W_CW2, NB * 512, 256, 256, 0);
              EpiCmp2<true> ev{VCMP}; GEMM(EpiCmp2<true>, ev, CH + (size_t)NB * 512 * 256, 256, wl + W_CW2 + (size_t)256 * 256, NB * 512, 256, 256, G / 2); }
            SYNC(5);
            {
                AttnCtx C;
                C.zb = R1; C.park = (float*)MG; C.ya = YA; C.yb = YA + (size_t)TC * 512; C.yc = YA + (size_t)2 * TC * 512; C.kcmp = KCMP; C.vtcmp = VCMP;
                C.rel_bias = KIN(18); C.lamp = KIN(6) + (size_t)L * 256; C.subln = KIN(7) + (size_t)L * 128; C.sinks = KIN(11) + (size_t)L * 8;
                C.lam_init = 0.8f - 0.6f * __expf(-0.3f * (float)L);
                for (int u = vcu; u < NB * 32; u += G) {
                    const int bl = u >> 5;
#ifndef NO_A
#if PROBE_CLASS == 7
                    const unsigned long long ta0_ = __builtin_amdgcn_s_memrealtime();
#endif
                    { const int h = (u >> 3) & 3, qp = u & 7;
#pragma unroll 1
                      for (int k = 0; k < 2; ++k) attn_unit_A(lds, C, bl, h, k ? 15 - qp : qp, tid); }
#if PROBE_CLASS == 7
                    pr_acc += __builtin_amdgcn_s_memrealtime() - ta0_;
#endif
#endif
                    { const int g = (u >> 4) & 1, is = u & 15;
#ifndef NO_B
#pragma unroll 1
                      for (int k = 0; k < 4; ++k) attn_unit_B(lds, C, bl, g, (k & 1) ? (k == 1 ? 31 : 63) - is : (k == 0 ? 0 : 32) + is, tid);
#endif
#ifndef NO_C
#pragma unroll 1
                      for (int k = 0; k < 4; ++k) attn_unit_C(lds, C, bl, g, (k & 1) ? (k == 1 ? 31 : 63) - is : (k == 0 ? 0 : 32) + is, tid);
#endif
                    }
                }
            }
            SYNC(1);
            for (int mi = 0; mi < 3; ++mi) {
                EpiBranch e{MG, R1 + ZSG, mi}; GEMM(EpiBranch, e, YA + (size_t)mi * TC * 512, 512, wl + W_WBR + (size_t)mi * 1024 * 512, TC, 1024, 512, 0);
            }
            SYNC(3);
            { EpiResid e{1.0f, c * TC, 2}; GEMM(EpiResid, e, MG, 1024, wl + W_WOUT, TC, 1024, 1024, 0); }
            if (c + 1 < NCHUNK) { EpiZ e{R1, SSQ + (size_t)(c + 1) * TC * 16, 0}; GEMM(EpiZ, e, XN + (size_t)(c + 1) * TC * DM, 1024, wl + W_WIN, TC, DINP - 256, 1024, 0); }
            SYNC(3);
        }
        {
            const f32x4* src = (const f32x4*)(KIN(1) + (size_t)L * T * PLE); u32x2* dst = (u32x2*)PBF;
            const int tq = opq(tid);
            for (size_t idx = (size_t)blk * NTHR + tq; idx < (size_t)T * PLE / 4; idx += (size_t)G * NTHR) { const f32x4 v = src[idx]; u32x2 w; w.x = cvtpk(v[0], v[1]); w.y = cvtpk(v[2], v[3]); dst[idx] = w; }
        }
        { EpiSwiglu e{R1, SSQ}; GEMM(EpiSwiglu, e, XN, 1024, wl + W_WI2, T, 5632, 1024, 0); }
        SYNC(3);
        { EpiResid e{0.5f, 0, 2}; GEMM(EpiResid, e, R1, DFF, wl + W_WO2, T, 1024, DFF, 0); }
        SYNC(3);
        { EpiBf<0> e{(bf16_t*)((uchar*)R1 + R1_E), 1024, nullptr}; GEMM(EpiBf<0>, e, PBF, 256, wl + W_WPE, T, 1024, 256, 0); }
        SYNC(3);
        { uchar* ws_ = WS_; EpiPle e{(const bf16_t*)(ws_ + WS_XN), (const bf16_t*)(ws_ + WS_R1 + R1_E), (const float*)(ws_ + WS_SSQ), (bf16_t*)(ws_ + WS_XN2), (float*)(ws_ + WS_SSQ2)}; GEMM(EpiPle, e, XN, 1024, wl + W_WPG, T, 1024, 1024, 0); }
        SYNC(3);
    }
    { DEF_IDS const int lq = opq(lane); float* ho = HOUT; const float* fg = KIN(19); const bf16_t* hb = XN2; for (int m = gw; m < T; m += ngw) rms_row_bf16in_f32(hb + (size_t)m * DM, fg, ho + (size_t)m * DM, lq); }
#if PROBE_CLASS
    if (blockIdx.x == 0) { const unsigned long long t0_ = __builtin_amdgcn_s_memrealtime(); while (__builtin_amdgcn_s_memrealtime() - t0_ < pr_acc) __builtin_amdgcn_s_sleep(20); }
#endif
}

extern "C" void kernel_launch(void* const* d_in, const int* in_sizes, int n_in, void* d_out, int out_size, void* d_ws, size_t ws_size, hipStream_t stream) {
    static int grid = 0;
    if (grid == 0) {
        if (n_in != 20 || out_size != T * DM || ws_size < WS_END) { fprintf(stderr, "kernel_launch: unexpected shapes (n_in %d out %d ws %zu)\n", n_in, out_size, ws_size); grid = -1; return; }
        int dev = 0, cus = 0, per_cu = 0;
        hipGetDevice(&dev);
        hipDeviceGetAttribute(&cus, hipDeviceAttributeMultiprocessorCount, dev);
        if (hipFuncSetAttribute((const void*)fwd_kernel, hipFuncAttributeMaxDynamicSharedMemorySize, LDS_BYTES) != hipSuccess) { fprintf(stderr, "kernel_launch: hipFuncSetAttribute failed\n"); grid = -1; return; }
        if (hipOccupancyMaxActiveBlocksPerMultiprocessor(&per_cu, (const void*)fwd_kernel, NTHR, LDS_BYTES) != hipSuccess || per_cu < 1) { fprintf(stderr, "kernel_launch: occupancy query says %d\n", per_cu); per_cu = 1; }
        (void)hipGetLastError();
        grid = cus;
        if (grid > 256) grid = 256;
    }
    if (grid < 0) return;
    if (hipMemsetAsync((char*)d_ws + WS_CTL, 0, CTL_ZERO_BYTES, stream) != hipSuccess) { fprintf(stderr, "kernel_launch: memset failed\n"); return; }
    Params p{};
    for (int i = 0; i < 20; ++i) p.in[i] = (const float*)d_in[i];
    p.out = (float*)d_out; p.ws = (uchar*)d_ws;
    void* args[] = {&p};
    hipError_t e = hipLaunchCooperativeKernel((const void*)fwd_kernel, dim3(grid), dim3(NTHR), args, LDS_BYTES, stream);
    if (e != hipSuccess) fprintf(stderr, "cooperative launch failed: %s (grid %d)\n", hipGetErrorString(e), grid);
}
```

```cpp
#include <hip/hip_runtime.h>
#include <hip/hip_cooperative_groups.h>
#include <cstdio>
#include <cstdint>
namespace cg = cooperative_groups;
namespace pg8 {
#define PG8_LAS __attribute__((address_space(3)))
typedef unsigned short bf16_t;
typedef short bf16x8 __attribute__((ext_vector_type(8)));
typedef float f32x4 __attribute__((ext_vector_type(4)));
typedef unsigned u32x4 __attribute__((ext_vector_type(4)));
constexpr int BM = 256, BK = 64, HALF = 128, HTB = HALF * BK * 2  , STAGE_BYTES = 8 * HTB, NXCD = 8, WGM = 4;

__host__ __device__ __forceinline__ int lds_byte(int r, int c) { const int st = (r >> 4) * 2 + (c >> 5), rr = r & 15, cc = c & 31, ob = rr * 64 + cc * 2; return st * 1024 + (ob ^ (((ob >> 9) & 1) << 5)); }
__host__ __device__ __forceinline__ void stage_rc(int b, int& R, int& C) { const int st = b / 1024, sb = b % 1024, swz = sb ^ (((sb >> 9) & 1) << 5); R = (st >> 1) * 16 + swz / 64; C = (st & 1) * 32 + (swz % 64) / 2; }
__host__ __device__ __forceinline__ int perm32(int rho) { const int n = rho >> 4, i = rho & 15; return 8 * (i >> 2) + 4 * n + (i & 3); }

struct Unit { int pm, pn; };
struct Gemm { const bf16_t* A; const bf16_t* Bt; int M, N, K, lda; };

struct StaticOrder {
    int nM, nN, nwg, G, c;
    __host__ __device__ void init(int M, int N, int G_, int c_) { nM = M / BM; nN = N / BM; nwg = nM * nN; G = G_; c = c_; }
    __host__ __device__ bool next(int i, Unit& u) const {
        const long L = (long)i * G + c; if (L >= nwg) return false;
        int wgid = (int)L; { const int q = nwg / NXCD, r = nwg % NXCD, xcd = wgid % NXCD, off = wgid / NXCD; wgid = (xcd < r ? xcd * (q + 1) : r * (q + 1) + (xcd - r) * q) + off; }
        const int nig = WGM * nN, gid = wgid / nig, fm = gid * WGM, gsz = (nM - fm) < WGM ? (nM - fm) : WGM;
        u.pm = fm + ((wgid % nig) % gsz); u.pn = (wgid % nig) / gsz; return true;
    }
    __device__ __forceinline__ void a_ready(const Unit&) const {}
    __device__ __forceinline__ void done(const Unit&) const {}
};

__device__ __forceinline__ unsigned cvt_pk_bf16(float lo, float hi) { unsigned r; asm volatile("v_cvt_pk_bf16_f32 %0, %1, %2" : "=v"(r) : "v"(lo), "v"(hi)); return r; }
typedef float f32x2 __attribute__((ext_vector_type(2)));
template <class Epi, class Sched, bool ALIGN_EPI = false, bool SP2 = false>
__device__ __forceinline__ void gemm_phase(PG8_LAS unsigned char* lds, const Gemm g, const Sched& S, const Epi& E) {
    int tid_ = threadIdx.x; asm volatile("" : "+v"(tid_)); const int tid = tid_, wid = __builtin_amdgcn_readfirstlane(tid >> 6), lane = tid & 63, wr = wid >> 2, wc = wid & 3, fr = lane & 15, fq = lane >> 4;
    const int K = g.K, nt = K / BK;
    unsigned voffA[2], voffB[2];
#pragma unroll
    for (int i = 0; i < 2; ++i) { int R, C; stage_rc(tid * 16 + i * 8192, R, C); const int Rb = Epi::PERM ? ((R & ~31) + perm32(R & 31)) : R;
        voffA[i] = (unsigned)(R * g.lda + C) * 2u; voffB[i] = (unsigned)(Rb * K + C) * 2u; }
    const size_t kstep = (size_t)(BK * 2);
    const size_t hstep = (size_t)HALF * K * 2;
    const size_t tstep = 2 * hstep; const size_t hstepA = (size_t)HALF * g.lda * 2, tstepA = 2 * hstepA;
    const unsigned ldsw = (unsigned)wid * 1024u;
    const int aoff = lds_byte(wr * 64 + fr, fq * 8), boff = lds_byte(wc * 32 + fr, fq * 8);
#define PG8_SA(b, h) (((b) * 2 + (h)) * HTB)
#define PG8_SB(b, h) ((4 + (b) * 2 + (h)) * HTB)
#define PG8_STAGE(bufoff, gbase, voff) do { _Pragma("unroll") for (int _i = 0; _i < 2; ++_i) \
        __builtin_amdgcn_global_load_lds((const unsigned*)((const char*)(gbase) + (voff)[_i]), (PG8_LAS unsigned*)(lds + (bufoff) + ldsw + _i * 8192), 16, 0, 0); } while (0)
#define PG8_LDA(dst, b, h) do { _Pragma("unroll") for (int m = 0; m < 4; ++m) _Pragma("unroll") for (int k = 0; k < 2; ++k) dst[m][k] = *(const PG8_LAS bf16x8*)(lds + PG8_SA(b, h) + aoff + m * 2048 + k * 1024); } while (0)
#define PG8_LDB(dst, b, h) do { _Pragma("unroll") for (int n = 0; n < 2; ++n) _Pragma("unroll") for (int k = 0; k < 2; ++k) dst[n][k] = *(const PG8_LAS bf16x8*)(lds + PG8_SB(b, h) + boff + n * 2048 + k * 1024); } while (0)
#define PG8_MMA(ai, bj, At, Bt) do { __builtin_amdgcn_s_setprio(1); _Pragma("unroll") for (int m = 0; m < 4; ++m) _Pragma("unroll") for (int n = 0; n < 2; ++n) _Pragma("unroll") for (int k = 0; k < 2; ++k) \
        acc[ai][bj][m][n] = __builtin_amdgcn_mfma_f32_16x16x32_bf16(Bt[n][k], At[m][k], acc[ai][bj][m][n], 0, 0, 0); __builtin_amdgcn_s_setprio(0); } while (0)
#define PG8_WAIT_V(n) asm volatile("s_waitcnt vmcnt(" #n ")" ::: "memory")
#define PG8_WAIT_L(n) asm volatile("s_waitcnt lgkmcnt(" #n ")" ::: "memory")
#define PG8_BAR __builtin_amdgcn_s_barrier()
#define PG8_SCHED __builtin_amdgcn_sched_barrier(0)
    Unit cur, nxt; int ui = 0;
    if (!S.next(0, cur)) return;
    f32x4 acc[2][2][4][2];
#pragma unroll
    for (int a = 0; a < 2; ++a)
#pragma unroll
        for (int b = 0; b < 2; ++b)
#pragma unroll
            for (int m = 0; m < 4; ++m)
#pragma unroll
                for (int n = 0; n < 2; ++n) acc[a][b][m][n] = (f32x4){0.f, 0.f, 0.f, 0.f};
    bf16x8 At[4][2], B0[2][2], B1[2][2];
    const char* cA = (const char*)g.A + (size_t)cur.pm * tstepA; const char* cB = (const char*)g.Bt + (size_t)cur.pn * tstep;
    S.a_ready(cur);
    if constexpr (SP2) {
        PG8_STAGE(PG8_SB(0, 0), cB, voffB); PG8_STAGE(PG8_SB(0, 1), cB + hstep, voffB); PG8_STAGE(PG8_SA(0, 0), cA, voffA); PG8_STAGE(PG8_SA(0, 1), cA + hstepA, voffA);
        if (wr == 1) PG8_BAR;
        PG8_WAIT_V(2); PG8_BAR;
        PG8_STAGE(PG8_SB(1, 0), cB + kstep, voffB); PG8_STAGE(PG8_SA(1, 0), cA + kstep, voffA); PG8_STAGE(PG8_SB(1, 1), cB + hstep + kstep, voffB);
        PG8_WAIT_V(6); PG8_BAR;
    } else {
        PG8_STAGE(PG8_SB(0, 0), cB, voffB); PG8_STAGE(PG8_SA(0, 0), cA, voffA); PG8_STAGE(PG8_SB(0, 1), cB + hstep, voffB); PG8_STAGE(PG8_SA(0, 1), cA + hstepA, voffA);
        if (wr == 1) PG8_BAR;
        PG8_WAIT_V(4); PG8_BAR;
        PG8_STAGE(PG8_SB(1, 0), cB + kstep, voffB); PG8_STAGE(PG8_SA(1, 0), cA + kstep, voffA); PG8_STAGE(PG8_SB(1, 1), cB + hstep + kstep, voffB);
        PG8_WAIT_V(6); PG8_BAR;
    }
    for (;;) {
        const bool has_next = S.next(ui + 1, nxt);
        const char* nA = has_next ? (const char*)g.A + (size_t)nxt.pm * tstepA : cA; const char* nB = has_next ? (const char*)g.Bt + (size_t)nxt.pn * tstep : cB;
        for (int t = 0; t < nt; t += 2) {
            const bool last = (t == nt - 2);
            const char* a1 = cA + (size_t)(t + 1) * kstep;
            const char* a2 = last ? nA : cA + (size_t)(t + 2) * kstep; const char* b2 = last ? nB : cB + (size_t)(t + 2) * kstep;
            const char* a3 = a2 + kstep; const char* b3 = b2 + kstep;
            if (last && has_next) S.a_ready(nxt);
            if constexpr (SP2) {
            PG8_LDB(B0, 0, 0); PG8_LDB(B1, 0, 1); PG8_SCHED; PG8_LDA(At, 0, 0); PG8_STAGE(PG8_SA(1, 1), a1 + hstepA, voffA);
            PG8_WAIT_V(8); PG8_WAIT_L(0); PG8_BAR; PG8_MMA(0, 0, At, B0); PG8_MMA(0, 1, At, B1); PG8_BAR; PG8_SCHED;
            PG8_LDA(At, 0, 1); PG8_STAGE(PG8_SB(0, 0), b2, voffB); PG8_STAGE(PG8_SB(0, 1), b2 + hstep, voffB); PG8_STAGE(PG8_SA(0, 0), a2, voffA);
            PG8_WAIT_V(8); PG8_WAIT_L(0); PG8_BAR; PG8_MMA(1, 0, At, B0); PG8_MMA(1, 1, At, B1); PG8_BAR; PG8_SCHED;
            PG8_LDB(B0, 1, 0); PG8_LDB(B1, 1, 1); PG8_SCHED; PG8_LDA(At, 1, 0); PG8_STAGE(PG8_SA(0, 1), a2 + hstepA, voffA);
            PG8_WAIT_V(8); PG8_WAIT_L(0); PG8_BAR; PG8_MMA(0, 0, At, B0); PG8_MMA(0, 1, At, B1); PG8_BAR; PG8_SCHED;
            PG8_LDA(At, 1, 1); PG8_STAGE(PG8_SB(1, 0), b3, voffB); PG8_STAGE(PG8_SB(1, 1), b3 + hstep, voffB); PG8_STAGE(PG8_SA(1, 0), a3, voffA);
            PG8_WAIT_V(8); PG8_WAIT_L(0); PG8_BAR; PG8_MMA(1, 0, At, B0); PG8_MMA(1, 1, At, B1); PG8_BAR; PG8_SCHED;
            } else {
            PG8_LDB(B0, 0, 0); PG8_SCHED; PG8_LDA(At, 0, 0); PG8_STAGE(PG8_SA(1, 1), a1 + hstepA, voffA);
            PG8_WAIT_L(8); PG8_BAR; PG8_WAIT_L(0); PG8_MMA(0, 0, At, B0); PG8_BAR; PG8_SCHED;
            PG8_LDB(B1, 0, 1); PG8_STAGE(PG8_SB(0, 0), b2, voffB);
            PG8_BAR; PG8_WAIT_L(0); PG8_MMA(0, 1, At, B1); PG8_BAR;
            PG8_LDA(At, 0, 1); PG8_STAGE(PG8_SA(0, 0), a2, voffA);
            PG8_BAR; PG8_WAIT_L(0); PG8_MMA(1, 0, At, B0); PG8_BAR; PG8_SCHED;
            PG8_STAGE(PG8_SB(0, 1), b2 + hstep, voffB);
            PG8_WAIT_V(6); PG8_BAR; PG8_MMA(1, 1, At, B1); PG8_BAR;
            PG8_LDB(B0, 1, 0); PG8_SCHED; PG8_LDA(At, 1, 0); PG8_STAGE(PG8_SA(0, 1), a2 + hstepA, voffA);
            PG8_WAIT_L(8); PG8_BAR; PG8_WAIT_L(0); PG8_MMA(0, 0, At, B0); PG8_BAR; PG8_SCHED;
            PG8_LDB(B1, 1, 1); PG8_STAGE(PG8_SB(1, 0), b3, voffB);
            PG8_BAR; PG8_WAIT_L(0); PG8_MMA(0, 1, At, B1); PG8_BAR;
            PG8_LDA(At, 1, 1); PG8_STAGE(PG8_SA(1, 0), a3, voffA);
            PG8_BAR; PG8_WAIT_L(0); PG8_MMA(1, 0, At, B0); PG8_BAR; PG8_SCHED;
            PG8_STAGE(PG8_SB(1, 1), b3 + hstep, voffB);
            PG8_WAIT_V(6); PG8_BAR; PG8_MMA(1, 1, At, B1); PG8_BAR;
            }
        }
        if constexpr (ALIGN_EPI) { if (wr == 0) PG8_BAR; }
        if constexpr (!Epi::AFTER_DRAIN) { E(acc, cur, wr, wc, fr, fq); S.done(cur); }
        if (!has_next) break;
#pragma unroll
        for (int a = 0; a < 2; ++a)
#pragma unroll
            for (int b = 0; b < 2; ++b)
#pragma unroll
                for (int m = 0; m < 4; ++m)
#pragma unroll
                    for (int n = 0; n < 2; ++n) acc[a][b][m][n] = (f32x4){0.f, 0.f, 0.f, 0.f};
        cur = nxt; cA = nA; cB = nB; ++ui;
        if constexpr (ALIGN_EPI) { if (wr == 1) PG8_BAR; }
    }
    PG8_WAIT_V(0);
    if constexpr (!ALIGN_EPI) { if (wr == 0) PG8_BAR; }
    PG8_BAR;
    if constexpr (Epi::AFTER_DRAIN) { E.fused(acc, cur, wr, wc, fr, fq, lds, wid, lane); S.done(cur); }
#undef PG8_SA
#undef PG8_SB
#undef PG8_STAGE
#undef PG8_LDA
#undef PG8_LDB
#undef PG8_MMA
#undef PG8_WAIT_V
#undef PG8_WAIT_L
#undef PG8_BAR
#undef PG8_SCHED
}
}

#define LAS __attribute__((address_space(3)))
using pg8::bf16_t; using pg8::bf16x8; using pg8::f32x4; using pg8::u32x4;
typedef float f32x16 __attribute__((ext_vector_type(16)));
typedef unsigned u32x2 __attribute__((ext_vector_type(2)));
typedef unsigned char uchar;
typedef float f32x2_t __attribute__((ext_vector_type(2)));
typedef __bf16 bf16x2_t __attribute__((ext_vector_type(2)));

constexpr int DM = 1024, NBATCH = 16, SEQ = 4096, DEPTH = 4, PLE = 256, DFF = 2816;
constexpr int T = NBATCH * SEQ;
constexpr int NB = 8, TC = NB * SEQ, NCHUNK = NBATCH / NB;
constexpr int DIN = 6680, DINP = 6912;
constexpr float EPS = 1e-6f, LOG2E = 1.4426950408889634f;
constexpr int NTHR = 512;

constexpr size_t W_WI1 = 0, W_WO1 = W_WI1 + (size_t)5632 * 1024, W_WIN = W_WO1 + (size_t)1024 * 2816, W_CW1 = W_WIN + (size_t)DINP * 1024,
                 W_CW2 = W_CW1 + (size_t)2 * 256 * 2048, W_WBR = W_CW2 + (size_t)2 * 256 * 256, W_WOUT = W_WBR + (size_t)3 * 1024 * 512,
                 W_WI2 = W_WOUT + (size_t)1024 * 1024, W_WO2 = W_WI2 + (size_t)5632 * 1024, W_WPE = W_WO2 + (size_t)1024 * 2816,
                 W_WPG = W_WPE + (size_t)1024 * 256, W_LAYER = W_WPG + (size_t)1024 * 1024;
static_assert(W_LAYER == 29491200, "weights");
constexpr size_t MiB = 1u << 20;
constexpr size_t WS_W = 0, WS_XN = 226 * MiB, WS_R1 = 354 * MiB, WS_Y = 782 * MiB, WS_MG = 878 * MiB, WS_CH = 942 * MiB, WS_KCMP = 946 * MiB,
                 WS_VCMP = WS_KCMP + MiB / 2, WS_CB = 947 * MiB, WS_SSQ = 948 * MiB, WS_SSQ2 = 952 * MiB, WS_CTL = 956 * MiB, WS_END = 957 * MiB;
constexpr size_t CTL_ZERO_BYTES = 65536;
constexpr size_t WS_XN2 = WS_Y, WS_PBF = WS_Y + 128 * MiB;
static_assert(W_LAYER * 2 * DEPTH <= WS_XN, "w");
constexpr size_t HS = 262144;
constexpr size_t ZQA = 0, ZKA = ZQA + NB * 8 * HS, ZVA = ZKA + NB * 8 * HS, ZQB = ZVA + NB * 8 * HS, ZKCI = ZQB + NB * 8 * HS, ZVCI = ZKCI + NB * 2 * HS,
                 ZKS = ZVCI + NB * 2 * HS, ZVS = ZKS + NB * 2 * HS, ZKW = ZVS + NB * 2 * HS, ZVW = ZKW + NB * 2 * HS, ZQC = ZVW + NB * 2 * HS,
                 ZKC = ZQC + NB * 8 * HS, ZVC = ZKC + NB * 2 * HS, ZSG = ZVC + NB * 2 * HS, ZBG = ZSG + (size_t)TC * 3072, ZEND = ZBG + (size_t)TC * 32 * 2;
static_assert(ZEND * 2 <= 428 * MiB, "zbuf");
static_assert((size_t)T * DFF * 2 <= 428 * MiB, "act");
constexpr size_t R1_E = 0;

struct Params {
    const float* in[20];
    float* out;
    uchar* ws;
};

__device__ __forceinline__ unsigned cvtpk(float lo, float hi) { f32x2_t v = {lo, hi}; bf16x2_t b = __builtin_convertvector(v, bf16x2_t); return __builtin_bit_cast(unsigned, b); }
__device__ __forceinline__ bf16_t cvt1(float x) { return (bf16_t)(cvtpk(x, 0.f) & 0xffffu); }
__device__ __forceinline__ float bf2f(unsigned short b) { return __uint_as_float((unsigned)b << 16); }
__device__ __forceinline__ float wave_sum(float v) {
#pragma unroll
    for (int o = 1; o < 64; o <<= 1) v += __shfl_xor(v, o);
    return v;
}
__device__ __forceinline__ int opq(int v) { asm volatile("" : "+v"(v)); return v; }
__device__ __forceinline__ float sigm(float x) { return __builtin_amdgcn_rcpf(1.f + __builtin_amdgcn_exp2f(-x * LOG2E)); }
__device__ __forceinline__ float gelu_tanh(float x) { const float u = 0.7978845608028654f * (x + 0.044715f * x * x * x); const float e = __builtin_amdgcn_exp2f(-2.f * LOG2E * u); const float th = 2.f * __builtin_amdgcn_rcpf(1.f + e) - 1.f; return 0.5f * x * (1.f + th); }

typedef const __attribute__((address_space(4))) Params* KParPtr;
__device__ __forceinline__ KParPtr kparams() { auto p = __builtin_amdgcn_kernarg_segment_ptr(); asm volatile("" : "+s"(p)); return (KParPtr)p; }
#ifndef ALIGN_T
#define ALIGN_T false
#endif
#ifndef ALIGN_F
#define ALIGN_F true
#endif
#ifndef ALIGN_SW
#define ALIGN_SW true
#endif
#ifndef ALIGN_BR
#define ALIGN_BR true
#endif
#ifndef ALIGN_Z
#define ALIGN_Z true
#endif
__device__ __forceinline__ float row_rstd(const float* ssq, int row) {
    const f32x4* p = (const f32x4*)(ssq + (size_t)row * 16); const f32x4 a = p[0], b = p[1], c = p[2], d = p[3];
    const float sm = (((a[0] + a[1]) + (a[2] + a[3])) + ((b[0] + b[1]) + (b[2] + b[3]))) + (((c[0] + c[1]) + (c[2] + c[3])) + ((d[0] + d[1]) + (d[2] + d[3])));
    return 1.0f / sqrtf(sm * (1.f / 1024.f) + 1e-6f);
}
typedef const pg8::f32x4 (&AccRef)[2][2][4][2];
__device__ __forceinline__ void wave_rstd(const float* ssq, int rowbase, float (&rsl)[2]) {
    const int lane = threadIdx.x & 63;
    rsl[0] = row_rstd(ssq, rowbase + lane); rsl[1] = row_rstd(ssq, rowbase + 128 + lane);
}
struct EpiSwiglu {
    static constexpr bool PERM = true, AFTER_DRAIN = false, ALIGN = ALIGN_SW;
    bf16_t* O; const float* ssq;
    __device__ __forceinline__ void operator()(AccRef acc, const pg8::Unit& u, int wr, int wc, int fr, int fq) const {
        asm volatile("" : "+v"(fr), "+v"(fq));
        const int row0 = u.pm * 256 + wr * 64 + fr, col0 = u.pn * 128 + wc * 32 + 8 * fq;
        float rsl[2]; wave_rstd(ssq, u.pm * 256 + wr * 64, rsl);
#pragma unroll
        for (int ai = 0; ai < 2; ++ai)
#pragma unroll
            for (int m = 0; m < 4; ++m) {
                bf16_t* rp = O + (size_t)(row0 + ai * 128 + m * 16) * DFF + col0;
                const float rs = __shfl(rsl[ai], 16 * m + fr);
                float o[8];
#pragma unroll
                for (int n = 0; n < 2; ++n)
#pragma unroll
                    for (int e = 0; e < 4; ++e) { const float g = acc[ai][0][m][n][e] * rs, up = acc[ai][1][m][n][e] * rs; o[n * 4 + e] = g * sigm(g) * up; }
                u32x4 w; w.x = cvtpk(o[0], o[1]); w.y = cvtpk(o[2], o[3]); w.z = cvtpk(o[4], o[5]); w.w = cvtpk(o[6], o[7]);
                *(u32x4*)rp = w;
            }
    }
};
struct EpiResid {
    static constexpr bool PERM = false, AFTER_DRAIN = false, ALIGN = ALIGN_F;
    float alpha; int row_off; int hsrc;
    __device__ __forceinline__ void operator()(AccRef acc, const pg8::Unit& u, int wr, int wc, int fr, int fq) const {
        asm volatile("" : "+v"(fr), "+v"(fq));
        const int row0 = row_off + u.pm * 256 + wr * 64 + fr, col0 = u.pn * 256 + wc * 32 + 4 * fq;
        const float* xin = kparams()->in[0];
        uchar* wsb = kparams()->ws; bf16_t* hb = (bf16_t*)(wsb + WS_XN); float* ssq = (float*)(wsb + WS_SSQ);
        const bf16_t* hin = (const bf16_t*)(wsb + (hsrc == 1 ? WS_XN2 : WS_XN));
#pragma unroll
        for (int ai = 0; ai < 2; ++ai)
#pragma unroll
            for (int m = 0; m < 4; ++m) {
                const size_t off = (size_t)(row0 + ai * 128 + m * 16) * DM + col0;
                float sq = 0.f;
#pragma unroll
                for (int bj = 0; bj < 2; ++bj)
#pragma unroll
                    for (int n = 0; n < 2; ++n) { f32x4 b;
                        if (hsrc == 0) b = *(const f32x4*)(xin + off + bj * 128 + n * 16);
                        else { const u32x2 hv = *(const u32x2*)(hin + off + bj * 128 + n * 16); b = (f32x4){__uint_as_float(hv.x << 16), __uint_as_float(hv.x & 0xffff0000u), __uint_as_float(hv.y << 16), __uint_as_float(hv.y & 0xffff0000u)}; }
                        const f32x4 v = b + acc[ai][bj][m][n] * alpha;
                        u32x2 w; w.x = cvtpk(v[0], v[1]); w.y = cvtpk(v[2], v[3]); *(u32x2*)(hb + off + bj * 128 + n * 16) = w; sq += (v[0] * v[0] + v[1] * v[1]) + (v[2] * v[2] + v[3] * v[3]); }
                sq += __shfl_xor(sq, 16); sq += __shfl_xor(sq, 32);
                if (fq == 0) ssq[(size_t)(row0 + ai * 128 + m * 16) * 16 + u.pn * 4 + wc] = sq;

            }
    }
};
struct EpiPle {
    static constexpr bool PERM = false, AFTER_DRAIN = false, ALIGN = ALIGN_F;
    const bf16_t* hin; const bf16_t* E; const float* ssq_in; bf16_t* hb; float* ssq_out;
    __device__ __forceinline__ void operator()(AccRef acc, const pg8::Unit& u, int wr, int wc, int fr, int fq) const {
        asm volatile("" : "+v"(fr), "+v"(fq));
        const int row0 = u.pm * 256 + wr * 64 + fr, col0 = u.pn * 256 + wc * 32 + 4 * fq;
        float rsl[2]; wave_rstd(ssq_in, u.pm * 256 + wr * 64, rsl);
#pragma unroll
        for (int ai = 0; ai < 2; ++ai)
#pragma unroll
            for (int m = 0; m < 4; ++m) {
                const size_t off = (size_t)(row0 + ai * 128 + m * 16) * DM + col0;
                const float rs = __shfl(rsl[ai], 16 * m + fr);
                float sq = 0.f;
#pragma unroll
                for (int bj = 0; bj < 2; ++bj)
#pragma unroll
                    for (int n = 0; n < 2; ++n) {
                        const size_t o2 = off + bj * 128 + n * 16;
                        const u32x2 ev = *(const u32x2*)(E + o2); const u32x2 hv = *(const u32x2*)(hin + o2); f32x4 b = (f32x4){__uint_as_float(hv.x << 16), __uint_as_float(hv.x & 0xffff0000u), __uint_as_float(hv.y << 16), __uint_as_float(hv.y & 0xffff0000u)}; const f32x4 a = acc[ai][bj][m][n];
                        b[0] += sigm(a[0] * rs) * __uint_as_float(ev.x << 16); b[1] += sigm(a[1] * rs) * __uint_as_float(ev.x & 0xffff0000u);
                        b[2] += sigm(a[2] * rs) * __uint_as_float(ev.y << 16); b[3] += sigm(a[3] * rs) * __uint_as_float(ev.y & 0xffff0000u);
                        u32x2 w; w.x = cvtpk(b[0], b[1]); w.y = cvtpk(b[2], b[3]); *(u32x2*)(hb + o2) = w; sq += (b[0] * b[0] + b[1] * b[1]) + (b[2] * b[2] + b[3] * b[3]);
                    }
                sq += __shfl_xor(sq, 16); sq += __shfl_xor(sq, 32);
                if (fq == 0) ssq_out[(size_t)(row0 + ai * 128 + m * 16) * 16 + u.pn * 4 + wc] = sq;

            }
    }
};
template <int MODE> struct EpiBf {
    static constexpr bool PERM = true, AFTER_DRAIN = false, ALIGN = ALIGN_T;
    bf16_t* O; int ldc; const float* bias;
    __device__ __forceinline__ void operator()(AccRef acc, const pg8::Unit& u, int wr, int wc, int fr, int fq) const {
        asm volatile("" : "+v"(fr), "+v"(fq));
        const int row0 = u.pm * 256 + wr * 64 + fr, col0 = u.pn * 256 + wc * 32 + 8 * fq;
#pragma unroll
        for (int bj = 0; bj < 2; ++bj) {
            float bv[8];
#pragma unroll
            for (int e = 0; e < 8; ++e) bv[e] = MODE == 1 ? bias[col0 + bj * 128 + e] : 0.f;
#pragma unroll
            for (int ai = 0; ai < 2; ++ai)
#pragma unroll
                for (int m = 0; m < 4; ++m) {
                    float o[8];
#pragma unroll
                    for (int n = 0; n < 2; ++n)
#pragma unroll
                        for (int e = 0; e < 4; ++e) { float v = acc[ai][bj][m][n][e] + bv[n * 4 + e]; if (MODE == 1) v = gelu_tanh(v); o[n * 4 + e] = v; }
                    u32x4 w; w.x = cvtpk(o[0], o[1]); w.y = cvtpk(o[2], o[3]); w.z = cvtpk(o[4], o[5]); w.w = cvtpk(o[6], o[7]);
                    *(u32x4*)(O + (size_t)(row0 + ai * 128 + m * 16) * ldc + col0 + bj * 128) = w;
                }
        }
    }
};
template <bool VT> struct EpiCmp2 {
    static constexpr bool PERM = true, AFTER_DRAIN = false, ALIGN = ALIGN_T;
    bf16_t* O;
    __device__ __forceinline__ void operator()(AccRef acc, const pg8::Unit& u, int wr, int wc, int fr, int fq) const {
        asm volatile("" : "+v"(fr), "+v"(fq));
        if (u.pn != 0 || wc >= 2) return;
        const int row0 = u.pm * 256 + wr * 64 + fr, d0 = wc * 32 + 8 * fq;
#pragma unroll
        for (int ai = 0; ai < 2; ++ai)
#pragma unroll
            for (int m = 0; m < 4; ++m) {
                const int row = row0 + ai * 128 + m * 16, bg = row >> 8, n = row & 255;
                float o[8];
#pragma unroll
                for (int nn = 0; nn < 2; ++nn)
#pragma unroll
                    for (int e = 0; e < 4; ++e) o[nn * 4 + e] = (n == 255) ? 0.f : acc[ai][0][m][nn][e];
                if (!VT) { u32x4 w; w.x = cvtpk(o[0], o[1]); w.y = cvtpk(o[2], o[3]); w.z = cvtpk(o[4], o[5]); w.w = cvtpk(o[6], o[7]); *(u32x4*)(O + (size_t)row * 64 + d0) = w; }
                else {
#pragma unroll
                    for (int e = 0; e < 8; ++e) O[((size_t)bg * 64 + d0 + e) * 256 + n] = cvt1(o[e]);
                }
            }
    }
};
struct EpiBranch {
    static constexpr bool PERM = true, AFTER_DRAIN = false, ALIGN = ALIGN_BR;
    bf16_t* mg; const bf16_t* sg; int mi;
    __device__ __forceinline__ void operator()(AccRef acc, const pg8::Unit& u, int wr, int wc, int fr, int fq) const {
        asm volatile("" : "+v"(fr), "+v"(fq));
        const int row0 = u.pm * 256 + wr * 64 + fr, col0 = u.pn * 256 + wc * 32 + 8 * fq;
#pragma unroll
        for (int ai = 0; ai < 2; ++ai)
#pragma unroll
            for (int m = 0; m < 4; ++m) {
                const int row = row0 + ai * 128 + m * 16;
#pragma unroll
                for (int bj = 0; bj < 2; ++bj) {
                    const int col = col0 + bj * 128;
                    const u32x2 gv = *(const u32x2*)((const uchar*)sg + (size_t)row * 3072 + mi * 1024 + col);
                    u32x4 ov = (u32x4){0u, 0u, 0u, 0u};
                    if (mi != 0) ov = *(const u32x4*)(mg + (size_t)row * DM + col);
                    float o[8];
#pragma unroll
                    for (int q = 0; q < 4; ++q) {
                        const unsigned oq = ov[q], gw2 = (q < 2 ? gv.x : gv.y) >> ((q & 1) * 16);
                        const float g0 = (float)(gw2 & 255u) * (1.f / 255.f), g1 = (float)((gw2 >> 8) & 255u) * (1.f / 255.f);
                        const float a0 = acc[ai][bj][m][q >> 1][(q & 1) * 2], a1 = acc[ai][bj][m][q >> 1][(q & 1) * 2 + 1];
                        o[2 * q] = __uint_as_float(oq << 16) + g0 * a0;
                        o[2 * q + 1] = __uint_as_float(oq & 0xffff0000u) + g1 * a1;
                    }
                    u32x4 w; w.x = cvtpk(o[0], o[1]); w.y = cvtpk(o[2], o[3]); w.z = cvtpk(o[4], o[5]); w.w = cvtpk(o[6], o[7]);
                    *(u32x4*)(mg + (size_t)row * DM + col) = w;
                }

            }
    }
};
struct EpiZ {
    static constexpr bool PERM = true, AFTER_DRAIN = false, ALIGN = ALIGN_Z;
    bf16_t* zb; const float* ssq; int pn_off;
    __device__ __forceinline__ void operator()(AccRef acc, const pg8::Unit& u, int wr, int wc, int fr, int fq) const {
        asm volatile("" : "+v"(fr), "+v"(fq));
        const int pn = u.pn + pn_off;
        float rsl[2]; wave_rstd(ssq, u.pm * 256 + wr * 64, rsl);
#pragma unroll
        for (int bj = 0; bj < 2; ++bj) {
            const int ch = 2 * bj + (wc >> 1), d0 = (wc & 1) * 32 + 8 * fq;
            size_t off = 0, bs = 8 * HS; int mode = 0;
            if (pn < 2) { off = ZQA + (size_t)(pn * 4 + ch) * HS; }
            else if (pn < 4) { off = ZKA + (size_t)((pn - 2) * 4 + ch) * HS; }
            else if (pn < 6) { off = ZVA + (size_t)((pn - 4) * 4 + ch) * HS; mode = 1; }
            else if (pn < 8) { off = ZQB + (size_t)((pn - 6) * 4 + ch) * HS; }
            else if (pn == 8) { bs = 2 * HS; off = (ch < 2) ? ZKCI + (size_t)ch * HS : ZVCI + (size_t)(ch - 2) * HS; }
            else if (pn == 9) { bs = 2 * HS; if (ch < 2) off = ZKS + (size_t)ch * HS; else { off = ZVS + (size_t)(ch - 2) * HS; mode = 1; } }
            else if (pn == 10) { bs = 2 * HS; if (ch < 2) off = ZKW + (size_t)ch * HS; else { off = ZVW + (size_t)(ch - 2) * HS; mode = 1; } }
            else if (pn < 13) { off = ZQC + (size_t)((pn - 11) * 4 + ch) * HS; }
            else if (pn == 13) { bs = 2 * HS; if (ch < 2) off = ZKC + (size_t)ch * HS; else { off = ZVC + (size_t)(ch - 2) * HS; mode = 1; } }
            else if (pn < 26) mode = 2;
            else mode = 3;
#pragma unroll
            for (int ai = 0; ai < 2; ++ai)
#pragma unroll
                for (int m = 0; m < 4; ++m) {
                    const int tl = u.pm * 256 + ai * 128 + wr * 64 + m * 16 + fr, bl = tl >> 12, s = tl & 4095;
                    const float rs = __shfl(rsl[ai], 16 * m + fr);
                    float o[8];
#pragma unroll
                    for (int n = 0; n < 2; ++n)
#pragma unroll
                        for (int e = 0; e < 4; ++e) o[n * 4 + e] = acc[ai][bj][m][n][e] * rs;
                    if (mode == 0) {
                        u32x4 w; w.x = cvtpk(o[0], o[1]); w.y = cvtpk(o[2], o[3]); w.z = cvtpk(o[4], o[5]); w.w = cvtpk(o[6], o[7]);
                        *(u32x4*)(zb + off + (size_t)bl * bs + (size_t)s * 64 + d0) = w;
                    } else if (mode == 1) {
                        bf16_t* p = zb + off + (size_t)bl * bs + (size_t)d0 * 4096 + s;
#pragma unroll
                        for (int e = 0; e < 8; ++e) p[(size_t)e * 4096] = cvt1(o[e]);
                    } else if (mode == 2) {
                        unsigned qb[8];
#pragma unroll
                        for (int e = 0; e < 8; ++e) qb[e] = (unsigned)(sigm(o[e]) * 255.f + 0.5f);
                        u32x2 w; w.x = qb[0] | (qb[1] << 8) | (qb[2] << 16) | (qb[3] << 24); w.y = qb[4] | (qb[5] << 8) | (qb[6] << 16) | (qb[7] << 24);
                        *(u32x2*)((uchar*)(zb + ZSG) + (size_t)tl * 3072 + (pn - 14) * 256 + bj * 128 + wc * 32 + 8 * fq) = w;
                    } else {
                        const int cc = bj * 128 + wc * 32 + 8 * fq;
                        if (cc < 24) {
                            float* bgp = (float*)(zb + ZBG) + (size_t)tl * 32 + cc;
                            *(f32x4*)bgp = (f32x4){sigm(o[0]), sigm(o[1]), sigm(o[2]), sigm(o[3])};
                            *(f32x4*)(bgp + 4) = (f32x4){sigm(o[4]), sigm(o[5]), sigm(o[6]), sigm(o[7])};
                        }
                    }
                }
        }
    }
};

__device__ __forceinline__ void rms_row_bf16(const float* xrow, const float* g, bf16_t* orow, int lane) {
    const f32x4* xr = (const f32x4*)xrow + lane; f32x4 v[4]; float s = 0.f;
#pragma unroll
    for (int j = 0; j < 4; ++j) { v[j] = xr[64 * j]; s += (v[j][0] * v[j][0] + v[j][1] * v[j][1]) + (v[j][2] * v[j][2] + v[j][3] * v[j][3]); }
    const float rstd = 1.0f / sqrtf(wave_sum(s) * (1.f / DM) + EPS);
    u32x2* o8 = (u32x2*)orow + lane;
#pragma unroll
    for (int j = 0; j < 4; ++j) { const f32x4 gg = ((const f32x4*)g)[lane + 64 * j]; u32x2 w; w.x = cvtpk(v[j][0] * rstd * gg[0], v[j][1] * rstd * gg[1]); w.y = cvtpk(v[j][2] * rstd * gg[2], v[j][3] * rstd * gg[3]); o8[64 * j] = w; }
}
__device__ __forceinline__ void rms_row_f32(const float* xrow, const float* g, float* orow, int lane) {
    const f32x4* xr = (const f32x4*)xrow + lane; f32x4 v[4]; float s = 0.f;
#pragma unroll
    for (int j = 0; j < 4; ++j) { v[j] = xr[64 * j]; s += (v[j][0] * v[j][0] + v[j][1] * v[j][1]) + (v[j][2] * v[j][2] + v[j][3] * v[j][3]); }
    const float rstd = 1.0f / sqrtf(wave_sum(s) * (1.f / DM) + EPS);
#pragma unroll
    for (int j = 0; j < 4; ++j) { const f32x4 gg = ((const f32x4*)g)[lane + 64 * j]; ((f32x4*)orow)[lane + 64 * j] = (v[j] * rstd) * gg; }
}
__device__ __forceinline__ void rms_row_bf16in_f32(const bf16_t* xrow, const float* g, float* orow, int lane) {
    const u32x2* xr = (const u32x2*)xrow + lane; f32x4 v[4]; float s = 0.f;
#pragma unroll
    for (int j = 0; j < 4; ++j) { const u32x2 hv = xr[64 * j]; v[j] = (f32x4){__uint_as_float(hv.x << 16), __uint_as_float(hv.x & 0xffff0000u), __uint_as_float(hv.y << 16), __uint_as_float(hv.y & 0xffff0000u)};
        s += (v[j][0] * v[j][0] + v[j][1] * v[j][1]) + (v[j][2] * v[j][2] + v[j][3] * v[j][3]); }
    const float rstd = 1.0f / sqrtf(wave_sum(s) * (1.f / DM) + EPS);
#pragma unroll
    for (int j = 0; j < 4; ++j) { const f32x4 gg = ((const f32x4*)g)[lane + 64 * j]; ((f32x4*)orow)[lane + 64 * j] = (v[j] * rstd) * gg; }
}
__device__ __forceinline__ void phase_prep(const float* src, bf16_t* dst, float* ssq, int gw, int ngw, int lane) {
    lane = opq(lane);
    for (int m = gw; m < T; m += ngw) {
        const f32x4* xr = (const f32x4*)(src + (size_t)m * DM) + lane; u32x2* o8 = (u32x2*)(dst + (size_t)m * DM) + lane; float s = 0.f;
#pragma unroll
        for (int j = 0; j < 4; ++j) { const f32x4 v = xr[64 * j]; s += (v[0] * v[0] + v[1] * v[1]) + (v[2] * v[2] + v[3] * v[3]); u32x2 w; w.x = cvtpk(v[0], v[1]); w.y = cvtpk(v[2], v[3]); o8[64 * j] = w; }
        s = wave_sum(s);
        if (lane < 16) ssq[(size_t)m * 16 + lane] = lane == 0 ? s : 0.f;
    }
}
__device__ __forceinline__ void phase_rms(const float* src, const float* g, bf16_t* dst, int gw, int ngw, int lane) {
    lane = opq(lane);
    for (int m = gw; m < T; m += ngw) rms_row_bf16(src + (size_t)m * DM, g, dst + (size_t)m * DM, lane);
}

__device__ __forceinline__ int srccol(int mode, int n) {
    if (mode == 0) return n;
    if (mode == 1) return ((n >> 7) & 1) * DFF + (n >> 8) * 128 + (n & 127);
    if (mode == 2) return n < 2816 ? n : (n < 6656 ? n + 24 : (n < 6680 ? 2816 + (n - 6656) : -1));
    return n < 64 ? n : -1;
}
__device__ __forceinline__ void conv_matrix(const float* src, int K, int ld, int Ndst, int mode, bf16_t* dst, int& base, LAS float* scr, int tid, int blk, int G, const float* gk = nullptr) {
    tid = opq(tid);
    const int ntn = Ndst / 64, ntiles = (K / 128) * ntn;
    int start = (blk - (base % G) + G) % G;
    for (int t = start; t < ntiles; t += G) {
        const int k0 = (t / ntn) * 128, n0 = (t % ntn) * 64;
        { const int kr = tid >> 6, n = tid & 63; const int col = srccol(mode, n0 + n);
          float v[16];
#pragma unroll
          for (int kk = 0; kk < 16; ++kk) { const int k = kr + 8 * kk; v[kk] = col >= 0 ? src[(size_t)(k0 + k) * ld + col] : 0.f; }
#pragma unroll
          for (int kk = 0; kk < 16; ++kk) { const int k = kr + 8 * kk; scr[k * 65 + n] = gk ? v[kk] * gk[k0 + k] : v[kk]; } }
        __syncthreads();
        { const int n = tid >> 3, ks = tid & 7;
#pragma unroll
          for (int h2 = 0; h2 < 2; ++h2) { const LAS float* sp = scr + (64 * h2 + 8 * ks) * 65 + n;
            u32x4 w; w.x = cvtpk(sp[0], sp[65]); w.y = cvtpk(sp[130], sp[195]); w.z = cvtpk(sp[260], sp[325]); w.w = cvtpk(sp[390], sp[455]);
            *(u32x4*)(dst + (size_t)(n0 + n) * K + k0 + 64 * h2 + 8 * ks) = w; } }
        __syncthreads();
    }
    base += ntiles;
}

constexpr int KP = 144;
constexpr int VP = 144;
constexpr int L_K0 = 0, L_K1 = 9216, L_V0 = 18432, L_V1 = 36864, L_TBL = 55296, L_IMP = 57344, L_SEL = 73984, L_RED = 74496;
constexpr float SC = 0.125f * LOG2E;
constexpr float MINIT = -10000.f, MASKED = -1e30f;

__device__ __forceinline__ int t5_bucket(int n) {
    if (n < 16) return n;
    int b = 16;
    b += (n >= 19); b += (n >= 21); b += (n >= 24); b += (n >= 27); b += (n >= 31); b += (n >= 35); b += (n >= 40); b += (n >= 46);
    b += (n >= 52); b += (n >= 59); b += (n >= 67); b += (n >= 77); b += (n >= 87); b += (n >= 99); b += (n >= 113);
    return b;
}
__device__ __forceinline__ void build_tbl(LAS uchar* lds, const float* rel_bias, int col0, int nh, int tid) {
    const int hd = tid >> 7, idx = tid & 127;
    if (hd < nh && idx < 114) ((LAS float*)(lds + L_TBL))[hd * 128 + idx] = rel_bias[t5_bucket(idx) * 20 + col0 + hd] * LOG2E;
}

template <int DV> struct TileRegs { u32x4 k; u32x4 v[DV / 64]; };
template <int DV, bool HASV>
__device__ __forceinline__ void tile_gload(TileRegs<DV>& r, const bf16_t* Kg, const bf16_t* Vt, int vpitch, int kt, int tid) {
    const int row = tid >> 3, seg = tid & 7;
    r.k = *(const u32x4*)(Kg + (size_t)(kt * 64 + row) * 64 + seg * 8);
    if (HASV) {
#pragma unroll
        for (int j = 0; j < DV / 64; ++j) r.v[j] = *(const u32x4*)(Vt + (size_t)(row + 64 * j) * vpitch + kt * 64 + seg * 8);
    }
}
template <int DV, bool HASV>
__device__ __forceinline__ void tile_swrite(const TileRegs<DV>& r, LAS uchar* lds, int buf, int tid) {
    const int row = tid >> 3, seg = tid & 7;
    *(LAS u32x4*)(lds + (buf ? L_K1 : L_K0) + row * KP + seg * 16) = r.k;
    if (HASV) {
#pragma unroll
        for (int j = 0; j < DV / 64; ++j) { LAS uchar* p = lds + (buf ? L_V1 : L_V0) + (row + 64 * j) * VP + (seg >> 1) * 32 + (seg & 1) * 8; *(LAS u32x2*)p = (u32x2){r.v[j].x, r.v[j].y}; *(LAS u32x2*)(p + 16) = (u32x2){r.v[j].z, r.v[j].w}; }
    }
}

template <int DV, bool IMPP>
__device__ __forceinline__ void attn_pass(LAS uchar* lds, const bf16_t* Kg, const bf16_t* Vt, int vpitch, int kt0, int kt1, int wave_kt_max,
                                          int qpos, int qmin_w, int qmax_w, int kmul, int kadd, unsigned W, bf16x8 (&q)[4], int tbl,
                                          unsigned long long selmask, bool use_sel, float& m, float& l, f32x16 (&acc)[DV / 32],
                                          float inv_l, int imp_row, float rel_far, int tid) {
    const int lane = tid & 63, n = lane & 31, hi = lane >> 5;
    TileRegs<DV> tr;
    if (kt0 >= kt1) return;
    float tfar = rel_far;
    asm volatile("s_waitcnt vmcnt(0)" ::: "memory");
    asm volatile("" : "+v"(q[0]), "+v"(q[1]), "+v"(q[2]), "+v"(q[3]), "+v"(tfar), "+v"(m), "+v"(l), "+v"(inv_l));
    tile_gload<DV, !IMPP>(tr, Kg, Vt, vpitch, kt0, tid);
    tile_swrite<DV, !IMPP>(tr, lds, 0, tid);
    __syncthreads();
    for (int kt = kt0; kt < kt1; ++kt) {
        const int cur = (kt - kt0) & 1;
        const bool more = kt + 1 < kt1;
        if (more) tile_gload<DV, !IMPP>(tr, Kg, Vt, vpitch, kt + 1, tid);
        if (kt <= wave_kt_max && (!use_sel || __builtin_amdgcn_ballot_w64((selmask >> kt) & 1ull) != 0ull)) {
            f32x16 s[2];
#pragma unroll
            for (int r = 0; r < 16; ++r) { s[0][r] = 0.f; s[1][r] = 0.f; }
            const LAS uchar* kb = lds + (cur ? L_K1 : L_K0) + n * KP + hi * 16;
#pragma unroll
            for (int ks = 0; ks < 4; ++ks) {
                const bf16x8 a0 = *(const LAS bf16x8*)(kb + ks * 32);
                const bf16x8 a1 = *(const LAS bf16x8*)(kb + 32 * KP + ks * 32);
                s[0] = __builtin_amdgcn_mfma_f32_32x32x16_bf16(a0, q[ks], s[0], 0, 0, 0);
                s[1] = __builtin_amdgcn_mfma_f32_32x32x16_bf16(a1, q[ks], s[1], 0, 0, 0);
            }
            const bool lane_ok = !use_sel || ((selmask >> kt) & 1ull);
            const bool fast = (qmin_w - (kmul * (64 * kt + 63) + kadd) >= 113) && ((unsigned)(qmax_w - (kmul * 64 * kt + kadd)) < W);
            if (fast) {
                const float cfar = lane_ok ? tfar - m : MASKED;
                const float scl = lane_ok ? SC : 0.f;
#pragma unroll
                for (int hh = 0; hh < 2; ++hh)
#pragma unroll
                    for (int r = 0; r < 16; ++r) s[hh][r] = s[hh][r] * scl + cfar;
            } else {
                int dq = qpos - kadd - kmul * (kt * 64 + 4 * hi);
                asm volatile("" : "+v"(dq));
                const unsigned Wl = lane_ok ? W : 0u;
                const LAS uchar* tb = lds + tbl;
#pragma unroll
                for (int hh = 0; hh < 2; ++hh)
#pragma unroll
                    for (int r = 0; r < 16; ++r) {
                        const int kk = 32 * hh + 8 * (r >> 2) + (r & 3);
                        const int dist = dq - kmul * kk;
                        const unsigned ud = (unsigned)dist;
                        const unsigned idx = ud < 113u ? ud : 113u;
                        const float bias = *(const LAS float*)(tb + idx * 4);
                        float v = s[hh][r] * SC + (bias - m);
                        v = (ud < Wl) ? v : MASKED;
                        s[hh][r] = v;
                    }
            }
            if (!IMPP) {
                float t0 = fmaxf(fmaxf(s[0][0], s[0][1]), s[0][2]), t1 = fmaxf(fmaxf(s[1][0], s[1][1]), s[1][2]);
#pragma unroll
                for (int r = 3; r < 15; r += 2) { t0 = fmaxf(fmaxf(t0, s[0][r]), s[0][r + 1]); t1 = fmaxf(fmaxf(t1, s[1][r]), s[1][r + 1]); }
                float tmax = fmaxf(fmaxf(t0, t1), fmaxf(s[0][15], s[1][15]));
                { auto rr = __builtin_amdgcn_permlane32_swap(__float_as_uint(tmax), __float_as_uint(tmax), false, false); tmax = fmaxf(__uint_as_float(rr[0]), __uint_as_float(rr[1])); }
                const bool need = tmax > 8.f;
                if (__builtin_amdgcn_ballot_w64(need) != 0ull) {
                    const float delta = need ? tmax : 0.f;
                    const float alpha = __builtin_amdgcn_exp2f(-delta);
                    m += delta; l *= alpha;
#pragma unroll
                    for (int dt = 0; dt < DV / 32; ++dt) acc[dt] = acc[dt] * alpha;
#pragma unroll
                    for (int hh = 0; hh < 2; ++hh)
#pragma unroll
                        for (int r = 0; r < 16; ++r) s[hh][r] -= delta;
                }
#pragma unroll
                for (int hh = 0; hh < 2; ++hh)
#pragma unroll
                    for (int r = 0; r < 16; ++r) s[hh][r] = __builtin_amdgcn_exp2f(s[hh][r]);
                f32x2_t ls2a = {0.f, 0.f}, ls2b = {0.f, 0.f};
#pragma unroll
                for (int r = 0; r < 16; r += 2) { ls2a += (f32x2_t){s[0][r], s[0][r + 1]}; ls2b += (f32x2_t){s[1][r], s[1][r + 1]}; }
                const float ls = (ls2a[0] + ls2a[1]) + (ls2b[0] + ls2b[1]);
                l += ls;
                const LAS uchar* vb = lds + (cur ? L_V1 : L_V0) + n * VP + hi * 16;
    #pragma unroll
                for (int hh = 0; hh < 2; ++hh)
#pragma unroll
                    for (int u2 = 0; u2 < 2; ++u2) {
                        u32x4 pw;
                        pw.x = cvtpk(s[hh][8 * u2 + 0], s[hh][8 * u2 + 1]); pw.y = cvtpk(s[hh][8 * u2 + 2], s[hh][8 * u2 + 3]);
                        pw.z = cvtpk(s[hh][8 * u2 + 4], s[hh][8 * u2 + 5]); pw.w = cvtpk(s[hh][8 * u2 + 6], s[hh][8 * u2 + 7]);
                        const bf16x8 pb = __builtin_bit_cast(bf16x8, pw);
                        const int kbase = 32 * hh + 16 * u2;
#pragma unroll
                        for (int dt = 0; dt < DV / 32; ++dt) {
                            const bf16x8 va = *(const LAS bf16x8*)(vb + dt * 32 * VP + kbase * 2);
                            acc[dt] = __builtin_amdgcn_mfma_f32_32x32x16_bf16(va, pb, acc[dt], 0, 0, 0);
                        }
                    }
                } else {
                LAS float* imp = (LAS float*)(lds + L_IMP) + imp_row * 65;
                float spill[8];
#pragma unroll
                for (int hh = 0; hh < 2; ++hh)
#pragma unroll
                    for (int gq = 0; gq < 4; ++gq) {
                        const float p0 = __builtin_amdgcn_exp2f(s[hh][4 * gq + 0]) * inv_l, p1 = __builtin_amdgcn_exp2f(s[hh][4 * gq + 1]) * inv_l;
                        const float p2 = __builtin_amdgcn_exp2f(s[hh][4 * gq + 2]) * inv_l, p3 = __builtin_amdgcn_exp2f(s[hh][4 * gq + 3]) * inv_l;
                        float mn = (p0 + p1) + (p2 + p3), sp = p3;
                        mn += __shfl_xor(mn, 8); mn += __shfl_xor(mn, 16);
                        sp += __shfl_xor(sp, 8); sp += __shfl_xor(sp, 16);
                        spill[hh * 4 + gq] = sp;
                        const int j = 16 * kt + 8 * hh + 2 * gq + hi;
                        if (n < 8) imp[j] += mn;
                    }
                __builtin_amdgcn_fence(__ATOMIC_RELEASE, "wavefront");
#pragma unroll
                for (int hh = 0; hh < 2; ++hh)
#pragma unroll
                    for (int gq = 0; gq < 4; ++gq) {
                        const int j = 16 * kt + 8 * hh + 2 * gq + hi + 1;
                        if (n < 8 && j < 64) imp[j] += spill[hh * 4 + gq];
                    }
                __builtin_amdgcn_fence(__ATOMIC_RELEASE, "wavefront");
            }
        }
        if (more) tile_swrite<DV, !IMPP>(tr, lds, cur ^ 1, tid);
        __syncthreads();
    }
}

template <int NT> __device__ __forceinline__ void acc_zero(f32x16 (&a)[NT]) {
#pragma unroll
    for (int t = 0; t < NT; ++t)
#pragma unroll
        for (int r = 0; r < 16; ++r) a[t][r] = 0.f;
}
template <int NT> __device__ __forceinline__ void acc_norm(f32x16 (&a)[NT], float l) {
    const float lt = l + __shfl_xor(l, 32);
    const float inv = lt > 0.f ? 1.f / lt : 0.f;
#pragma unroll
    for (int t = 0; t < NT; ++t)
#pragma unroll
        for (int r = 0; r < 16; ++r) a[t][r] *= inv;
}
__device__ __forceinline__ void load_q(bf16x8 (&qf)[4], const bf16_t* qrow, int hi) {
#pragma unroll
    for (int ks = 0; ks < 4; ++ks) qf[ks] = *(const bf16x8*)(qrow + 16 * ks + 8 * hi);
}

struct AttnCtx {
    const bf16_t* zb;
    bf16_t *ya, *yb, *yc;
    float* park;
    const bf16_t *kcmp, *vtcmp;
    const float *rel_bias, *lamp, *subln, *sinks;
    float lam_init;
};

__device__ __forceinline__ void attn_unit_A(LAS uchar* lds, const AttnCtx& C, int bl, int h, int qt, int tid) {
    tid = opq(tid);
    const int lane = tid & 63, n = lane & 31, hi = lane >> 5, w = __builtin_amdgcn_readfirstlane(tid >> 6);
    build_tbl(lds, C.rel_bias, h, 1, tid);
    float lam;
    { const float a = C.lamp[lane] * C.lamp[64 + lane], b = C.lamp[128 + lane] * C.lamp[192 + lane]; lam = __expf(wave_sum(a)) - __expf(wave_sum(b)) + C.lam_init; }
    const int qpos = 256 * qt + 32 * w + n;
    const float rfar = C.rel_bias[31 * 20 + h] * LOG2E;
    const int kt1 = 4 * qt + 4, wkm = 4 * qt + (w >> 1);
    const bf16_t* Vt = C.zb + ZVA + ((size_t)bl * 8 + 2 * h) * HS;
    f32x16 acc[4];
    bf16x8 qf[4];
    float m, l;
    float* prow = C.park + ((size_t)bl * 4096 + qpos) * 512 + h * 128;
#pragma unroll 1
    for (int c = 1; c >= 0; --c) {
        const size_t hoff = ((size_t)bl * 8 + 2 * h + c) * HS;
        load_q(qf, C.zb + ZQA + hoff + (size_t)qpos * 64, hi);
        acc_zero<4>(acc); m = MINIT; l = 0.f;
        attn_pass<128, false>(lds, C.zb + ZKA + hoff, Vt, 4096, 0, kt1, wkm, qpos, 256 * qt + 32 * w, 256 * qt + 32 * w + 31, 1, 0, 0x7fffffffu, qf, L_TBL, 0ull, false, m, l, acc, 0.f, 0, rfar, tid);
        acc_norm<4>(acc, l);
        if (c == 1) {
#pragma unroll
            for (int t = 0; t < 4; ++t)
#pragma unroll
                for (int gq = 0; gq < 4; ++gq) *(f32x4*)(prow + 32 * t + 8 * gq + 4 * hi) = (f32x4){acc[t][4 * gq], acc[t][4 * gq + 1], acc[t][4 * gq + 2], acc[t][4 * gq + 3]};
        }
    }
    float ss = 0.f;
#pragma unroll
    for (int t = 0; t < 4; ++t)
#pragma unroll
        for (int gq = 0; gq < 4; ++gq) { const f32x4 o1 = *(const f32x4*)(prow + 32 * t + 8 * gq + 4 * hi);
#pragma unroll
            for (int e = 0; e < 4; ++e) { const float y = acc[t][4 * gq + e] - lam * o1[e]; acc[t][4 * gq + e] = y; ss += y * y; } }
    ss += __shfl_xor(ss, 32);
    const float rs = (1.0f / sqrtf(ss * (1.f / 128.f) + EPS)) * (1.f - C.lam_init);
    bf16_t* yrow = C.ya + ((size_t)bl * 4096 + qpos) * 512 + h * 128;
#pragma unroll
    for (int t = 0; t < 4; ++t)
#pragma unroll
        for (int gq = 0; gq < 4; ++gq) {
            const int d = 32 * t + 8 * gq + 4 * hi;
            const f32x4 gg = *(const f32x4*)(C.subln + d);
            u32x2 wv; wv.x = cvtpk(acc[t][4 * gq] * rs * gg[0], acc[t][4 * gq + 1] * rs * gg[1]); wv.y = cvtpk(acc[t][4 * gq + 2] * rs * gg[2], acc[t][4 * gq + 3] * rs * gg[3]);
            *(u32x2*)(yrow + d) = wv;
        }
}

__device__ __forceinline__ void attn_unit_B(LAS uchar* lds, const AttnCtx& C, int bl, int g, int i, int tid) {
    tid = opq(tid);
    const int lane = tid & 63, n = lane & 31, hi = lane >> 5, w = __builtin_amdgcn_readfirstlane(tid >> 6);
    build_tbl(lds, C.rel_bias, 4 + 4 * g, 4, tid);
    const int ql = 8 * w + (n & 7), hr = n >> 3, qpos = 64 * i + ql, head = 4 * g + hr, qlo = 64 * i + 8 * w;
    const float rfar = C.rel_bias[31 * 20 + 4 + head] * LOG2E;
    const int tbl = L_TBL + hr * 512;
    bf16x8 qf[4];
    load_q(qf, C.zb + ZQB + ((size_t)bl * 8 + head) * HS + (size_t)qpos * 64, hi);
    const size_t goff = ((size_t)bl * 2 + g) * HS;
    f32x16 acc[2];
    LAS float* otl = (LAS float*)(lds + L_RED) + tid;
    float m, l;
    const size_t tok = (size_t)bl * 4096 + qpos;
    const float* bg = (const float*)(C.zb + ZBG) + tok * 32 + head * 3;
    const float g0 = bg[0], g1 = bg[1], g2 = bg[2];
    const bf16_t* Kc = C.kcmp + ((size_t)bl * 2 + g) * 256 * 64;
    const bf16_t* Vc = C.vtcmp + ((size_t)bl * 2 + g) * 64 * 256;
    const int ktc1 = ((4 * i + 2) >> 6) + 1;
    acc_zero<2>(acc); m = MINIT; l = 0.f;
    attn_pass<64, false>(lds, Kc, Vc, 256, 0, ktc1, 1 << 20, qpos, qlo, qlo + 7, 16, 31, 0x7fffffffu, qf, tbl, 0ull, false, m, l, acc, 0.f, 0, rfar, tid);
    acc_norm<2>(acc, l);
#pragma unroll
    for (int t = 0; t < 2; ++t)
#pragma unroll
        for (int r = 0; r < 16; ++r) otl[(t * 16 + r) * NTHR] = g0 * acc[t][r];
    unsigned long long selmask = ~0ull;
    if (i >= 16) {
    {
        const float lt = l + __shfl_xor(l, 32);
        const float inv_l = lt > 0.f ? 1.f / lt : 0.f;
        LAS float* impw = (LAS float*)(lds + L_IMP) + (8 * w) * 65;
        for (int x = lane; x < 8 * 65; x += 64) impw[x] = 0.f;
        __builtin_amdgcn_fence(__ATOMIC_RELEASE, "wavefront");
        attn_pass<64, true>(lds, Kc, Vc, 256, 0, ktc1, 1 << 20, qpos, qlo, qlo + 7, 16, 31, 0x7fffffffu, qf, tbl, 0ull, false, m, l, acc, inv_l, ql, rfar, tid);
    }
    {
        const int q = tid & 63, part = tid >> 6;
        const LAS float* row = (const LAS float*)(lds + L_IMP) + q * 65;
        float cand[8]; int rank[8];
#pragma unroll
        for (int c = 0; c < 8; ++c) { const int j = 8 * part + c; float v = row[j]; v = (j == 0 || j == i || j == i - 1) ? 1e6f : (j > i ? -1e6f : v); cand[c] = v; rank[c] = 0; }
        for (int jj = 0; jj <= i; ++jj) {
            float x = row[jj]; x = (jj == 0 || jj == i || jj == i - 1) ? 1e6f : (jj > i ? -1e6f : x);
#pragma unroll
            for (int c = 0; c < 8; ++c) { const int j = 8 * part + c; rank[c] += (x > cand[c] || (x == cand[c] && jj < j)) ? 1 : 0; }
        }
        unsigned bits = 0;
#pragma unroll
        for (int c = 0; c < 8; ++c) bits |= (rank[c] < 16 ? 1u : 0u) << c;
        ((LAS uchar*)(lds + L_SEL))[q * 8 + part] = (uchar)bits;
    }
    __syncthreads();
    { const u32x2 sm = *(const LAS u32x2*)(lds + L_SEL + ql * 8); selmask = (unsigned long long)sm.x | ((unsigned long long)sm.y << 32); }
    }
    acc_zero<2>(acc); m = MINIT; l = 0.f;
    attn_pass<64, false>(lds, C.zb + ZKS + goff, C.zb + ZVS + goff, 4096, 0, i + 1, 1 << 20, qpos, qlo, qlo + 7, 1, 0, 0x7fffffffu, qf, tbl, selmask, true, m, l, acc, 0.f, 0, rfar, tid);
    acc_norm<2>(acc, l);
#pragma unroll
    for (int t = 0; t < 2; ++t)
#pragma unroll
        for (int r = 0; r < 16; ++r) otl[(t * 16 + r) * NTHR] += g1 * acc[t][r];
    acc_zero<2>(acc); m = MINIT; l = 0.f;
    attn_pass<64, false>(lds, C.zb + ZKW + goff, C.zb + ZVW + goff, 4096, i > 8 ? i - 8 : 0, i + 1, 1 << 20, qpos, qlo, qlo + 7, 1, 0, 512u, qf, tbl, 0ull, false, m, l, acc, 0.f, 0, rfar, tid);
    acc_norm<2>(acc, l);
    bf16_t* yrow = C.yb + tok * 512 + head * 64;
#pragma unroll
    for (int t = 0; t < 2; ++t)
#pragma unroll
        for (int gq = 0; gq < 4; ++gq) {
            const int d = 32 * t + 8 * gq + 4 * hi;
            float o[4];
#pragma unroll
            for (int e = 0; e < 4; ++e) o[e] = otl[(t * 16 + 4 * gq + e) * NTHR] + g2 * acc[t][4 * gq + e];
            u32x2 wv; wv.x = cvtpk(o[0], o[1]); wv.y = cvtpk(o[2], o[3]);
            *(u32x2*)(yrow + d) = wv;
        }
}

__device__ __forceinline__ void attn_unit_C(LAS uchar* lds, const AttnCtx& C, int bl, int g, int i, int tid) {
    tid = opq(tid);
    const int lane = tid & 63, n = lane & 31, hi = lane >> 5, w = __builtin_amdgcn_readfirstlane(tid >> 6);
    build_tbl(lds, C.rel_bias, 12 + 4 * g, 4, tid);
    const int ql = 8 * w + (n & 7), hr = n >> 3, qpos = 64 * i + ql, head = 4 * g + hr, qlo = 64 * i + 8 * w;
    const float rfar = C.rel_bias[31 * 20 + 12 + head] * LOG2E;
    const int tbl = L_TBL + hr * 512;
    bf16x8 qf[4];
    load_q(qf, C.zb + ZQC + ((size_t)bl * 8 + head) * HS + (size_t)qpos * 64, hi);
    const size_t goff = ((size_t)bl * 2 + g) * HS;
    f32x16 acc[2];
    acc_zero<2>(acc);
    float m = C.sinks[head] * LOG2E, l = hi == 0 ? 1.f : 0.f;
    attn_pass<64, false>(lds, C.zb + ZKC + goff, C.zb + ZVC + goff, 4096, i > 2 ? i - 2 : 0, i + 1, 1 << 20, qpos, qlo, qlo + 7, 1, 0, 128u, qf, tbl, 0ull, false, m, l, acc, 0.f, 0, rfar, tid);
    acc_norm<2>(acc, l);
    const size_t tok = (size_t)bl * 4096 + qpos;
    bf16_t* yrow = C.yc + tok * 512 + head * 64;
#pragma unroll
    for (int t = 0; t < 2; ++t)
#pragma unroll
        for (int gq = 0; gq < 4; ++gq) {
            const int d = 32 * t + 8 * gq + 4 * hi;
            u32x2 wv; wv.x = cvtpk(acc[t][4 * gq], acc[t][4 * gq + 1]); wv.y = cvtpk(acc[t][4 * gq + 2], acc[t][4 * gq + 3]);
            *(u32x2*)(yrow + d) = wv;
        }
}

#define XB_TMO      128
#define XB_XCNT(j)  (256  + 64 * (j))
#define XB_XSUB(j)  (1280 + 64 * (j))
#define XB_XGEN(j)  (2304 + 64 * (j))
#define XB_TOP      3328
#define XB_TOPGEN   3392
#define XCD_BAR_WORDS 3456
#define XB_SPIN_CAP (1u << 18)

__device__ __forceinline__ unsigned xb_ld(unsigned* p)              { return __hip_atomic_load(p, __ATOMIC_RELAXED, __HIP_MEMORY_SCOPE_AGENT); }
__device__ __forceinline__ unsigned xb_add(unsigned* p, unsigned v) { return __hip_atomic_fetch_add(p, v, __ATOMIC_RELAXED, __HIP_MEMORY_SCOPE_AGENT); }
__device__ __forceinline__ unsigned xb_xcc_id() { return (unsigned)__builtin_amdgcn_s_getreg((3 << 11) | 20) & 0xFu; }
#define XB_SPIN(cond, bar) do { unsigned _sp = 0; while (cond) { __builtin_amdgcn_s_sleep(1); \
    if ((++_sp & 255u) == 0u) { if (xb_ld(&(bar)[XB_TMO])) break; if (_sp > XB_SPIN_CAP) { atomicAdd(&(bar)[XB_TMO], 1u); break; } } } } while (0)

struct XcdBarrier {
    unsigned* bar; unsigned x;
    volatile __attribute__((address_space(3))) unsigned* st;
};

__device__ __forceinline__ XcdBarrier xcd_barrier_post(unsigned* bar, volatile __attribute__((address_space(3))) unsigned* st) {
    XcdBarrier b; b.bar = bar; b.x = xb_xcc_id(); b.st = st;
    if (threadIdx.x == 0) (void)xb_add(&bar[XB_XCNT(b.x)], 1u);
    return b;
}
__device__ __forceinline__ void xcd_barrier_complete(unsigned* bar, unsigned x, unsigned& nloc, unsigned& nx) {
    const unsigned G = gridDim.x * gridDim.y * gridDim.z;
    unsigned sum, cnt, mine, sp = 0u;
    for (;;) {
        sum = 0u; cnt = 0u; mine = 0u;
#pragma unroll
        for (unsigned j = 0; j < 16; ++j) { const unsigned c = xb_ld(&bar[XB_XCNT(j)]); sum += c; cnt += (c > 0u) ? 1u : 0u; mine = (j == x) ? c : mine; }
        if (sum == G) break;
        __builtin_amdgcn_s_sleep(1);
        if ((++sp & 255u) == 0u) { if (xb_ld(&bar[XB_TMO])) break; if (sp > XB_SPIN_CAP) { atomicAdd(&bar[XB_TMO], 1u); break; } }
    }
    nloc = mine > 0u ? mine : 1u; nx = cnt > 0u ? cnt : 1u;
}

__device__ __forceinline__ void xcd_barrier(const XcdBarrier& b) {
    asm volatile("s_waitcnt vmcnt(0)" ::: "memory");
    __syncthreads();
    if (threadIdx.x == 0) {
        unsigned* bar = b.bar;
        __builtin_amdgcn_s_waitcnt(0);
        unsigned nloc = b.st[0], nx = b.st[1];
        if (nloc == 0u) { xcd_barrier_complete(bar, b.x, nloc, nx); b.st[0] = nloc; b.st[1] = nx; }
        const unsigned old = xb_add(&bar[XB_XSUB(b.x)], 1u);
        const unsigned gen = old / nloc;
        if (old + 1u == (gen + 1u) * nloc) {
            __builtin_amdgcn_fence(__ATOMIC_RELEASE, "agent");
            asm volatile("s_waitcnt vmcnt(0)" ::: "memory");
            const unsigned og = xb_add(&bar[XB_TOP], 1u);
            const unsigned tg = og / nx;
            if (og + 1u == (tg + 1u) * nx) xb_add(&bar[XB_TOPGEN], 1u);
            else XB_SPIN(xb_ld(&bar[XB_TOPGEN]) == tg, bar);
            __builtin_amdgcn_fence(__ATOMIC_ACQUIRE, "agent");
            xb_add(&bar[XB_XGEN(b.x)], 1u);
            asm volatile("s_waitcnt vmcnt(0)" ::: "memory");
        } else {
            XB_SPIN(xb_ld(&bar[XB_XGEN(b.x)]) == gen, bar);
            __builtin_amdgcn_fence(__ATOMIC_ACQUIRE, "agent");
            asm volatile("s_waitcnt vmcnt(0)" ::: "memory");
        }
    }
    __syncthreads();
}

#define KIN(i) (kparams()->in[i])
#define WS_ (kparams()->ws)
#define HOUT (kparams()->out)
#define Wb ((bf16_t*)(WS_ + WS_W))
#define XN ((bf16_t*)(WS_ + WS_XN))
#define R1 ((bf16_t*)(WS_ + WS_R1))
#define YA ((bf16_t*)(WS_ + WS_Y))
#define MG ((bf16_t*)(WS_ + WS_MG))
#define CH ((bf16_t*)(WS_ + WS_CH))
#define KCMP ((bf16_t*)(WS_ + WS_KCMP))
#define VCMP ((bf16_t*)(WS_ + WS_VCMP))
#define CB ((float*)(WS_ + WS_CB))
#define XN2 ((bf16_t*)(WS_ + WS_XN2))
#define PBF ((bf16_t*)(WS_ + WS_PBF))
#define SSQ ((float*)(WS_ + WS_SSQ))
#define SSQ2 ((float*)(WS_ + WS_SSQ2))
constexpr int LDS_BYTES = 147456;
#ifdef ONLY_EPI
#include <type_traits>
#define ONLY_OK(E) (std::is_same<E, ONLY_EPI>::value)
#else
#define ONLY_OK(E) true
#endif
#ifdef NO_GEMM
#define GEMM(EPI, e, A_, lda_, Bt_, M_, N_, K_, cshift) do { (void)(e); } while (0)
#else
#define GEMM(EPI, e, A_, lda_, Bt_, M_, N_, K_, cshift) do { pg8::Gemm g_{(const bf16_t*)(A_), (const bf16_t*)(Bt_), (M_), (N_), (K_), (lda_)}; pg8::StaticOrder S_; \
    int c_ = (int)((blk + (cshift)) % G), G_ = G; asm volatile("" : "+s"(c_), "+s"(G_)); S_.init((M_), (N_), G_, c_); if (ONLY_OK(EPI)) pg8::gemm_phase<EPI, pg8::StaticOrder, EPI::ALIGN, true>(lds, g_, S_, (e)); } while (0)
#endif
#ifdef NO_GEMM
#define GEMM_X(EPI, e, A_, lda_, Bt_, M_, N_, K_, cidx, gsz) do { (void)(e); } while (0)
#else
#define GEMM_X(EPI, e, A_, lda_, Bt_, M_, N_, K_, cidx, gsz) do { pg8::Gemm g_{(const bf16_t*)(A_), (const bf16_t*)(Bt_), (M_), (N_), (K_), (lda_)}; pg8::StaticOrder S_; \
    int c_ = (int)(cidx), G_ = (int)(gsz); asm volatile("" : "+s"(c_), "+s"(G_)); S_.init((M_), (N_), G_, c_); if (ONLY_OK(EPI)) pg8::gemm_phase<EPI, pg8::StaticOrder, EPI::ALIGN, true>(lds, g_, S_, (e)); } while (0)
#endif

__global__ void __launch_bounds__(NTHR, 2) fwd_kernel(Params P) {
    extern __shared__ __attribute__((aligned(16))) unsigned char lds_raw[];
    LAS uchar* lds = (LAS uchar*)lds_raw;
    cg::grid_group grid = cg::this_grid();
    volatile LAS unsigned* xst = (volatile LAS unsigned*)(lds + LDS_BYTES - 64);
    if (threadIdx.x < 2) xst[threadIdx.x] = 0u;
    __syncthreads();
    const XcdBarrier xbar = xcd_barrier_post((unsigned*)(kparams()->ws + WS_CTL), xst);
#ifndef PROBE_CLASS
#define PROBE_CLASS 0
#endif
#if PROBE_CLASS
    unsigned long long pr_acc = 0, pr_last = __builtin_amdgcn_s_memrealtime();
#define SYNC(cls) do { const unsigned long long t1_ = __builtin_amdgcn_s_memrealtime(); if ((cls) == PROBE_CLASS) pr_acc += t1_ - pr_last; if ((cls) == 6) grid.sync(); else xcd_barrier(xbar); \
    const unsigned long long t2_ = __builtin_amdgcn_s_memrealtime(); if (PROBE_CLASS == 2) pr_acc += t2_ - t1_; pr_last = t2_; } while (0)
#else
#define SYNC(cls) do { if ((cls) == 6) grid.sync(); else xcd_barrier(xbar); } while (0)
#endif
#define DEF_IDS \
    int tid_o = threadIdx.x, G_o = gridDim.x, blk_o = blockIdx.x; asm volatile("" : "+v"(tid_o), "+s"(G_o), "+s"(blk_o)); \
    const int tid = tid_o, lane = tid & 63, wave = __builtin_amdgcn_readfirstlane(tid >> 6); \
    const int G = G_o, blk = blk_o; \
    const int vcu = (G % 8 == 0) ? (blk % 8) * (G / 8) + blk / 8 : blk; \
    const int gw = blk * 8 + wave, ngw = G * 8; (void)vcu; (void)gw; (void)ngw; (void)lane;
    {
        DEF_IDS
        LAS float* scr = (LAS float*)lds;
        int base = 0;
        for (int L = 0; L < DEPTH; ++L) {
            bf16_t* wl = Wb + (size_t)L * W_LAYER;
            conv_matrix(KIN(3) + (size_t)L * 1024 * 5632, 1024, 5632, 5632, 1, wl + W_WI1, base, scr, tid, blk, G, KIN(2) + (size_t)(L * 4 + 0) * DM);
            conv_matrix(KIN(4) + (size_t)L * 2816 * 1024, 2816, 1024, 1024, 0, wl + W_WO1, base, scr, tid, blk, G);
            conv_matrix(KIN(5) + (size_t)L * 1024 * DIN, 1024, DIN, DINP, 2, wl + W_WIN, base, scr, tid, blk, G, KIN(2) + (size_t)(L * 4 + 1) * DM);
            for (int t = 0; t < 2; ++t) conv_matrix(KIN(9) + ((size_t)L * 2 + t) * 2048 * 256, 2048, 256, 256, 0, wl + W_CW1 + (size_t)t * 256 * 2048, base, scr, tid, blk, G);
            for (int t = 0; t < 2; ++t) conv_matrix(KIN(10) + ((size_t)L * 2 + t) * 256 * 64, 256, 64, 256, 3, wl + W_CW2 + (size_t)t * 256 * 256, base, scr, tid, blk, G);
            for (int t = 0; t < 3; ++t) conv_matrix(KIN(12) + ((size_t)L * 3 + t) * 512 * 1024, 512, 1024, 1024, 0, wl + W_WBR + (size_t)t * 1024 * 512, base, scr, tid, blk, G);
            conv_matrix(KIN(13) + (size_t)L * 1024 * 1024, 1024, 1024, 1024, 0, wl + W_WOUT, base, scr, tid, blk, G);
            conv_matrix(KIN(14) + (size_t)L * 1024 * 5632, 1024, 5632, 5632, 1, wl + W_WI2, base, scr, tid, blk, G, KIN(2) + (size_t)(L * 4 + 2) * DM);
            conv_matrix(KIN(15) + (size_t)L * 2816 * 1024, 2816, 1024, 1024, 0, wl + W_WO2, base, scr, tid, blk, G);
            conv_matrix(KIN(16) + (size_t)L * 256 * 1024, 256, 1024, 1024, 0, wl + W_WPE, base, scr, tid, blk, G);
            conv_matrix(KIN(17) + (size_t)L * 1024 * 1024, 1024, 1024, 1024, 0, wl + W_WPG, base, scr, tid, blk, G, KIN(2) + (size_t)(L * 4 + 3) * DM);
        }
        for (int pr = blk; pr < DEPTH * 2; pr += G) {
            const float* pos = KIN(8) + (size_t)pr * 2048; const float* w1 = KIN(9) + (size_t)pr * 2048 * 256;
            float a[4] = {0.f, 0.f, 0.f, 0.f};
            for (int k = wave * 256; k < wave * 256 + 256; ++k) { const float pv = pos[k];
#pragma unroll
                for (int j = 0; j < 4; ++j) a[j] += pv * w1[(size_t)k * 256 + lane + 64 * j]; }
#pragma unroll
            for (int j = 0; j < 4; ++j) scr[wave * 256 + lane + 64 * j] = a[j];
            __syncthreads();
            if (tid < 256) { float s = 0.f;
#pragma unroll
                for (int ww = 0; ww < 8; ++ww) s += scr[ww * 256 + tid];
                CB[pr * 256 + tid] = s; }
            __syncthreads();
        }
        phase_prep(KIN(0), XN2, SSQ2, gw, ngw, lane);
    }
    SYNC(6);

#pragma unroll 1
    for (int L = 0; L < DEPTH; ++L) {
        DEF_IDS
#define wl (Wb + (size_t)L * W_LAYER)
#define ng (KIN(2) + (size_t)L * 4 * DM)
        { EpiSwiglu e{R1, SSQ2}; GEMM(EpiSwiglu, e, XN2, 1024, wl + W_WI1, T, 5632, 1024, 0); }
        SYNC(3);
        { EpiResid e{0.5f, 0, L == 0 ? 0 : 1}; GEMM(EpiResid, e, R1, DFF, wl + W_WO1, T, 1024, DFF, 0); }
        SYNC(3);
        { EpiZ e{R1, SSQ, 0}; GEMM(EpiZ, e, XN, 1024, wl + W_WIN, TC, DINP - 256, 1024, 0); }
        SYNC(3);
        for (int c = 0; c < NCHUNK; ++c) {
            {
                const bool offl = (G >= 64) && ((G & 1) == 0), has_cmp = blk < 16 || (blk >= G / 2 && blk < G / 2 + 16);
                EpiZ e{R1, SSQ + (size_t)c * TC * 16, 26};
                if (!offl) GEMM(EpiZ, e, XN + (size_t)c * TC * DM, 1024, wl + W_WIN + (size_t)(DINP - 256) * 1024, TC, 256, 1024, 0);
                else if (!has_cmp) GEMM_X(EpiZ, e, XN + (size_t)c * TC * DM, 1024, wl + W_WIN + (size_t)(DINP - 256) * 1024, TC, 256, 1024, blk < G / 2 ? blk - 16 : blk - 32, G - 32);
            }
            { EpiBf<1> ek{CH, 256, CB + (L * 2 + 0) * 256}; GEMM(EpiBf<1>, ek, R1 + ZKCI, 1024, wl + W_CW1, NB * 512, 256, 2048, 0);
              EpiBf<1> ev{CH + (size_t)NB * 512 * 256, 256, CB + (L * 2 + 1) * 256}; GEMM(EpiBf<1>, ev, R1 + ZVCI, 1024, wl + W_CW1 + (size_t)256 * 2048, NB * 512, 256, 2048, G / 2); }
            __builtin_amdgcn_fence(__ATOMIC_RELEASE, "workgroup"); __syncthreads(); __builtin_amdgcn_fence(__ATOMIC_ACQUIRE, "workgroup");
            { EpiCmp2<false> ek{KCMP}; GEMM(EpiCmp2<false>, ek, CH, 256, wl + W_CW2, NB * 512, 256, 256, 0);
              EpiCmp2<true> ev{VCMP}; GEMM(EpiCmp2<true>, ev, CH + (size_t)NB * 512 * 256, 256, wl + W_CW2 + (size_t)256 * 256, NB * 512, 256, 256, G / 2); }
            SYNC(5);
            {
                AttnCtx C;
                C.zb = R1; C.park = (float*)MG; C.ya = YA; C.yb = YA + (size_t)TC * 512; C.yc = YA + (size_t)2 * TC * 512; C.kcmp = KCMP; C.vtcmp = VCMP;
                C.rel_bias = KIN(18); C.lamp = KIN(6) + (size_t)L * 256; C.subln = KIN(7) + (size_t)L * 128; C.sinks = KIN(11) + (size_t)L * 8;
                C.lam_init = 0.8f - 0.6f * __expf(-0.3f * (float)L);
                for (int u = vcu; u < NB * 32; u += G) {
                    const int bl = u >> 5;
#ifndef NO_A
#if PROBE_CLASS == 7
                    const unsigned long long ta0_ = __builtin_amdgcn_s_memrealtime();
#endif
                    { const int h = (u >> 3) & 3, qp = u & 7;
#pragma unroll 1
                      for (int k = 0; k < 2; ++k) attn_unit_A(lds, C, bl, h, k ? 15 - qp : qp, tid); }
#if PROBE_CLASS == 7
                    pr_acc += __builtin_amdgcn_s_memrealtime() - ta0_;
#endif
#endif
                    { const int g = (u >> 4) & 1, is = u & 15;
#ifndef NO_B
#pragma unroll 1
                      for (int k = 0; k < 4; ++k) attn_unit_B(lds, C, bl, g, (k & 1) ? (k == 1 ? 31 : 63) - is : (k == 0 ? 0 : 32) + is, tid);
#endif
#ifndef NO_C
#pragma unroll 1
                      for (int k = 0; k < 4; ++k) attn_unit_C(lds, C, bl, g, (k & 1) ? (k == 1 ? 31 : 63) - is : (k == 0 ? 0 : 32) + is, tid);
#endif
                    }
                }
            }
            SYNC(1);
            for (int mi = 0; mi < 3; ++mi) {
                EpiBranch e{MG, R1 + ZSG, mi}; GEMM(EpiBranch, e, YA + (size_t)mi * TC * 512, 512, wl + W_WBR + (size_t)mi * 1024 * 512, TC, 1024, 512, 0);
            }
            SYNC(3);
            { EpiResid e{1.0f, c * TC, 2}; GEMM(EpiResid, e, MG, 1024, wl + W_WOUT, TC, 1024, 1024, 0); }
            if (c + 1 < NCHUNK) { EpiZ e{R1, SSQ + (size_t)(c + 1) * TC * 16, 0}; GEMM(EpiZ, e, XN + (size_t)(c + 1) * TC * DM, 1024, wl + W_WIN, TC, DINP - 256, 1024, 0); }
            SYNC(3);
        }
        {
            const f32x4* src = (const f32x4*)(KIN(1) + (size_t)L * T * PLE); u32x2* dst = (u32x2*)PBF;
            const int tq = opq(tid);
            for (size_t idx = (size_t)blk * NTHR + tq; idx < (size_t)T * PLE / 4; idx += (size_t)G * NTHR) { const f32x4 v = src[idx]; u32x2 w; w.x = cvtpk(v[0], v[1]); w.y = cvtpk(v[2], v[3]); dst[idx] = w; }
        }
        { EpiSwiglu e{R1, SSQ}; GEMM(EpiSwiglu, e, XN, 1024, wl + W_WI2, T, 5632, 1024, 0); }
        SYNC(3);
        { EpiResid e{0.5f, 0, 2}; GEMM(EpiResid, e, R1, DFF, wl + W_WO2, T, 1024, DFF, 0); }
        SYNC(3);
        { EpiBf<0> e{(bf16_t*)((uchar*)R1 + R1_E), 1024, nullptr}; GEMM(EpiBf<0>, e, PBF, 256, wl + W_WPE, T, 1024, 256, 0); }
        SYNC(3);
        { uchar* ws_ = WS_; EpiPle e{(const bf16_t*)(ws_ + WS_XN), (const bf16_t*)(ws_ + WS_R1 + R1_E), (const float*)(ws_ + WS_SSQ), (bf16_t*)(ws_ + WS_XN2), (float*)(ws_ + WS_SSQ2)}; GEMM(EpiPle, e, XN, 1024, wl + W_WPG, T, 1024, 1024, 0); }
        SYNC(3);
    }
    { DEF_IDS const int lq = opq(lane); float* ho = HOUT; const float* fg = KIN(19); const bf16_t* hb = XN2; for (int m = gw; m < T; m += ngw) rms_row_bf16in_f32(hb + (size_t)m * DM, fg, ho + (size_t)m * DM, lq); }
#if PROBE_CLASS
    if (blockIdx.x == 0) { const unsigned long long t0_ = __builtin_amdgcn_s_memrealtime(); while (__builtin_amdgcn_s_memrealtime() - t0_ < pr_acc) __builtin_amdgcn_s_sleep(20); }
#endif
}

extern "C" void kernel_launch(void* const* d_in, const int* in_sizes, int n_in, void* d_out, int out_size, void* d_ws, size_t ws_size, hipStream_t stream) {
    static int grid = 0;
    if (grid == 0) {
        if (n_in != 20 || out_size != T * DM || ws_size < WS_END) { fprintf(stderr, "kernel_launch: unexpected shapes (n_in %d out %d ws %zu)\n", n_in, out_size, ws_size); grid = -1; return; }
        int dev = 0, cus = 0, per_cu = 0;
        hipGetDevice(&dev);
        hipDeviceGetAttribute(&cus, hipDeviceAttributeMultiprocessorCount, dev);
        if (hipFuncSetAttribute((const void*)fwd_kernel, hipFuncAttributeMaxDynamicSharedMemorySize, LDS_BYTES) != hipSuccess) { fprintf(stderr, "kernel_launch: hipFuncSetAttribute failed\n"); grid = -1; return; }
        if (hipOccupancyMaxActiveBlocksPerMultiprocessor(&per_cu, (const void*)fwd_kernel, NTHR, LDS_BYTES) != hipSuccess || per_cu < 1) { fprintf(stderr, "kernel_launch: occupancy query says %d\n", per_cu); per_cu = 1; }
        (void)hipGetLastError();
        grid = cus;
        if (grid > 256) grid = 256;
    }
    if (grid < 0) return;
    if (hipMemsetAsync((char*)d_ws + WS_CTL, 0, CTL_ZERO_BYTES, stream) != hipSuccess) { fprintf(stderr, "kernel_launch: memset failed\n"); return; }
    Params p{};
    for (int i = 0; i < 20; ++i) p.in[i] = (const float*)d_in[i];
    p.out = (float*)d_out; p.ws = (uchar*)d_ws;
    void* args[] = {&p};
    hipError_t e = hipLaunchCooperativeKernel((const void*)fwd_kernel, dim3(grid), dim3(NTHR), args, LDS_BYTES, stream);
    if (e != hipSuccess) fprintf(stderr, "cooperative launch failed: %s (grid %d)\n", hipGetErrorString(e), grid);
}
```

```cpp
#include <hip/hip_runtime.h>
#include <hip/hip_cooperative_groups.h>
#include <cstdio>
#include <cstdint>
namespace cg = cooperative_groups;
namespace pg8 {
#define PG8_LAS __attribute__((address_space(3)))
typedef unsigned short bf16_t;
typedef short bf16x8 __attribute__((ext_vector_type(8)));
typedef float f32x4 __attribute__((ext_vector_type(4)));
typedef unsigned u32x4 __attribute__((ext_vector_type(4)));
constexpr int BM = 256, BK = 64, HALF = 128, HTB = HALF * BK * 2  , STAGE_BYTES = 8 * HTB, NXCD = 8, WGM = 4;

__host__ __device__ __forceinline__ int lds_byte(int r, int c) { const int st = (r >> 4) * 2 + (c >> 5), rr = r & 15, cc = c & 31, ob = rr * 64 + cc * 2; return st * 1024 + (ob ^ (((ob >> 9) & 1) << 5)); }
__host__ __device__ __forceinline__ void stage_rc(int b, int& R, int& C) { const int st = b / 1024, sb = b % 1024, swz = sb ^ (((sb >> 9) & 1) << 5); R = (st >> 1) * 16 + swz / 64; C = (st & 1) * 32 + (swz % 64) / 2; }
__host__ __device__ __forceinline__ int perm32(int rho) { const int n = rho >> 4, i = rho & 15; return 8 * (i >> 2) + 4 * n + (i & 3); }

struct Unit { int pm, pn; };
struct Gemm { const bf16_t* A; const bf16_t* Bt; int M, N, K, lda; };

struct StaticOrder {
    int nM, nN, nwg, G, c;
    __host__ __device__ void init(int M, int N, int G_, int c_) { nM = M / BM; nN = N / BM; nwg = nM * nN; G = G_; c = c_; }
    __host__ __device__ bool next(int i, Unit& u) const {
        const long L = (long)i * G + c; if (L >= nwg) return false;
        int wgid = (int)L; { const int q = nwg / NXCD, r = nwg % NXCD, xcd = wgid % NXCD, off = wgid / NXCD; wgid = (xcd < r ? xcd * (q + 1) : r * (q + 1) + (xcd - r) * q) + off; }
        const int nig = WGM * nN, gid = wgid / nig, fm = gid * WGM, gsz = (nM - fm) < WGM ? (nM - fm) : WGM;
        u.pm = fm + ((wgid % nig) % gsz); u.pn = (wgid % nig) / gsz; return true;
    }
    __device__ __forceinline__ void a_ready(const Unit&) const {}
    __device__ __forceinline__ void done(const Unit&) const {}
};

__device__ __forceinline__ unsigned cvt_pk_bf16(float lo, float hi) { unsigned r; asm volatile("v_cvt_pk_bf16_f32 %0, %1, %2" : "=v"(r) : "v"(lo), "v"(hi)); return r; }
typedef float f32x2 __attribute__((ext_vector_type(2)));
template <class Epi, class Sched, bool ALIGN_EPI = false, bool SP2 = false>
__device__ __forceinline__ void gemm_phase(PG8_LAS unsigned char* lds, const Gemm g, const Sched& S, const Epi& E) {
    int tid_ = threadIdx.x; asm volatile("" : "+v"(tid_)); const int tid = tid_, wid = __builtin_amdgcn_readfirstlane(tid >> 6), lane = tid & 63, wr = wid >> 2, wc = wid & 3, fr = lane & 15, fq = lane >> 4;
    const int K = g.K, nt = K / BK;
    unsigned voffA[2], voffB[2];
#pragma unroll
    for (int i = 0; i < 2; ++i) { int R, C; stage_rc(tid * 16 + i * 8192, R, C); const int Rb = Epi::PERM ? ((R & ~31) + perm32(R & 31)) : R;
        voffA[i] = (unsigned)(R * g.lda + C) * 2u; voffB[i] = (unsigned)(Rb * K + C) * 2u; }
    const size_t kstep = (size_t)(BK * 2);
    const size_t hstep = (size_t)HALF * K * 2;
    const size_t tstep = 2 * hstep; const size_t hstepA = (size_t)HALF * g.lda * 2, tstepA = 2 * hstepA;
    const unsigned ldsw = (unsigned)wid * 1024u;
    const int aoff = lds_byte(wr * 64 + fr, fq * 8), boff = lds_byte(wc * 32 + fr, fq * 8);
#define PG8_SA(b, h) (((b) * 2 + (h)) * HTB)
#define PG8_SB(b, h) ((4 + (b) * 2 + (h)) * HTB)
#define PG8_STAGE(bufoff, gbase, voff) do { _Pragma("unroll") for (int _i = 0; _i < 2; ++_i) \
        __builtin_amdgcn_global_load_lds((const unsigned*)((const char*)(gbase) + (voff)[_i]), (PG8_LAS unsigned*)(lds + (bufoff) + ldsw + _i * 8192), 16, 0, 0); } while (0)
#define PG8_LDA(dst, b, h) do { _Pragma("unroll") for (int m = 0; m < 4; ++m) _Pragma("unroll") for (int k = 0; k < 2; ++k) dst[m][k] = *(const PG8_LAS bf16x8*)(lds + PG8_SA(b, h) + aoff + m * 2048 + k * 1024); } while (0)
#define PG8_LDB(dst, b, h) do { _Pragma("unroll") for (int n = 0; n < 2; ++n) _Pragma("unroll") for (int k = 0; k < 2; ++k) dst[n][k] = *(const PG8_LAS bf16x8*)(lds + PG8_SB(b, h) + boff + n * 2048 + k * 1024); } while (0)
#define PG8_MMA(ai, bj, At, Bt) do { __builtin_amdgcn_s_setprio(1); _Pragma("unroll") for (int m = 0; m < 4; ++m) _Pragma("unroll") for (int n = 0; n < 2; ++n) _Pragma("unroll") for (int k = 0; k < 2; ++k) \
        acc[ai][bj][m][n] = __builtin_amdgcn_mfma_f32_16x16x32_bf16(Bt[n][k], At[m][k], acc[ai][bj][m][n], 0, 0, 0); __builtin_amdgcn_s_setprio(0); } while (0)
#define PG8_WAIT_V(n) asm volatile("s_waitcnt vmcnt(" #n ")" ::: "memory")
#define PG8_WAIT_L(n) asm volatile("s_waitcnt lgkmcnt(" #n ")" ::: "memory")
#define PG8_BAR __builtin_amdgcn_s_barrier()
#define PG8_SCHED __builtin_amdgcn_sched_barrier(0)
    Unit cur, nxt; int ui = 0;
    if (!S.next(0, cur)) return;
    f32x4 acc[2][2][4][2];
#pragma unroll
    for (int a = 0; a < 2; ++a)
#pragma unroll
        for (int b = 0; b < 2; ++b)
#pragma unroll
            for (int m = 0; m < 4; ++m)
#pragma unroll
                for (int n = 0; n < 2; ++n) acc[a][b][m][n] = (f32x4){0.f, 0.f, 0.f, 0.f};
    bf16x8 At[4][2], B0[2][2], B1[2][2];
    const char* cA = (const char*)g.A + (size_t)cur.pm * tstepA; const char* cB = (const char*)g.Bt + (size_t)cur.pn * tstep;
    S.a_ready(cur);
    if constexpr (SP2) {
        PG8_STAGE(PG8_SB(0, 0), cB, voffB); PG8_STAGE(PG8_SB(0, 1), cB + hstep, voffB); PG8_STAGE(PG8_SA(0, 0), cA, voffA); PG8_STAGE(PG8_SA(0, 1), cA + hstepA, voffA);
        if (wr == 1) PG8_BAR;
        PG8_WAIT_V(2); PG8_BAR;
        PG8_STAGE(PG8_SB(1, 0), cB + kstep, voffB); PG8_STAGE(PG8_SA(1, 0), cA + kstep, voffA); PG8_STAGE(PG8_SB(1, 1), cB + hstep + kstep, voffB);
        PG8_WAIT_V(6); PG8_BAR;
    } else {
        PG8_STAGE(PG8_SB(0, 0), cB, voffB); PG8_STAGE(PG8_SA(0, 0), cA, voffA); PG8_STAGE(PG8_SB(0, 1), cB + hstep, voffB); PG8_STAGE(PG8_SA(0, 1), cA + hstepA, voffA);
        if (wr == 1) PG8_BAR;
        PG8_WAIT_V(4); PG8_BAR;
        PG8_STAGE(PG8_SB(1, 0), cB + kstep, voffB); PG8_STAGE(PG8_SA(1, 0), cA + kstep, voffA); PG8_STAGE(PG8_SB(1, 1), cB + hstep + kstep, voffB);
        PG8_WAIT_V(6); PG8_BAR;
    }
    for (;;) {
        const bool has_next = S.next(ui + 1, nxt);
        const char* nA = has_next ? (const char*)g.A + (size_t)nxt.pm * tstepA : cA; const char* nB = has_next ? (const char*)g.Bt + (size_t)nxt.pn * tstep : cB;
        for (int t = 0; t < nt; t += 2) {
            const bool last = (t == nt - 2);
            const char* a1 = cA + (size_t)(t + 1) * kstep;
            const char* a2 = last ? nA : cA + (size_t)(t + 2) * kstep; const char* b2 = last ? nB : cB + (size_t)(t + 2) * kstep;
            const char* a3 = a2 + kstep; const char* b3 = b2 + kstep;
            if (last && has_next) S.a_ready(nxt);
            if constexpr (SP2) {
            PG8_LDB(B0, 0, 0); PG8_LDB(B1, 0, 1); PG8_SCHED; PG8_LDA(At, 0, 0); PG8_STAGE(PG8_SA(1, 1), a1 + hstepA, voffA);
            PG8_WAIT_V(8); PG8_WAIT_L(0); PG8_BAR; PG8_MMA(0, 0, At, B0); PG8_MMA(0, 1, At, B1); PG8_BAR; PG8_SCHED;
            PG8_LDA(At, 0, 1); PG8_STAGE(PG8_SB(0, 0), b2, voffB); PG8_STAGE(PG8_SB(0, 1), b2 + hstep, voffB); PG8_STAGE(PG8_SA(0, 0), a2, voffA);
            PG8_WAIT_V(8); PG8_WAIT_L(0); PG8_BAR; PG8_MMA(1, 0, At, B0); PG8_MMA(1, 1, At, B1); PG8_BAR; PG8_SCHED;
            PG8_LDB(B0, 1, 0); PG8_LDB(B1, 1, 1); PG8_SCHED; PG8_LDA(At, 1, 0); PG8_STAGE(PG8_SA(0, 1), a2 + hstepA, voffA);
            PG8_WAIT_V(8); PG8_WAIT_L(0); PG8_BAR; PG8_MMA(0, 0, At, B0); PG8_MMA(0, 1, At, B1); PG8_BAR; PG8_SCHED;
            PG8_LDA(At, 1, 1); PG8_STAGE(PG8_SB(1, 0), b3, voffB); PG8_STAGE(PG8_SB(1, 1), b3 + hstep, voffB); PG8_STAGE(PG8_SA(1, 0), a3, voffA);
            PG8_WAIT_V(8); PG8_WAIT_L(0); PG8_BAR; PG8_MMA(1, 0, At, B0); PG8_MMA(1, 1, At, B1); PG8_BAR; PG8_SCHED;
            } else {
            PG8_LDB(B0, 0, 0); PG8_SCHED; PG8_LDA(At, 0, 0); PG8_STAGE(PG8_SA(1, 1), a1 + hstepA, voffA);
            PG8_WAIT_L(8); PG8_BAR; PG8_WAIT_L(0); PG8_MMA(0, 0, At, B0); PG8_BAR; PG8_SCHED;
            PG8_LDB(B1, 0, 1); PG8_STAGE(PG8_SB(0, 0), b2, voffB);
            PG8_BAR; PG8_WAIT_L(0); PG8_MMA(0, 1, At, B1); PG8_BAR;
            PG8_LDA(At, 0, 1); PG8_STAGE(PG8_SA(0, 0), a2, voffA);
            PG8_BAR; PG8_WAIT_L(0); PG8_MMA(1, 0, At, B0); PG8_BAR; PG8_SCHED;
            PG8_STAGE(PG8_SB(0, 1), b2 + hstep, voffB);
            PG8_WAIT_V(6); PG8_BAR; PG8_MMA(1, 1, At, B1); PG8_BAR;
            PG8_LDB(B0, 1, 0); PG8_SCHED; PG8_LDA(At, 1, 0); PG8_STAGE(PG8_SA(0, 1), a2 + hstepA, voffA);
            PG8_WAIT_L(8); PG8_BAR; PG8_WAIT_L(0); PG8_MMA(0, 0, At, B0); PG8_BAR; PG8_SCHED;
            PG8_LDB(B1, 1, 1); PG8_STAGE(PG8_SB(1, 0), b3, voffB);
            PG8_BAR; PG8_WAIT_L(0); PG8_MMA(0, 1, At, B1); PG8_BAR;
            PG8_LDA(At, 1, 1); PG8_STAGE(PG8_SA(1, 0), a3, voffA);
            PG8_BAR; PG8_WAIT_L(0); PG8_MMA(1, 0, At, B0); PG8_BAR; PG8_SCHED;
            PG8_STAGE(PG8_SB(1, 1), b3 + hstep, voffB);
            PG8_WAIT_V(6); PG8_BAR; PG8_MMA(1, 1, At, B1); PG8_BAR;
            }
        }
        if constexpr (ALIGN_EPI) { if (wr == 0) PG8_BAR; }
        if constexpr (!Epi::AFTER_DRAIN) { E(acc, cur, wr, wc, fr, fq); S.done(cur); }
        if (!has_next) break;
#pragma unroll
        for (int a = 0; a < 2; ++a)
#pragma unroll
            for (int b = 0; b < 2; ++b)
#pragma unroll
                for (int m = 0; m < 4; ++m)
#pragma unroll
                    for (int n = 0; n < 2; ++n) acc[a][b][m][n] = (f32x4){0.f, 0.f, 0.f, 0.f};
        cur = nxt; cA = nA; cB = nB; ++ui;
        if constexpr (ALIGN_EPI) { if (wr == 1) PG8_BAR; }
    }
    PG8_WAIT_V(0);
    if constexpr (!ALIGN_EPI) { if (wr == 0) PG8_BAR; }
    PG8_BAR;
    if constexpr (Epi::AFTER_DRAIN) { E.fused(acc, cur, wr, wc, fr, fq, lds, wid, lane); S.done(cur); }
#undef PG8_SA
#undef PG8_SB
#undef PG8_STAGE
#undef PG8_LDA
#undef PG8_LDB
#undef PG8_MMA
#undef PG8_WAIT_V
#undef PG8_WAIT_L
#undef PG8_BAR
#undef PG8_SCHED
}
}

#define LAS __attribute__((address_space(3)))
using pg8::bf16_t; using pg8::bf16x8; using pg8::f32x4; using pg8::u32x4;
typedef float f32x16 __attribute__((ext_vector_type(16)));
typedef unsigned u32x2 __attribute__((ext_vector_type(2)));
typedef unsigned char uchar;
typedef float f32x2_t __attribute__((ext_vector_type(2)));
typedef __bf16 bf16x2_t __attribute__((ext_vector_type(2)));

constexpr int DM = 1024, NBATCH = 16, SEQ = 4096, DEPTH = 4, PLE = 256, DFF = 2816;
constexpr int T = NBATCH * SEQ;
constexpr int NB = 8, TC = NB * SEQ, NCHUNK = NBATCH / NB;
constexpr int DIN = 6680, DINP = 6912;
constexpr float EPS = 1e-6f, LOG2E = 1.4426950408889634f;
constexpr int NTHR = 512;

constexpr size_t W_WI1 = 0, W_WO1 = W_WI1 + (size_t)5632 * 1024, W_WIN = W_WO1 + (size_t)1024 * 2816, W_CW1 = W_WIN + (size_t)DINP * 1024,
                 W_CW2 = W_CW1 + (size_t)2 * 256 * 2048, W_WBR = W_CW2 + (size_t)2 * 256 * 256, W_WOUT = W_WBR + (size_t)3 * 1024 * 512,
                 W_WI2 = W_WOUT + (size_t)1024 * 1024, W_WO2 = W_WI2 + (size_t)5632 * 1024, W_WPE = W_WO2 + (size_t)1024 * 2816,
                 W_WPG = W_WPE + (size_t)1024 * 256, W_LAYER = W_WPG + (size_t)1024 * 1024;
static_assert(W_LAYER == 29491200, "weights");
constexpr size_t MiB = 1u << 20;
constexpr size_t WS_W = 0, WS_XN = 226 * MiB, WS_R1 = 354 * MiB, WS_Y = 782 * MiB, WS_MG = 878 * MiB, WS_CH = 942 * MiB, WS_KCMP = 946 * MiB,
                 WS_VCMP = WS_KCMP + MiB / 2, WS_CB = 947 * MiB, WS_SSQ = 948 * MiB, WS_SSQ2 = 952 * MiB, WS_CTL = 956 * MiB, WS_END = 992 * MiB;
constexpr size_t CTL_ZERO_BYTES = 65536;
constexpr size_t WS_XN2 = WS_Y, WS_PBF = 960 * MiB;
static_assert(W_LAYER * 2 * DEPTH <= WS_XN, "w");
constexpr size_t HS = 262144;
constexpr size_t ZQA = 0, ZKA = ZQA + NB * 8 * HS, ZVA = ZKA + NB * 8 * HS, ZQB = ZVA + NB * 8 * HS, ZKCI = ZQB + NB * 8 * HS, ZVCI = ZKCI + NB * 2 * HS,
                 ZKS = ZVCI + NB * 2 * HS, ZVS = ZKS + NB * 2 * HS, ZKW = ZVS + NB * 2 * HS, ZVW = ZKW + NB * 2 * HS, ZQC = ZVW + NB * 2 * HS,
                 ZKC = ZQC + NB * 8 * HS, ZVC = ZKC + NB * 2 * HS, ZSG = ZVC + NB * 2 * HS, ZBG = ZSG + (size_t)TC * 3072, ZEND = ZBG + (size_t)TC * 32 * 2;
static_assert(ZEND * 2 <= 428 * MiB, "zbuf");
static_assert((size_t)T * DFF * 2 <= 428 * MiB, "act");
constexpr size_t R1_E = 0;

struct Params {
    const float* in[20];
    float* out;
    uchar* ws;
};

__device__ __forceinline__ unsigned cvtpk(float lo, float hi) { f32x2_t v = {lo, hi}; bf16x2_t b = __builtin_convertvector(v, bf16x2_t); return __builtin_bit_cast(unsigned, b); }
__device__ __forceinline__ bf16_t cvt1(float x) { return (bf16_t)(cvtpk(x, 0.f) & 0xffffu); }
__device__ __forceinline__ float bf2f(unsigned short b) { return __uint_as_float((unsigned)b << 16); }
__device__ __forceinline__ float wave_sum(float v) {
#pragma unroll
    for (int o = 1; o < 64; o <<= 1) v += __shfl_xor(v, o);
    return v;
}
__device__ __forceinline__ int opq(int v) { asm volatile("" : "+v"(v)); return v; }
__device__ __forceinline__ float sigm(float x) { return __builtin_amdgcn_rcpf(1.f + __builtin_amdgcn_exp2f(-x * LOG2E)); }
__device__ __forceinline__ float gelu_tanh(float x) { const float u = 0.7978845608028654f * (x + 0.044715f * x * x * x); const float e = __builtin_amdgcn_exp2f(-2.f * LOG2E * u); const float th = 2.f * __builtin_amdgcn_rcpf(1.f + e) - 1.f; return 0.5f * x * (1.f + th); }

typedef const __attribute__((address_space(4))) Params* KParPtr;
__device__ __forceinline__ KParPtr kparams() { auto p = __builtin_amdgcn_kernarg_segment_ptr(); asm volatile("" : "+s"(p)); return (KParPtr)p; }
#ifndef ALIGN_T
#define ALIGN_T false
#endif
#ifndef ALIGN_F
#define ALIGN_F true
#endif
#ifndef ALIGN_SW
#define ALIGN_SW true
#endif
#ifndef ALIGN_BR
#define ALIGN_BR true
#endif
#ifndef ALIGN_Z
#define ALIGN_Z true
#endif
__device__ __forceinline__ float row_rstd(const float* ssq, int row) {
    const f32x4* p = (const f32x4*)(ssq + (size_t)row * 16); const f32x4 a = p[0], b = p[1], c = p[2], d = p[3];
    const float sm = (((a[0] + a[1]) + (a[2] + a[3])) + ((b[0] + b[1]) + (b[2] + b[3]))) + (((c[0] + c[1]) + (c[2] + c[3])) + ((d[0] + d[1]) + (d[2] + d[3])));
    return 1.0f / sqrtf(sm * (1.f / 1024.f) + 1e-6f);
}
typedef const pg8::f32x4 (&AccRef)[2][2][4][2];
__device__ __forceinline__ void wave_rstd(const float* ssq, int rowbase, float (&rsl)[2]) {
    const int lane = threadIdx.x & 63;
    rsl[0] = row_rstd(ssq, rowbase + lane); rsl[1] = row_rstd(ssq, rowbase + 128 + lane);
}
struct EpiSwiglu {
    static constexpr bool PERM = true, AFTER_DRAIN = false, ALIGN = ALIGN_SW;
    bf16_t* O; const float* ssq;
    __device__ __forceinline__ void operator()(AccRef acc, const pg8::Unit& u, int wr, int wc, int fr, int fq) const {
        asm volatile("" : "+v"(fr), "+v"(fq));
        const int row0 = u.pm * 256 + wr * 64 + fr, col0 = u.pn * 128 + wc * 32 + 8 * fq;
        float rsl[2]; wave_rstd(ssq, u.pm * 256 + wr * 64, rsl);
#pragma unroll
        for (int ai = 0; ai < 2; ++ai)
#pragma unroll
            for (int m = 0; m < 4; ++m) {
                bf16_t* rp = O + (size_t)(row0 + ai * 128 + m * 16) * DFF + col0;
                const float rs = __shfl(rsl[ai], 16 * m + fr);
                float o[8];
#pragma unroll
                for (int n = 0; n < 2; ++n)
#pragma unroll
                    for (int e = 0; e < 4; ++e) { const float g = acc[ai][0][m][n][e] * rs, up = acc[ai][1][m][n][e] * rs; o[n * 4 + e] = g * sigm(g) * up; }
                u32x4 w; w.x = cvtpk(o[0], o[1]); w.y = cvtpk(o[2], o[3]); w.z = cvtpk(o[4], o[5]); w.w = cvtpk(o[6], o[7]);
                *(u32x4*)rp = w;
            }
    }
};
struct EpiResid {
    static constexpr bool PERM = false, AFTER_DRAIN = false, ALIGN = ALIGN_F;
    float alpha; int row_off; int hsrc;
    __device__ __forceinline__ void operator()(AccRef acc, const pg8::Unit& u, int wr, int wc, int fr, int fq) const {
        asm volatile("" : "+v"(fr), "+v"(fq));
        const int row0 = row_off + u.pm * 256 + wr * 64 + fr, col0 = u.pn * 256 + wc * 32 + 4 * fq;
        const float* xin = kparams()->in[0];
        uchar* wsb = kparams()->ws; bf16_t* hb = (bf16_t*)(wsb + WS_XN); float* ssq = (float*)(wsb + WS_SSQ);
        const bf16_t* hin = (const bf16_t*)(wsb + (hsrc == 1 ? WS_XN2 : WS_XN));
#pragma unroll
        for (int ai = 0; ai < 2; ++ai)
#pragma unroll
            for (int m = 0; m < 4; ++m) {
                const size_t off = (size_t)(row0 + ai * 128 + m * 16) * DM + col0;
                float sq = 0.f;
#pragma unroll
                for (int bj = 0; bj < 2; ++bj)
#pragma unroll
                    for (int n = 0; n < 2; ++n) { f32x4 b;
                        if (hsrc == 0) b = *(const f32x4*)(xin + off + bj * 128 + n * 16);
                        else { const u32x2 hv = *(const u32x2*)(hin + off + bj * 128 + n * 16); b = (f32x4){__uint_as_float(hv.x << 16), __uint_as_float(hv.x & 0xffff0000u), __uint_as_float(hv.y << 16), __uint_as_float(hv.y & 0xffff0000u)}; }
                        const f32x4 v = b + acc[ai][bj][m][n] * alpha;
                        u32x2 w; w.x = cvtpk(v[0], v[1]); w.y = cvtpk(v[2], v[3]); *(u32x2*)(hb + off + bj * 128 + n * 16) = w; sq += (v[0] * v[0] + v[1] * v[1]) + (v[2] * v[2] + v[3] * v[3]); }
                sq += __shfl_xor(sq, 16); sq += __shfl_xor(sq, 32);
                if (fq == 0) ssq[(size_t)(row0 + ai * 128 + m * 16) * 16 + u.pn * 4 + wc] = sq;

            }
    }
};
struct EpiPle {
    static constexpr bool PERM = false, AFTER_DRAIN = false, ALIGN = ALIGN_F;
    const bf16_t* hin; const bf16_t* E; const float* ssq_in; bf16_t* hb; float* ssq_out;
    __device__ __forceinline__ void operator()(AccRef acc, const pg8::Unit& u, int wr, int wc, int fr, int fq) const {
        asm volatile("" : "+v"(fr), "+v"(fq));
        const int row0 = u.pm * 256 + wr * 64 + fr, col0 = u.pn * 256 + wc * 32 + 4 * fq;
        float rsl[2]; wave_rstd(ssq_in, u.pm * 256 + wr * 64, rsl);
#pragma unroll
        for (int ai = 0; ai < 2; ++ai)
#pragma unroll
            for (int m = 0; m < 4; ++m) {
                const size_t off = (size_t)(row0 + ai * 128 + m * 16) * DM + col0;
                const float rs = __shfl(rsl[ai], 16 * m + fr);
                float sq = 0.f;
#pragma unroll
                for (int bj = 0; bj < 2; ++bj)
#pragma unroll
                    for (int n = 0; n < 2; ++n) {
                        const size_t o2 = off + bj * 128 + n * 16;
                        const u32x2 ev = *(const u32x2*)(E + o2); const u32x2 hv = *(const u32x2*)(hin + o2); f32x4 b = (f32x4){__uint_as_float(hv.x << 16), __uint_as_float(hv.x & 0xffff0000u), __uint_as_float(hv.y << 16), __uint_as_float(hv.y & 0xffff0000u)}; const f32x4 a = acc[ai][bj][m][n];
                        b[0] += sigm(a[0] * rs) * __uint_as_float(ev.x << 16); b[1] += sigm(a[1] * rs) * __uint_as_float(ev.x & 0xffff0000u);
                        b[2] += sigm(a[2] * rs) * __uint_as_float(ev.y << 16); b[3] += sigm(a[3] * rs) * __uint_as_float(ev.y & 0xffff0000u);
                        u32x2 w; w.x = cvtpk(b[0], b[1]); w.y = cvtpk(b[2], b[3]); *(u32x2*)(hb + o2) = w; sq += (b[0] * b[0] + b[1] * b[1]) + (b[2] * b[2] + b[3] * b[3]);
                    }
                sq += __shfl_xor(sq, 16); sq += __shfl_xor(sq, 32);
                if (fq == 0) ssq_out[(size_t)(row0 + ai * 128 + m * 16) * 16 + u.pn * 4 + wc] = sq;

            }
    }
};
template <int MODE> struct EpiBf {
    static constexpr bool PERM = true, AFTER_DRAIN = false, ALIGN = ALIGN_T;
    bf16_t* O; int ldc; const float* bias;
    __device__ __forceinline__ void operator()(AccRef acc, const pg8::Unit& u, int wr, int wc, int fr, int fq) const {
        asm volatile("" : "+v"(fr), "+v"(fq));
        const int row0 = u.pm * 256 + wr * 64 + fr, col0 = u.pn * 256 + wc * 32 + 8 * fq;
#pragma unroll
        for (int bj = 0; bj < 2; ++bj) {
            float bv[8];
#pragma unroll
            for (int e = 0; e < 8; ++e) bv[e] = MODE == 1 ? bias[col0 + bj * 128 + e] : 0.f;
#pragma unroll
            for (int ai = 0; ai < 2; ++ai)
#pragma unroll
                for (int m = 0; m < 4; ++m) {
                    float o[8];
#pragma unroll
                    for (int n = 0; n < 2; ++n)
#pragma unroll
                        for (int e = 0; e < 4; ++e) { float v = acc[ai][bj][m][n][e] + bv[n * 4 + e]; if (MODE == 1) v = gelu_tanh(v); o[n * 4 + e] = v; }
                    u32x4 w; w.x = cvtpk(o[0], o[1]); w.y = cvtpk(o[2], o[3]); w.z = cvtpk(o[4], o[5]); w.w = cvtpk(o[6], o[7]);
                    *(u32x4*)(O + (size_t)(row0 + ai * 128 + m * 16) * ldc + col0 + bj * 128) = w;
                }
        }
    }
};
template <bool VT> struct EpiCmp2 {
    static constexpr bool PERM = true, AFTER_DRAIN = false, ALIGN = ALIGN_T;
    bf16_t* O;
    __device__ __forceinline__ void operator()(AccRef acc, const pg8::Unit& u, int wr, int wc, int fr, int fq) const {
        asm volatile("" : "+v"(fr), "+v"(fq));
        if (u.pn != 0 || wc >= 2) return;
        const int row0 = u.pm * 256 + wr * 64 + fr, d0 = wc * 32 + 8 * fq;
#pragma unroll
        for (int ai = 0; ai < 2; ++ai)
#pragma unroll
            for (int m = 0; m < 4; ++m) {
                const int row = row0 + ai * 128 + m * 16, bg = row >> 8, n = row & 255;
                float o[8];
#pragma unroll
                for (int nn = 0; nn < 2; ++nn)
#pragma unroll
                    for (int e = 0; e < 4; ++e) o[nn * 4 + e] = (n == 255) ? 0.f : acc[ai][0][m][nn][e];
                if (!VT) { u32x4 w; w.x = cvtpk(o[0], o[1]); w.y = cvtpk(o[2], o[3]); w.z = cvtpk(o[4], o[5]); w.w = cvtpk(o[6], o[7]); *(u32x4*)(O + (size_t)row * 64 + d0) = w; }
                else {
#pragma unroll
                    for (int e = 0; e < 8; ++e) O[((size_t)bg * 64 + d0 + e) * 256 + n] = cvt1(o[e]);
                }
            }
    }
};
struct EpiBranch {
    static constexpr bool PERM = true, AFTER_DRAIN = false, ALIGN = ALIGN_BR;
    bf16_t* mg; const bf16_t* sg; int mi;
    __device__ __forceinline__ void operator()(AccRef acc, const pg8::Unit& u, int wr, int wc, int fr, int fq) const {
        asm volatile("" : "+v"(fr), "+v"(fq));
        const int row0 = u.pm * 256 + wr * 64 + fr, col0 = u.pn * 256 + wc * 32 + 8 * fq;
#pragma unroll
        for (int ai = 0; ai < 2; ++ai)
#pragma unroll
            for (int m = 0; m < 4; ++m) {
                const int row = row0 + ai * 128 + m * 16;
#pragma unroll
                for (int bj = 0; bj < 2; ++bj) {
                    const int col = col0 + bj * 128;
                    const u32x2 gv = *(const u32x2*)((const uchar*)sg + (size_t)row * 3072 + mi * 1024 + col);
                    u32x4 ov = (u32x4){0u, 0u, 0u, 0u};
                    if (mi != 0) ov = *(const u32x4*)(mg + (size_t)row * DM + col);
                    float o[8];
#pragma unroll
                    for (int q = 0; q < 4; ++q) {
                        const unsigned oq = ov[q], gw2 = (q < 2 ? gv.x : gv.y) >> ((q & 1) * 16);
                        const float g0 = (float)(gw2 & 255u) * (1.f / 255.f), g1 = (float)((gw2 >> 8) & 255u) * (1.f / 255.f);
                        const float a0 = acc[ai][bj][m][q >> 1][(q & 1) * 2], a1 = acc[ai][bj][m][q >> 1][(q & 1) * 2 + 1];
                        o[2 * q] = __uint_as_float(oq << 16) + g0 * a0;
                        o[2 * q + 1] = __uint_as_float(oq & 0xffff0000u) + g1 * a1;
                    }
                    u32x4 w; w.x = cvtpk(o[0], o[1]); w.y = cvtpk(o[2], o[3]); w.z = cvtpk(o[4], o[5]); w.w = cvtpk(o[6], o[7]);
                    *(u32x4*)(mg + (size_t)row * DM + col) = w;
                }

            }
    }
};
struct EpiZ {
    static constexpr bool PERM = true, AFTER_DRAIN = false, ALIGN = ALIGN_Z;
    bf16_t* zb; const float* ssq; int pn_off;
    __device__ __forceinline__ void operator()(AccRef acc, const pg8::Unit& u, int wr, int wc, int fr, int fq) const {
        asm volatile("" : "+v"(fr), "+v"(fq));
        const int pn = u.pn + pn_off;
        float rsl[2]; wave_rstd(ssq, u.pm * 256 + wr * 64, rsl);
#pragma unroll
        for (int bj = 0; bj < 2; ++bj) {
            const int ch = 2 * bj + (wc >> 1), d0 = (wc & 1) * 32 + 8 * fq;
            size_t off = 0, bs = 8 * HS; int mode = 0;
            if (pn < 2) { off = ZQA + (size_t)(pn * 4 + ch) * HS; }
            else if (pn < 4) { off = ZKA + (size_t)((pn - 2) * 4 + ch) * HS; }
            else if (pn < 6) { off = ZVA + (size_t)((pn - 4) * 4 + ch) * HS; mode = 1; }
            else if (pn < 8) { off = ZQB + (size_t)((pn - 6) * 4 + ch) * HS; }
            else if (pn == 8) { bs = 2 * HS; off = (ch < 2) ? ZKCI + (size_t)ch * HS : ZVCI + (size_t)(ch - 2) * HS; }
            else if (pn == 9) { bs = 2 * HS; if (ch < 2) off = ZKS + (size_t)ch * HS; else { off = ZVS + (size_t)(ch - 2) * HS; mode = 1; } }
            else if (pn == 10) { bs = 2 * HS; if (ch < 2) off = ZKW + (size_t)ch * HS; else { off = ZVW + (size_t)(ch - 2) * HS; mode = 1; } }
            else if (pn < 13) { off = ZQC + (size_t)((pn - 11) * 4 + ch) * HS; }
            else if (pn == 13) { bs = 2 * HS; if (ch < 2) off = ZKC + (size_t)ch * HS; else { off = ZVC + (size_t)(ch - 2) * HS; mode = 1; } }
            else if (pn < 26) mode = 2;
            else mode = 3;
#pragma unroll
            for (int ai = 0; ai < 2; ++ai)
#pragma unroll
                for (int m = 0; m < 4; ++m) {
                    const int tl = u.pm * 256 + ai * 128 + wr * 64 + m * 16 + fr, bl = tl >> 12, s = tl & 4095;
                    const float rs = __shfl(rsl[ai], 16 * m + fr);
                    float o[8];
#pragma unroll
                    for (int n = 0; n < 2; ++n)
#pragma unroll
                        for (int e = 0; e < 4; ++e) o[n * 4 + e] = acc[ai][bj][m][n][e] * rs;
                    if (mode == 0) {
                        u32x4 w; w.x = cvtpk(o[0], o[1]); w.y = cvtpk(o[2], o[3]); w.z = cvtpk(o[4], o[5]); w.w = cvtpk(o[6], o[7]);
                        *(u32x4*)(zb + off + (size_t)bl * bs + (size_t)s * 64 + d0) = w;
                    } else if (mode == 1) {
                        bf16_t* p = zb + off + (size_t)bl * bs + (size_t)d0 * 4096 + s;
#pragma unroll
                        for (int e = 0; e < 8; ++e) p[(size_t)e * 4096] = cvt1(o[e]);
                    } else if (mode == 2) {
                        unsigned qb[8];
#pragma unroll
                        for (int e = 0; e < 8; ++e) qb[e] = (unsigned)(sigm(o[e]) * 255.f + 0.5f);
                        u32x2 w; w.x = qb[0] | (qb[1] << 8) | (qb[2] << 16) | (qb[3] << 24); w.y = qb[4] | (qb[5] << 8) | (qb[6] << 16) | (qb[7] << 24);
                        *(u32x2*)((uchar*)(zb + ZSG) + (size_t)tl * 3072 + (pn - 14) * 256 + bj * 128 + wc * 32 + 8 * fq) = w;
                    } else {
                        const int cc = bj * 128 + wc * 32 + 8 * fq;
                        if (cc < 24) {
                            float* bgp = (float*)(zb + ZBG) + (size_t)tl * 32 + cc;
                            *(f32x4*)bgp = (f32x4){sigm(o[0]), sigm(o[1]), sigm(o[2]), sigm(o[3])};
                            *(f32x4*)(bgp + 4) = (f32x4){sigm(o[4]), sigm(o[5]), sigm(o[6]), sigm(o[7])};
                        }
                    }
                }
        }
    }
};

__device__ __forceinline__ void rms_row_bf16(const float* xrow, const float* g, bf16_t* orow, int lane) {
    const f32x4* xr = (const f32x4*)xrow + lane; f32x4 v[4]; float s = 0.f;
#pragma unroll
    for (int j = 0; j < 4; ++j) { v[j] = xr[64 * j]; s += (v[j][0] * v[j][0] + v[j][1] * v[j][1]) + (v[j][2] * v[j][2] + v[j][3] * v[j][3]); }
    const float rstd = 1.0f / sqrtf(wave_sum(s) * (1.f / DM) + EPS);
    u32x2* o8 = (u32x2*)orow + lane;
#pragma unroll
    for (int j = 0; j < 4; ++j) { const f32x4 gg = ((const f32x4*)g)[lane + 64 * j]; u32x2 w; w.x = cvtpk(v[j][0] * rstd * gg[0], v[j][1] * rstd * gg[1]); w.y = cvtpk(v[j][2] * rstd * gg[2], v[j][3] * rstd * gg[3]); o8[64 * j] = w; }
}
__device__ __forceinline__ void rms_row_f32(const float* xrow, const float* g, float* orow, int lane) {
    const f32x4* xr = (const f32x4*)xrow + lane; f32x4 v[4]; float s = 0.f;
#pragma unroll
    for (int j = 0; j < 4; ++j) { v[j] = xr[64 * j]; s += (v[j][0] * v[j][0] + v[j][1] * v[j][1]) + (v[j][2] * v[j][2] + v[j][3] * v[j][3]); }
    const float rstd = 1.0f / sqrtf(wave_sum(s) * (1.f / DM) + EPS);
#pragma unroll
    for (int j = 0; j < 4; ++j) { const f32x4 gg = ((const f32x4*)g)[lane + 64 * j]; ((f32x4*)orow)[lane + 64 * j] = (v[j] * rstd) * gg; }
}
__device__ __forceinline__ void rms_row_bf16in_f32(const bf16_t* xrow, const float* g, float* orow, int lane) {
    const u32x2* xr = (const u32x2*)xrow + lane; f32x4 v[4]; float s = 0.f;
#pragma unroll
    for (int j = 0; j < 4; ++j) { const u32x2 hv = xr[64 * j]; v[j] = (f32x4){__uint_as_float(hv.x << 16), __uint_as_float(hv.x & 0xffff0000u), __uint_as_float(hv.y << 16), __uint_as_float(hv.y & 0xffff0000u)};
        s += (v[j][0] * v[j][0] + v[j][1] * v[j][1]) + (v[j][2] * v[j][2] + v[j][3] * v[j][3]); }
    const float rstd = 1.0f / sqrtf(wave_sum(s) * (1.f / DM) + EPS);
#pragma unroll
    for (int j = 0; j < 4; ++j) { const f32x4 gg = ((const f32x4*)g)[lane + 64 * j]; ((f32x4*)orow)[lane + 64 * j] = (v[j] * rstd) * gg; }
}
__device__ __forceinline__ void phase_prep(const float* src, bf16_t* dst, float* ssq, int gw, int ngw, int lane) {
    lane = opq(lane);
    for (int m = gw; m < T; m += ngw) {
        const f32x4* xr = (const f32x4*)(src + (size_t)m * DM) + lane; u32x2* o8 = (u32x2*)(dst + (size_t)m * DM) + lane; float s = 0.f;
#pragma unroll
        for (int j = 0; j < 4; ++j) { const f32x4 v = xr[64 * j]; s += (v[0] * v[0] + v[1] * v[1]) + (v[2] * v[2] + v[3] * v[3]); u32x2 w; w.x = cvtpk(v[0], v[1]); w.y = cvtpk(v[2], v[3]); o8[64 * j] = w; }
        s = wave_sum(s);
        if (lane < 16) ssq[(size_t)m * 16 + lane] = lane == 0 ? s : 0.f;
    }
}
__device__ __forceinline__ void phase_rms(const float* src, const float* g, bf16_t* dst, int gw, int ngw, int lane) {
    lane = opq(lane);
    for (int m = gw; m < T; m += ngw) rms_row_bf16(src + (size_t)m * DM, g, dst + (size_t)m * DM, lane);
}

__device__ __forceinline__ int srccol(int mode, int n) {
    if (mode == 0) return n;
    if (mode == 1) return ((n >> 7) & 1) * DFF + (n >> 8) * 128 + (n & 127);
    if (mode == 2) return n < 2816 ? n : (n < 6656 ? n + 24 : (n < 6680 ? 2816 + (n - 6656) : -1));
    return n < 64 ? n : -1;
}
__device__ __forceinline__ void conv_matrix(const float* src, int K, int ld, int Ndst, int mode, bf16_t* dst, int& base, LAS float* scr, int tid, int blk, int G, const float* gk = nullptr) {
    tid = opq(tid);
    const int ntn = Ndst / 64, ntiles = (K / 128) * ntn;
    int start = (blk - (base % G) + G) % G;
    for (int t = start; t < ntiles; t += G) {
        const int k0 = (t / ntn) * 128, n0 = (t % ntn) * 64;
        { const int kr = tid >> 6, n = tid & 63; const int col = srccol(mode, n0 + n);
          float v[16];
#pragma unroll
          for (int kk = 0; kk < 16; ++kk) { const int k = kr + 8 * kk; v[kk] = col >= 0 ? src[(size_t)(k0 + k) * ld + col] : 0.f; }
#pragma unroll
          for (int kk = 0; kk < 16; ++kk) { const int k = kr + 8 * kk; scr[k * 65 + n] = gk ? v[kk] * gk[k0 + k] : v[kk]; } }
        __syncthreads();
        { const int n = tid >> 3, ks = tid & 7;
#pragma unroll
          for (int h2 = 0; h2 < 2; ++h2) { const LAS float* sp = scr + (64 * h2 + 8 * ks) * 65 + n;
            u32x4 w; w.x = cvtpk(sp[0], sp[65]); w.y = cvtpk(sp[130], sp[195]); w.z = cvtpk(sp[260], sp[325]); w.w = cvtpk(sp[390], sp[455]);
            *(u32x4*)(dst + (size_t)(n0 + n) * K + k0 + 64 * h2 + 8 * ks) = w; } }
        __syncthreads();
    }
    base += ntiles;
}

constexpr int KP = 144;
constexpr int VP = 144;
constexpr int L_K0 = 0, L_K1 = 9216, L_V0 = 18432, L_V1 = 36864, L_TBL = 55296, L_IMP = 57344, L_SEL = 73984, L_RED = 74496;
constexpr float SC = 0.125f * LOG2E;
constexpr float MINIT = -10000.f, MASKED = -1e30f;

__device__ __forceinline__ int t5_bucket(int n) {
    if (n < 16) return n;
    int b = 16;
    b += (n >= 19); b += (n >= 21); b += (n >= 24); b += (n >= 27); b += (n >= 31); b += (n >= 35); b += (n >= 40); b += (n >= 46);
    b += (n >= 52); b += (n >= 59); b += (n >= 67); b += (n >= 77); b += (n >= 87); b += (n >= 99); b += (n >= 113);
    return b;
}
__device__ __forceinline__ void build_tbl(LAS uchar* lds, const float* rel_bias, int col0, int nh, int tid) {
    const int hd = tid >> 7, idx = tid & 127;
    if (hd < nh && idx < 114) ((LAS float*)(lds + L_TBL))[hd * 128 + idx] = rel_bias[t5_bucket(idx) * 20 + col0 + hd] * LOG2E;
}

template <int DV> struct TileRegs { u32x4 k; u32x4 v[DV / 64]; };
template <int DV, bool HASV>
__device__ __forceinline__ void tile_gload(TileRegs<DV>& r, const bf16_t* Kg, const bf16_t* Vt, int vpitch, int kt, int tid) {
    const int row = tid >> 3, seg = tid & 7;
    r.k = *(const u32x4*)(Kg + (size_t)(kt * 64 + row) * 64 + seg * 8);
    if (HASV) {
#pragma unroll
        for (int j = 0; j < DV / 64; ++j) r.v[j] = *(const u32x4*)(Vt + (size_t)(row + 64 * j) * vpitch + kt * 64 + seg * 8);
    }
}
template <int DV, bool HASV>
__device__ __forceinline__ void tile_swrite(const TileRegs<DV>& r, LAS uchar* lds, int buf, int tid) {
    const int row = tid >> 3, seg = tid & 7;
    *(LAS u32x4*)(lds + (buf ? L_K1 : L_K0) + row * KP + seg * 16) = r.k;
    if (HASV) {
#pragma unroll
        for (int j = 0; j < DV / 64; ++j) { LAS uchar* p = lds + (buf ? L_V1 : L_V0) + (row + 64 * j) * VP + (seg >> 1) * 32 + (seg & 1) * 8; *(LAS u32x2*)p = (u32x2){r.v[j].x, r.v[j].y}; *(LAS u32x2*)(p + 16) = (u32x2){r.v[j].z, r.v[j].w}; }
    }
}

template <int DV, bool IMPP>
__device__ __forceinline__ void attn_pass(LAS uchar* lds, const bf16_t* Kg, const bf16_t* Vt, int vpitch, int kt0, int kt1, int wave_kt_max,
                                          int qpos, int qmin_w, int qmax_w, int kmul, int kadd, unsigned W, bf16x8 (&q)[4], int tbl,
                                          unsigned long long selmask, bool use_sel, float& m, float& l, f32x16 (&acc)[DV / 32],
                                          float inv_l, int imp_row, float rel_far, int tid) {
    const int lane = tid & 63, n = lane & 31, hi = lane >> 5;
    TileRegs<DV> tr;
    if (kt0 >= kt1) return;
    float tfar = rel_far;
    asm volatile("s_waitcnt vmcnt(0)" ::: "memory");
    asm volatile("" : "+v"(q[0]), "+v"(q[1]), "+v"(q[2]), "+v"(q[3]), "+v"(tfar), "+v"(m), "+v"(l), "+v"(inv_l));
    tile_gload<DV, !IMPP>(tr, Kg, Vt, vpitch, kt0, tid);
    tile_swrite<DV, !IMPP>(tr, lds, 0, tid);
    __syncthreads();
    for (int kt = kt0; kt < kt1; ++kt) {
        const int cur = (kt - kt0) & 1;
        const bool more = kt + 1 < kt1;
        if (more) tile_gload<DV, !IMPP>(tr, Kg, Vt, vpitch, kt + 1, tid);
        if (kt <= wave_kt_max && (!use_sel || __builtin_amdgcn_ballot_w64((selmask >> kt) & 1ull) != 0ull)) {
            f32x16 s[2];
#pragma unroll
            for (int r = 0; r < 16; ++r) { s[0][r] = 0.f; s[1][r] = 0.f; }
            const LAS uchar* kb = lds + (cur ? L_K1 : L_K0) + n * KP + hi * 16;
#pragma unroll
            for (int ks = 0; ks < 4; ++ks) {
                const bf16x8 a0 = *(const LAS bf16x8*)(kb + ks * 32);
                const bf16x8 a1 = *(const LAS bf16x8*)(kb + 32 * KP + ks * 32);
                s[0] = __builtin_amdgcn_mfma_f32_32x32x16_bf16(a0, q[ks], s[0], 0, 0, 0);
                s[1] = __builtin_amdgcn_mfma_f32_32x32x16_bf16(a1, q[ks], s[1], 0, 0, 0);
            }
            const bool lane_ok = !use_sel || ((selmask >> kt) & 1ull);
            const bool fast = (qmin_w - (kmul * (64 * kt + 63) + kadd) >= 113) && ((unsigned)(qmax_w - (kmul * 64 * kt + kadd)) < W);
            if (fast) {
                const float cfar = lane_ok ? tfar - m : MASKED;
                const float scl = lane_ok ? SC : 0.f;
#pragma unroll
                for (int hh = 0; hh < 2; ++hh)
#pragma unroll
                    for (int r = 0; r < 16; ++r) s[hh][r] = s[hh][r] * scl + cfar;
            } else {
                int dq = qpos - kadd - kmul * (kt * 64 + 4 * hi);
                asm volatile("" : "+v"(dq));
                const unsigned Wl = lane_ok ? W : 0u;
                const LAS uchar* tb = lds + tbl;
#pragma unroll
                for (int hh = 0; hh < 2; ++hh)
#pragma unroll
                    for (int r = 0; r < 16; ++r) {
                        const int kk = 32 * hh + 8 * (r >> 2) + (r & 3);
                        const int dist = dq - kmul * kk;
                        const unsigned ud = (unsigned)dist;
                        const unsigned idx = ud < 113u ? ud : 113u;
                        const float bias = *(const LAS float*)(tb + idx * 4);
                        float v = s[hh][r] * SC + (bias - m);
                        v = (ud < Wl) ? v : MASKED;
                        s[hh][r] = v;
                    }
            }
            if (!IMPP) {
                float t0 = fmaxf(fmaxf(s[0][0], s[0][1]), s[0][2]), t1 = fmaxf(fmaxf(s[1][0], s[1][1]), s[1][2]);
#pragma unroll
                for (int r = 3; r < 15; r += 2) { t0 = fmaxf(fmaxf(t0, s[0][r]), s[0][r + 1]); t1 = fmaxf(fmaxf(t1, s[1][r]), s[1][r + 1]); }
                float tmax = fmaxf(fmaxf(t0, t1), fmaxf(s[0][15], s[1][15]));
                { auto rr = __builtin_amdgcn_permlane32_swap(__float_as_uint(tmax), __float_as_uint(tmax), false, false); tmax = fmaxf(__uint_as_float(rr[0]), __uint_as_float(rr[1])); }
                const bool need = tmax > 8.f;
                if (__builtin_amdgcn_ballot_w64(need) != 0ull) {
                    const float delta = need ? tmax : 0.f;
                    const float alpha = __builtin_amdgcn_exp2f(-delta);
                    m += delta; l *= alpha;
#pragma unroll
                    for (int dt = 0; dt < DV / 32; ++dt) acc[dt] = acc[dt] * alpha;
#pragma unroll
                    for (int hh = 0; hh < 2; ++hh)
#pragma unroll
                        for (int r = 0; r < 16; ++r) s[hh][r] -= delta;
                }
#pragma unroll
                for (int hh = 0; hh < 2; ++hh)
#pragma unroll
                    for (int r = 0; r < 16; ++r) s[hh][r] = __builtin_amdgcn_exp2f(s[hh][r]);
                f32x2_t ls2a = {0.f, 0.f}, ls2b = {0.f, 0.f};
#pragma unroll
                for (int r = 0; r < 16; r += 2) { ls2a += (f32x2_t){s[0][r], s[0][r + 1]}; ls2b += (f32x2_t){s[1][r], s[1][r + 1]}; }
                const float ls = (ls2a[0] + ls2a[1]) + (ls2b[0] + ls2b[1]);
                l += ls;
                const LAS uchar* vb = lds + (cur ? L_V1 : L_V0) + n * VP + hi * 16;
    #pragma unroll
                for (int hh = 0; hh < 2; ++hh)
#pragma unroll
                    for (int u2 = 0; u2 < 2; ++u2) {
                        u32x4 pw;
                        pw.x = cvtpk(s[hh][8 * u2 + 0], s[hh][8 * u2 + 1]); pw.y = cvtpk(s[hh][8 * u2 + 2], s[hh][8 * u2 + 3]);
                        pw.z = cvtpk(s[hh][8 * u2 + 4], s[hh][8 * u2 + 5]); pw.w = cvtpk(s[hh][8 * u2 + 6], s[hh][8 * u2 + 7]);
                        const bf16x8 pb = __builtin_bit_cast(bf16x8, pw);
                        const int kbase = 32 * hh + 16 * u2;
#pragma unroll
                        for (int dt = 0; dt < DV / 32; ++dt) {
                            const bf16x8 va = *(const LAS bf16x8*)(vb + dt * 32 * VP + kbase * 2);
                            acc[dt] = __builtin_amdgcn_mfma_f32_32x32x16_bf16(va, pb, acc[dt], 0, 0, 0);
                        }
                    }
                } else {
                LAS float* imp = (LAS float*)(lds + L_IMP) + imp_row * 65;
                float spill[8];
#pragma unroll
                for (int hh = 0; hh < 2; ++hh)
#pragma unroll
                    for (int gq = 0; gq < 4; ++gq) {
                        const float p0 = __builtin_amdgcn_exp2f(s[hh][4 * gq + 0]) * inv_l, p1 = __builtin_amdgcn_exp2f(s[hh][4 * gq + 1]) * inv_l;
                        const float p2 = __builtin_amdgcn_exp2f(s[hh][4 * gq + 2]) * inv_l, p3 = __builtin_amdgcn_exp2f(s[hh][4 * gq + 3]) * inv_l;
                        float mn = (p0 + p1) + (p2 + p3), sp = p3;
                        mn += __shfl_xor(mn, 8); mn += __shfl_xor(mn, 16);
                        sp += __shfl_xor(sp, 8); sp += __shfl_xor(sp, 16);
                        spill[hh * 4 + gq] = sp;
                        const int j = 16 * kt + 8 * hh + 2 * gq + hi;
                        if (n < 8) imp[j] += mn;
                    }
                __builtin_amdgcn_fence(__ATOMIC_RELEASE, "wavefront");
#pragma unroll
                for (int hh = 0; hh < 2; ++hh)
#pragma unroll
                    for (int gq = 0; gq < 4; ++gq) {
                        const int j = 16 * kt + 8 * hh + 2 * gq + hi + 1;
                        if (n < 8 && j < 64) imp[j] += spill[hh * 4 + gq];
                    }
                __builtin_amdgcn_fence(__ATOMIC_RELEASE, "wavefront");
            }
        }
        if (more) tile_swrite<DV, !IMPP>(tr, lds, cur ^ 1, tid);
        __syncthreads();
    }
}

template <int NT> __device__ __forceinline__ void acc_zero(f32x16 (&a)[NT]) {
#pragma unroll
    for (int t = 0; t < NT; ++t)
#pragma unroll
        for (int r = 0; r < 16; ++r) a[t][r] = 0.f;
}
template <int NT> __device__ __forceinline__ void acc_norm(f32x16 (&a)[NT], float l) {
    const float lt = l + __shfl_xor(l, 32);
    const float inv = lt > 0.f ? 1.f / lt : 0.f;
#pragma unroll
    for (int t = 0; t < NT; ++t)
#pragma unroll
        for (int r = 0; r < 16; ++r) a[t][r] *= inv;
}
__device__ __forceinline__ void load_q(bf16x8 (&qf)[4], const bf16_t* qrow, int hi) {
#pragma unroll
    for (int ks = 0; ks < 4; ++ks) qf[ks] = *(const bf16x8*)(qrow + 16 * ks + 8 * hi);
}

struct AttnCtx {
    const bf16_t* zb;
    bf16_t *ya, *yb, *yc;
    float* park;
    const bf16_t *kcmp, *vtcmp;
    const float *rel_bias, *lamp, *subln, *sinks;
    float lam_init;
};

__device__ __forceinline__ void attn_unit_A(LAS uchar* lds, const AttnCtx& C, int bl, int h, int qt, int tid) {
    tid = opq(tid);
    const int lane = tid & 63, n = lane & 31, hi = lane >> 5, w = __builtin_amdgcn_readfirstlane(tid >> 6);
    build_tbl(lds, C.rel_bias, h, 1, tid);
    float lam;
    { const float a = C.lamp[lane] * C.lamp[64 + lane], b = C.lamp[128 + lane] * C.lamp[192 + lane]; lam = __expf(wave_sum(a)) - __expf(wave_sum(b)) + C.lam_init; }
    const int qpos = 256 * qt + 32 * w + n;
    const float rfar = C.rel_bias[31 * 20 + h] * LOG2E;
    const int kt1 = 4 * qt + 4, wkm = 4 * qt + (w >> 1);
    const bf16_t* Vt = C.zb + ZVA + ((size_t)bl * 8 + 2 * h) * HS;
    f32x16 acc[4];
    bf16x8 qf[4];
    float m, l;
    float* prow = C.park + ((size_t)bl * 4096 + qpos) * 512 + h * 128;
#pragma unroll 1
    for (int c = 1; c >= 0; --c) {
        const size_t hoff = ((size_t)bl * 8 + 2 * h + c) * HS;
        load_q(qf, C.zb + ZQA + hoff + (size_t)qpos * 64, hi);
        acc_zero<4>(acc); m = MINIT; l = 0.f;
        attn_pass<128, false>(lds, C.zb + ZKA + hoff, Vt, 4096, 0, kt1, wkm, qpos, 256 * qt + 32 * w, 256 * qt + 32 * w + 31, 1, 0, 0x7fffffffu, qf, L_TBL, 0ull, false, m, l, acc, 0.f, 0, rfar, tid);
        acc_norm<4>(acc, l);
        if (c == 1) {
#pragma unroll
            for (int t = 0; t < 4; ++t)
#pragma unroll
                for (int gq = 0; gq < 4; ++gq) *(f32x4*)(prow + 32 * t + 8 * gq + 4 * hi) = (f32x4){acc[t][4 * gq], acc[t][4 * gq + 1], acc[t][4 * gq + 2], acc[t][4 * gq + 3]};
        }
    }
    float ss = 0.f;
#pragma unroll
    for (int t = 0; t < 4; ++t)
#pragma unroll
        for (int gq = 0; gq < 4; ++gq) { const f32x4 o1 = *(const f32x4*)(prow + 32 * t + 8 * gq + 4 * hi);
#pragma unroll
            for (int e = 0; e < 4; ++e) { const float y = acc[t][4 * gq + e] - lam * o1[e]; acc[t][4 * gq + e] = y; ss += y * y; } }
    ss += __shfl_xor(ss, 32);
    const float rs = (1.0f / sqrtf(ss * (1.f / 128.f) + EPS)) * (1.f - C.lam_init);
    bf16_t* yrow = C.ya + ((size_t)bl * 4096 + qpos) * 512 + h * 128;
#pragma unroll
    for (int t = 0; t < 4; ++t)
#pragma unroll
        for (int gq = 0; gq < 4; ++gq) {
            const int d = 32 * t + 8 * gq + 4 * hi;
            const f32x4 gg = *(const f32x4*)(C.subln + d);
            u32x2 wv; wv.x = cvtpk(acc[t][4 * gq] * rs * gg[0], acc[t][4 * gq + 1] * rs * gg[1]); wv.y = cvtpk(acc[t][4 * gq + 2] * rs * gg[2], acc[t][4 * gq + 3] * rs * gg[3]);
            *(u32x2*)(yrow + d) = wv;
        }
}

__device__ __forceinline__ void attn_unit_B(LAS uchar* lds, const AttnCtx& C, int bl, int g, int i, int tid) {
    tid = opq(tid);
    const int lane = tid & 63, n = lane & 31, hi = lane >> 5, w = __builtin_amdgcn_readfirstlane(tid >> 6);
    build_tbl(lds, C.rel_bias, 4 + 4 * g, 4, tid);
    const int ql = 8 * w + (n & 7), hr = n >> 3, qpos = 64 * i + ql, head = 4 * g + hr, qlo = 64 * i + 8 * w;
    const float rfar = C.rel_bias[31 * 20 + 4 + head] * LOG2E;
    const int tbl = L_TBL + hr * 512;
    bf16x8 qf[4];
    load_q(qf, C.zb + ZQB + ((size_t)bl * 8 + head) * HS + (size_t)qpos * 64, hi);
    const size_t goff = ((size_t)bl * 2 + g) * HS;
    f32x16 acc[2];
    LAS float* otl = (LAS float*)(lds + L_RED) + tid;
    float m, l;
    const size_t tok = (size_t)bl * 4096 + qpos;
    const float* bg = (const float*)(C.zb + ZBG) + tok * 32 + head * 3;
    const float g0 = bg[0], g1 = bg[1], g2 = bg[2];
    const bf16_t* Kc = C.kcmp + ((size_t)bl * 2 + g) * 256 * 64;
    const bf16_t* Vc = C.vtcmp + ((size_t)bl * 2 + g) * 64 * 256;
    const int ktc1 = ((4 * i + 2) >> 6) + 1;
    acc_zero<2>(acc); m = MINIT; l = 0.f;
    attn_pass<64, false>(lds, Kc, Vc, 256, 0, ktc1, 1 << 20, qpos, qlo, qlo + 7, 16, 31, 0x7fffffffu, qf, tbl, 0ull, false, m, l, acc, 0.f, 0, rfar, tid);
    acc_norm<2>(acc, l);
#pragma unroll
    for (int t = 0; t < 2; ++t)
#pragma unroll
        for (int r = 0; r < 16; ++r) otl[(t * 16 + r) * NTHR] = g0 * acc[t][r];
    unsigned long long selmask = ~0ull;
    if (i >= 16) {
    {
        const float lt = l + __shfl_xor(l, 32);
        const float inv_l = lt > 0.f ? 1.f / lt : 0.f;
        LAS float* impw = (LAS float*)(lds + L_IMP) + (8 * w) * 65;
        for (int x = lane; x < 8 * 65; x += 64) impw[x] = 0.f;
        __builtin_amdgcn_fence(__ATOMIC_RELEASE, "wavefront");
        attn_pass<64, true>(lds, Kc, Vc, 256, 0, ktc1, 1 << 20, qpos, qlo, qlo + 7, 16, 31, 0x7fffffffu, qf, tbl, 0ull, false, m, l, acc, inv_l, ql, rfar, tid);
    }
    {
        const int q = tid & 63, part = tid >> 6;
        const LAS float* row = (const LAS float*)(lds + L_IMP) + q * 65;
        float cand[8]; int rank[8];
#pragma unroll
        for (int c = 0; c < 8; ++c) { const int j = 8 * part + c; float v = row[j]; v = (j == 0 || j == i || j == i - 1) ? 1e6f : (j > i ? -1e6f : v); cand[c] = v; rank[c] = 0; }
        for (int jj = 0; jj <= i; ++jj) {
            float x = row[jj]; x = (jj == 0 || jj == i || jj == i - 1) ? 1e6f : (jj > i ? -1e6f : x);
#pragma unroll
            for (int c = 0; c < 8; ++c) { const int j = 8 * part + c; rank[c] += (x > cand[c] || (x == cand[c] && jj < j)) ? 1 : 0; }
        }
        unsigned bits = 0;
#pragma unroll
        for (int c = 0; c < 8; ++c) bits |= (rank[c] < 16 ? 1u : 0u) << c;
        ((LAS uchar*)(lds + L_SEL))[q * 8 + part] = (uchar)bits;
    }
    __syncthreads();
    { const u32x2 sm = *(const LAS u32x2*)(lds + L_SEL + ql * 8); selmask = (unsigned long long)sm.x | ((unsigned long long)sm.y << 32); }
    }
    acc_zero<2>(acc); m = MINIT; l = 0.f;
    attn_pass<64, false>(lds, C.zb + ZKS + goff, C.zb + ZVS + goff, 4096, 0, i + 1, 1 << 20, qpos, qlo, qlo + 7, 1, 0, 0x7fffffffu, qf, tbl, selmask, true, m, l, acc, 0.f, 0, rfar, tid);
    acc_norm<2>(acc, l);
#pragma unroll
    for (int t = 0; t < 2; ++t)
#pragma unroll
        for (int r = 0; r < 16; ++r) otl[(t * 16 + r) * NTHR] += g1 * acc[t][r];
    acc_zero<2>(acc); m = MINIT; l = 0.f;
    attn_pass<64, false>(lds, C.zb + ZKW + goff, C.zb + ZVW + goff, 4096, i > 8 ? i - 8 : 0, i + 1, 1 << 20, qpos, qlo, qlo + 7, 1, 0, 512u, qf, tbl, 0ull, false, m, l, acc, 0.f, 0, rfar, tid);
    acc_norm<2>(acc, l);
    bf16_t* yrow = C.yb + tok * 512 + head * 64;
#pragma unroll
    for (int t = 0; t < 2; ++t)
#pragma unroll
        for (int gq = 0; gq < 4; ++gq) {
            const int d = 32 * t + 8 * gq + 4 * hi;
            float o[4];
#pragma unroll
            for (int e = 0; e < 4; ++e) o[e] = otl[(t * 16 + 4 * gq + e) * NTHR] + g2 * acc[t][4 * gq + e];
            u32x2 wv; wv.x = cvtpk(o[0], o[1]); wv.y = cvtpk(o[2], o[3]);
            *(u32x2*)(yrow + d) = wv;
        }
}

__device__ __forceinline__ void attn_unit_C(LAS uchar* lds, const AttnCtx& C, int bl, int g, int i, int tid) {
    tid = opq(tid);
    const int lane = tid & 63, n = lane & 31, hi = lane >> 5, w = __builtin_amdgcn_readfirstlane(tid >> 6);
    build_tbl(lds, C.rel_bias, 12 + 4 * g, 4, tid);
    const int ql = 8 * w + (n & 7), hr = n >> 3, qpos = 64 * i + ql, head = 4 * g + hr, qlo = 64 * i + 8 * w;
    const float rfar = C.rel_bias[31 * 20 + 12 + head] * LOG2E;
    const int tbl = L_TBL + hr * 512;
    bf16x8 qf[4];
    load_q(qf, C.zb + ZQC + ((size_t)bl * 8 + head) * HS + (size_t)qpos * 64, hi);
    const size_t goff = ((size_t)bl * 2 + g) * HS;
    f32x16 acc[2];
    acc_zero<2>(acc);
    float m = C.sinks[head] * LOG2E, l = hi == 0 ? 1.f : 0.f;
    attn_pass<64, false>(lds, C.zb + ZKC + goff, C.zb + ZVC + goff, 4096, i > 2 ? i - 2 : 0, i + 1, 1 << 20, qpos, qlo, qlo + 7, 1, 0, 128u, qf, tbl, 0ull, false, m, l, acc, 0.f, 0, rfar, tid);
    acc_norm<2>(acc, l);
    const size_t tok = (size_t)bl * 4096 + qpos;
    bf16_t* yrow = C.yc + tok * 512 + head * 64;
#pragma unroll
    for (int t = 0; t < 2; ++t)
#pragma unroll
        for (int gq = 0; gq < 4; ++gq) {
            const int d = 32 * t + 8 * gq + 4 * hi;
            u32x2 wv; wv.x = cvtpk(acc[t][4 * gq], acc[t][4 * gq + 1]); wv.y = cvtpk(acc[t][4 * gq + 2], acc[t][4 * gq + 3]);
            *(u32x2*)(yrow + d) = wv;
        }
}

#define XB_TMO      128
#define XB_XCNT(j)  (256  + 64 * (j))
#define XB_XSUB(j)  (1280 + 64 * (j))
#define XB_XGEN(j)  (2304 + 64 * (j))
#define XB_TOP      3328
#define XB_TOPGEN   3392
#define XCD_BAR_WORDS 3456
#define XB_SPIN_CAP (1u << 18)

__device__ __forceinline__ unsigned xb_ld(unsigned* p)              { return __hip_atomic_load(p, __ATOMIC_RELAXED, __HIP_MEMORY_SCOPE_AGENT); }
__device__ __forceinline__ unsigned xb_add(unsigned* p, unsigned v) { return __hip_atomic_fetch_add(p, v, __ATOMIC_RELAXED, __HIP_MEMORY_SCOPE_AGENT); }
__device__ __forceinline__ unsigned xb_xcc_id() { return (unsigned)__builtin_amdgcn_s_getreg((3 << 11) | 20) & 0xFu; }
#define XB_SPIN(cond, bar) do { unsigned _sp = 0; while (cond) { __builtin_amdgcn_s_sleep(1); \
    if ((++_sp & 255u) == 0u) { if (xb_ld(&(bar)[XB_TMO])) break; if (_sp > XB_SPIN_CAP) { atomicAdd(&(bar)[XB_TMO], 1u); break; } } } } while (0)

struct XcdBarrier {
    unsigned* bar; unsigned x;
    volatile __attribute__((address_space(3))) unsigned* st;
};

__device__ __forceinline__ XcdBarrier xcd_barrier_post(unsigned* bar, volatile __attribute__((address_space(3))) unsigned* st) {
    XcdBarrier b; b.bar = bar; b.x = xb_xcc_id(); b.st = st;
    if (threadIdx.x == 0) (void)xb_add(&bar[XB_XCNT(b.x)], 1u);
    return b;
}
__device__ __forceinline__ void xcd_barrier_complete(unsigned* bar, unsigned x, unsigned& nloc, unsigned& nx) {
    const unsigned G = gridDim.x * gridDim.y * gridDim.z;
    unsigned sum, cnt, mine, sp = 0u;
    for (;;) {
        sum = 0u; cnt = 0u; mine = 0u;
#pragma unroll
        for (unsigned j = 0; j < 16; ++j) { const unsigned c = xb_ld(&bar[XB_XCNT(j)]); sum += c; cnt += (c > 0u) ? 1u : 0u; mine = (j == x) ? c : mine; }
        if (sum == G) break;
        __builtin_amdgcn_s_sleep(1);
        if ((++sp & 255u) == 0u) { if (xb_ld(&bar[XB_TMO])) break; if (sp > XB_SPIN_CAP) { atomicAdd(&bar[XB_TMO], 1u); break; } }
    }
    nloc = mine > 0u ? mine : 1u; nx = cnt > 0u ? cnt : 1u;
}

__device__ __forceinline__ void xcd_barrier(const XcdBarrier& b) {
    asm volatile("s_waitcnt vmcnt(0)" ::: "memory");
    __syncthreads();
    if (threadIdx.x == 0) {
        unsigned* bar = b.bar;
        __builtin_amdgcn_s_waitcnt(0);
        unsigned nloc = b.st[0], nx = b.st[1];
        if (nloc == 0u) { xcd_barrier_complete(bar, b.x, nloc, nx); b.st[0] = nloc; b.st[1] = nx; }
        const unsigned old = xb_add(&bar[XB_XSUB(b.x)], 1u);
        const unsigned gen = old / nloc;
        if (old + 1u == (gen + 1u) * nloc) {
            __builtin_amdgcn_fence(__ATOMIC_RELEASE, "agent");
            asm volatile("s_waitcnt vmcnt(0)" ::: "memory");
            const unsigned og = xb_add(&bar[XB_TOP], 1u);
            const unsigned tg = og / nx;
            if (og + 1u == (tg + 1u) * nx) xb_add(&bar[XB_TOPGEN], 1u);
            else XB_SPIN(xb_ld(&bar[XB_TOPGEN]) == tg, bar);
            __builtin_amdgcn_fence(__ATOMIC_ACQUIRE, "agent");
            xb_add(&bar[XB_XGEN(b.x)], 1u);
            asm volatile("s_waitcnt vmcnt(0)" ::: "memory");
        } else {
            XB_SPIN(xb_ld(&bar[XB_XGEN(b.x)]) == gen, bar);
            __builtin_amdgcn_fence(__ATOMIC_ACQUIRE, "agent");
            asm volatile("s_waitcnt vmcnt(0)" ::: "memory");
        }
    }
    __syncthreads();
}

#define KIN(i) (kparams()->in[i])
#define WS_ (kparams()->ws)
#define HOUT (kparams()->out)
#define Wb ((bf16_t*)(WS_ + WS_W))
#define XN ((bf16_t*)(WS_ + WS_XN))
#define R1 ((bf16_t*)(WS_ + WS_R1))
#define YA ((bf16_t*)(WS_ + WS_Y))
#define MG ((bf16_t*)(WS_ + WS_MG))
#define CH ((bf16_t*)(WS_ + WS_CH))
#define KCMP ((bf16_t*)(WS_ + WS_KCMP))
#define VCMP ((bf16_t*)(WS_ + WS_VCMP))
#define CB ((float*)(WS_ + WS_CB))
#define XN2 ((bf16_t*)(WS_ + WS_XN2))
#define PBF ((bf16_t*)(WS_ + WS_PBF))
#define SSQ ((float*)(WS_ + WS_SSQ))
#define SSQ2 ((float*)(WS_ + WS_SSQ2))
constexpr int LDS_BYTES = 147456;
#ifdef ONLY_EPI
#include <type_traits>
#define ONLY_OK(E) (std::is_same<E, ONLY_EPI>::value)
#else
#define ONLY_OK(E) true
#endif
#ifdef NO_GEMM
#define GEMM(EPI, e, A_, lda_, Bt_, M_, N_, K_, cshift) do { (void)(e); } while (0)
#else
#define GEMM(EPI, e, A_, lda_, Bt_, M_, N_, K_, cshift) do { pg8::Gemm g_{(const bf16_t*)(A_), (const bf16_t*)(Bt_), (M_), (N_), (K_), (lda_)}; pg8::StaticOrder S_; \
    int c_ = (int)((blk + (cshift)) % G), G_ = G; asm volatile("" : "+s"(c_), "+s"(G_)); S_.init((M_), (N_), G_, c_); if (ONLY_OK(EPI)) pg8::gemm_phase<EPI, pg8::StaticOrder, EPI::ALIGN, true>(lds, g_, S_, (e)); } while (0)
#endif
#ifdef NO_GEMM
#define GEMM_X(EPI, e, A_, lda_, Bt_, M_, N_, K_, cidx, gsz) do { (void)(e); } while (0)
#else
#define GEMM_X(EPI, e, A_, lda_, Bt_, M_, N_, K_, cidx, gsz) do { pg8::Gemm g_{(const bf16_t*)(A_), (const bf16_t*)(Bt_), (M_), (N_), (K_), (lda_)}; pg8::StaticOrder S_; \
    int c_ = (int)(cidx), G_ = (int)(gsz); asm volatile("" : "+s"(c_), "+s"(G_)); S_.init((M_), (N_), G_, c_); if (ONLY_OK(EPI)) pg8::gemm_phase<EPI, pg8::StaticOrder, EPI::ALIGN, true>(lds, g_, S_, (e)); } while (0)
#endif

__global__ void __launch_bounds__(NTHR, 2) fwd_kernel(Params P) {
    extern __shared__ __attribute__((aligned(16))) unsigned char lds_raw[];
    LAS uchar* lds = (LAS uchar*)lds_raw;
    cg::grid_group grid = cg::this_grid();
    volatile LAS unsigned* xst = (volatile LAS unsigned*)(lds + LDS_BYTES - 64);
    if (threadIdx.x < 2) xst[threadIdx.x] = 0u;
    __syncthreads();
    const XcdBarrier xbar = xcd_barrier_post((unsigned*)(kparams()->ws + WS_CTL), xst);
#ifndef PROBE_CLASS
#define PROBE_CLASS 0
#endif
#if PROBE_CLASS
    unsigned long long pr_acc = 0, pr_last = __builtin_amdgcn_s_memrealtime();
#define SYNC(cls) do { const unsigned long long t1_ = __builtin_amdgcn_s_memrealtime(); if ((cls) == PROBE_CLASS) pr_acc += t1_ - pr_last; if ((cls) == 6) grid.sync(); else xcd_barrier(xbar); \
    const unsigned long long t2_ = __builtin_amdgcn_s_memrealtime(); if (PROBE_CLASS == 2) pr_acc += t2_ - t1_; pr_last = t2_; } while (0)
#else
#define SYNC(cls) do { if ((cls) == 6) grid.sync(); else xcd_barrier(xbar); } while (0)
#endif
#define DEF_IDS \
    int tid_o = threadIdx.x, G_o = gridDim.x, blk_o = blockIdx.x; asm volatile("" : "+v"(tid_o), "+s"(G_o), "+s"(blk_o)); \
    const int tid = tid_o, lane = tid & 63, wave = __builtin_amdgcn_readfirstlane(tid >> 6); \
    const int G = G_o, blk = blk_o; \
    const int vcu = (G % 8 == 0) ? (blk % 8) * (G / 8) + blk / 8 : blk; \
    const int gw = blk * 8 + wave, ngw = G * 8; (void)vcu; (void)gw; (void)ngw; (void)lane;
    {
        DEF_IDS
        LAS float* scr = (LAS float*)lds;
        int base = 0;
        for (int L = 0; L < DEPTH; ++L) {
            bf16_t* wl = Wb + (size_t)L * W_LAYER;
            conv_matrix(KIN(3) + (size_t)L * 1024 * 5632, 1024, 5632, 5632, 1, wl + W_WI1, base, scr, tid, blk, G, KIN(2) + (size_t)(L * 4 + 0) * DM);
            conv_matrix(KIN(4) + (size_t)L * 2816 * 1024, 2816, 1024, 1024, 0, wl + W_WO1, base, scr, tid, blk, G);
            conv_matrix(KIN(5) + (size_t)L * 1024 * DIN, 1024, DIN, DINP, 2, wl + W_WIN, base, scr, tid, blk, G, KIN(2) + (size_t)(L * 4 + 1) * DM);
            for (int t = 0; t < 2; ++t) conv_matrix(KIN(9) + ((size_t)L * 2 + t) * 2048 * 256, 2048, 256, 256, 0, wl + W_CW1 + (size_t)t * 256 * 2048, base, scr, tid, blk, G);
            for (int t = 0; t < 2; ++t) conv_matrix(KIN(10) + ((size_t)L * 2 + t) * 256 * 64, 256, 64, 256, 3, wl + W_CW2 + (size_t)t * 256 * 256, base, scr, tid, blk, G);
            for (int t = 0; t < 3; ++t) conv_matrix(KIN(12) + ((size_t)L * 3 + t) * 512 * 1024, 512, 1024, 1024, 0, wl + W_WBR + (size_t)t * 1024 * 512, base, scr, tid, blk, G);
            conv_matrix(KIN(13) + (size_t)L * 1024 * 1024, 1024, 1024, 1024, 0, wl + W_WOUT, base, scr, tid, blk, G);
            conv_matrix(KIN(14) + (size_t)L * 1024 * 5632, 1024, 5632, 5632, 1, wl + W_WI2, base, scr, tid, blk, G, KIN(2) + (size_t)(L * 4 + 2) * DM);
            conv_matrix(KIN(15) + (size_t)L * 2816 * 1024, 2816, 1024, 1024, 0, wl + W_WO2, base, scr, tid, blk, G);
            conv_matrix(KIN(16) + (size_t)L * 256 * 1024, 256, 1024, 1024, 0, wl + W_WPE, base, scr, tid, blk, G);
            conv_matrix(KIN(17) + (size_t)L * 1024 * 1024, 1024, 1024, 1024, 0, wl + W_WPG, base, scr, tid, blk, G, KIN(2) + (size_t)(L * 4 + 3) * DM);
        }
        for (int pr = blk; pr < DEPTH * 2; pr += G) {
            const float* pos = KIN(8) + (size_t)pr * 2048; const float* w1 = KIN(9) + (size_t)pr * 2048 * 256;
            float a[4] = {0.f, 0.f, 0.f, 0.f};
            for (int k = wave * 256; k < wave * 256 + 256; ++k) { const float pv = pos[k];
#pragma unroll
                for (int j = 0; j < 4; ++j) a[j] += pv * w1[(size_t)k * 256 + lane + 64 * j]; }
#pragma unroll
            for (int j = 0; j < 4; ++j) scr[wave * 256 + lane + 64 * j] = a[j];
            __syncthreads();
            if (tid < 256) { float s = 0.f;
#pragma unroll
                for (int ww = 0; ww < 8; ++ww) s += scr[ww * 256 + tid];
                CB[pr * 256 + tid] = s; }
            __syncthreads();
        }
        phase_prep(KIN(0), XN2, SSQ2, gw, ngw, lane);
    }
    SYNC(6);

#pragma unroll 1
    for (int L = 0; L < DEPTH; ++L) {
        DEF_IDS
#define wl (Wb + (size_t)L * W_LAYER)
#define ng (KIN(2) + (size_t)L * 4 * DM)
        { EpiSwiglu e{R1, SSQ2}; GEMM(EpiSwiglu, e, XN2, 1024, wl + W_WI1, T, 5632, 1024, 0); }
        SYNC(3);
        { EpiResid e{0.5f, 0, L == 0 ? 0 : 1}; GEMM(EpiResid, e, R1, DFF, wl + W_WO1, T, 1024, DFF, 0); }
        SYNC(3);
        {
            const f32x4* src = (const f32x4*)(KIN(1) + (size_t)L * T * PLE); u32x2* dst = (u32x2*)PBF;
            const int tq = opq(tid);
            for (size_t idx = (size_t)blk * NTHR + tq; idx < (size_t)T * PLE / 4; idx += (size_t)G * NTHR) { const f32x4 v = src[idx]; u32x2 w; w.x = cvtpk(v[0], v[1]); w.y = cvtpk(v[2], v[3]); dst[idx] = w; }
        }
        { EpiZ e{R1, SSQ, 0}; GEMM(EpiZ, e, XN, 1024, wl + W_WIN, TC, DINP - 256, 1024, 0); }
        SYNC(3);
        for (int c = 0; c < NCHUNK; ++c) {
            {
                const bool offl = (G >= 64) && ((G & 1) == 0), has_cmp = blk < 16 || (blk >= G / 2 && blk < G / 2 + 16);
                EpiZ e{R1, SSQ + (size_t)c * TC * 16, 26};
                if (!offl) GEMM(EpiZ, e, XN + (size_t)c * TC * DM, 1024, wl + W_WIN + (size_t)(DINP - 256) * 1024, TC, 256, 1024, 0);
                else if (!has_cmp) GEMM_X(EpiZ, e, XN + (size_t)c * TC * DM, 1024, wl + W_WIN + (size_t)(DINP - 256) * 1024, TC, 256, 1024, blk < G / 2 ? blk - 16 : blk - 32, G - 32);
                EpiBf<0> ee{(bf16_t*)HOUT + (size_t)c * TC * DM, 1024, nullptr};
                if (!offl) GEMM(EpiBf<0>, ee, PBF + (size_t)c * TC * PLE, 256, wl + W_WPE, TC, 1024, 256, 0);
                else if (!has_cmp) GEMM_X(EpiBf<0>, ee, PBF + (size_t)c * TC * PLE, 256, wl + W_WPE, TC, 1024, 256, blk < G / 2 ? blk - 16 : blk - 32, G - 32);
            }
            { EpiBf<1> ek{CH, 256, CB + (L * 2 + 0) * 256}; GEMM(EpiBf<1>, ek, R1 + ZKCI, 1024, wl + W_CW1, NB * 512, 256, 2048, 0);
              EpiBf<1> ev{CH + (size_t)NB * 512 * 256, 256, CB + (L * 2 + 1) * 256}; GEMM(EpiBf<1>, ev, R1 + ZVCI, 1024, wl + W_CW1 + (size_t)256 * 2048, NB * 512, 256, 2048, G / 2); }
            __builtin_amdgcn_fence(__ATOMIC_RELEASE, "workgroup"); __syncthreads(); __builtin_amdgcn_fence(__ATOMIC_ACQUIRE, "workgroup");
            { EpiCmp2<false> ek{KCMP}; GEMM(EpiCmp2<false>, ek, CH, 256, wl + W_CW2, NB * 512, 256, 256, 0);
              EpiCmp2<true> ev{VCMP}; GEMM(EpiCmp2<true>, ev, CH + (size_t)NB * 512 * 256, 256, wl + W_CW2 + (size_t)256 * 256, NB * 512, 256, 256, G / 2); }
            SYNC(5);
            {
                AttnCtx C;
                C.zb = R1; C.park = (float*)MG; C.ya = YA; C.yb = YA + (size_t)TC * 512; C.yc = YA + (size_t)2 * TC * 512; C.kcmp = KCMP; C.vtcmp = VCMP;
                C.rel_bias = KIN(18); C.lamp = KIN(6) + (size_t)L * 256; C.subln = KIN(7) + (size_t)L * 128; C.sinks = KIN(11) + (size_t)L * 8;
                C.lam_init = 0.8f - 0.6f * __expf(-0.3f * (float)L);
                for (int u = vcu; u < NB * 32; u += G) {
                    const int bl = u >> 5;
#ifndef NO_A
#if PROBE_CLASS == 7
                    const unsigned long long ta0_ = __builtin_amdgcn_s_memrealtime();
#endif
                    { const int h = (u >> 3) & 3, qp = u & 7;
#pragma unroll 1
                      for (int k = 0; k < 2; ++k) attn_unit_A(lds, C, bl, h, k ? 15 - qp : qp, tid); }
#if PROBE_CLASS == 7
                    pr_acc += __builtin_amdgcn_s_memrealtime() - ta0_;
#endif
#endif
                    { const int g = (u >> 4) & 1, is = u & 15;
#ifndef NO_B
#pragma unroll 1
                      for (int k = 0; k < 4; ++k) attn_unit_B(lds, C, bl, g, (k & 1) ? (k == 1 ? 31 : 63) - is : (k == 0 ? 0 : 32) + is, tid);
#endif
#ifndef NO_C
#pragma unroll 1
                      for (int k = 0; k < 4; ++k) attn_unit_C(lds, C, bl, g, (k & 1) ? (k == 1 ? 31 : 63) - is : (k == 0 ? 0 : 32) + is, tid);
#endif
                    }
                }
            }
            SYNC(1);
            for (int mi = 0; mi < 3; ++mi) {
                EpiBranch e{MG, R1 + ZSG, mi}; GEMM(EpiBranch, e, YA + (size_t)mi * TC * 512, 512, wl + W_WBR + (size_t)mi * 1024 * 512, TC, 1024, 512, 0);
            }
            SYNC(3);
            { EpiResid e{1.0f, c * TC, 2}; GEMM(EpiResid, e, MG, 1024, wl + W_WOUT, TC, 1024, 1024, 0); }
            if (c + 1 < NCHUNK) { EpiZ e{R1, SSQ + (size_t)(c + 1) * TC * 16, 0}; GEMM(EpiZ, e, XN + (size_t)(c + 1) * TC * DM, 1024, wl + W_WIN, TC, DINP - 256, 1024, 0); }
            SYNC(3);
        }
        { EpiSwiglu e{R1, SSQ}; GEMM(EpiSwiglu, e, XN, 1024, wl + W_WI2, T, 5632, 1024, 0); }
        SYNC(3);
        { EpiResid e{0.5f, 0, 2}; GEMM(EpiResid, e, R1, DFF, wl + W_WO2, T, 1024, DFF, 0); }
        SYNC(3);
        { uchar* ws_ = WS_; EpiPle e{(const bf16_t*)(ws_ + WS_XN), (const bf16_t*)HOUT, (const float*)(ws_ + WS_SSQ), (bf16_t*)(ws_ + WS_XN2), (float*)(ws_ + WS_SSQ2)}; GEMM(EpiPle, e, XN, 1024, wl + W_WPG, T, 1024, 1024, 0); }
        SYNC(3);
    }
    { DEF_IDS const int lq = opq(lane); float* ho = HOUT; const float* fg = KIN(19); const bf16_t* hb = XN2; for (int m = gw; m < T; m += ngw) rms_row_bf16in_f32(hb + (size_t)m * DM, fg, ho + (size_t)m * DM, lq); }
#if PROBE_CLASS
    if (blockIdx.x == 0) { const unsigned long long t0_ = __builtin_amdgcn_s_memrealtime(); while (__builtin_amdgcn_s_memrealtime() - t0_ < pr_acc) __builtin_amdgcn_s_sleep(20); }
#endif
}

extern "C" void kernel_launch(void* const* d_in, const int* in_sizes, int n_in, void* d_out, int out_size, void* d_ws, size_t ws_size, hipStream_t stream) {
    static int grid = 0;
    if (grid == 0) {
        if (n_in != 20 || out_size != T * DM || ws_size < WS_END) { fprintf(stderr, "kernel_launch: unexpected shapes (n_in %d out %d ws %zu)\n", n_in, out_size, ws_size); grid = -1; return; }
        int dev = 0, cus = 0, per_cu = 0;
        hipGetDevice(&dev);
        hipDeviceGetAttribute(&cus, hipDeviceAttributeMultiprocessorCount, dev);
        if (hipFuncSetAttribute((const void*)fwd_kernel, hipFuncAttributeMaxDynamicSharedMemorySize, LDS_BYTES) != hipSuccess) { fprintf(stderr, "kernel_launch: hipFuncSetAttribute failed\n"); grid = -1; return; }
        if (hipOccupancyMaxActiveBlocksPerMultiprocessor(&per_cu, (const void*)fwd_kernel, NTHR, LDS_BYTES) != hipSuccess || per_cu < 1) { fprintf(stderr, "kernel_launch: occupancy query says %d\n", per_cu); per_cu = 1; }
        (void)hipGetLastError();
        grid = cus;
        if (grid > 256) grid = 256;
    }
    if (grid < 0) return;
    if (hipMemsetAsync((char*)d_ws + WS_CTL, 0, CTL_ZERO_BYTES, stream) != hipSuccess) { fprintf(stderr, "kernel_launch: memset failed\n"); return; }
    Params p{};
    for (int i = 0; i < 20; ++i) p.in[i] = (const float*)d_in[i];
    p.out = (float*)d_out; p.ws = (uchar*)d_ws;
    void* args[] = {&p};
    hipError_t e = hipLaunchCooperativeKernel((const void*)fwd_kernel, dim3(grid), dim3(NTHR), args, LDS_BYTES, stream);
    if (e != hipSuccess) fprintf(stderr, "cooperative launch failed: %s (grid %d)\n", hipGetErrorString(e), grid);
}
```

```cpp
#include <hip/hip_runtime.h>
#include <hip/hip_cooperative_groups.h>
#include <cstdio>
#include <cstdint>
namespace cg = cooperative_groups;
namespace pg8 {
#define PG8_LAS __attribute__((address_space(3)))
typedef unsigned short bf16_t;
typedef short bf16x8 __attribute__((ext_vector_type(8)));
typedef float f32x4 __attribute__((ext_vector_type(4)));
typedef unsigned u32x4 __attribute__((ext_vector_type(4)));
constexpr int BM = 256, BK = 64, HALF = 128, HTB = HALF * BK * 2  , STAGE_BYTES = 8 * HTB, NXCD = 8, WGM = 4;

__host__ __device__ __forceinline__ int lds_byte(int r, int c) { const int st = (r >> 4) * 2 + (c >> 5), rr = r & 15, cc = c & 31, ob = rr * 64 + cc * 2; return st * 1024 + (ob ^ (((ob >> 9) & 1) << 5)); }
__host__ __device__ __forceinline__ void stage_rc(int b, int& R, int& C) { const int st = b / 1024, sb = b % 1024, swz = sb ^ (((sb >> 9) & 1) << 5); R = (st >> 1) * 16 + swz / 64; C = (st & 1) * 32 + (swz % 64) / 2; }
__host__ __device__ __forceinline__ int perm32(int rho) { const int n = rho >> 4, i = rho & 15; return 8 * (i >> 2) + 4 * n + (i & 3); }

struct Unit { int pm, pn; };
struct Gemm { const bf16_t* A; const bf16_t* Bt; int M, N, K, lda; };

struct StaticOrder {
    int nM, nN, nwg, G, c;
    __host__ __device__ void init(int M, int N, int G_, int c_) { nM = M / BM; nN = N / BM; nwg = nM * nN; G = G_; c = c_; }
    __host__ __device__ bool next(int i, Unit& u) const {
        const long L = (long)i * G + c; if (L >= nwg) return false;
        int wgid = (int)L; { const int q = nwg / NXCD, r = nwg % NXCD, xcd = wgid % NXCD, off = wgid / NXCD; wgid = (xcd < r ? xcd * (q + 1) : r * (q + 1) + (xcd - r) * q) + off; }
        const int nig = WGM * nN, gid = wgid / nig, fm = gid * WGM, gsz = (nM - fm) < WGM ? (nM - fm) : WGM;
        u.pm = fm + ((wgid % nig) % gsz); u.pn = (wgid % nig) / gsz; return true;
    }
    __device__ __forceinline__ void a_ready(const Unit&) const {}
    __device__ __forceinline__ void done(const Unit&) const {}
};

__device__ __forceinline__ unsigned cvt_pk_bf16(float lo, float hi) { unsigned r; asm volatile("v_cvt_pk_bf16_f32 %0, %1, %2" : "=v"(r) : "v"(lo), "v"(hi)); return r; }
typedef float f32x2 __attribute__((ext_vector_type(2)));
template <class Epi, class Sched, bool ALIGN_EPI = false, bool SP2 = false>
__device__ __forceinline__ void gemm_phase(PG8_LAS unsigned char* lds, const Gemm g, const Sched& S, const Epi& E) {
    int tid_ = threadIdx.x; asm volatile("" : "+v"(tid_)); const int tid = tid_, wid = __builtin_amdgcn_readfirstlane(tid >> 6), lane = tid & 63, wr = wid >> 2, wc = wid & 3, fr = lane & 15, fq = lane >> 4;
    const int K = g.K, nt = K / BK;
    unsigned voffA[2], voffB[2];
#pragma unroll
    for (int i = 0; i < 2; ++i) { int R, C; stage_rc(tid * 16 + i * 8192, R, C); const int Rb = Epi::PERM ? ((R & ~31) + perm32(R & 31)) : R;
        voffA[i] = (unsigned)(R * g.lda + C) * 2u; voffB[i] = (unsigned)(Rb * K + C) * 2u; }
    const size_t kstep = (size_t)(BK * 2);
    const size_t hstep = (size_t)HALF * K * 2;
    const size_t tstep = 2 * hstep; const size_t hstepA = (size_t)HALF * g.lda * 2, tstepA = 2 * hstepA;
    const unsigned ldsw = (unsigned)wid * 1024u;
    const int aoff = lds_byte(wr * 64 + fr, fq * 8), boff = lds_byte(wc * 32 + fr, fq * 8);
#define PG8_SA(b, h) (((b) * 2 + (h)) * HTB)
#define PG8_SB(b, h) ((4 + (b) * 2 + (h)) * HTB)
#define PG8_STAGE(bufoff, gbase, voff) do { _Pragma("unroll") for (int _i = 0; _i < 2; ++_i) \
        __builtin_amdgcn_global_load_lds((const unsigned*)((const char*)(gbase) + (voff)[_i]), (PG8_LAS unsigned*)(lds + (bufoff) + ldsw + _i * 8192), 16, 0, 0); } while (0)
#define PG8_LDA(dst, b, h) do { _Pragma("unroll") for (int m = 0; m < 4; ++m) _Pragma("unroll") for (int k = 0; k < 2; ++k) dst[m][k] = *(const PG8_LAS bf16x8*)(lds + PG8_SA(b, h) + aoff + m * 2048 + k * 1024); } while (0)
#define PG8_LDB(dst, b, h) do { _Pragma("unroll") for (int n = 0; n < 2; ++n) _Pragma("unroll") for (int k = 0; k < 2; ++k) dst[n][k] = *(const PG8_LAS bf16x8*)(lds + PG8_SB(b, h) + boff + n * 2048 + k * 1024); } while (0)
#define PG8_MMA(ai, bj, At, Bt) do { __builtin_amdgcn_s_setprio(1); _Pragma("unroll") for (int m = 0; m < 4; ++m) _Pragma("unroll") for (int n = 0; n < 2; ++n) _Pragma("unroll") for (int k = 0; k < 2; ++k) \
        acc[ai][bj][m][n] = __builtin_amdgcn_mfma_f32_16x16x32_bf16(Bt[n][k], At[m][k], acc[ai][bj][m][n], 0, 0, 0); __builtin_amdgcn_s_setprio(0); } while (0)
#define PG8_WAIT_V(n) asm volatile("s_waitcnt vmcnt(" #n ")" ::: "memory")
#define PG8_WAIT_L(n) asm volatile("s_waitcnt lgkmcnt(" #n ")" ::: "memory")
#define PG8_BAR __builtin_amdgcn_s_barrier()
#define PG8_SCHED __builtin_amdgcn_sched_barrier(0)
    Unit cur, nxt; int ui = 0;
    if (!S.next(0, cur)) return;
    f32x4 acc[2][2][4][2];
#pragma unroll
    for (int a = 0; a < 2; ++a)
#pragma unroll
        for (int b = 0; b < 2; ++b)
#pragma unroll
            for (int m = 0; m < 4; ++m)
#pragma unroll
                for (int n = 0; n < 2; ++n) acc[a][b][m][n] = (f32x4){0.f, 0.f, 0.f, 0.f};
    bf16x8 At[4][2], B0[2][2], B1[2][2];
    const char* cA = (const char*)g.A + (size_t)cur.pm * tstepA; const char* cB = (const char*)g.Bt + (size_t)cur.pn * tstep;
    S.a_ready(cur);
    if constexpr (SP2) {
        PG8_STAGE(PG8_SB(0, 0), cB, voffB); PG8_STAGE(PG8_SB(0, 1), cB + hstep, voffB); PG8_STAGE(PG8_SA(0, 0), cA, voffA); PG8_STAGE(PG8_SA(0, 1), cA + hstepA, voffA);
        if (wr == 1) PG8_BAR;
        PG8_WAIT_V(2); PG8_BAR;
        PG8_STAGE(PG8_SB(1, 0), cB + kstep, voffB); PG8_STAGE(PG8_SA(1, 0), cA + kstep, voffA); PG8_STAGE(PG8_SB(1, 1), cB + hstep + kstep, voffB);
        PG8_WAIT_V(6); PG8_BAR;
    } else {
        PG8_STAGE(PG8_SB(0, 0), cB, voffB); PG8_STAGE(PG8_SA(0, 0), cA, voffA); PG8_STAGE(PG8_SB(0, 1), cB + hstep, voffB); PG8_STAGE(PG8_SA(0, 1), cA + hstepA, voffA);
        if (wr == 1) PG8_BAR;
        PG8_WAIT_V(4); PG8_BAR;
        PG8_STAGE(PG8_SB(1, 0), cB + kstep, voffB); PG8_STAGE(PG8_SA(1, 0), cA + kstep, voffA); PG8_STAGE(PG8_SB(1, 1), cB + hstep + kstep, voffB);
        PG8_WAIT_V(6); PG8_BAR;
    }
    for (;;) {
        const bool has_next = S.next(ui + 1, nxt);
        const char* nA = has_next ? (const char*)g.A + (size_t)nxt.pm * tstepA : cA; const char* nB = has_next ? (const char*)g.Bt + (size_t)nxt.pn * tstep : cB;
        for (int t = 0; t < nt; t += 2) {
            const bool last = (t == nt - 2);
            const char* a1 = cA + (size_t)(t + 1) * kstep;
            const char* a2 = last ? nA : cA + (size_t)(t + 2) * kstep; const char* b2 = last ? nB : cB + (size_t)(t + 2) * kstep;
            const char* a3 = a2 + kstep; const char* b3 = b2 + kstep;
            if (last && has_next) S.a_ready(nxt);
            if constexpr (SP2) {
            PG8_LDB(B0, 0, 0); PG8_LDB(B1, 0, 1); PG8_SCHED; PG8_LDA(At, 0, 0); PG8_STAGE(PG8_SA(1, 1), a1 + hstepA, voffA);
            PG8_WAIT_V(8); PG8_WAIT_L(0); PG8_BAR; PG8_MMA(0, 0, At, B0); PG8_MMA(0, 1, At, B1); PG8_BAR; PG8_SCHED;
            PG8_LDA(At, 0, 1); PG8_STAGE(PG8_SB(0, 0), b2, voffB); PG8_STAGE(PG8_SB(0, 1), b2 + hstep, voffB); PG8_STAGE(PG8_SA(0, 0), a2, voffA);
            PG8_WAIT_V(8); PG8_WAIT_L(0); PG8_BAR; PG8_MMA(1, 0, At, B0); PG8_MMA(1, 1, At, B1); PG8_BAR; PG8_SCHED;
            PG8_LDB(B0, 1, 0); PG8_LDB(B1, 1, 1); PG8_SCHED; PG8_LDA(At, 1, 0); PG8_STAGE(PG8_SA(0, 1), a2 + hstepA, voffA);
            PG8_WAIT_V(8); PG8_WAIT_L(0); PG8_BAR; PG8_MMA(0, 0, At, B0); PG8_MMA(0, 1, At, B1); PG8_BAR; PG8_SCHED;
            PG8_LDA(At, 1, 1); PG8_STAGE(PG8_SB(1, 0), b3, voffB); PG8_STAGE(PG8_SB(1, 1), b3 + hstep, voffB); PG8_STAGE(PG8_SA(1, 0), a3, voffA);
            PG8_WAIT_V(8); PG8_WAIT_L(0); PG8_BAR; PG8_MMA(1, 0, At, B0); PG8_MMA(1, 1, At, B1); PG8_BAR; PG8_SCHED;
            } else {
            PG8_LDB(B0, 0, 0); PG8_SCHED; PG8_LDA(At, 0, 0); PG8_STAGE(PG8_SA(1, 1), a1 + hstepA, voffA);
            PG8_WAIT_L(8); PG8_BAR; PG8_WAIT_L(0); PG8_MMA(0, 0, At, B0); PG8_BAR; PG8_SCHED;
            PG8_LDB(B1, 0, 1); PG8_STAGE(PG8_SB(0, 0), b2, voffB);
            PG8_BAR; PG8_WAIT_L(0); PG8_MMA(0, 1, At, B1); PG8_BAR;
            PG8_LDA(At, 0, 1); PG8_STAGE(PG8_SA(0, 0), a2, voffA);
            PG8_BAR; PG8_WAIT_L(0); PG8_MMA(1, 0, At, B0); PG8_BAR; PG8_SCHED;
            PG8_STAGE(PG8_SB(0, 1), b2 + hstep, voffB);
            PG8_WAIT_V(6); PG8_BAR; PG8_MMA(1, 1, At, B1); PG8_BAR;
            PG8_LDB(B0, 1, 0); PG8_SCHED; PG8_LDA(At, 1, 0); PG8_STAGE(PG8_SA(0, 1), a2 + hstepA, voffA);
            PG8_WAIT_L(8); PG8_BAR; PG8_WAIT_L(0); PG8_MMA(0, 0, At, B0); PG8_BAR; PG8_SCHED;
            PG8_LDB(B1, 1, 1); PG8_STAGE(PG8_SB(1, 0), b3, voffB);
            PG8_BAR; PG8_WAIT_L(0); PG8_MMA(0, 1, At, B1); PG8_BAR;
            PG8_LDA(At, 1, 1); PG8_STAGE(PG8_SA(1, 0), a3, voffA);
            PG8_BAR; PG8_WAIT_L(0); PG8_MMA(1, 0, At, B0); PG8_BAR; PG8_SCHED;
            PG8_STAGE(PG8_SB(1, 1), b3 + hstep, voffB);
            PG8_WAIT_V(6); PG8_BAR; PG8_MMA(1, 1, At, B1); PG8_BAR;
            }
        }
        if constexpr (ALIGN_EPI) { if (wr == 0) PG8_BAR; }
        if constexpr (!Epi::AFTER_DRAIN) { E(acc, cur, wr, wc, fr, fq); S.done(cur); }
        if (!has_next) break;
#pragma unroll
        for (int a = 0; a < 2; ++a)
#pragma unroll
            for (int b = 0; b < 2; ++b)
#pragma unroll
                for (int m = 0; m < 4; ++m)
#pragma unroll
                    for (int n = 0; n < 2; ++n) acc[a][b][m][n] = (f32x4){0.f, 0.f, 0.f, 0.f};
        cur = nxt; cA = nA; cB = nB; ++ui;
        if constexpr (ALIGN_EPI) { if (wr == 1) PG8_BAR; }
    }
    PG8_WAIT_V(0);
    if constexpr (!ALIGN_EPI) { if (wr == 0) PG8_BAR; }
    PG8_BAR;
    if constexpr (Epi::AFTER_DRAIN) { E.fused(acc, cur, wr, wc, fr, fq, lds, wid, lane); S.done(cur); }
#undef PG8_SA
#undef PG8_SB
#undef PG8_STAGE
#undef PG8_LDA
#undef PG8_LDB
#undef PG8_MMA
#undef PG8_WAIT_V
#undef PG8_WAIT_L
#undef PG8_BAR
#undef PG8_SCHED
}
}

#define LAS __attribute__((address_space(3)))
using pg8::bf16_t; using pg8::bf16x8; using pg8::f32x4; using pg8::u32x4;
typedef float f32x16 __attribute__((ext_vector_type(16)));
typedef unsigned u32x2 __attribute__((ext_vector_type(2)));
typedef unsigned char uchar;
typedef float f32x2_t __attribute__((ext_vector_type(2)));
typedef __bf16 bf16x2_t __attribute__((ext_vector_type(2)));

constexpr int DM = 1024, NBATCH = 16, SEQ = 4096, DEPTH = 4, PLE = 256, DFF = 2816;
constexpr int T = NBATCH * SEQ;
constexpr int NB = 8, TC = NB * SEQ, NCHUNK = NBATCH / NB;
constexpr int DIN = 6680, DINP = 6912;
constexpr float EPS = 1e-6f, LOG2E = 1.4426950408889634f;
constexpr int NTHR = 512;

constexpr size_t W_WI1 = 0, W_WO1 = W_WI1 + (size_t)5632 * 1024, W_WIN = W_WO1 + (size_t)1024 * 2816, W_CW1 = W_WIN + (size_t)DINP * 1024,
                 W_CW2 = W_CW1 + (size_t)2 * 256 * 2048, W_WBR = W_CW2 + (size_t)2 * 256 * 256, W_WOUT = W_WBR + (size_t)3 * 1024 * 512,
                 W_WI2 = W_WOUT + (size_t)1024 * 1024, W_WO2 = W_WI2 + (size_t)5632 * 1024, W_WPE = W_WO2 + (size_t)1024 * 2816,
                 W_WPG = W_WPE + (size_t)1024 * 256, W_LAYER = W_WPG + (size_t)1024 * 1024;
static_assert(W_LAYER == 29491200, "weights");
constexpr size_t MiB = 1u << 20;
constexpr size_t WS_W = 0, WS_XN = 226 * MiB, WS_R1 = 354 * MiB, WS_Y = 782 * MiB, WS_MG = 878 * MiB, WS_CH = 942 * MiB, WS_KCMP = 946 * MiB,
                 WS_VCMP = WS_KCMP + MiB / 2, WS_CB = 947 * MiB, WS_SSQ = 948 * MiB, WS_SSQ2 = 952 * MiB, WS_CTL = 956 * MiB, WS_END = 992 * MiB;
constexpr size_t CTL_ZERO_BYTES = 65536;
constexpr size_t WS_XN2 = WS_Y, WS_PBF = 960 * MiB;
static_assert(W_LAYER * 2 * DEPTH <= WS_XN, "w");
constexpr size_t HS = 262144;
constexpr size_t ZQA = 0, ZKA = ZQA + NB * 8 * HS, ZVA = ZKA + NB * 8 * HS, ZQB = ZVA + NB * 8 * HS, ZKCI = ZQB + NB * 8 * HS, ZVCI = ZKCI + NB * 2 * HS,
                 ZKS = ZVCI + NB * 2 * HS, ZVS = ZKS + NB * 2 * HS, ZKW = ZVS + NB * 2 * HS, ZVW = ZKW + NB * 2 * HS, ZQC = ZVW + NB * 2 * HS,
                 ZKC = ZQC + NB * 8 * HS, ZVC = ZKC + NB * 2 * HS, ZSG = ZVC + NB * 2 * HS, ZBG = ZSG + (size_t)TC * 3072, ZEND = ZBG + (size_t)TC * 32 * 2;
static_assert(ZEND * 2 <= 428 * MiB, "zbuf");
static_assert((size_t)T * DFF * 2 <= 428 * MiB, "act");
constexpr size_t R1_E = 0;

struct Params {
    const float* in[20];
    float* out;
    uchar* ws;
};

__device__ __forceinline__ unsigned cvtpk(float lo, float hi) { f32x2_t v = {lo, hi}; bf16x2_t b = __builtin_convertvector(v, bf16x2_t); return __builtin_bit_cast(unsigned, b); }
__device__ __forceinline__ bf16_t cvt1(float x) { return (bf16_t)(cvtpk(x, 0.f) & 0xffffu); }
__device__ __forceinline__ float bf2f(unsigned short b) { return __uint_as_float((unsigned)b << 16); }
__device__ __forceinline__ float wave_sum(float v) {
#pragma unroll
    for (int o = 1; o < 64; o <<= 1) v += __shfl_xor(v, o);
    return v;
}
__device__ __forceinline__ int opq(int v) { asm volatile("" : "+v"(v)); return v; }
__device__ __forceinline__ float sigm(float x) { return __builtin_amdgcn_rcpf(1.f + __builtin_amdgcn_exp2f(-x * LOG2E)); }
__device__ __forceinline__ float gelu_tanh(float x) { const float u = 0.7978845608028654f * (x + 0.044715f * x * x * x); const float e = __builtin_amdgcn_exp2f(-2.f * LOG2E * u); const float th = 2.f * __builtin_amdgcn_rcpf(1.f + e) - 1.f; return 0.5f * x * (1.f + th); }

typedef const __attribute__((address_space(4))) Params* KParPtr;
__device__ __forceinline__ KParPtr kparams() { auto p = __builtin_amdgcn_kernarg_segment_ptr(); asm volatile("" : "+s"(p)); return (KParPtr)p; }
#ifndef ALIGN_T
#define ALIGN_T false
#endif
#ifndef ALIGN_F
#define ALIGN_F true
#endif
#ifndef ALIGN_SW
#define ALIGN_SW true
#endif
#ifndef ALIGN_BR
#define ALIGN_BR true
#endif
#ifndef ALIGN_Z
#define ALIGN_Z true
#endif
__device__ __forceinline__ float row_rstd(const float* ssq, int row) {
    const f32x4* p = (const f32x4*)(ssq + (size_t)row * 16); const f32x4 a = p[0], b = p[1], c = p[2], d = p[3];
    const float sm = (((a[0] + a[1]) + (a[2] + a[3])) + ((b[0] + b[1]) + (b[2] + b[3]))) + (((c[0] + c[1]) + (c[2] + c[3])) + ((d[0] + d[1]) + (d[2] + d[3])));
    return 1.0f / sqrtf(sm * (1.f / 1024.f) + 1e-6f);
}
typedef const pg8::f32x4 (&AccRef)[2][2][4][2];
__device__ __forceinline__ void wave_rstd(const float* ssq, int rowbase, float (&rsl)[2]) {
    const int lane = threadIdx.x & 63;
    rsl[0] = row_rstd(ssq, rowbase + lane); rsl[1] = row_rstd(ssq, rowbase + 128 + lane);
}
struct EpiSwiglu {
    static constexpr bool PERM = true, AFTER_DRAIN = false, ALIGN = ALIGN_SW;
    bf16_t* O; const float* ssq;
    __device__ __forceinline__ void operator()(AccRef acc, const pg8::Unit& u, int wr, int wc, int fr, int fq) const {
        asm volatile("" : "+v"(fr), "+v"(fq));
        const int row0 = u.pm * 256 + wr * 64 + fr, col0 = u.pn * 128 + wc * 32 + 8 * fq;
        float rsl[2]; wave_rstd(ssq, u.pm * 256 + wr * 64, rsl);
#pragma unroll
        for (int ai = 0; ai < 2; ++ai)
#pragma unroll
            for (int m = 0; m < 4; ++m) {
                bf16_t* rp = O + (size_t)(row0 + ai * 128 + m * 16) * DFF + col0;
                const float rs = __shfl(rsl[ai], 16 * m + fr);
                float o[8];
#pragma unroll
                for (int n = 0; n < 2; ++n)
#pragma unroll
                    for (int e = 0; e < 4; ++e) { const float g = acc[ai][0][m][n][e] * rs, up = acc[ai][1][m][n][e] * rs; o[n * 4 + e] = g * sigm(g) * up; }
                u32x4 w; w.x = cvtpk(o[0], o[1]); w.y = cvtpk(o[2], o[3]); w.z = cvtpk(o[4], o[5]); w.w = cvtpk(o[6], o[7]);
                *(u32x4*)rp = w;
            }
    }
};
struct EpiResid {
    static constexpr bool PERM = false, AFTER_DRAIN = false, ALIGN = ALIGN_F;
    float alpha; int row_off; int hsrc;
    __device__ __forceinline__ void operator()(AccRef acc, const pg8::Unit& u, int wr, int wc, int fr, int fq) const {
        asm volatile("" : "+v"(fr), "+v"(fq));
        const int row0 = row_off + u.pm * 256 + wr * 64 + fr, col0 = u.pn * 256 + wc * 32 + 4 * fq;
        const float* xin = kparams()->in[0];
        uchar* wsb = kparams()->ws; bf16_t* hb = (bf16_t*)(wsb + WS_XN); float* ssq = (float*)(wsb + WS_SSQ);
        const bf16_t* hin = (const bf16_t*)(wsb + (hsrc == 1 ? WS_XN2 : WS_XN));
#pragma unroll
        for (int ai = 0; ai < 2; ++ai)
#pragma unroll
            for (int m = 0; m < 4; ++m) {
                const size_t off = (size_t)(row0 + ai * 128 + m * 16) * DM + col0;
                float sq = 0.f;
#pragma unroll
                for (int bj = 0; bj < 2; ++bj)
#pragma unroll
                    for (int n = 0; n < 2; ++n) { f32x4 b;
                        if (hsrc == 0) b = *(const f32x4*)(xin + off + bj * 128 + n * 16);
                        else { const u32x2 hv = *(const u32x2*)(hin + off + bj * 128 + n * 16); b = (f32x4){__uint_as_float(hv.x << 16), __uint_as_float(hv.x & 0xffff0000u), __uint_as_float(hv.y << 16), __uint_as_float(hv.y & 0xffff0000u)}; }
                        const f32x4 v = b + acc[ai][bj][m][n] * alpha;
                        u32x2 w; w.x = cvtpk(v[0], v[1]); w.y = cvtpk(v[2], v[3]); *(u32x2*)(hb + off + bj * 128 + n * 16) = w; sq += (v[0] * v[0] + v[1] * v[1]) + (v[2] * v[2] + v[3] * v[3]); }
                sq += __shfl_xor(sq, 16); sq += __shfl_xor(sq, 32);
                if (fq == 0) ssq[(size_t)(row0 + ai * 128 + m * 16) * 16 + u.pn * 4 + wc] = sq;

            }
    }
};
struct EpiPle {
    static constexpr bool PERM = false, AFTER_DRAIN = false, ALIGN = ALIGN_F;
    const bf16_t* hin; const bf16_t* E; const float* ssq_in; bf16_t* hb; float* ssq_out;
    __device__ __forceinline__ void operator()(AccRef acc, const pg8::Unit& u, int wr, int wc, int fr, int fq) const {
        asm volatile("" : "+v"(fr), "+v"(fq));
        const int row0 = u.pm * 256 + wr * 64 + fr, col0 = u.pn * 256 + wc * 32 + 4 * fq;
        float rsl[2]; wave_rstd(ssq_in, u.pm * 256 + wr * 64, rsl);
#pragma unroll
        for (int ai = 0; ai < 2; ++ai)
#pragma unroll
            for (int m = 0; m < 4; ++m) {
                const size_t off = (size_t)(row0 + ai * 128 + m * 16) * DM + col0;
                const float rs = __shfl(rsl[ai], 16 * m + fr);
                float sq = 0.f;
#pragma unroll
                for (int bj = 0; bj < 2; ++bj)
#pragma unroll
                    for (int n = 0; n < 2; ++n) {
                        const size_t o2 = off + bj * 128 + n * 16;
                        const u32x2 ev = *(const u32x2*)(E + o2); const u32x2 hv = *(const u32x2*)(hin + o2); f32x4 b = (f32x4){__uint_as_float(hv.x << 16), __uint_as_float(hv.x & 0xffff0000u), __uint_as_float(hv.y << 16), __uint_as_float(hv.y & 0xffff0000u)}; const f32x4 a = acc[ai][bj][m][n];
                        b[0] += sigm(a[0] * rs) * __uint_as_float(ev.x << 16); b[1] += sigm(a[1] * rs) * __uint_as_float(ev.x & 0xffff0000u);
                        b[2] += sigm(a[2] * rs) * __uint_as_float(ev.y << 16); b[3] += sigm(a[3] * rs) * __uint_as_float(ev.y & 0xffff0000u);
                        u32x2 w; w.x = cvtpk(b[0], b[1]); w.y = cvtpk(b[2], b[3]); *(u32x2*)(hb + o2) = w; sq += (b[0] * b[0] + b[1] * b[1]) + (b[2] * b[2] + b[3] * b[3]);
                    }
                sq += __shfl_xor(sq, 16); sq += __shfl_xor(sq, 32);
                if (fq == 0) ssq_out[(size_t)(row0 + ai * 128 + m * 16) * 16 + u.pn * 4 + wc] = sq;

            }
    }
};
template <int MODE> struct EpiBf {
    static constexpr bool PERM = true, AFTER_DRAIN = false, ALIGN = ALIGN_T;
    bf16_t* O; int ldc; const float* bias;
    __device__ __forceinline__ void operator()(AccRef acc, const pg8::Unit& u, int wr, int wc, int fr, int fq) const {
        asm volatile("" : "+v"(fr), "+v"(fq));
        const int row0 = u.pm * 256 + wr * 64 + fr, col0 = u.pn * 256 + wc * 32 + 8 * fq;
#pragma unroll
        for (int bj = 0; bj < 2; ++bj) {
            float bv[8];
#pragma unroll
            for (int e = 0; e < 8; ++e) bv[e] = MODE == 1 ? bias[col0 + bj * 128 + e] : 0.f;
#pragma unroll
            for (int ai = 0; ai < 2; ++ai)
#pragma unroll
                for (int m = 0; m < 4; ++m) {
                    float o[8];
#pragma unroll
                    for (int n = 0; n < 2; ++n)
#pragma unroll
                        for (int e = 0; e < 4; ++e) { float v = acc[ai][bj][m][n][e] + bv[n * 4 + e]; if (MODE == 1) v = gelu_tanh(v); o[n * 4 + e] = v; }
                    u32x4 w; w.x = cvtpk(o[0], o[1]); w.y = cvtpk(o[2], o[3]); w.z = cvtpk(o[4], o[5]); w.w = cvtpk(o[6], o[7]);
                    *(u32x4*)(O + (size_t)(row0 + ai * 128 + m * 16) * ldc + col0 + bj * 128) = w;
                }
        }
    }
};
template <bool VT> struct EpiCmp2 {
    static constexpr bool PERM = true, AFTER_DRAIN = false, ALIGN = ALIGN_T;
    bf16_t* O;
    __device__ __forceinline__ void operator()(AccRef acc, const pg8::Unit& u, int wr, int wc, int fr, int fq) const {
        asm volatile("" : "+v"(fr), "+v"(fq));
        if (u.pn != 0 || wc >= 2) return;
        const int row0 = u.pm * 256 + wr * 64 + fr, d0 = wc * 32 + 8 * fq;
#pragma unroll
        for (int ai = 0; ai < 2; ++ai)
#pragma unroll
            for (int m = 0; m < 4; ++m) {
                const int row = row0 + ai * 128 + m * 16, bg = row >> 8, n = row & 255;
                float o[8];
#pragma unroll
                for (int nn = 0; nn < 2; ++nn)
#pragma unroll
                    for (int e = 0; e < 4; ++e) o[nn * 4 + e] = (n == 255) ? 0.f : acc[ai][0][m][nn][e];
                if (!VT) { u32x4 w; w.x = cvtpk(o[0], o[1]); w.y = cvtpk(o[2], o[3]); w.z = cvtpk(o[4], o[5]); w.w = cvtpk(o[6], o[7]); *(u32x4*)(O + (size_t)row * 64 + d0) = w; }
                else {
#pragma unroll
                    for (int e = 0; e < 8; ++e) O[((size_t)bg * 64 + d0 + e) * 256 + n] = cvt1(o[e]);
                }
            }
    }
};
struct EpiBranch {
    static constexpr bool PERM = true, AFTER_DRAIN = false, ALIGN = ALIGN_BR;
    bf16_t* mg; const bf16_t* sg; int mi;
    __device__ __forceinline__ void operator()(AccRef acc, const pg8::Unit& u, int wr, int wc, int fr, int fq) const {
        asm volatile("" : "+v"(fr), "+v"(fq));
        const int row0 = u.pm * 256 + wr * 64 + fr, col0 = u.pn * 256 + wc * 32 + 8 * fq;
#pragma unroll
        for (int ai = 0; ai < 2; ++ai)
#pragma unroll
            for (int m = 0; m < 4; ++m) {
                const int row = row0 + ai * 128 + m * 16;
#pragma unroll
                for (int bj = 0; bj < 2; ++bj) {
                    const int col = col0 + bj * 128;
                    const u32x2 gv = *(const u32x2*)((const uchar*)sg + (size_t)row * 3072 + mi * 1024 + col);
                    u32x4 ov = (u32x4){0u, 0u, 0u, 0u};
                    if (mi != 0) ov = *(const u32x4*)(mg + (size_t)row * DM + col);
                    float o[8];
#pragma unroll
                    for (int q = 0; q < 4; ++q) {
                        const unsigned oq = ov[q], gw2 = (q < 2 ? gv.x : gv.y) >> ((q & 1) * 16);
                        const float g0 = (float)(gw2 & 255u) * (1.f / 255.f), g1 = (float)((gw2 >> 8) & 255u) * (1.f / 255.f);
                        const float a0 = acc[ai][bj][m][q >> 1][(q & 1) * 2], a1 = acc[ai][bj][m][q >> 1][(q & 1) * 2 + 1];
                        o[2 * q] = __uint_as_float(oq << 16) + g0 * a0;
                        o[2 * q + 1] = __uint_as_float(oq & 0xffff0000u) + g1 * a1;
                    }
                    u32x4 w; w.x = cvtpk(o[0], o[1]); w.y = cvtpk(o[2], o[3]); w.z = cvtpk(o[4], o[5]); w.w = cvtpk(o[6], o[7]);
                    *(u32x4*)(mg + (size_t)row * DM + col) = w;
                }

            }
    }
};
struct EpiZ {
    static constexpr bool PERM = true, AFTER_DRAIN = false, ALIGN = ALIGN_Z;
    bf16_t* zb; const float* ssq; int pn_off;
    __device__ __forceinline__ void operator()(AccRef acc, const pg8::Unit& u, int wr, int wc, int fr, int fq) const {
        asm volatile("" : "+v"(fr), "+v"(fq));
        const int pn = u.pn + pn_off;
        float rsl[2]; wave_rstd(ssq, u.pm * 256 + wr * 64, rsl);
#pragma unroll
        for (int bj = 0; bj < 2; ++bj) {
            const int ch = 2 * bj + (wc >> 1), d0 = (wc & 1) * 32 + 8 * fq;
            size_t off = 0, bs = 8 * HS; int mode = 0;
            if (pn < 2) { off = ZQA + (size_t)(pn * 4 + ch) * HS; }
            else if (pn < 4) { off = ZKA + (size_t)((pn - 2) * 4 + ch) * HS; }
            else if (pn < 6) { off = ZVA + (size_t)((pn - 4) * 4 + ch) * HS; mode = 1; }
            else if (pn < 8) { off = ZQB + (size_t)((pn - 6) * 4 + ch) * HS; }
            else if (pn == 8) { bs = 2 * HS; off = (ch < 2) ? ZKCI + (size_t)ch * HS : ZVCI + (size_t)(ch - 2) * HS; }
            else if (pn == 9) { bs = 2 * HS; if (ch < 2) off = ZKS + (size_t)ch * HS; else { off = ZVS + (size_t)(ch - 2) * HS; mode = 1; } }
            else if (pn == 10) { bs = 2 * HS; if (ch < 2) off = ZKW + (size_t)ch * HS; else { off = ZVW + (size_t)(ch - 2) * HS; mode = 1; } }
            else if (pn < 13) { off = ZQC + (size_t)((pn - 11) * 4 + ch) * HS; }
            else if (pn == 13) { bs = 2 * HS; if (ch < 2) off = ZKC + (size_t)ch * HS; else { off = ZVC + (size_t)(ch - 2) * HS; mode = 1; } }
            else if (pn < 26) mode = 2;
            else mode = 3;
#pragma unroll
            for (int ai = 0; ai < 2; ++ai)
#pragma unroll
                for (int m = 0; m < 4; ++m) {
                    const int tl = u.pm * 256 + ai * 128 + wr * 64 + m * 16 + fr, bl = tl >> 12, s = tl & 4095;
                    const float rs = __shfl(rsl[ai], 16 * m + fr);
                    float o[8];
#pragma unroll
                    for (int n = 0; n < 2; ++n)
#pragma unroll
                        for (int e = 0; e < 4; ++e) o[n * 4 + e] = acc[ai][bj][m][n][e] * rs;
                    if (mode == 0) {
                        u32x4 w; w.x = cvtpk(o[0], o[1]); w.y = cvtpk(o[2], o[3]); w.z = cvtpk(o[4], o[5]); w.w = cvtpk(o[6], o[7]);
                        *(u32x4*)(zb + off + (size_t)bl * bs + (size_t)s * 64 + d0) = w;
                    } else if (mode == 1) {
                        bf16_t* p = zb + off + (size_t)bl * bs + (size_t)d0 * 4096 + s;
#pragma unroll
                        for (int e = 0; e < 8; ++e) p[(size_t)e * 4096] = cvt1(o[e]);
                    } else if (mode == 2) {
                        unsigned qb[8];
#pragma unroll
                        for (int e = 0; e < 8; ++e) qb[e] = (unsigned)(sigm(o[e]) * 255.f + 0.5f);
                        u32x2 w; w.x = qb[0] | (qb[1] << 8) | (qb[2] << 16) | (qb[3] << 24); w.y = qb[4] | (qb[5] << 8) | (qb[6] << 16) | (qb[7] << 24);
                        *(u32x2*)((uchar*)(zb + ZSG) + (size_t)tl * 3072 + (pn - 14) * 256 + bj * 128 + wc * 32 + 8 * fq) = w;
                    } else {
                        const int cc = bj * 128 + wc * 32 + 8 * fq;
                        if (cc < 24) {
                            float* bgp = (float*)(zb + ZBG) + (size_t)tl * 32 + cc;
                            *(f32x4*)bgp = (f32x4){sigm(o[0]), sigm(o[1]), sigm(o[2]), sigm(o[3])};
                            *(f32x4*)(bgp + 4) = (f32x4){sigm(o[4]), sigm(o[5]), sigm(o[6]), sigm(o[7])};
                        }
                    }
                }
        }
    }
};

__device__ __forceinline__ void rms_row_bf16(const float* xrow, const float* g, bf16_t* orow, int lane) {
    const f32x4* xr = (const f32x4*)xrow + lane; f32x4 v[4]; float s = 0.f;
#pragma unroll
    for (int j = 0; j < 4; ++j) { v[j] = xr[64 * j]; s += (v[j][0] * v[j][0] + v[j][1] * v[j][1]) + (v[j][2] * v[j][2] + v[j][3] * v[j][3]); }
    const float rstd = 1.0f / sqrtf(wave_sum(s) * (1.f / DM) + EPS);
    u32x2* o8 = (u32x2*)orow + lane;
#pragma unroll
    for (int j = 0; j < 4; ++j) { const f32x4 gg = ((const f32x4*)g)[lane + 64 * j]; u32x2 w; w.x = cvtpk(v[j][0] * rstd * gg[0], v[j][1] * rstd * gg[1]); w.y = cvtpk(v[j][2] * rstd * gg[2], v[j][3] * rstd * gg[3]); o8[64 * j] = w; }
}
__device__ __forceinline__ void rms_row_f32(const float* xrow, const float* g, float* orow, int lane) {
    const f32x4* xr = (const f32x4*)xrow + lane; f32x4 v[4]; float s = 0.f;
#pragma unroll
    for (int j = 0; j < 4; ++j) { v[j] = xr[64 * j]; s += (v[j][0] * v[j][0] + v[j][1] * v[j][1]) + (v[j][2] * v[j][2] + v[j][3] * v[j][3]); }
    const float rstd = 1.0f / sqrtf(wave_sum(s) * (1.f / DM) + EPS);
#pragma unroll
    for (int j = 0; j < 4; ++j) { const f32x4 gg = ((const f32x4*)g)[lane + 64 * j]; ((f32x4*)orow)[lane + 64 * j] = (v[j] * rstd) * gg; }
}
__device__ __forceinline__ void rms_row_bf16in_f32(const bf16_t* xrow, const float* g, float* orow, int lane) {
    const u32x2* xr = (const u32x2*)xrow + lane; f32x4 v[4]; float s = 0.f;
#pragma unroll
    for (int j = 0; j < 4; ++j) { const u32x2 hv = xr[64 * j]; v[j] = (f32x4){__uint_as_float(hv.x << 16), __uint_as_float(hv.x & 0xffff0000u), __uint_as_float(hv.y << 16), __uint_as_float(hv.y & 0xffff0000u)};
        s += (v[j][0] * v[j][0] + v[j][1] * v[j][1]) + (v[j][2] * v[j][2] + v[j][3] * v[j][3]); }
    const float rstd = 1.0f / sqrtf(wave_sum(s) * (1.f / DM) + EPS);
#pragma unroll
    for (int j = 0; j < 4; ++j) { const f32x4 gg = ((const f32x4*)g)[lane + 64 * j]; ((f32x4*)orow)[lane + 64 * j] = (v[j] * rstd) * gg; }
}
__device__ __forceinline__ void phase_prep(const float* src, bf16_t* dst, float* ssq, int gw, int ngw, int lane) {
    lane = opq(lane);
    for (int m = gw; m < T; m += ngw) {
        const f32x4* xr = (const f32x4*)(src + (size_t)m * DM) + lane; u32x2* o8 = (u32x2*)(dst + (size_t)m * DM) + lane; float s = 0.f;
#pragma unroll
        for (int j = 0; j < 4; ++j) { const f32x4 v = xr[64 * j]; s += (v[0] * v[0] + v[1] * v[1]) + (v[2] * v[2] + v[3] * v[3]); u32x2 w; w.x = cvtpk(v[0], v[1]); w.y = cvtpk(v[2], v[3]); o8[64 * j] = w; }
        s = wave_sum(s);
        if (lane < 16) ssq[(size_t)m * 16 + lane] = lane == 0 ? s : 0.f;
    }
}
__device__ __forceinline__ void phase_rms(const float* src, const float* g, bf16_t* dst, int gw, int ngw, int lane) {
    lane = opq(lane);
    for (int m = gw; m < T; m += ngw) rms_row_bf16(src + (size_t)m * DM, g, dst + (size_t)m * DM, lane);
}

__device__ __forceinline__ int srccol(int mode, int n) {
    if (mode == 0) return n;
    if (mode == 1) return ((n >> 7) & 1) * DFF + (n >> 8) * 128 + (n & 127);
    if (mode == 2) return n < 2816 ? n : (n < 6656 ? n + 24 : (n < 6680 ? 2816 + (n - 6656) : -1));
    return n < 64 ? n : -1;
}
__device__ __forceinline__ void conv_matrix(const float* src, int K, int ld, int Ndst, int mode, bf16_t* dst, int& base, LAS float* scr, int tid, int blk, int G, const float* gk = nullptr) {
    tid = opq(tid);
    const int ntn = Ndst / 64, ntiles = (K / 128) * ntn;
    int start = (blk - (base % G) + G) % G;
    for (int t = start; t < ntiles; t += G) {
        const int k0 = (t / ntn) * 128, n0 = (t % ntn) * 64;
        { const int kr = tid >> 6, n = tid & 63; const int col = srccol(mode, n0 + n);
          float v[16];
#pragma unroll
          for (int kk = 0; kk < 16; ++kk) { const int k = kr + 8 * kk; v[kk] = col >= 0 ? src[(size_t)(k0 + k) * ld + col] : 0.f; }
#pragma unroll
          for (int kk = 0; kk < 16; ++kk) { const int k = kr + 8 * kk; scr[k * 65 + n] = gk ? v[kk] * gk[k0 + k] : v[kk]; } }
        __syncthreads();
        { const int n = tid >> 3, ks = tid & 7;
#pragma unroll
          for (int h2 = 0; h2 < 2; ++h2) { const LAS float* sp = scr + (64 * h2 + 8 * ks) * 65 + n;
            u32x4 w; w.x = cvtpk(sp[0], sp[65]); w.y = cvtpk(sp[130], sp[195]); w.z = cvtpk(sp[260], sp[325]); w.w = cvtpk(sp[390], sp[455]);
            *(u32x4*)(dst + (size_t)(n0 + n) * K + k0 + 64 * h2 + 8 * ks) = w; } }
        __syncthreads();
    }
    base += ntiles;
}

constexpr int KP = 144;
constexpr int VP = 144;
constexpr int L_K0 = 0, L_K1 = 9216, L_V0 = 18432, L_V1 = 36864, L_TBL = 55296, L_IMP = 57344, L_SEL = 73984, L_RED = 74496;
constexpr float SC = 0.125f * LOG2E;
constexpr float MINIT = -10000.f, MASKED = -1e30f;

__device__ __forceinline__ int t5_bucket(int n) {
    if (n < 16) return n;
    int b = 16;
    b += (n >= 19); b += (n >= 21); b += (n >= 24); b += (n >= 27); b += (n >= 31); b += (n >= 35); b += (n >= 40); b += (n >= 46);
    b += (n >= 52); b += (n >= 59); b += (n >= 67); b += (n >= 77); b += (n >= 87); b += (n >= 99); b += (n >= 113);
    return b;
}
__device__ __forceinline__ void build_tbl(LAS uchar* lds, const float* rel_bias, int col0, int nh, int tid) {
    const int hd = tid >> 7, idx = tid & 127;
    if (hd < nh && idx < 114) ((LAS float*)(lds + L_TBL))[hd * 128 + idx] = rel_bias[t5_bucket(idx) * 20 + col0 + hd] * LOG2E;
}

template <int DV> struct TileRegs { u32x4 k; u32x4 v[DV / 64]; };
template <int DV, bool HASV>
__device__ __forceinline__ void tile_gload(TileRegs<DV>& r, const bf16_t* Kg, const bf16_t* Vt, int vpitch, int kt, int tid) {
    const int row = tid >> 3, seg = tid & 7;
    r.k = *(const u32x4*)(Kg + (size_t)(kt * 64 + row) * 64 + seg * 8);
    if (HASV) {
#pragma unroll
        for (int j = 0; j < DV / 64; ++j) r.v[j] = *(const u32x4*)(Vt + (size_t)(row + 64 * j) * vpitch + kt * 64 + seg * 8);
    }
}
template <int DV, bool HASV>
__device__ __forceinline__ void tile_swrite(const TileRegs<DV>& r, LAS uchar* lds, int buf, int tid) {
    const int row = tid >> 3, seg = tid & 7;
    *(LAS u32x4*)(lds + (buf ? L_K1 : L_K0) + row * KP + seg * 16) = r.k;
    if (HASV) {
#pragma unroll
        for (int j = 0; j < DV / 64; ++j) { LAS uchar* p = lds + (buf ? L_V1 : L_V0) + (row + 64 * j) * VP + (seg >> 1) * 32 + (seg & 1) * 8; *(LAS u32x2*)p = (u32x2){r.v[j].x, r.v[j].y}; *(LAS u32x2*)(p + 16) = (u32x2){r.v[j].z, r.v[j].w}; }
    }
}

template <int DV, bool IMPP>
__device__ __forceinline__ void attn_pass(LAS uchar* lds, const bf16_t* Kg, const bf16_t* Vt, int vpitch, int kt0, int kt1, int wave_kt_max,
                                          int qpos, int qmin_w, int qmax_w, int kmul, int kadd, unsigned W, bf16x8 (&q)[4], int tbl,
                                          unsigned long long selmask, bool use_sel, float& m, float& l, f32x16 (&acc)[DV / 32],
                                          float inv_l, int imp_row, float rel_far, int tid) {
    const int lane = tid & 63, n = lane & 31, hi = lane >> 5;
    TileRegs<DV> tr;
    if (kt0 >= kt1) return;
    float tfar = rel_far;
    asm volatile("s_waitcnt vmcnt(0)" ::: "memory");
    asm volatile("" : "+v"(q[0]), "+v"(q[1]), "+v"(q[2]), "+v"(q[3]), "+v"(tfar), "+v"(m), "+v"(l), "+v"(inv_l));
    tile_gload<DV, !IMPP>(tr, Kg, Vt, vpitch, kt0, tid);
    tile_swrite<DV, !IMPP>(tr, lds, 0, tid);
    __syncthreads();
    for (int kt = kt0; kt < kt1; ++kt) {
        const int cur = (kt - kt0) & 1;
        const bool more = kt + 1 < kt1;
        if (more) tile_gload<DV, !IMPP>(tr, Kg, Vt, vpitch, kt + 1, tid);
        if (kt <= wave_kt_max && (!use_sel || __builtin_amdgcn_ballot_w64((selmask >> kt) & 1ull) != 0ull)) {
            f32x16 s[2];
#pragma unroll
            for (int r = 0; r < 16; ++r) { s[0][r] = 0.f; s[1][r] = 0.f; }
            const LAS uchar* kb = lds + (cur ? L_K1 : L_K0) + n * KP + hi * 16;
#pragma unroll
            for (int ks = 0; ks < 4; ++ks) {
                const bf16x8 a0 = *(const LAS bf16x8*)(kb + ks * 32);
                const bf16x8 a1 = *(const LAS bf16x8*)(kb + 32 * KP + ks * 32);
                s[0] = __builtin_amdgcn_mfma_f32_32x32x16_bf16(a0, q[ks], s[0], 0, 0, 0);
                s[1] = __builtin_amdgcn_mfma_f32_32x32x16_bf16(a1, q[ks], s[1], 0, 0, 0);
            }
            const bool lane_ok = !use_sel || ((selmask >> kt) & 1ull);
            const bool fast = (qmin_w - (kmul * (64 * kt + 63) + kadd) >= 113) && ((unsigned)(qmax_w - (kmul * 64 * kt + kadd)) < W);
            if (fast) {
                const float cfar = lane_ok ? tfar - m : MASKED;
                const float scl = lane_ok ? SC : 0.f;
#pragma unroll
                for (int hh = 0; hh < 2; ++hh)
#pragma unroll
                    for (int r = 0; r < 16; ++r) s[hh][r] = s[hh][r] * scl + cfar;
            } else {
                int dq = qpos - kadd - kmul * (kt * 64 + 4 * hi);
                asm volatile("" : "+v"(dq));
                const unsigned Wl = lane_ok ? W : 0u;
                const LAS uchar* tb = lds + tbl;
#pragma unroll
                for (int hh = 0; hh < 2; ++hh)
#pragma unroll
                    for (int r = 0; r < 16; ++r) {
                        const int kk = 32 * hh + 8 * (r >> 2) + (r & 3);
                        const int dist = dq - kmul * kk;
                        const unsigned ud = (unsigned)dist;
                        const unsigned idx = ud < 113u ? ud : 113u;
                        const float bias = *(const LAS float*)(tb + idx * 4);
                        float v = s[hh][r] * SC + (bias - m);
                        v = (ud < Wl) ? v : MASKED;
                        s[hh][r] = v;
                    }
            }
            if (!IMPP) {
                float t0 = fmaxf(fmaxf(s[0][0], s[0][1]), s[0][2]), t1 = fmaxf(fmaxf(s[1][0], s[1][1]), s[1][2]);
#pragma unroll
                for (int r = 3; r < 15; r += 2) { t0 = fmaxf(fmaxf(t0, s[0][r]), s[0][r + 1]); t1 = fmaxf(fmaxf(t1, s[1][r]), s[1][r + 1]); }
                float tmax = fmaxf(fmaxf(t0, t1), fmaxf(s[0][15], s[1][15]));
                { auto rr = __builtin_amdgcn_permlane32_swap(__float_as_uint(tmax), __float_as_uint(tmax), false, false); tmax = fmaxf(__uint_as_float(rr[0]), __uint_as_float(rr[1])); }
                const bool need = tmax > 8.f;
                if (__builtin_amdgcn_ballot_w64(need) != 0ull) {
                    const float delta = need ? tmax : 0.f;
                    const float alpha = __builtin_amdgcn_exp2f(-delta);
                    m += delta; l *= alpha;
#pragma unroll
                    for (int dt = 0; dt < DV / 32; ++dt) acc[dt] = acc[dt] * alpha;
#pragma unroll
                    for (int hh = 0; hh < 2; ++hh)
#pragma unroll
                        for (int r = 0; r < 16; ++r) s[hh][r] -= delta;
                }
#pragma unroll
                for (int hh = 0; hh < 2; ++hh)
#pragma unroll
                    for (int r = 0; r < 16; ++r) s[hh][r] = __builtin_amdgcn_exp2f(s[hh][r]);
                f32x2_t ls2a = {0.f, 0.f}, ls2b = {0.f, 0.f};
#pragma unroll
                for (int r = 0; r < 16; r += 2) { ls2a += (f32x2_t){s[0][r], s[0][r + 1]}; ls2b += (f32x2_t){s[1][r], s[1][r + 1]}; }
                const float ls = (ls2a[0] + ls2a[1]) + (ls2b[0] + ls2b[1]);
                l += ls;
                const LAS uchar* vb = lds + (cur ? L_V1 : L_V0) + n * VP + hi * 16;
    #pragma unroll
                for (int hh = 0; hh < 2; ++hh)
#pragma unroll
                    for (int u2 = 0; u2 < 2; ++u2) {
                        u32x4 pw;
                        pw.x = cvtpk(s[hh][8 * u2 + 0], s[hh][8 * u2 + 1]); pw.y = cvtpk(s[hh][8 * u2 + 2], s[hh][8 * u2 + 3]);
                        pw.z = cvtpk(s[hh][8 * u2 + 4], s[hh][8 * u2 + 5]); pw.w = cvtpk(s[hh][8 * u2 + 6], s[hh][8 * u2 + 7]);
                        const bf16x8 pb = __builtin_bit_cast(bf16x8, pw);
                        const int kbase = 32 * hh + 16 * u2;
#pragma unroll
                        for (int dt = 0; dt < DV / 32; ++dt) {
                            const bf16x8 va = *(const LAS bf16x8*)(vb + dt * 32 * VP + kbase * 2);
                            acc[dt] = __builtin_amdgcn_mfma_f32_32x32x16_bf16(va, pb, acc[dt], 0, 0, 0);
                        }
                    }
                } else {
                LAS float* imp = (LAS float*)(lds + L_IMP) + imp_row * 65;
                float spill[8];
#pragma unroll
                for (int hh = 0; hh < 2; ++hh)
#pragma unroll
                    for (int gq = 0; gq < 4; ++gq) {
                        const float p0 = __builtin_amdgcn_exp2f(s[hh][4 * gq + 0]) * inv_l, p1 = __builtin_amdgcn_exp2f(s[hh][4 * gq + 1]) * inv_l;
                        const float p2 = __builtin_amdgcn_exp2f(s[hh][4 * gq + 2]) * inv_l, p3 = __builtin_amdgcn_exp2f(s[hh][4 * gq + 3]) * inv_l;
                        float mn = (p0 + p1) + (p2 + p3), sp = p3;
                        mn += __shfl_xor(mn, 8); mn += __shfl_xor(mn, 16);
                        sp += __shfl_xor(sp, 8); sp += __shfl_xor(sp, 16);
                        spill[hh * 4 + gq] = sp;
                        const int j = 16 * kt + 8 * hh + 2 * gq + hi;
                        if (n < 8) imp[j] += mn;
                    }
                __builtin_amdgcn_fence(__ATOMIC_RELEASE, "wavefront");
#pragma unroll
                for (int hh = 0; hh < 2; ++hh)
#pragma unroll
                    for (int gq = 0; gq < 4; ++gq) {
                        const int j = 16 * kt + 8 * hh + 2 * gq + hi + 1;
                        if (n < 8 && j < 64) imp[j] += spill[hh * 4 + gq];
                    }
                __builtin_amdgcn_fence(__ATOMIC_RELEASE, "wavefront");
            }
        }
        if (more) tile_swrite<DV, !IMPP>(tr, lds, cur ^ 1, tid);
        __syncthreads();
    }
}

template <int NT> __device__ __forceinline__ void acc_zero(f32x16 (&a)[NT]) {
#pragma unroll
    for (int t = 0; t < NT; ++t)
#pragma unroll
        for (int r = 0; r < 16; ++r) a[t][r] = 0.f;
}
template <int NT> __device__ __forceinline__ void acc_norm(f32x16 (&a)[NT], float l) {
    const float lt = l + __shfl_xor(l, 32);
    const float inv = lt > 0.f ? 1.f / lt : 0.f;
#pragma unroll
    for (int t = 0; t < NT; ++t)
#pragma unroll
        for (int r = 0; r < 16; ++r) a[t][r] *= inv;
}
__device__ __forceinline__ void load_q(bf16x8 (&qf)[4], const bf16_t* qrow, int hi) {
#pragma unroll
    for (int ks = 0; ks < 4; ++ks) qf[ks] = *(const bf16x8*)(qrow + 16 * ks + 8 * hi);
}

struct AttnCtx {
    const bf16_t* zb;
    bf16_t *ya, *yb, *yc;
    float* park;
    const bf16_t *kcmp, *vtcmp;
    const float *rel_bias, *lamp, *subln, *sinks;
    float lam_init;
};

__device__ __forceinline__ void attn_unit_A(LAS uchar* lds, const AttnCtx& C, int bl, int h, int qt, int tid) {
    tid = opq(tid);
    const int lane = tid & 63, n = lane & 31, hi = lane >> 5, w = __builtin_amdgcn_readfirstlane(tid >> 6);
    build_tbl(lds, C.rel_bias, h, 1, tid);
    float lam;
    { const float a = C.lamp[lane] * C.lamp[64 + lane], b = C.lamp[128 + lane] * C.lamp[192 + lane]; lam = __expf(wave_sum(a)) - __expf(wave_sum(b)) + C.lam_init; }
    const int qpos = 256 * qt + 32 * w + n;
    const float rfar = C.rel_bias[31 * 20 + h] * LOG2E;
    const int kt1 = 4 * qt + 4, wkm = 4 * qt + (w >> 1);
    const bf16_t* Vt = C.zb + ZVA + ((size_t)bl * 8 + 2 * h) * HS;
    f32x16 acc[4];
    bf16x8 qf[4];
    float m, l;
    LAS unsigned* pl = (LAS unsigned*)(lds + L_RED) + tid;
#pragma unroll 1
    for (int c = 1; c >= 0; --c) {
        const size_t hoff = ((size_t)bl * 8 + 2 * h + c) * HS;
        load_q(qf, C.zb + ZQA + hoff + (size_t)qpos * 64, hi);
        acc_zero<4>(acc); m = MINIT; l = 0.f;
        attn_pass<128, false>(lds, C.zb + ZKA + hoff, Vt, 4096, 0, kt1, wkm, qpos, 256 * qt + 32 * w, 256 * qt + 32 * w + 31, 1, 0, 0x7fffffffu, qf, L_TBL, 0ull, false, m, l, acc, 0.f, 0, rfar, tid);
        acc_norm<4>(acc, l);
        if (c == 1) {
#pragma unroll
            for (int t = 0; t < 4; ++t)
#pragma unroll
                for (int gq = 0; gq < 4; ++gq) { pl[(t * 8 + 2 * gq) * NTHR] = cvtpk(acc[t][4 * gq], acc[t][4 * gq + 1]); pl[(t * 8 + 2 * gq + 1) * NTHR] = cvtpk(acc[t][4 * gq + 2], acc[t][4 * gq + 3]); }
        }
    }
    float ss = 0.f;
#pragma unroll
    for (int t = 0; t < 4; ++t)
#pragma unroll
        for (int gq = 0; gq < 4; ++gq) { const unsigned pa = pl[(t * 8 + 2 * gq) * NTHR], pb = pl[(t * 8 + 2 * gq + 1) * NTHR];
            const f32x4 o1 = (f32x4){__uint_as_float(pa << 16), __uint_as_float(pa & 0xffff0000u), __uint_as_float(pb << 16), __uint_as_float(pb & 0xffff0000u)};
#pragma unroll
            for (int e = 0; e < 4; ++e) { const float y = acc[t][4 * gq + e] - lam * o1[e]; acc[t][4 * gq + e] = y; ss += y * y; } }
    ss += __shfl_xor(ss, 32);
    const float rs = (1.0f / sqrtf(ss * (1.f / 128.f) + EPS)) * (1.f - C.lam_init);
    bf16_t* yrow = C.ya + ((size_t)bl * 4096 + qpos) * 512 + h * 128;
#pragma unroll
    for (int t = 0; t < 4; ++t)
#pragma unroll
        for (int gq = 0; gq < 4; ++gq) {
            const int d = 32 * t + 8 * gq + 4 * hi;
            const f32x4 gg = *(const f32x4*)(C.subln + d);
            u32x2 wv; wv.x = cvtpk(acc[t][4 * gq] * rs * gg[0], acc[t][4 * gq + 1] * rs * gg[1]); wv.y = cvtpk(acc[t][4 * gq + 2] * rs * gg[2], acc[t][4 * gq + 3] * rs * gg[3]);
            *(u32x2*)(yrow + d) = wv;
        }
}

__device__ __forceinline__ void attn_unit_B(LAS uchar* lds, const AttnCtx& C, int bl, int g, int i, int tid) {
    tid = opq(tid);
    const int lane = tid & 63, n = lane & 31, hi = lane >> 5, w = __builtin_amdgcn_readfirstlane(tid >> 6);
    build_tbl(lds, C.rel_bias, 4 + 4 * g, 4, tid);
    const int ql = 8 * w + (n & 7), hr = n >> 3, qpos = 64 * i + ql, head = 4 * g + hr, qlo = 64 * i + 8 * w;
    const float rfar = C.rel_bias[31 * 20 + 4 + head] * LOG2E;
    const int tbl = L_TBL + hr * 512;
    bf16x8 qf[4];
    load_q(qf, C.zb + ZQB + ((size_t)bl * 8 + head) * HS + (size_t)qpos * 64, hi);
    const size_t goff = ((size_t)bl * 2 + g) * HS;
    f32x16 acc[2];
    LAS float* otl = (LAS float*)(lds + L_RED) + tid;
    float m, l;
    const size_t tok = (size_t)bl * 4096 + qpos;
    const float* bg = (const float*)(C.zb + ZBG) + tok * 32 + head * 3;
    const float g0 = bg[0], g1 = bg[1], g2 = bg[2];
    const bf16_t* Kc = C.kcmp + ((size_t)bl * 2 + g) * 256 * 64;
    const bf16_t* Vc = C.vtcmp + ((size_t)bl * 2 + g) * 64 * 256;
    const int ktc1 = ((4 * i + 2) >> 6) + 1;
    acc_zero<2>(acc); m = MINIT; l = 0.f;
    attn_pass<64, false>(lds, Kc, Vc, 256, 0, ktc1, 1 << 20, qpos, qlo, qlo + 7, 16, 31, 0x7fffffffu, qf, tbl, 0ull, false, m, l, acc, 0.f, 0, rfar, tid);
    acc_norm<2>(acc, l);
#pragma unroll
    for (int t = 0; t < 2; ++t)
#pragma unroll
        for (int r = 0; r < 16; ++r) otl[(t * 16 + r) * NTHR] = g0 * acc[t][r];
    unsigned long long selmask = ~0ull;
    if (i >= 16) {
    {
        const float lt = l + __shfl_xor(l, 32);
        const float inv_l = lt > 0.f ? 1.f / lt : 0.f;
        LAS float* impw = (LAS float*)(lds + L_IMP) + (8 * w) * 65;
        for (int x = lane; x < 8 * 65; x += 64) impw[x] = 0.f;
        __builtin_amdgcn_fence(__ATOMIC_RELEASE, "wavefront");
        attn_pass<64, true>(lds, Kc, Vc, 256, 0, ktc1, 1 << 20, qpos, qlo, qlo + 7, 16, 31, 0x7fffffffu, qf, tbl, 0ull, false, m, l, acc, inv_l, ql, rfar, tid);
    }
    {
        const int q = tid & 63, part = tid >> 6;
        const LAS float* row = (const LAS float*)(lds + L_IMP) + q * 65;
        float cand[8]; int rank[8];
#pragma unroll
        for (int c = 0; c < 8; ++c) { const int j = 8 * part + c; float v = row[j]; v = (j == 0 || j == i || j == i - 1) ? 1e6f : (j > i ? -1e6f : v); cand[c] = v; rank[c] = 0; }
        for (int jj = 0; jj <= i; ++jj) {
            float x = row[jj]; x = (jj == 0 || jj == i || jj == i - 1) ? 1e6f : (jj > i ? -1e6f : x);
#pragma unroll
            for (int c = 0; c < 8; ++c) { const int j = 8 * part + c; rank[c] += (x > cand[c] || (x == cand[c] && jj < j)) ? 1 : 0; }
        }
        unsigned bits = 0;
#pragma unroll
        for (int c = 0; c < 8; ++c) bits |= (rank[c] < 16 ? 1u : 0u) << c;
        ((LAS uchar*)(lds + L_SEL))[q * 8 + part] = (uchar)bits;
    }
    __syncthreads();
    { const u32x2 sm = *(const LAS u32x2*)(lds + L_SEL + ql * 8); selmask = (unsigned long long)sm.x | ((unsigned long long)sm.y << 32); }
    }
    acc_zero<2>(acc); m = MINIT; l = 0.f;
    attn_pass<64, false>(lds, C.zb + ZKS + goff, C.zb + ZVS + goff, 4096, 0, i + 1, 1 << 20, qpos, qlo, qlo + 7, 1, 0, 0x7fffffffu, qf, tbl, selmask, true, m, l, acc, 0.f, 0, rfar, tid);
    acc_norm<2>(acc, l);
#pragma unroll
    for (int t = 0; t < 2; ++t)
#pragma unroll
        for (int r = 0; r < 16; ++r) otl[(t * 16 + r) * NTHR] += g1 * acc[t][r];
    acc_zero<2>(acc); m = MINIT; l = 0.f;
    attn_pass<64, false>(lds, C.zb + ZKW + goff, C.zb + ZVW + goff, 4096, i > 8 ? i - 8 : 0, i + 1, 1 << 20, qpos, qlo, qlo + 7, 1, 0, 512u, qf, tbl, 0ull, false, m, l, acc, 0.f, 0, rfar, tid);
    acc_norm<2>(acc, l);
    bf16_t* yrow = C.yb + tok * 512 + head * 64;
#pragma unroll
    for (int t = 0; t < 2; ++t)
#pragma unroll
        for (int gq = 0; gq < 4; ++gq) {
            const int d = 32 * t + 8 * gq + 4 * hi;
            float o[4];
#pragma unroll
            for (int e = 0; e < 4; ++e) o[e] = otl[(t * 16 + 4 * gq + e) * NTHR] + g2 * acc[t][4 * gq + e];
            u32x2 wv; wv.x = cvtpk(o[0], o[1]); wv.y = cvtpk(o[2], o[3]);
            *(u32x2*)(yrow + d) = wv;
        }
}

__device__ __forceinline__ void attn_unit_C(LAS uchar* lds, const AttnCtx& C, int bl, int g, int i, int tid) {
    tid = opq(tid);
    const int lane = tid & 63, n = lane & 31, hi = lane >> 5, w = __builtin_amdgcn_readfirstlane(tid >> 6);
    build_tbl(lds, C.rel_bias, 12 + 4 * g, 4, tid);
    const int ql = 8 * w + (n & 7), hr = n >> 3, qpos = 64 * i + ql, head = 4 * g + hr, qlo = 64 * i + 8 * w;
    const float rfar = C.rel_bias[31 * 20 + 12 + head] * LOG2E;
    const int tbl = L_TBL + hr * 512;
    bf16x8 qf[4];
    load_q(qf, C.zb + ZQC + ((size_t)bl * 8 + head) * HS + (size_t)qpos * 64, hi);
    const size_t goff = ((size_t)bl * 2 + g) * HS;
    f32x16 acc[2];
    acc_zero<2>(acc);
    float m = C.sinks[head] * LOG2E, l = hi == 0 ? 1.f : 0.f;
    attn_pass<64, false>(lds, C.zb + ZKC + goff, C.zb + ZVC + goff, 4096, i > 2 ? i - 2 : 0, i + 1, 1 << 20, qpos, qlo, qlo + 7, 1, 0, 128u, qf, tbl, 0ull, false, m, l, acc, 0.f, 0, rfar, tid);
    acc_norm<2>(acc, l);
    const size_t tok = (size_t)bl * 4096 + qpos;
    bf16_t* yrow = C.yc + tok * 512 + head * 64;
#pragma unroll
    for (int t = 0; t < 2; ++t)
#pragma unroll
        for (int gq = 0; gq < 4; ++gq) {
            const int d = 32 * t + 8 * gq + 4 * hi;
            u32x2 wv; wv.x = cvtpk(acc[t][4 * gq], acc[t][4 * gq + 1]); wv.y = cvtpk(acc[t][4 * gq + 2], acc[t][4 * gq + 3]);
            *(u32x2*)(yrow + d) = wv;
        }
}

#define XB_TMO      128
#define XB_XCNT(j)  (256  + 64 * (j))
#define XB_XSUB(j)  (1280 + 64 * (j))
#define XB_XGEN(j)  (2304 + 64 * (j))
#define XB_TOP      3328
#define XB_TOPGEN   3392
#define XCD_BAR_WORDS 3456
#define XB_SPIN_CAP (1u << 18)

__device__ __forceinline__ unsigned xb_ld(unsigned* p)              { return __hip_atomic_load(p, __ATOMIC_RELAXED, __HIP_MEMORY_SCOPE_AGENT); }
__device__ __forceinline__ unsigned xb_add(unsigned* p, unsigned v) { return __hip_atomic_fetch_add(p, v, __ATOMIC_RELAXED, __HIP_MEMORY_SCOPE_AGENT); }
__device__ __forceinline__ unsigned xb_xcc_id() { return (unsigned)__builtin_amdgcn_s_getreg((3 << 11) | 20) & 0xFu; }
#define XB_SPIN(cond, bar) do { unsigned _sp = 0; while (cond) { __builtin_amdgcn_s_sleep(1); \
    if ((++_sp & 255u) == 0u) { if (xb_ld(&(bar)[XB_TMO])) break; if (_sp > XB_SPIN_CAP) { atomicAdd(&(bar)[XB_TMO], 1u); break; } } } } while (0)

struct XcdBarrier {
    unsigned* bar; unsigned x;
    volatile __attribute__((address_space(3))) unsigned* st;
};

__device__ __forceinline__ XcdBarrier xcd_barrier_post(unsigned* bar, volatile __attribute__((address_space(3))) unsigned* st) {
    XcdBarrier b; b.bar = bar; b.x = xb_xcc_id(); b.st = st;
    if (threadIdx.x == 0) (void)xb_add(&bar[XB_XCNT(b.x)], 1u);
    return b;
}
__device__ __forceinline__ void xcd_barrier_complete(unsigned* bar, unsigned x, unsigned& nloc, unsigned& nx) {
    const unsigned G = gridDim.x * gridDim.y * gridDim.z;
    unsigned sum, cnt, mine, sp = 0u;
    for (;;) {
        sum = 0u; cnt = 0u; mine = 0u;
#pragma unroll
        for (unsigned j = 0; j < 16; ++j) { const unsigned c = xb_ld(&bar[XB_XCNT(j)]); sum += c; cnt += (c > 0u) ? 1u : 0u; mine = (j == x) ? c : mine; }
        if (sum == G) break;
        __builtin_amdgcn_s_sleep(1);
        if ((++sp & 255u) == 0u) { if (xb_ld(&bar[XB_TMO])) break; if (sp > XB_SPIN_CAP) { atomicAdd(&bar[XB_TMO], 1u); break; } }
    }
    nloc = mine > 0u ? mine : 1u; nx = cnt > 0u ? cnt : 1u;
}

__device__ __forceinline__ void xcd_barrier(const XcdBarrier& b) {
    asm volatile("s_waitcnt vmcnt(0)" ::: "memory");
    __syncthreads();
    if (threadIdx.x == 0) {
        unsigned* bar = b.bar;
        __builtin_amdgcn_s_waitcnt(0);
        unsigned nloc = b.st[0], nx = b.st[1];
        if (nloc == 0u) { xcd_barrier_complete(bar, b.x, nloc, nx); b.st[0] = nloc; b.st[1] = nx; }
        const unsigned old = xb_add(&bar[XB_XSUB(b.x)], 1u);
        const unsigned gen = old / nloc;
        if (old + 1u == (gen + 1u) * nloc) {
            __builtin_amdgcn_fence(__ATOMIC_RELEASE, "agent");
            asm volatile("s_waitcnt vmcnt(0)" ::: "memory");
            const unsigned og = xb_add(&bar[XB_TOP], 1u);
            const unsigned tg = og / nx;
            if (og + 1u == (tg + 1u) * nx) xb_add(&bar[XB_TOPGEN], 1u);
            else XB_SPIN(xb_ld(&bar[XB_TOPGEN]) == tg, bar);
            __builtin_amdgcn_fence(__ATOMIC_ACQUIRE, "agent");
            xb_add(&bar[XB_XGEN(b.x)], 1u);
            asm volatile("s_waitcnt vmcnt(0)" ::: "memory");
        } else {
            XB_SPIN(xb_ld(&bar[XB_XGEN(b.x)]) == gen, bar);
            __builtin_amdgcn_fence(__ATOMIC_ACQUIRE, "agent");
            asm volatile("s_waitcnt vmcnt(0)" ::: "memory");
        }
    }
    __syncthreads();
}

#define KIN(i) (kparams()->in[i])
#define WS_ (kparams()->ws)
#define HOUT (kparams()->out)
#define Wb ((bf16_t*)(WS_ + WS_W))
#define XN ((bf16_t*)(WS_ + WS_XN))
#define R1 ((bf16_t*)(WS_ + WS_R1))
#define YA ((bf16_t*)(WS_ + WS_Y))
#define MG ((bf16_t*)(WS_ + WS_MG))
#define CH ((bf16_t*)(WS_ + WS_CH))
#define KCMP ((bf16_t*)(WS_ + WS_KCMP))
#define VCMP ((bf16_t*)(WS_ + WS_VCMP))
#define CB ((float*)(WS_ + WS_CB))
#define XN2 ((bf16_t*)(WS_ + WS_XN2))
#define PBF ((bf16_t*)(WS_ + WS_PBF))
#define SSQ ((float*)(WS_ + WS_SSQ))
#define SSQ2 ((float*)(WS_ + WS_SSQ2))
constexpr int LDS_BYTES = 147456;
#ifdef ONLY_EPI
#include <type_traits>
#define ONLY_OK(E) (std::is_same<E, ONLY_EPI>::value)
#else
#define ONLY_OK(E) true
#endif
#ifdef NO_GEMM
#define GEMM(EPI, e, A_, lda_, Bt_, M_, N_, K_, cshift) do { (void)(e); } while (0)
#else
#define GEMM(EPI, e, A_, lda_, Bt_, M_, N_, K_, cshift) do { pg8::Gemm g_{(const bf16_t*)(A_), (const bf16_t*)(Bt_), (M_), (N_), (K_), (lda_)}; pg8::StaticOrder S_; \
    int c_ = (int)((blk + (cshift)) % G), G_ = G; asm volatile("" : "+s"(c_), "+s"(G_)); S_.init((M_), (N_), G_, c_); if (ONLY_OK(EPI)) pg8::gemm_phase<EPI, pg8::StaticOrder, EPI::ALIGN, true>(lds, g_, S_, (e)); } while (0)
#endif
#ifdef NO_GEMM
#define GEMM_X(EPI, e, A_, lda_, Bt_, M_, N_, K_, cidx, gsz) do { (void)(e); } while (0)
#else
#define GEMM_X(EPI, e, A_, lda_, Bt_, M_, N_, K_, cidx, gsz) do { pg8::Gemm g_{(const bf16_t*)(A_), (const bf16_t*)(Bt_), (M_), (N_), (K_), (lda_)}; pg8::StaticOrder S_; \
    int c_ = (int)(cidx), G_ = (int)(gsz); asm volatile("" : "+s"(c_), "+s"(G_)); S_.init((M_), (N_), G_, c_); if (ONLY_OK(EPI)) pg8::gemm_phase<EPI, pg8::StaticOrder, EPI::ALIGN, true>(lds, g_, S_, (e)); } while (0)
#endif

__global__ void __launch_bounds__(NTHR, 2) fwd_kernel(Params P) {
    extern __shared__ __attribute__((aligned(16))) unsigned char lds_raw[];
    LAS uchar* lds = (LAS uchar*)lds_raw;
    cg::grid_group grid = cg::this_grid();
    volatile LAS unsigned* xst = (volatile LAS unsigned*)(lds + LDS_BYTES - 64);
    if (threadIdx.x < 2) xst[threadIdx.x] = 0u;
    __syncthreads();
    const XcdBarrier xbar = xcd_barrier_post((unsigned*)(kparams()->ws + WS_CTL), xst);
#ifndef PROBE_CLASS
#define PROBE_CLASS 0
#endif
#if PROBE_CLASS
    unsigned long long pr_acc = 0, pr_last = __builtin_amdgcn_s_memrealtime();
#define SYNC(cls) do { const unsigned long long t1_ = __builtin_amdgcn_s_memrealtime(); if ((cls) == PROBE_CLASS) pr_acc += t1_ - pr_last; if ((cls) == 6) grid.sync(); else xcd_barrier(xbar); \
    const unsigned long long t2_ = __builtin_amdgcn_s_memrealtime(); if (PROBE_CLASS == 2) pr_acc += t2_ - t1_; pr_last = t2_; } while (0)
#else
#define SYNC(cls) do { if ((cls) == 6) grid.sync(); else xcd_barrier(xbar); } while (0)
#endif
#define DEF_IDS \
    int tid_o = threadIdx.x, G_o = gridDim.x, blk_o = blockIdx.x; asm volatile("" : "+v"(tid_o), "+s"(G_o), "+s"(blk_o)); \
    const int tid = tid_o, lane = tid & 63, wave = __builtin_amdgcn_readfirstlane(tid >> 6); \
    const int G = G_o, blk = blk_o; \
    const int vcu = (G % 8 == 0) ? (blk % 8) * (G / 8) + blk / 8 : blk; \
    const int gw = blk * 8 + wave, ngw = G * 8; (void)vcu; (void)gw; (void)ngw; (void)lane;
    {
        DEF_IDS
        LAS float* scr = (LAS float*)lds;
        int base = 0;
        for (int L = 0; L < DEPTH; ++L) {
            bf16_t* wl = Wb + (size_t)L * W_LAYER;
            conv_matrix(KIN(3) + (size_t)L * 1024 * 5632, 1024, 5632, 5632, 1, wl + W_WI1, base, scr, tid, blk, G, KIN(2) + (size_t)(L * 4 + 0) * DM);
            conv_matrix(KIN(4) + (size_t)L * 2816 * 1024, 2816, 1024, 1024, 0, wl + W_WO1, base, scr, tid, blk, G);
            conv_matrix(KIN(5) + (size_t)L * 1024 * DIN, 1024, DIN, DINP, 2, wl + W_WIN, base, scr, tid, blk, G, KIN(2) + (size_t)(L * 4 + 1) * DM);
            for (int t = 0; t < 2; ++t) conv_matrix(KIN(9) + ((size_t)L * 2 + t) * 2048 * 256, 2048, 256, 256, 0, wl + W_CW1 + (size_t)t * 256 * 2048, base, scr, tid, blk, G);
            for (int t = 0; t < 2; ++t) conv_matrix(KIN(10) + ((size_t)L * 2 + t) * 256 * 64, 256, 64, 256, 3, wl + W_CW2 + (size_t)t * 256 * 256, base, scr, tid, blk, G);
            for (int t = 0; t < 3; ++t) conv_matrix(KIN(12) + ((size_t)L * 3 + t) * 512 * 1024, 512, 1024, 1024, 0, wl + W_WBR + (size_t)t * 1024 * 512, base, scr, tid, blk, G);
            conv_matrix(KIN(13) + (size_t)L * 1024 * 1024, 1024, 1024, 1024, 0, wl + W_WOUT, base, scr, tid, blk, G);
            conv_matrix(KIN(14) + (size_t)L * 1024 * 5632, 1024, 5632, 5632, 1, wl + W_WI2, base, scr, tid, blk, G, KIN(2) + (size_t)(L * 4 + 2) * DM);
            conv_matrix(KIN(15) + (size_t)L * 2816 * 1024, 2816, 1024, 1024, 0, wl + W_WO2, base, scr, tid, blk, G);
            conv_matrix(KIN(16) + (size_t)L * 256 * 1024, 256, 1024, 1024, 0, wl + W_WPE, base, scr, tid, blk, G);
            conv_matrix(KIN(17) + (size_t)L * 1024 * 1024, 1024, 1024, 1024, 0, wl + W_WPG, base, scr, tid, blk, G, KIN(2) + (size_t)(L * 4 + 3) * DM);
        }
        for (int pr = blk; pr < DEPTH * 2; pr += G) {
            const float* pos = KIN(8) + (size_t)pr * 2048; const float* w1 = KIN(9) + (size_t)pr * 2048 * 256;
            float a[4] = {0.f, 0.f, 0.f, 0.f};
            for (int k = wave * 256; k < wave * 256 + 256; ++k) { const float pv = pos[k];
#pragma unroll
                for (int j = 0; j < 4; ++j) a[j] += pv * w1[(size_t)k * 256 + lane + 64 * j]; }
#pragma unroll
            for (int j = 0; j < 4; ++j) scr[wave * 256 + lane + 64 * j] = a[j];
            __syncthreads();
            if (tid < 256) { float s = 0.f;
#pragma unroll
                for (int ww = 0; ww < 8; ++ww) s += scr[ww * 256 + tid];
                CB[pr * 256 + tid] = s; }
            __syncthreads();
        }
        phase_prep(KIN(0), XN2, SSQ2, gw, ngw, lane);
    }
    SYNC(6);

#pragma unroll 1
    for (int L = 0; L < DEPTH; ++L) {
        DEF_IDS
#define wl (Wb + (size_t)L * W_LAYER)
#define ng (KIN(2) + (size_t)L * 4 * DM)
        { EpiSwiglu e{R1, SSQ2}; GEMM(EpiSwiglu, e, XN2, 1024, wl + W_WI1, T, 5632, 1024, 0); }
        SYNC(3);
        { EpiResid e{0.5f, 0, L == 0 ? 0 : 1}; GEMM(EpiResid, e, R1, DFF, wl + W_WO1, T, 1024, DFF, 0); }
        SYNC(3);
        {
            const f32x4* src = (const f32x4*)(KIN(1) + (size_t)L * T * PLE); u32x2* dst = (u32x2*)PBF;
            const int tq = opq(tid);
            for (size_t idx = (size_t)blk * NTHR + tq; idx < (size_t)T * PLE / 4; idx += (size_t)G * NTHR) { const f32x4 v = src[idx]; u32x2 w; w.x = cvtpk(v[0], v[1]); w.y = cvtpk(v[2], v[3]); dst[idx] = w; }
        }
        { EpiZ e{R1, SSQ, 0}; GEMM(EpiZ, e, XN, 1024, wl + W_WIN, TC, DINP - 256, 1024, 0); }
        SYNC(3);
        for (int c = 0; c < NCHUNK; ++c) {
            {
                const bool offl = (G >= 64) && ((G & 1) == 0), has_cmp = blk < 16 || (blk >= G / 2 && blk < G / 2 + 16);
                EpiZ e{R1, SSQ + (size_t)c * TC * 16, 26};
                if (!offl) GEMM(EpiZ, e, XN + (size_t)c * TC * DM, 1024, wl + W_WIN + (size_t)(DINP - 256) * 1024, TC, 256, 1024, 0);
                else if (!has_cmp) GEMM_X(EpiZ, e, XN + (size_t)c * TC * DM, 1024, wl + W_WIN + (size_t)(DINP - 256) * 1024, TC, 256, 1024, blk < G / 2 ? blk - 16 : blk - 32, G - 32);
                EpiBf<0> ee{(bf16_t*)HOUT + (size_t)c * TC * DM, 1024, nullptr};
                if (!offl) GEMM(EpiBf<0>, ee, PBF + (size_t)c * TC * PLE, 256, wl + W_WPE, TC, 1024, 256, 0);
                else if (!has_cmp) GEMM_X(EpiBf<0>, ee, PBF + (size_t)c * TC * PLE, 256, wl + W_WPE, TC, 1024, 256, blk < G / 2 ? blk - 16 : blk - 32, G - 32);
            }
            { EpiBf<1> ek{CH, 256, CB + (L * 2 + 0) * 256}; GEMM(EpiBf<1>, ek, R1 + ZKCI, 1024, wl + W_CW1, NB * 512, 256, 2048, 0);
              EpiBf<1> ev{CH + (size_t)NB * 512 * 256, 256, CB + (L * 2 + 1) * 256}; GEMM(EpiBf<1>, ev, R1 + ZVCI, 1024, wl + W_CW1 + (size_t)256 * 2048, NB * 512, 256, 2048, G / 2); }
            __builtin_amdgcn_fence(__ATOMIC_RELEASE, "workgroup"); __syncthreads(); __builtin_amdgcn_fence(__ATOMIC_ACQUIRE, "workgroup");
            { EpiCmp2<false> ek{KCMP}; GEMM(EpiCmp2<false>, ek, CH, 256, wl + W_CW2, NB * 512, 256, 256, 0);
              EpiCmp2<true> ev{VCMP}; GEMM(EpiCmp2<true>, ev, CH + (size_t)NB * 512 * 256, 256, wl + W_CW2 + (size_t)256 * 256, NB * 512, 256, 256, G / 2); }
            SYNC(5);
            {
                AttnCtx C;
                C.zb = R1; C.park = (float*)MG; C.ya = YA; C.yb = YA + (size_t)TC * 512; C.yc = YA + (size_t)2 * TC * 512; C.kcmp = KCMP; C.vtcmp = VCMP;
                C.rel_bias = KIN(18); C.lamp = KIN(6) + (size_t)L * 256; C.subln = KIN(7) + (size_t)L * 128; C.sinks = KIN(11) + (size_t)L * 8;
                C.lam_init = 0.8f - 0.6f * __expf(-0.3f * (float)L);
                for (int u = vcu; u < NB * 32; u += G) {
                    const int bl = u >> 5;
#ifndef NO_A
#if PROBE_CLASS == 7
                    const unsigned long long ta0_ = __builtin_amdgcn_s_memrealtime();
#endif
                    { const int h = (u >> 3) & 3, qp = u & 7;
#pragma unroll 1
                      for (int k = 0; k < 2; ++k) attn_unit_A(lds, C, bl, h, k ? 15 - qp : qp, tid); }
#if PROBE_CLASS == 7
                    pr_acc += __builtin_amdgcn_s_memrealtime() - ta0_;
#endif
#endif
                    { const int g = (u >> 4) & 1, is = u & 15;
#ifndef NO_B
#pragma unroll 1
                      for (int k = 0; k < 4; ++k) attn_unit_B(lds, C, bl, g, (k & 1) ? (k == 1 ? 31 : 63) - is : (k == 0 ? 0 : 32) + is, tid);
#endif
#ifndef NO_C
#pragma unroll 1
                      for (int k = 0; k < 4; ++k) attn_unit_C(lds, C, bl, g, (k & 1) ? (k == 1 ? 31 : 63) - is : (k == 0 ? 0 : 32) + is, tid);
#endif
                    }
                }
            }
            SYNC(1);
            for (int mi = 0; mi < 3; ++mi) {
                EpiBranch e{MG, R1 + ZSG, mi}; GEMM(EpiBranch, e, YA + (size_t)mi * TC * 512, 512, wl + W_WBR + (size_t)mi * 1024 * 512, TC, 1024, 512, 0);
            }
            SYNC(3);
            { EpiResid e{1.0f, c * TC, 2}; GEMM(EpiResid, e, MG, 1024, wl + W_WOUT, TC, 1024, 1024, 0); }
            if (c + 1 < NCHUNK) { EpiZ e{R1, SSQ + (size_t)(c + 1) * TC * 16, 0}; GEMM(EpiZ, e, XN + (size_t)(c + 1) * TC * DM, 1024, wl + W_WIN, TC, DINP - 256, 1024, 0); }
            SYNC(3);
        }
        { EpiSwiglu e{R1, SSQ}; GEMM(EpiSwiglu, e, XN, 1024, wl + W_WI2, T, 5632, 1024, 0); }
        SYNC(3);
        { EpiResid e{0.5f, 0, 2}; GEMM(EpiResid, e, R1, DFF, wl + W_WO2, T, 1024, DFF, 0); }
        SYNC(3);
        { uchar* ws_ = WS_; EpiPle e{(const bf16_t*)(ws_ + WS_XN), (const bf16_t*)HOUT, (const float*)(ws_ + WS_SSQ), (bf16_t*)(ws_ + WS_XN2), (float*)(ws_ + WS_SSQ2)}; GEMM(EpiPle, e, XN, 1024, wl + W_WPG, T, 1024, 1024, 0); }
        SYNC(3);
    }
    { DEF_IDS const int lq = opq(lane); float* ho = HOUT; const float* fg = KIN(19); const bf16_t* hb = XN2; for (int m = gw; m < T; m += ngw) rms_row_bf16in_f32(hb + (size_t)m * DM, fg, ho + (size_t)m * DM, lq); }
#if PROBE_CLASS
    if (blockIdx.x == 0) { const unsigned long long t0_ = __builtin_amdgcn_s_memrealtime(); while (__builtin_amdgcn_s_memrealtime() - t0_ < pr_acc) __builtin_amdgcn_s_sleep(20); }
#endif
}

extern "C" void kernel_launch(void* const* d_in, const int* in_sizes, int n_in, void* d_out, int out_size, void* d_ws, size_t ws_size, hipStream_t stream) {
    static int grid = 0;
    if (grid == 0) {
        if (n_in != 20 || out_size != T * DM || ws_size < WS_END) { fprintf(stderr, "kernel_launch: unexpected shapes (n_in %d out %d ws %zu)\n", n_in, out_size, ws_size); grid = -1; return; }
        int dev = 0, cus = 0, per_cu = 0;
        hipGetDevice(&dev);
        hipDeviceGetAttribute(&cus, hipDeviceAttributeMultiprocessorCount, dev);
        if (hipFuncSetAttribute((const void*)fwd_kernel, hipFuncAttributeMaxDynamicSharedMemorySize, LDS_BYTES) != hipSuccess) { fprintf(stderr, "kernel_launch: hipFuncSetAttribute failed\n"); grid = -1; return; }
        if (hipOccupancyMaxActiveBlocksPerMultiprocessor(&per_cu, (const void*)fwd_kernel, NTHR, LDS_BYTES) != hipSuccess || per_cu < 1) { fprintf(stderr, "kernel_launch: occupancy query says %d\n", per_cu); per_cu = 1; }
        (void)hipGetLastError();
        grid = cus;
        if (grid > 256) grid = 256;
    }
    if (grid < 0) return;
    if (hipMemsetAsync((char*)d_ws + WS_CTL, 0, CTL_ZERO_BYTES, stream) != hipSuccess) { fprintf(stderr, "kernel_launch: memset failed\n"); return; }
    Params p{};
    for (int i = 0; i < 20; ++i) p.in[i] = (const float*)d_in[i];
    p.out = (float*)d_out; p.ws = (uchar*)d_ws;
    void* args[] = {&p};
    hipError_t e = hipLaunchCooperativeKernel((const void*)fwd_kernel, dim3(grid), dim3(NTHR), args, LDS_BYTES, stream);
    if (e != hipSuccess) fprintf(stderr, "cooperative launch failed: %s (grid %d)\n", hipGetErrorString(e), grid);
}
```

```cpp
#include <hip/hip_runtime.h>
#include <hip/hip_cooperative_groups.h>
#include <cstdio>
#include <cstdint>
namespace cg = cooperative_groups;
namespace pg8 {
#define PG8_LAS __attribute__((address_space(3)))
typedef unsigned short bf16_t;
typedef short bf16x8 __attribute__((ext_vector_type(8)));
typedef float f32x4 __attribute__((ext_vector_type(4)));
typedef unsigned u32x4 __attribute__((ext_vector_type(4)));
constexpr int BM = 256, BK = 64, HALF = 128, HTB = HALF * BK * 2  , STAGE_BYTES = 8 * HTB, NXCD = 8, WGM = 4;

__host__ __device__ __forceinline__ int lds_byte(int r, int c) { const int st = (r >> 4) * 2 + (c >> 5), rr = r & 15, cc = c & 31, ob = rr * 64 + cc * 2; return st * 1024 + (ob ^ (((ob >> 9) & 1) << 5)); }
__host__ __device__ __forceinline__ void stage_rc(int b, int& R, int& C) { const int st = b / 1024, sb = b % 1024, swz = sb ^ (((sb >> 9) & 1) << 5); R = (st >> 1) * 16 + swz / 64; C = (st & 1) * 32 + (swz % 64) / 2; }
__host__ __device__ __forceinline__ int perm32(int rho) { const int n = rho >> 4, i = rho & 15; return 8 * (i >> 2) + 4 * n + (i & 3); }

struct Unit { int pm, pn; };
struct Gemm { const bf16_t* A; const bf16_t* Bt; int M, N, K, lda; };

struct StaticOrder {
    int nM, nN, nwg, G, c;
    __host__ __device__ void init(int M, int N, int G_, int c_) { nM = M / BM; nN = N / BM; nwg = nM * nN; G = G_; c = c_; }
    __host__ __device__ bool next(int i, Unit& u) const {
        const long L = (long)i * G + c; if (L >= nwg) return false;
        int wgid = (int)L; { const int q = nwg / NXCD, r = nwg % NXCD, xcd = wgid % NXCD, off = wgid / NXCD; wgid = (xcd < r ? xcd * (q + 1) : r * (q + 1) + (xcd - r) * q) + off; }
        const int nig = WGM * nN, gid = wgid / nig, fm = gid * WGM, gsz = (nM - fm) < WGM ? (nM - fm) : WGM;
        u.pm = fm + ((wgid % nig) % gsz); u.pn = (wgid % nig) / gsz; return true;
    }
    __device__ __forceinline__ void a_ready(const Unit&) const {}
    __device__ __forceinline__ void done(const Unit&) const {}
};

__device__ __forceinline__ unsigned cvt_pk_bf16(float lo, float hi) { unsigned r; asm volatile("v_cvt_pk_bf16_f32 %0, %1, %2" : "=v"(r) : "v"(lo), "v"(hi)); return r; }
typedef float f32x2 __attribute__((ext_vector_type(2)));
template <class Epi, class Sched, bool ALIGN_EPI = false, bool SP2 = false>
__device__ __forceinline__ void gemm_phase(PG8_LAS unsigned char* lds, const Gemm g, const Sched& S, const Epi& E) {
    int tid_ = threadIdx.x; asm volatile("" : "+v"(tid_)); const int tid = tid_, wid = __builtin_amdgcn_readfirstlane(tid >> 6), lane = tid & 63, wr = wid >> 2, wc = wid & 3, fr = lane & 15, fq = lane >> 4;
    const int K = g.K, nt = K / BK;
    unsigned voffA[2], voffB[2];
#pragma unroll
    for (int i = 0; i < 2; ++i) { int R, C; stage_rc(tid * 16 + i * 8192, R, C); const int Rb = Epi::PERM ? ((R & ~31) + perm32(R & 31)) : R;
        voffA[i] = (unsigned)(R * g.lda + C) * 2u; voffB[i] = (unsigned)(Rb * K + C) * 2u; }
    const size_t kstep = (size_t)(BK * 2);
    const size_t hstep = (size_t)HALF * K * 2;
    const size_t tstep = 2 * hstep; const size_t hstepA = (size_t)HALF * g.lda * 2, tstepA = 2 * hstepA;
    const unsigned ldsw = (unsigned)wid * 1024u;
    const int aoff = lds_byte(wr * 64 + fr, fq * 8), boff = lds_byte(wc * 32 + fr, fq * 8);
#define PG8_SA(b, h) (((b) * 2 + (h)) * HTB)
#define PG8_SB(b, h) ((4 + (b) * 2 + (h)) * HTB)
#define PG8_STAGE(bufoff, gbase, voff) do { _Pragma("unroll") for (int _i = 0; _i < 2; ++_i) \
        __builtin_amdgcn_global_load_lds((const unsigned*)((const char*)(gbase) + (voff)[_i]), (PG8_LAS unsigned*)(lds + (bufoff) + ldsw + _i * 8192), 16, 0, 0); } while (0)
#define PG8_LDA(dst, b, h) do { _Pragma("unroll") for (int m = 0; m < 4; ++m) _Pragma("unroll") for (int k = 0; k < 2; ++k) dst[m][k] = *(const PG8_LAS bf16x8*)(lds + PG8_SA(b, h) + aoff + m * 2048 + k * 1024); } while (0)
#define PG8_LDB(dst, b, h) do { _Pragma("unroll") for (int n = 0; n < 2; ++n) _Pragma("unroll") for (int k = 0; k < 2; ++k) dst[n][k] = *(const PG8_LAS bf16x8*)(lds + PG8_SB(b, h) + boff + n * 2048 + k * 1024); } while (0)
#define PG8_MMA(ai, bj, At, Bt) do { __builtin_amdgcn_s_setprio(1); _Pragma("unroll") for (int m = 0; m < 4; ++m) _Pragma("unroll") for (int n = 0; n < 2; ++n) _Pragma("unroll") for (int k = 0; k < 2; ++k) \
        acc[ai][bj][m][n] = __builtin_amdgcn_mfma_f32_16x16x32_bf16(Bt[n][k], At[m][k], acc[ai][bj][m][n], 0, 0, 0); __builtin_amdgcn_s_setprio(0); } while (0)
#define PG8_WAIT_V(n) asm volatile("s_waitcnt vmcnt(" #n ")" ::: "memory")
#define PG8_WAIT_L(n) asm volatile("s_waitcnt lgkmcnt(" #n ")" ::: "memory")
#define PG8_BAR __builtin_amdgcn_s_barrier()
#define PG8_SCHED __builtin_amdgcn_sched_barrier(0)
    Unit cur, nxt; int ui = 0;
    if (!S.next(0, cur)) return;
    f32x4 acc[2][2][4][2];
#pragma unroll
    for (int a = 0; a < 2; ++a)
#pragma unroll
        for (int b = 0; b < 2; ++b)
#pragma unroll
            for (int m = 0; m < 4; ++m)
#pragma unroll
                for (int n = 0; n < 2; ++n) acc[a][b][m][n] = (f32x4){0.f, 0.f, 0.f, 0.f};
    bf16x8 At[4][2], B0[2][2], B1[2][2];
    const char* cA = (const char*)g.A + (size_t)cur.pm * tstepA; const char* cB = (const char*)g.Bt + (size_t)cur.pn * tstep;
    S.a_ready(cur);
    if constexpr (SP2) {
        PG8_STAGE(PG8_SB(0, 0), cB, voffB); PG8_STAGE(PG8_SB(0, 1), cB + hstep, voffB); PG8_STAGE(PG8_SA(0, 0), cA, voffA); PG8_STAGE(PG8_SA(0, 1), cA + hstepA, voffA);
        if (wr == 1) PG8_BAR;
        PG8_WAIT_V(2); PG8_BAR;
        PG8_STAGE(PG8_SB(1, 0), cB + kstep, voffB); PG8_STAGE(PG8_SA(1, 0), cA + kstep, voffA); PG8_STAGE(PG8_SB(1, 1), cB + hstep + kstep, voffB);
        PG8_WAIT_V(6); PG8_BAR;
    } else {
        PG8_STAGE(PG8_SB(0, 0), cB, voffB); PG8_STAGE(PG8_SA(0, 0), cA, voffA); PG8_STAGE(PG8_SB(0, 1), cB + hstep, voffB); PG8_STAGE(PG8_SA(0, 1), cA + hstepA, voffA);
        if (wr == 1) PG8_BAR;
        PG8_WAIT_V(4); PG8_BAR;
        PG8_STAGE(PG8_SB(1, 0), cB + kstep, voffB); PG8_STAGE(PG8_SA(1, 0), cA + kstep, voffA); PG8_STAGE(PG8_SB(1, 1), cB + hstep + kstep, voffB);
        PG8_WAIT_V(6); PG8_BAR;
    }
    for (;;) {
        const bool has_next = S.next(ui + 1, nxt);
        const char* nA = has_next ? (const char*)g.A + (size_t)nxt.pm * tstepA : cA; const char* nB = has_next ? (const char*)g.Bt + (size_t)nxt.pn * tstep : cB;
        for (int t = 0; t < nt; t += 2) {
            const bool last = (t == nt - 2);
            const char* a1 = cA + (size_t)(t + 1) * kstep;
            const char* a2 = last ? nA : cA + (size_t)(t + 2) * kstep; const char* b2 = last ? nB : cB + (size_t)(t + 2) * kstep;
            const char* a3 = a2 + kstep; const char* b3 = b2 + kstep;
            if (last && has_next) S.a_ready(nxt);
            if constexpr (SP2) {
            PG8_LDB(B0, 0, 0); PG8_LDB(B1, 0, 1); PG8_SCHED; PG8_LDA(At, 0, 0); PG8_STAGE(PG8_SA(1, 1), a1 + hstepA, voffA);
            PG8_WAIT_V(8); PG8_WAIT_L(0); PG8_BAR; PG8_MMA(0, 0, At, B0); PG8_MMA(0, 1, At, B1); PG8_BAR; PG8_SCHED;
            PG8_LDA(At, 0, 1); PG8_STAGE(PG8_SB(0, 0), b2, voffB); PG8_STAGE(PG8_SB(0, 1), b2 + hstep, voffB); PG8_STAGE(PG8_SA(0, 0), a2, voffA);
            PG8_WAIT_V(8); PG8_WAIT_L(0); PG8_BAR; PG8_MMA(1, 0, At, B0); PG8_MMA(1, 1, At, B1); PG8_BAR; PG8_SCHED;
            PG8_LDB(B0, 1, 0); PG8_LDB(B1, 1, 1); PG8_SCHED; PG8_LDA(At, 1, 0); PG8_STAGE(PG8_SA(0, 1), a2 + hstepA, voffA);
            PG8_WAIT_V(8); PG8_WAIT_L(0); PG8_BAR; PG8_MMA(0, 0, At, B0); PG8_MMA(0, 1, At, B1); PG8_BAR; PG8_SCHED;
            PG8_LDA(At, 1, 1); PG8_STAGE(PG8_SB(1, 0), b3, voffB); PG8_STAGE(PG8_SB(1, 1), b3 + hstep, voffB); PG8_STAGE(PG8_SA(1, 0), a3, voffA);
            PG8_WAIT_V(8); PG8_WAIT_L(0); PG8_BAR; PG8_MMA(1, 0, At, B0); PG8_MMA(1, 1, At, B1); PG8_BAR; PG8_SCHED;
            } else {
            PG8_LDB(B0, 0, 0); PG8_SCHED; PG8_LDA(At, 0, 0); PG8_STAGE(PG8_SA(1, 1), a1 + hstepA, voffA);
            PG8_WAIT_L(8); PG8_BAR; PG8_WAIT_L(0); PG8_MMA(0, 0, At, B0); PG8_BAR; PG8_SCHED;
            PG8_LDB(B1, 0, 1); PG8_STAGE(PG8_SB(0, 0), b2, voffB);
            PG8_BAR; PG8_WAIT_L(0); PG8_MMA(0, 1, At, B1); PG8_BAR;
            PG8_LDA(At, 0, 1); PG8_STAGE(PG8_SA(0, 0), a2, voffA);
            PG8_BAR; PG8_WAIT_L(0); PG8_MMA(1, 0, At, B0); PG8_BAR; PG8_SCHED;
            PG8_STAGE(PG8_SB(0, 1), b2 + hstep, voffB);
            PG8_WAIT_V(6); PG8_BAR; PG8_MMA(1, 1, At, B1); PG8_BAR;
            PG8_LDB(B0, 1, 0); PG8_SCHED; PG8_LDA(At, 1, 0); PG8_STAGE(PG8_SA(0, 1), a2 + hstepA, voffA);
            PG8_WAIT_L(8); PG8_BAR; PG8_WAIT_L(0); PG8_MMA(0, 0, At, B0); PG8_BAR; PG8_SCHED;
            PG8_LDB(B1, 1, 1); PG8_STAGE(PG8_SB(1, 0), b3, voffB);
            PG8_BAR; PG8_WAIT_L(0); PG8_MMA(0, 1, At, B1); PG8_BAR;
            PG8_LDA(At, 1, 1); PG8_STAGE(PG8_SA(1, 0), a3, voffA);
            PG8_BAR; PG8_WAIT_L(0); PG8_MMA(1, 0, At, B0); PG8_BAR; PG8_SCHED;
            PG8_STAGE(PG8_SB(1, 1), b3 + hstep, voffB);
            PG8_WAIT_V(6); PG8_BAR; PG8_MMA(1, 1, At, B1); PG8_BAR;
            }
        }
        if constexpr (ALIGN_EPI) { if (wr == 0) PG8_BAR; }
        if constexpr (!Epi::AFTER_DRAIN) { E(acc, cur, wr, wc, fr, fq); S.done(cur); }
        if (!has_next) break;
#pragma unroll
        for (int a = 0; a < 2; ++a)
#pragma unroll
            for (int b = 0; b < 2; ++b)
#pragma unroll
                for (int m = 0; m < 4; ++m)
#pragma unroll
                    for (int n = 0; n < 2; ++n) acc[a][b][m][n] = (f32x4){0.f, 0.f, 0.f, 0.f};
        cur = nxt; cA = nA; cB = nB; ++ui;
        if constexpr (ALIGN_EPI) { if (wr == 1) PG8_BAR; }
    }
    PG8_WAIT_V(0);
    if constexpr (!ALIGN_EPI) { if (wr == 0) PG8_BAR; }
    PG8_BAR;
    if constexpr (Epi::AFTER_DRAIN) { E.fused(acc, cur, wr, wc, fr, fq, lds, wid, lane); S.done(cur); }
#undef PG8_SA
#undef PG8_SB
#undef PG8_STAGE
#undef PG8_LDA
#undef PG8_LDB
#undef PG8_MMA
#undef PG8_WAIT_V
#undef PG8_WAIT_L
#undef PG8_BAR
#undef PG8_SCHED
}
}

#define LAS __attribute__((address_space(3)))
using pg8::bf16_t; using pg8::bf16x8; using pg8::f32x4; using pg8::u32x4;
typedef float f32x16 __attribute__((ext_vector_type(16)));
typedef unsigned u32x2 __attribute__((ext_vector_type(2)));
typedef unsigned char uchar;
typedef float f32x2_t __attribute__((ext_vector_type(2)));
typedef __bf16 bf16x2_t __attribute__((ext_vector_type(2)));

constexpr int DM = 1024, NBATCH = 16, SEQ = 4096, DEPTH = 4, PLE = 256, DFF = 2816;
constexpr int T = NBATCH * SEQ;
constexpr int NB = 8, TC = NB * SEQ, NCHUNK = NBATCH / NB;
constexpr int DIN = 6680, DINP = 6912;
constexpr float EPS = 1e-6f, LOG2E = 1.4426950408889634f;
constexpr int NTHR = 512;

constexpr size_t W_WI1 = 0, W_WO1 = W_WI1 + (size_t)5632 * 1024, W_WIN = W_WO1 + (size_t)1024 * 2816, W_CW1 = W_WIN + (size_t)DINP * 1024,
                 W_CW2 = W_CW1 + (size_t)2 * 256 * 2048, W_WBR = W_CW2 + (size_t)2 * 256 * 256, W_WOUT = W_WBR + (size_t)3 * 1024 * 512,
                 W_WI2 = W_WOUT + (size_t)1024 * 1024, W_WO2 = W_WI2 + (size_t)5632 * 1024, W_WPE = W_WO2 + (size_t)1024 * 2816,
                 W_WPG = W_WPE + (size_t)1024 * 256, W_LAYER = W_WPG + (size_t)1024 * 1024;
static_assert(W_LAYER == 29491200, "weights");
constexpr size_t MiB = 1u << 20;
constexpr size_t WS_W = 0, WS_XN = 226 * MiB, WS_R1 = 354 * MiB, WS_Y = 782 * MiB, WS_MG = 878 * MiB, WS_CH = 942 * MiB, WS_KCMP = 946 * MiB,
                 WS_VCMP = WS_KCMP + MiB / 2, WS_CB = 947 * MiB, WS_SSQ = 948 * MiB, WS_SSQ2 = 952 * MiB, WS_CTL = 956 * MiB, WS_END = 992 * MiB;
constexpr size_t CTL_ZERO_BYTES = 65536;
constexpr size_t WS_XN2 = WS_Y, WS_PBF = 960 * MiB;
static_assert(W_LAYER * 2 * DEPTH <= WS_XN, "w");
constexpr size_t HS = 262144;
constexpr size_t ZQA = 0, ZKA = ZQA + NB * 8 * HS, ZVA = ZKA + NB * 8 * HS, ZQB = ZVA + NB * 8 * HS, ZKCI = ZQB + NB * 8 * HS, ZVCI = ZKCI + NB * 2 * HS,
                 ZKS = ZVCI + NB * 2 * HS, ZVS = ZKS + NB * 2 * HS, ZKW = ZVS + NB * 2 * HS, ZVW = ZKW + NB * 2 * HS, ZQC = ZVW + NB * 2 * HS,
                 ZKC = ZQC + NB * 8 * HS, ZVC = ZKC + NB * 2 * HS, ZSG = ZVC + NB * 2 * HS, ZBG = ZSG + (size_t)TC * 3072, ZEND = ZBG + (size_t)TC * 32 * 2;
static_assert(ZEND * 2 <= 428 * MiB, "zbuf");
static_assert((size_t)T * DFF * 2 <= 428 * MiB, "act");
constexpr size_t R1_E = 0;

struct Params {
    const float* in[20];
    float* out;
    uchar* ws;
};

__device__ __forceinline__ unsigned cvtpk(float lo, float hi) { f32x2_t v = {lo, hi}; bf16x2_t b = __builtin_convertvector(v, bf16x2_t); return __builtin_bit_cast(unsigned, b); }
__device__ __forceinline__ bf16_t cvt1(float x) { return (bf16_t)(cvtpk(x, 0.f) & 0xffffu); }
__device__ __forceinline__ float bf2f(unsigned short b) { return __uint_as_float((unsigned)b << 16); }
__device__ __forceinline__ float wave_sum(float v) {
#pragma unroll
    for (int o = 1; o < 64; o <<= 1) v += __shfl_xor(v, o);
    return v;
}
__device__ __forceinline__ int opq(int v) { asm volatile("" : "+v"(v)); return v; }
__device__ __forceinline__ float sigm(float x) { return __builtin_amdgcn_rcpf(1.f + __builtin_amdgcn_exp2f(-x * LOG2E)); }
__device__ __forceinline__ float gelu_tanh(float x) { const float u = 0.7978845608028654f * (x + 0.044715f * x * x * x); const float e = __builtin_amdgcn_exp2f(-2.f * LOG2E * u); const float th = 2.f * __builtin_amdgcn_rcpf(1.f + e) - 1.f; return 0.5f * x * (1.f + th); }

typedef const __attribute__((address_space(4))) Params* KParPtr;
__device__ __forceinline__ KParPtr kparams() { auto p = __builtin_amdgcn_kernarg_segment_ptr(); asm volatile("" : "+s"(p)); return (KParPtr)p; }
#ifndef ALIGN_T
#define ALIGN_T false
#endif
#ifndef ALIGN_F
#define ALIGN_F true
#endif
#ifndef ALIGN_SW
#define ALIGN_SW true
#endif
#ifndef ALIGN_BR
#define ALIGN_BR true
#endif
#ifndef ALIGN_Z
#define ALIGN_Z true
#endif
__device__ __forceinline__ float row_rstd(const float* ssq, int row) {
    const f32x4* p = (const f32x4*)(ssq + (size_t)row * 16); const f32x4 a = p[0], b = p[1], c = p[2], d = p[3];
    const float sm = (((a[0] + a[1]) + (a[2] + a[3])) + ((b[0] + b[1]) + (b[2] + b[3]))) + (((c[0] + c[1]) + (c[2] + c[3])) + ((d[0] + d[1]) + (d[2] + d[3])));
    return 1.0f / sqrtf(sm * (1.f / 1024.f) + 1e-6f);
}
typedef const pg8::f32x4 (&AccRef)[2][2][4][2];
__device__ __forceinline__ void wave_rstd(const float* ssq, int rowbase, float (&rsl)[2]) {
    const int lane = threadIdx.x & 63;
    rsl[0] = row_rstd(ssq, rowbase + lane); rsl[1] = row_rstd(ssq, rowbase + 128 + lane);
}
struct EpiSwiglu {
    static constexpr bool PERM = true, AFTER_DRAIN = false, ALIGN = ALIGN_SW;
    bf16_t* O; const float* ssq;
    __device__ __forceinline__ void operator()(AccRef acc, const pg8::Unit& u, int wr, int wc, int fr, int fq) const {
        asm volatile("" : "+v"(fr), "+v"(fq));
        const int row0 = u.pm * 256 + wr * 64 + fr, col0 = u.pn * 128 + wc * 32 + 8 * fq;
        float rsl[2]; wave_rstd(ssq, u.pm * 256 + wr * 64, rsl);
#pragma unroll
        for (int ai = 0; ai < 2; ++ai)
#pragma unroll
            for (int m = 0; m < 4; ++m) {
                bf16_t* rp = O + (size_t)(row0 + ai * 128 + m * 16) * DFF + col0;
                const float rs = __shfl(rsl[ai], 16 * m + fr);
                float o[8];
#pragma unroll
                for (int n = 0; n < 2; ++n)
#pragma unroll
                    for (int e = 0; e < 4; ++e) { const float g = acc[ai][0][m][n][e] * rs, up = acc[ai][1][m][n][e] * rs; o[n * 4 + e] = g * sigm(g) * up; }
                u32x4 w; w.x = cvtpk(o[0], o[1]); w.y = cvtpk(o[2], o[3]); w.z = cvtpk(o[4], o[5]); w.w = cvtpk(o[6], o[7]);
                *(u32x4*)rp = w;
            }
    }
};
struct EpiResid {
    static constexpr bool PERM = false, AFTER_DRAIN = false, ALIGN = ALIGN_F;
    float alpha; int row_off; int hsrc;
    __device__ __forceinline__ void operator()(AccRef acc, const pg8::Unit& u, int wr, int wc, int fr, int fq) const {
        asm volatile("" : "+v"(fr), "+v"(fq));
        const int row0 = row_off + u.pm * 256 + wr * 64 + fr, col0 = u.pn * 256 + wc * 32 + 4 * fq;
        const float* xin = kparams()->in[0];
        uchar* wsb = kparams()->ws; bf16_t* hb = (bf16_t*)(wsb + WS_XN); float* ssq = (float*)(wsb + WS_SSQ);
        const bf16_t* hin = (const bf16_t*)(wsb + (hsrc == 1 ? WS_XN2 : WS_XN));
#pragma unroll
        for (int ai = 0; ai < 2; ++ai)
#pragma unroll
            for (int m = 0; m < 4; ++m) {
                const size_t off = (size_t)(row0 + ai * 128 + m * 16) * DM + col0;
                float sq = 0.f;
#pragma unroll
                for (int bj = 0; bj < 2; ++bj)
#pragma unroll
                    for (int n = 0; n < 2; ++n) { f32x4 b;
                        if (hsrc == 0) b = *(const f32x4*)(xin + off + bj * 128 + n * 16);
                        else { const u32x2 hv = *(const u32x2*)(hin + off + bj * 128 + n * 16); b = (f32x4){__uint_as_float(hv.x << 16), __uint_as_float(hv.x & 0xffff0000u), __uint_as_float(hv.y << 16), __uint_as_float(hv.y & 0xffff0000u)}; }
                        const f32x4 v = b + acc[ai][bj][m][n] * alpha;
                        u32x2 w; w.x = cvtpk(v[0], v[1]); w.y = cvtpk(v[2], v[3]); *(u32x2*)(hb + off + bj * 128 + n * 16) = w; sq += (v[0] * v[0] + v[1] * v[1]) + (v[2] * v[2] + v[3] * v[3]); }
                sq += __shfl_xor(sq, 16); sq += __shfl_xor(sq, 32);
                if (fq == 0) ssq[(size_t)(row0 + ai * 128 + m * 16) * 16 + u.pn * 4 + wc] = sq;

            }
    }
};
struct EpiPle {
    static constexpr bool PERM = false, AFTER_DRAIN = false, ALIGN = ALIGN_F;
    const bf16_t* hin; const bf16_t* E; const float* ssq_in; bf16_t* hb; float* ssq_out;
    __device__ __forceinline__ void operator()(AccRef acc, const pg8::Unit& u, int wr, int wc, int fr, int fq) const {
        asm volatile("" : "+v"(fr), "+v"(fq));
        const int row0 = u.pm * 256 + wr * 64 + fr, col0 = u.pn * 256 + wc * 32 + 4 * fq;
        float rsl[2]; wave_rstd(ssq_in, u.pm * 256 + wr * 64, rsl);
#pragma unroll
        for (int ai = 0; ai < 2; ++ai)
#pragma unroll
            for (int m = 0; m < 4; ++m) {
                const size_t off = (size_t)(row0 + ai * 128 + m * 16) * DM + col0;
                const float rs = __shfl(rsl[ai], 16 * m + fr);
                float sq = 0.f;
#pragma unroll
                for (int bj = 0; bj < 2; ++bj)
#pragma unroll
                    for (int n = 0; n < 2; ++n) {
                        const size_t o2 = off + bj * 128 + n * 16;
                        const u32x2 ev = *(const u32x2*)(E + o2); const u32x2 hv = *(const u32x2*)(hin + o2); f32x4 b = (f32x4){__uint_as_float(hv.x << 16), __uint_as_float(hv.x & 0xffff0000u), __uint_as_float(hv.y << 16), __uint_as_float(hv.y & 0xffff0000u)}; const f32x4 a = acc[ai][bj][m][n];
                        b[0] += sigm(a[0] * rs) * __uint_as_float(ev.x << 16); b[1] += sigm(a[1] * rs) * __uint_as_float(ev.x & 0xffff0000u);
                        b[2] += sigm(a[2] * rs) * __uint_as_float(ev.y << 16); b[3] += sigm(a[3] * rs) * __uint_as_float(ev.y & 0xffff0000u);
                        u32x2 w; w.x = cvtpk(b[0], b[1]); w.y = cvtpk(b[2], b[3]); *(u32x2*)(hb + o2) = w; sq += (b[0] * b[0] + b[1] * b[1]) + (b[2] * b[2] + b[3] * b[3]);
                    }
                sq += __shfl_xor(sq, 16); sq += __shfl_xor(sq, 32);
                if (fq == 0) ssq_out[(size_t)(row0 + ai * 128 + m * 16) * 16 + u.pn * 4 + wc] = sq;

            }
    }
};
template <int MODE> struct EpiBf {
    static constexpr bool PERM = true, AFTER_DRAIN = false, ALIGN = ALIGN_T;
    bf16_t* O; int ldc; const float* bias;
    __device__ __forceinline__ void operator()(AccRef acc, const pg8::Unit& u, int wr, int wc, int fr, int fq) const {
        asm volatile("" : "+v"(fr), "+v"(fq));
        const int row0 = u.pm * 256 + wr * 64 + fr, col0 = u.pn * 256 + wc * 32 + 8 * fq;
#pragma unroll
        for (int bj = 0; bj < 2; ++bj) {
            float bv[8];
#pragma unroll
            for (int e = 0; e < 8; ++e) bv[e] = MODE == 1 ? bias[col0 + bj * 128 + e] : 0.f;
#pragma unroll
            for (int ai = 0; ai < 2; ++ai)
#pragma unroll
                for (int m = 0; m < 4; ++m) {
                    float o[8];
#pragma unroll
                    for (int n = 0; n < 2; ++n)
#pragma unroll
                        for (int e = 0; e < 4; ++e) { float v = acc[ai][bj][m][n][e] + bv[n * 4 + e]; if (MODE == 1) v = gelu_tanh(v); o[n * 4 + e] = v; }
                    u32x4 w; w.x = cvtpk(o[0], o[1]); w.y = cvtpk(o[2], o[3]); w.z = cvtpk(o[4], o[5]); w.w = cvtpk(o[6], o[7]);
                    *(u32x4*)(O + (size_t)(row0 + ai * 128 + m * 16) * ldc + col0 + bj * 128) = w;
                }
        }
    }
};
template <bool VT> struct EpiCmp2 {
    static constexpr bool PERM = true, AFTER_DRAIN = false, ALIGN = ALIGN_T;
    bf16_t* O;
    __device__ __forceinline__ void operator()(AccRef acc, const pg8::Unit& u, int wr, int wc, int fr, int fq) const {
        asm volatile("" : "+v"(fr), "+v"(fq));
        if (u.pn != 0 || wc >= 2) return;
        const int row0 = u.pm * 256 + wr * 64 + fr, d0 = wc * 32 + 8 * fq;
#pragma unroll
        for (int ai = 0; ai < 2; ++ai)
#pragma unroll
            for (int m = 0; m < 4; ++m) {
                const int row = row0 + ai * 128 + m * 16, bg = row >> 8, n = row & 255;
                float o[8];
#pragma unroll
                for (int nn = 0; nn < 2; ++nn)
#pragma unroll
                    for (int e = 0; e < 4; ++e) o[nn * 4 + e] = (n == 255) ? 0.f : acc[ai][0][m][nn][e];
                if (!VT) { u32x4 w; w.x = cvtpk(o[0], o[1]); w.y = cvtpk(o[2], o[3]); w.z = cvtpk(o[4], o[5]); w.w = cvtpk(o[6], o[7]); *(u32x4*)(O + (size_t)row * 64 + d0) = w; }
                else {
#pragma unroll
                    for (int e = 0; e < 8; ++e) O[((size_t)bg * 64 + d0 + e) * 256 + n] = cvt1(o[e]);
                }
            }
    }
};
struct EpiBranch {
    static constexpr bool PERM = true, AFTER_DRAIN = false, ALIGN = ALIGN_BR;
    bf16_t* mg; const bf16_t* sg; int mi;
    __device__ __forceinline__ void operator()(AccRef acc, const pg8::Unit& u, int wr, int wc, int fr, int fq) const {
        asm volatile("" : "+v"(fr), "+v"(fq));
        const int row0 = u.pm * 256 + wr * 64 + fr, col0 = u.pn * 256 + wc * 32 + 8 * fq;
#pragma unroll
        for (int ai = 0; ai < 2; ++ai)
#pragma unroll
            for (int m = 0; m < 4; ++m) {
                const int row = row0 + ai * 128 + m * 16;
#pragma unroll
                for (int bj = 0; bj < 2; ++bj) {
                    const int col = col0 + bj * 128;
                    const u32x2 gv = *(const u32x2*)((const uchar*)sg + (size_t)row * 3072 + mi * 1024 + col);
                    u32x4 ov = (u32x4){0u, 0u, 0u, 0u};
                    if (mi != 0) ov = *(const u32x4*)(mg + (size_t)row * DM + col);
                    float o[8];
#pragma unroll
                    for (int q = 0; q < 4; ++q) {
                        const unsigned oq = ov[q], gw2 = (q < 2 ? gv.x : gv.y) >> ((q & 1) * 16);
                        const float g0 = (float)(gw2 & 255u) * (1.f / 255.f), g1 = (float)((gw2 >> 8) & 255u) * (1.f / 255.f);
                        const float a0 = acc[ai][bj][m][q >> 1][(q & 1) * 2], a1 = acc[ai][bj][m][q >> 1][(q & 1) * 2 + 1];
                        o[2 * q] = __uint_as_float(oq << 16) + g0 * a0;
                        o[2 * q + 1] = __uint_as_float(oq & 0xffff0000u) + g1 * a1;
                    }
                    u32x4 w; w.x = cvtpk(o[0], o[1]); w.y = cvtpk(o[2], o[3]); w.z = cvtpk(o[4], o[5]); w.w = cvtpk(o[6], o[7]);
                    *(u32x4*)(mg + (size_t)row * DM + col) = w;
                }

            }
    }
};
struct EpiZ {
    static constexpr bool PERM = true, AFTER_DRAIN = false, ALIGN = ALIGN_Z;
    bf16_t* zb; const float* ssq; int pn_off;
    __device__ __forceinline__ void operator()(AccRef acc, const pg8::Unit& u, int wr, int wc, int fr, int fq) const {
        asm volatile("" : "+v"(fr), "+v"(fq));
        const int pn = u.pn + pn_off;
        float rsl[2]; wave_rstd(ssq, u.pm * 256 + wr * 64, rsl);
#pragma unroll
        for (int bj = 0; bj < 2; ++bj) {
            const int ch = 2 * bj + (wc >> 1), d0 = (wc & 1) * 32 + 8 * fq;
            size_t off = 0, bs = 8 * HS; int mode = 0;
            if (pn < 2) { off = ZQA + (size_t)(pn * 4 + ch) * HS; }
            else if (pn < 4) { off = ZKA + (size_t)((pn - 2) * 4 + ch) * HS; }
            else if (pn < 6) { off = ZVA + (size_t)((pn - 4) * 4 + ch) * HS; mode = 1; }
            else if (pn < 8) { off = ZQB + (size_t)((pn - 6) * 4 + ch) * HS; }
            else if (pn == 8) { bs = 2 * HS; off = (ch < 2) ? ZKCI + (size_t)ch * HS : ZVCI + (size_t)(ch - 2) * HS; }
            else if (pn == 9) { bs = 2 * HS; if (ch < 2) off = ZKS + (size_t)ch * HS; else { off = ZVS + (size_t)(ch - 2) * HS; mode = 1; } }
            else if (pn == 10) { bs = 2 * HS; if (ch < 2) off = ZKW + (size_t)ch * HS; else { off = ZVW + (size_t)(ch - 2) * HS; mode = 1; } }
            else if (pn < 13) { off = ZQC + (size_t)((pn - 11) * 4 + ch) * HS; }
            else if (pn == 13) { bs = 2 * HS; if (ch < 2) off = ZKC + (size_t)ch * HS; else { off = ZVC + (size_t)(ch - 2) * HS; mode = 1; } }
            else if (pn < 26) mode = 2;
            else mode = 3;
#pragma unroll
            for (int ai = 0; ai < 2; ++ai)
#pragma unroll
                for (int m = 0; m < 4; ++m) {
                    const int tl = u.pm * 256 + ai * 128 + wr * 64 + m * 16 + fr, bl = tl >> 12, s = tl & 4095;
                    const float rs = __shfl(rsl[ai], 16 * m + fr);
                    float o[8];
#pragma unroll
                    for (int n = 0; n < 2; ++n)
#pragma unroll
                        for (int e = 0; e < 4; ++e) o[n * 4 + e] = acc[ai][bj][m][n][e] * rs;
                    if (mode == 0) {
                        u32x4 w; w.x = cvtpk(o[0], o[1]); w.y = cvtpk(o[2], o[3]); w.z = cvtpk(o[4], o[5]); w.w = cvtpk(o[6], o[7]);
                        *(u32x4*)(zb + off + (size_t)bl * bs + (size_t)s * 64 + d0) = w;
                    } else if (mode == 1) {
                        bf16_t* p = zb + off + (size_t)bl * bs + (size_t)d0 * 4096 + s;
#pragma unroll
                        for (int e = 0; e < 8; ++e) p[(size_t)e * 4096] = cvt1(o[e]);
                    } else if (mode == 2) {
                        unsigned qb[8];
#pragma unroll
                        for (int e = 0; e < 8; ++e) qb[e] = (unsigned)(sigm(o[e]) * 255.f + 0.5f);
                        u32x2 w; w.x = qb[0] | (qb[1] << 8) | (qb[2] << 16) | (qb[3] << 24); w.y = qb[4] | (qb[5] << 8) | (qb[6] << 16) | (qb[7] << 24);
                        *(u32x2*)((uchar*)(zb + ZSG) + (size_t)tl * 3072 + (pn - 14) * 256 + bj * 128 + wc * 32 + 8 * fq) = w;
                    } else {
                        const int cc = bj * 128 + wc * 32 + 8 * fq;
                        if (cc < 24) {
                            float* bgp = (float*)(zb + ZBG) + (size_t)tl * 32 + cc;
                            *(f32x4*)bgp = (f32x4){sigm(o[0]), sigm(o[1]), sigm(o[2]), sigm(o[3])};
                            *(f32x4*)(bgp + 4) = (f32x4){sigm(o[4]), sigm(o[5]), sigm(o[6]), sigm(o[7])};
                        }
                    }
                }
        }
    }
};

__device__ __forceinline__ void rms_row_bf16(const float* xrow, const float* g, bf16_t* orow, int lane) {
    const f32x4* xr = (const f32x4*)xrow + lane; f32x4 v[4]; float s = 0.f;
#pragma unroll
    for (int j = 0; j < 4; ++j) { v[j] = xr[64 * j]; s += (v[j][0] * v[j][0] + v[j][1] * v[j][1]) + (v[j][2] * v[j][2] + v[j][3] * v[j][3]); }
    const float rstd = 1.0f / sqrtf(wave_sum(s) * (1.f / DM) + EPS);
    u32x2* o8 = (u32x2*)orow + lane;
#pragma unroll
    for (int j = 0; j < 4; ++j) { const f32x4 gg = ((const f32x4*)g)[lane + 64 * j]; u32x2 w; w.x = cvtpk(v[j][0] * rstd * gg[0], v[j][1] * rstd * gg[1]); w.y = cvtpk(v[j][2] * rstd * gg[2], v[j][3] * rstd * gg[3]); o8[64 * j] = w; }
}
__device__ __forceinline__ void rms_row_f32(const float* xrow, const float* g, float* orow, int lane) {
    const f32x4* xr = (const f32x4*)xrow + lane; f32x4 v[4]; float s = 0.f;
#pragma unroll
    for (int j = 0; j < 4; ++j) { v[j] = xr[64 * j]; s += (v[j][0] * v[j][0] + v[j][1] * v[j][1]) + (v[j][2] * v[j][2] + v[j][3] * v[j][3]); }
    const float rstd = 1.0f / sqrtf(wave_sum(s) * (1.f / DM) + EPS);
#pragma unroll
    for (int j = 0; j < 4; ++j) { const f32x4 gg = ((const f32x4*)g)[lane + 64 * j]; ((f32x4*)orow)[lane + 64 * j] = (v[j] * rstd) * gg; }
}
__device__ __forceinline__ void rms_row_bf16in_f32(const bf16_t* xrow, const float* g, float* orow, int lane) {
    const u32x2* xr = (const u32x2*)xrow + lane; f32x4 v[4]; float s = 0.f;
#pragma unroll
    for (int j = 0; j < 4; ++j) { const u32x2 hv = xr[64 * j]; v[j] = (f32x4){__uint_as_float(hv.x << 16), __uint_as_float(hv.x & 0xffff0000u), __uint_as_float(hv.y << 16), __uint_as_float(hv.y & 0xffff0000u)};
        s += (v[j][0] * v[j][0] + v[j][1] * v[j][1]) + (v[j][2] * v[j][2] + v[j][3] * v[j][3]); }
    const float rstd = 1.0f / sqrtf(wave_sum(s) * (1.f / DM) + EPS);
#pragma unroll
    for (int j = 0; j < 4; ++j) { const f32x4 gg = ((const f32x4*)g)[lane + 64 * j]; ((f32x4*)orow)[lane + 64 * j] = (v[j] * rstd) * gg; }
}
__device__ __forceinline__ void phase_prep(const float* src, bf16_t* dst, float* ssq, int gw, int ngw, int lane) {
    lane = opq(lane);
    for (int m = gw; m < T; m += ngw) {
        const f32x4* xr = (const f32x4*)(src + (size_t)m * DM) + lane; u32x2* o8 = (u32x2*)(dst + (size_t)m * DM) + lane; float s = 0.f;
#pragma unroll
        for (int j = 0; j < 4; ++j) { const f32x4 v = xr[64 * j]; s += (v[0] * v[0] + v[1] * v[1]) + (v[2] * v[2] + v[3] * v[3]); u32x2 w; w.x = cvtpk(v[0], v[1]); w.y = cvtpk(v[2], v[3]); o8[64 * j] = w; }
        s = wave_sum(s);
        if (lane < 16) ssq[(size_t)m * 16 + lane] = lane == 0 ? s : 0.f;
    }
}
__device__ __forceinline__ void phase_rms(const float* src, const float* g, bf16_t* dst, int gw, int ngw, int lane) {
    lane = opq(lane);
    for (int m = gw; m < T; m += ngw) rms_row_bf16(src + (size_t)m * DM, g, dst + (size_t)m * DM, lane);
}

__device__ __forceinline__ int srccol(int mode, int n) {
    if (mode == 0) return n;
    if (mode == 1) return ((n >> 7) & 1) * DFF + (n >> 8) * 128 + (n & 127);
    if (mode == 2) return n < 2816 ? n : (n < 6656 ? n + 24 : (n < 6680 ? 2816 + (n - 6656) : -1));
    return n < 64 ? n : -1;
}
__device__ __forceinline__ void conv_matrix(const float* src, int K, int ld, int Ndst, int mode, bf16_t* dst, int& base, LAS float* scr, int tid, int blk, int G, const float* gk = nullptr) {
    tid = opq(tid);
    const int ntn = Ndst / 64, ntiles = (K / 128) * ntn;
    int start = (blk - (base % G) + G) % G;
    for (int t = start; t < ntiles; t += G) {
        const int k0 = (t / ntn) * 128, n0 = (t % ntn) * 64;
        { const int kr = tid >> 6, n = tid & 63; const int col = srccol(mode, n0 + n);
          float v[16];
#pragma unroll
          for (int kk = 0; kk < 16; ++kk) { const int k = kr + 8 * kk; v[kk] = col >= 0 ? src[(size_t)(k0 + k) * ld + col] : 0.f; }
#pragma unroll
          for (int kk = 0; kk < 16; ++kk) { const int k = kr + 8 * kk; scr[k * 65 + n] = gk ? v[kk] * gk[k0 + k] : v[kk]; } }
        __syncthreads();
        { const int n = tid >> 3, ks = tid & 7;
#pragma unroll
          for (int h2 = 0; h2 < 2; ++h2) { const LAS float* sp = scr + (64 * h2 + 8 * ks) * 65 + n;
            u32x4 w; w.x = cvtpk(sp[0], sp[65]); w.y = cvtpk(sp[130], sp[195]); w.z = cvtpk(sp[260], sp[325]); w.w = cvtpk(sp[390], sp[455]);
            *(u32x4*)(dst + (size_t)(n0 + n) * K + k0 + 64 * h2 + 8 * ks) = w; } }
        __syncthreads();
    }
    base += ntiles;
}

constexpr int KP = 144;
constexpr int VP = 144;
constexpr int L_K0 = 0, L_K1 = 9216, L_V0 = 18432, L_V1 = 36864, L_TBL = 55296, L_IMP = 57344, L_SEL = 73984, L_RED = 74496;
constexpr float SC = 0.125f * LOG2E;
constexpr float MINIT = -10000.f, MASKED = -1e30f;

__device__ __forceinline__ int t5_bucket(int n) {
    if (n < 16) return n;
    int b = 16;
    b += (n >= 19); b += (n >= 21); b += (n >= 24); b += (n >= 27); b += (n >= 31); b += (n >= 35); b += (n >= 40); b += (n >= 46);
    b += (n >= 52); b += (n >= 59); b += (n >= 67); b += (n >= 77); b += (n >= 87); b += (n >= 99); b += (n >= 113);
    return b;
}
__device__ __forceinline__ void build_tbl(LAS uchar* lds, const float* rel_bias, int col0, int nh, int tid) {
    const int hd = tid >> 7, idx = tid & 127;
    if (hd < nh && idx < 114) ((LAS float*)(lds + L_TBL))[hd * 128 + idx] = rel_bias[t5_bucket(idx) * 20 + col0 + hd] * LOG2E;
}

template <int DV> struct TileRegs { u32x4 k; u32x4 v[DV / 64]; };
template <int DV, bool HASV>
__device__ __forceinline__ void tile_gload(TileRegs<DV>& r, const bf16_t* Kg, const bf16_t* Vt, int vpitch, int kt, int tid) {
    const int row = tid >> 3, seg = tid & 7;
    r.k = *(const u32x4*)(Kg + (size_t)(kt * 64 + row) * 64 + seg * 8);
    if (HASV) {
#pragma unroll
        for (int j = 0; j < DV / 64; ++j) r.v[j] = *(const u32x4*)(Vt + (size_t)(row + 64 * j) * vpitch + kt * 64 + seg * 8);
    }
}
template <int DV, bool HASV>
__device__ __forceinline__ void tile_swrite(const TileRegs<DV>& r, LAS uchar* lds, int buf, int tid) {
    const int row = tid >> 3, seg = tid & 7;
    *(LAS u32x4*)(lds + (buf ? L_K1 : L_K0) + row * KP + seg * 16) = r.k;
    if (HASV) {
#pragma unroll
        for (int j = 0; j < DV / 64; ++j) { LAS uchar* p = lds + (buf ? L_V1 : L_V0) + (row + 64 * j) * VP + (seg >> 1) * 32 + (seg & 1) * 8; *(LAS u32x2*)p = (u32x2){r.v[j].x, r.v[j].y}; *(LAS u32x2*)(p + 16) = (u32x2){r.v[j].z, r.v[j].w}; }
    }
}

template <int DV, bool IMPP>
__device__ __forceinline__ void attn_pass(LAS uchar* lds, const bf16_t* Kg, const bf16_t* Vt, int vpitch, int kt0, int kt1, int wave_kt_max,
                                          int qpos, int qmin_w, int qmax_w, int kmul, int kadd, unsigned W, bf16x8 (&q)[4], int tbl,
                                          unsigned long long selmask, bool use_sel, float& m, float& l, f32x16 (&acc)[DV / 32],
                                          float inv_l, int imp_row, float rel_far, int tid) {
    const int lane = tid & 63, n = lane & 31, hi = lane >> 5;
    TileRegs<DV> tr;
    if (kt0 >= kt1) return;
    float tfar = rel_far;
    asm volatile("s_waitcnt vmcnt(0)" ::: "memory");
    asm volatile("" : "+v"(q[0]), "+v"(q[1]), "+v"(q[2]), "+v"(q[3]), "+v"(tfar), "+v"(m), "+v"(l), "+v"(inv_l));
    tile_gload<DV, !IMPP>(tr, Kg, Vt, vpitch, kt0, tid);
    tile_swrite<DV, !IMPP>(tr, lds, 0, tid);
    __syncthreads();
    for (int kt = kt0; kt < kt1; ++kt) {
        const int cur = (kt - kt0) & 1;
        const bool more = kt + 1 < kt1;
        if (more) tile_gload<DV, !IMPP>(tr, Kg, Vt, vpitch, kt + 1, tid);
        if (kt <= wave_kt_max && (!use_sel || __builtin_amdgcn_ballot_w64((selmask >> kt) & 1ull) != 0ull)) {
            f32x16 s[2];
#pragma unroll
            for (int r = 0; r < 16; ++r) { s[0][r] = 0.f; s[1][r] = 0.f; }
            const LAS uchar* kb = lds + (cur ? L_K1 : L_K0) + n * KP + hi * 16;
#pragma unroll
            for (int ks = 0; ks < 4; ++ks) {
                const bf16x8 a0 = *(const LAS bf16x8*)(kb + ks * 32);
                const bf16x8 a1 = *(const LAS bf16x8*)(kb + 32 * KP + ks * 32);
                s[0] = __builtin_amdgcn_mfma_f32_32x32x16_bf16(a0, q[ks], s[0], 0, 0, 0);
                s[1] = __builtin_amdgcn_mfma_f32_32x32x16_bf16(a1, q[ks], s[1], 0, 0, 0);
            }
            const bool lane_ok = !use_sel || ((selmask >> kt) & 1ull);
            const bool fast = (qmin_w - (kmul * (64 * kt + 63) + kadd) >= 113) && ((unsigned)(qmax_w - (kmul * 64 * kt + kadd)) < W);
            if (fast) {
                const float cfar = lane_ok ? tfar - m : MASKED;
                const float scl = lane_ok ? SC : 0.f;
#pragma unroll
                for (int hh = 0; hh < 2; ++hh)
#pragma unroll
                    for (int r = 0; r < 16; ++r) s[hh][r] = s[hh][r] * scl + cfar;
            } else {
                int dq = qpos - kadd - kmul * (kt * 64 + 4 * hi);
                asm volatile("" : "+v"(dq));
                const unsigned Wl = lane_ok ? W : 0u;
                const LAS uchar* tb = lds + tbl;
#pragma unroll
                for (int hh = 0; hh < 2; ++hh)
#pragma unroll
                    for (int r = 0; r < 16; ++r) {
                        const int kk = 32 * hh + 8 * (r >> 2) + (r & 3);
                        const int dist = dq - kmul * kk;
                        const unsigned ud = (unsigned)dist;
                        const unsigned idx = ud < 113u ? ud : 113u;
                        const float bias = *(const LAS float*)(tb + idx * 4);
                        float v = s[hh][r] * SC + (bias - m);
                        v = (ud < Wl) ? v : MASKED;
                        s[hh][r] = v;
                    }
            }
            if (!IMPP) {
                float t0 = fmaxf(fmaxf(s[0][0], s[0][1]), s[0][2]), t1 = fmaxf(fmaxf(s[1][0], s[1][1]), s[1][2]);
#pragma unroll
                for (int r = 3; r < 15; r += 2) { t0 = fmaxf(fmaxf(t0, s[0][r]), s[0][r + 1]); t1 = fmaxf(fmaxf(t1, s[1][r]), s[1][r + 1]); }
                float tmax = fmaxf(fmaxf(t0, t1), fmaxf(s[0][15], s[1][15]));
                { auto rr = __builtin_amdgcn_permlane32_swap(__float_as_uint(tmax), __float_as_uint(tmax), false, false); tmax = fmaxf(__uint_as_float(rr[0]), __uint_as_float(rr[1])); }
                const bool need = tmax > 8.f;
                if (__builtin_amdgcn_ballot_w64(need) != 0ull) {
                    const float delta = need ? tmax : 0.f;
                    const float alpha = __builtin_amdgcn_exp2f(-delta);
                    m += delta; l *= alpha;
#pragma unroll
                    for (int dt = 0; dt < DV / 32; ++dt) acc[dt] = acc[dt] * alpha;
#pragma unroll
                    for (int hh = 0; hh < 2; ++hh)
#pragma unroll
                        for (int r = 0; r < 16; ++r) s[hh][r] -= delta;
                }
#pragma unroll
                for (int hh = 0; hh < 2; ++hh)
#pragma unroll
                    for (int r = 0; r < 16; ++r) s[hh][r] = __builtin_amdgcn_exp2f(s[hh][r]);
                f32x2_t ls2a = {0.f, 0.f}, ls2b = {0.f, 0.f};
#pragma unroll
                for (int r = 0; r < 16; r += 2) { ls2a += (f32x2_t){s[0][r], s[0][r + 1]}; ls2b += (f32x2_t){s[1][r], s[1][r + 1]}; }
                const float ls = (ls2a[0] + ls2a[1]) + (ls2b[0] + ls2b[1]);
                l += ls;
                const LAS uchar* vb = lds + (cur ? L_V1 : L_V0) + n * VP + hi * 16;
    #pragma unroll
                for (int hh = 0; hh < 2; ++hh)
#pragma unroll
                    for (int u2 = 0; u2 < 2; ++u2) {
                        u32x4 pw;
                        pw.x = cvtpk(s[hh][8 * u2 + 0], s[hh][8 * u2 + 1]); pw.y = cvtpk(s[hh][8 * u2 + 2], s[hh][8 * u2 + 3]);
                        pw.z = cvtpk(s[hh][8 * u2 + 4], s[hh][8 * u2 + 5]); pw.w = cvtpk(s[hh][8 * u2 + 6], s[hh][8 * u2 + 7]);
                        const bf16x8 pb = __builtin_bit_cast(bf16x8, pw);
                        const int kbase = 32 * hh + 16 * u2;
#pragma unroll
                        for (int dt = 0; dt < DV / 32; ++dt) {
                            const bf16x8 va = *(const LAS bf16x8*)(vb + dt * 32 * VP + kbase * 2);
                            acc[dt] = __builtin_amdgcn_mfma_f32_32x32x16_bf16(va, pb, acc[dt], 0, 0, 0);
                        }
                    }
                } else {
                LAS float* imp = (LAS float*)(lds + L_IMP) + imp_row * 65;
                float spill[8];
#pragma unroll
                for (int hh = 0; hh < 2; ++hh)
#pragma unroll
                    for (int gq = 0; gq < 4; ++gq) {
                        const float p0 = __builtin_amdgcn_exp2f(s[hh][4 * gq + 0]) * inv_l, p1 = __builtin_amdgcn_exp2f(s[hh][4 * gq + 1]) * inv_l;
                        const float p2 = __builtin_amdgcn_exp2f(s[hh][4 * gq + 2]) * inv_l, p3 = __builtin_amdgcn_exp2f(s[hh][4 * gq + 3]) * inv_l;
                        float mn = (p0 + p1) + (p2 + p3), sp = p3;
                        mn += __shfl_xor(mn, 8); mn += __shfl_xor(mn, 16);
                        sp += __shfl_xor(sp, 8); sp += __shfl_xor(sp, 16);
                        spill[hh * 4 + gq] = sp;
                        const int j = 16 * kt + 8 * hh + 2 * gq + hi;
                        if (n < 8) imp[j] += mn;
                    }
                __builtin_amdgcn_fence(__ATOMIC_RELEASE, "wavefront");
#pragma unroll
                for (int hh = 0; hh < 2; ++hh)
#pragma unroll
                    for (int gq = 0; gq < 4; ++gq) {
                        const int j = 16 * kt + 8 * hh + 2 * gq + hi + 1;
                        if (n < 8 && j < 64) imp[j] += spill[hh * 4 + gq];
                    }
                __builtin_amdgcn_fence(__ATOMIC_RELEASE, "wavefront");
            }
        }
        if (more) tile_swrite<DV, !IMPP>(tr, lds, cur ^ 1, tid);
        __syncthreads();
    }
}

template <int NT> __device__ __forceinline__ void acc_zero(f32x16 (&a)[NT]) {
#pragma unroll
    for (int t = 0; t < NT; ++t)
#pragma unroll
        for (int r = 0; r < 16; ++r) a[t][r] = 0.f;
}
template <int NT> __device__ __forceinline__ void acc_norm(f32x16 (&a)[NT], float l) {
    const float lt = l + __shfl_xor(l, 32);
    const float inv = lt > 0.f ? 1.f / lt : 0.f;
#pragma unroll
    for (int t = 0; t < NT; ++t)
#pragma unroll
        for (int r = 0; r < 16; ++r) a[t][r] *= inv;
}
__device__ __forceinline__ void load_q(bf16x8 (&qf)[4], const bf16_t* qrow, int hi) {
#pragma unroll
    for (int ks = 0; ks < 4; ++ks) qf[ks] = *(const bf16x8*)(qrow + 16 * ks + 8 * hi);
}

struct AttnCtx {
    const bf16_t* zb;
    bf16_t *ya, *yb, *yc;
    float* park;
    const bf16_t *kcmp, *vtcmp;
    const float *rel_bias, *lamp, *subln, *sinks;
    float lam_init;
};

__device__ __forceinline__ void attn_unit_A(LAS uchar* lds, const AttnCtx& C, int bl, int h, int qt, int tid) {
    tid = opq(tid);
    const int lane = tid & 63, n = lane & 31, hi = lane >> 5, w = __builtin_amdgcn_readfirstlane(tid >> 6);
    build_tbl(lds, C.rel_bias, h, 1, tid);
    float lam;
    { const float a = C.lamp[lane] * C.lamp[64 + lane], b = C.lamp[128 + lane] * C.lamp[192 + lane]; lam = __expf(wave_sum(a)) - __expf(wave_sum(b)) + C.lam_init; }
    const int qpos = 256 * qt + 32 * w + n;
    const float rfar = C.rel_bias[31 * 20 + h] * LOG2E;
    const int kt1 = 4 * qt + 4, wkm = 4 * qt + (w >> 1);
    const bf16_t* Vt = C.zb + ZVA + ((size_t)bl * 8 + 2 * h) * HS;
    f32x16 acc[4];
    bf16x8 qf[4];
    float m, l;
    LAS unsigned* pl = (LAS unsigned*)(lds + L_RED) + tid;
#pragma unroll 1
    for (int c = 1; c >= 0; --c) {
        const size_t hoff = ((size_t)bl * 8 + 2 * h + c) * HS;
        load_q(qf, C.zb + ZQA + hoff + (size_t)qpos * 64, hi);
        acc_zero<4>(acc); m = MINIT; l = 0.f;
        attn_pass<128, false>(lds, C.zb + ZKA + hoff, Vt, 4096, 0, kt1, wkm, qpos, 256 * qt + 32 * w, 256 * qt + 32 * w + 31, 1, 0, 0x7fffffffu, qf, L_TBL, 0ull, false, m, l, acc, 0.f, 0, rfar, tid);
        acc_norm<4>(acc, l);
        if (c == 1) {
#pragma unroll
            for (int t = 0; t < 4; ++t)
#pragma unroll
                for (int gq = 0; gq < 4; ++gq) { pl[(t * 8 + 2 * gq) * NTHR] = cvtpk(acc[t][4 * gq], acc[t][4 * gq + 1]); pl[(t * 8 + 2 * gq + 1) * NTHR] = cvtpk(acc[t][4 * gq + 2], acc[t][4 * gq + 3]); }
        }
    }
    float ss = 0.f;
#pragma unroll
    for (int t = 0; t < 4; ++t)
#pragma unroll
        for (int gq = 0; gq < 4; ++gq) { const unsigned pa = pl[(t * 8 + 2 * gq) * NTHR], pb = pl[(t * 8 + 2 * gq + 1) * NTHR];
            const f32x4 o1 = (f32x4){__uint_as_float(pa << 16), __uint_as_float(pa & 0xffff0000u), __uint_as_float(pb << 16), __uint_as_float(pb & 0xffff0000u)};
#pragma unroll
            for (int e = 0; e < 4; ++e) { const float y = acc[t][4 * gq + e] - lam * o1[e]; acc[t][4 * gq + e] = y; ss += y * y; } }
    ss += __shfl_xor(ss, 32);
    const float rs = (1.0f / sqrtf(ss * (1.f / 128.f) + EPS)) * (1.f - C.lam_init);
    bf16_t* yrow = C.ya + ((size_t)bl * 4096 + qpos) * 512 + h * 128;
#pragma unroll
    for (int t = 0; t < 4; ++t)
#pragma unroll
        for (int gq = 0; gq < 4; ++gq) {
            const int d = 32 * t + 8 * gq + 4 * hi;
            const f32x4 gg = *(const f32x4*)(C.subln + d);
            u32x2 wv; wv.x = cvtpk(acc[t][4 * gq] * rs * gg[0], acc[t][4 * gq + 1] * rs * gg[1]); wv.y = cvtpk(acc[t][4 * gq + 2] * rs * gg[2], acc[t][4 * gq + 3] * rs * gg[3]);
            *(u32x2*)(yrow + d) = wv;
        }
}

__device__ __forceinline__ void attn_unit_B(LAS uchar* lds, const AttnCtx& C, int bl, int g, int i, int tid) {
    tid = opq(tid);
    const int lane = tid & 63, n = lane & 31, hi = lane >> 5, w = __builtin_amdgcn_readfirstlane(tid >> 6);
    build_tbl(lds, C.rel_bias, 4 + 4 * g, 4, tid);
    const int ql = 8 * w + (n & 7), hr = n >> 3, qpos = 64 * i + ql, head = 4 * g + hr, qlo = 64 * i + 8 * w;
    const float rfar = C.rel_bias[31 * 20 + 4 + head] * LOG2E;
    const int tbl = L_TBL + hr * 512;
    bf16x8 qf[4];
    load_q(qf, C.zb + ZQB + ((size_t)bl * 8 + head) * HS + (size_t)qpos * 64, hi);
    const size_t goff = ((size_t)bl * 2 + g) * HS;
    f32x16 acc[2];
    LAS float* otl = (LAS float*)(lds + L_RED) + tid;
    float m, l;
    const size_t tok = (size_t)bl * 4096 + qpos;
    const float* bg = (const float*)(C.zb + ZBG) + tok * 32 + head * 3;
    const float g0 = bg[0], g1 = bg[1], g2 = bg[2];
    const bf16_t* Kc = C.kcmp + ((size_t)bl * 2 + g) * 256 * 64;
    const bf16_t* Vc = C.vtcmp + ((size_t)bl * 2 + g) * 64 * 256;
    const int ktc1 = ((4 * i + 2) >> 6) + 1;
    acc_zero<2>(acc); m = MINIT; l = 0.f;
    attn_pass<64, false>(lds, Kc, Vc, 256, 0, ktc1, 1 << 20, qpos, qlo, qlo + 7, 16, 31, 0x7fffffffu, qf, tbl, 0ull, false, m, l, acc, 0.f, 0, rfar, tid);
    acc_norm<2>(acc, l);
#pragma unroll
    for (int t = 0; t < 2; ++t)
#pragma unroll
        for (int r = 0; r < 16; ++r) otl[(t * 16 + r) * NTHR] = g0 * acc[t][r];
    unsigned long long selmask = ~0ull;
    if (i >= 16) {
    {
        const float lt = l + __shfl_xor(l, 32);
        const float inv_l = lt > 0.f ? 1.f / lt : 0.f;
        LAS float* impw = (LAS float*)(lds + L_IMP) + (8 * w) * 65;
        for (int x = lane; x < 8 * 65; x += 64) impw[x] = 0.f;
        __builtin_amdgcn_fence(__ATOMIC_RELEASE, "wavefront");
        attn_pass<64, true>(lds, Kc, Vc, 256, 0, ktc1, 1 << 20, qpos, qlo, qlo + 7, 16, 31, 0x7fffffffu, qf, tbl, 0ull, false, m, l, acc, inv_l, ql, rfar, tid);
    }
    {
        const int q = tid & 63, part = tid >> 6;
        const LAS float* row = (const LAS float*)(lds + L_IMP) + q * 65;
        float cand[8]; int rank[8];
#pragma unroll
        for (int c = 0; c < 8; ++c) { const int j = 8 * part + c; float v = row[j]; v = (j == 0 || j == i || j == i - 1) ? 1e6f : (j > i ? -1e6f : v); cand[c] = v; rank[c] = 0; }
        for (int jj = 0; jj <= i; ++jj) {
            float x = row[jj]; x = (jj == 0 || jj == i || jj == i - 1) ? 1e6f : (jj > i ? -1e6f : x);
#pragma unroll
            for (int c = 0; c < 8; ++c) { const int j = 8 * part + c; rank[c] += (x > cand[c] || (x == cand[c] && jj < j)) ? 1 : 0; }
        }
        unsigned bits = 0;
#pragma unroll
        for (int c = 0; c < 8; ++c) bits |= (rank[c] < 16 ? 1u : 0u) << c;
        ((LAS uchar*)(lds + L_SEL))[q * 8 + part] = (uchar)bits;
    }
    __syncthreads();
    { const u32x2 sm = *(const LAS u32x2*)(lds + L_SEL + ql * 8); selmask = (unsigned long long)sm.x | ((unsigned long long)sm.y << 32); }
    }
    acc_zero<2>(acc); m = MINIT; l = 0.f;
    attn_pass<64, false>(lds, C.zb + ZKS + goff, C.zb + ZVS + goff, 4096, 0, i + 1, 1 << 20, qpos, qlo, qlo + 7, 1, 0, 0x7fffffffu, qf, tbl, selmask, true, m, l, acc, 0.f, 0, rfar, tid);
    acc_norm<2>(acc, l);
#pragma unroll
    for (int t = 0; t < 2; ++t)
#pragma unroll
        for (int r = 0; r < 16; ++r) otl[(t * 16 + r) * NTHR] += g1 * acc[t][r];
    acc_zero<2>(acc); m = MINIT; l = 0.f;
    attn_pass<64, false>(lds, C.zb + ZKW + goff, C.zb + ZVW + goff, 4096, i > 8 ? i - 8 : 0, i + 1, 1 << 20, qpos, qlo, qlo + 7, 1, 0, 512u, qf, tbl, 0ull, false, m, l, acc, 0.f, 0, rfar, tid);
    acc_norm<2>(acc, l);
    bf16_t* yrow = C.yb + tok * 512 + head * 64;
#pragma unroll
    for (int t = 0; t < 2; ++t)
#pragma unroll
        for (int gq = 0; gq < 4; ++gq) {
            const int d = 32 * t + 8 * gq + 4 * hi;
            float o[4];
#pragma unroll
            for (int e = 0; e < 4; ++e) o[e] = otl[(t * 16 + 4 * gq + e) * NTHR] + g2 * acc[t][4 * gq + e];
            u32x2 wv; wv.x = cvtpk(o[0], o[1]); wv.y = cvtpk(o[2], o[3]);
            *(u32x2*)(yrow + d) = wv;
        }
}

__device__ __forceinline__ void attn_unit_C(LAS uchar* lds, const AttnCtx& C, int bl, int g, int i, int tid) {
    tid = opq(tid);
    const int lane = tid & 63, n = lane & 31, hi = lane >> 5, w = __builtin_amdgcn_readfirstlane(tid >> 6);
    build_tbl(lds, C.rel_bias, 12 + 4 * g, 4, tid);
    const int ql = 8 * w + (n & 7), hr = n >> 3, qpos = 64 * i + ql, head = 4 * g + hr, qlo = 64 * i + 8 * w;
    const float rfar = C.rel_bias[31 * 20 + 12 + head] * LOG2E;
    const int tbl = L_TBL + hr * 512;
    bf16x8 qf[4];
    load_q(qf, C.zb + ZQC + ((size_t)bl * 8 + head) * HS + (size_t)qpos * 64, hi);
    const size_t goff = ((size_t)bl * 2 + g) * HS;
    f32x16 acc[2];
    acc_zero<2>(acc);
    float m = C.sinks[head] * LOG2E, l = hi == 0 ? 1.f : 0.f;
    attn_pass<64, false>(lds, C.zb + ZKC + goff, C.zb + ZVC + goff, 4096, i > 2 ? i - 2 : 0, i + 1, 1 << 20, qpos, qlo, qlo + 7, 1, 0, 128u, qf, tbl, 0ull, false, m, l, acc, 0.f, 0, rfar, tid);
    acc_norm<2>(acc, l);
    const size_t tok = (size_t)bl * 4096 + qpos;
    bf16_t* yrow = C.yc + tok * 512 + head * 64;
#pragma unroll
    for (int t = 0; t < 2; ++t)
#pragma unroll
        for (int gq = 0; gq < 4; ++gq) {
            const int d = 32 * t + 8 * gq + 4 * hi;
            u32x2 wv; wv.x = cvtpk(acc[t][4 * gq], acc[t][4 * gq + 1]); wv.y = cvtpk(acc[t][4 * gq + 2], acc[t][4 * gq + 3]);
            *(u32x2*)(yrow + d) = wv;
        }
}

#define XB_TMO      128
#define XB_XCNT(j)  (256  + 64 * (j))
#define XB_XSUB(j)  (1280 + 64 * (j))
#define XB_XGEN(j)  (2304 + 64 * (j))
#define XB_TOP      3328
#define XB_TOPGEN   3392
#define XCD_BAR_WORDS 3456
#define XB_SPIN_CAP (1u << 18)

__device__ __forceinline__ unsigned xb_ld(unsigned* p)              { return __hip_atomic_load(p, __ATOMIC_RELAXED, __HIP_MEMORY_SCOPE_AGENT); }
__device__ __forceinline__ unsigned xb_add(unsigned* p, unsigned v) { return __hip_atomic_fetch_add(p, v, __ATOMIC_RELAXED, __HIP_MEMORY_SCOPE_AGENT); }
__device__ __forceinline__ unsigned xb_xcc_id() { return (unsigned)__builtin_amdgcn_s_getreg((3 << 11) | 20) & 0xFu; }
#define XB_SPIN(cond, bar) do { unsigned _sp = 0; while (cond) { __builtin_amdgcn_s_sleep(1); \
    if ((++_sp & 255u) == 0u) { if (xb_ld(&(bar)[XB_TMO])) break; if (_sp > XB_SPIN_CAP) { atomicAdd(&(bar)[XB_TMO], 1u); break; } } } } while (0)

struct XcdBarrier {
    unsigned* bar; unsigned x;
    volatile __attribute__((address_space(3))) unsigned* st;
};

__device__ __forceinline__ XcdBarrier xcd_barrier_post(unsigned* bar, volatile __attribute__((address_space(3))) unsigned* st) {
    XcdBarrier b; b.bar = bar; b.x = xb_xcc_id(); b.st = st;
    if (threadIdx.x == 0) (void)xb_add(&bar[XB_XCNT(b.x)], 1u);
    return b;
}
__device__ __forceinline__ void xcd_barrier_complete(unsigned* bar, unsigned x, unsigned& nloc, unsigned& nx) {
    const unsigned G = gridDim.x * gridDim.y * gridDim.z;
    unsigned sum, cnt, mine, sp = 0u;
    for (;;) {
        sum = 0u; cnt = 0u; mine = 0u;
#pragma unroll
        for (unsigned j = 0; j < 16; ++j) { const unsigned c = xb_ld(&bar[XB_XCNT(j)]); sum += c; cnt += (c > 0u) ? 1u : 0u; mine = (j == x) ? c : mine; }
        if (sum == G) break;
        __builtin_amdgcn_s_sleep(1);
        if ((++sp & 255u) == 0u) { if (xb_ld(&bar[XB_TMO])) break; if (sp > XB_SPIN_CAP) { atomicAdd(&bar[XB_TMO], 1u); break; } }
    }
    nloc = mine > 0u ? mine : 1u; nx = cnt > 0u ? cnt : 1u;
}

__device__ __forceinline__ void xcd_barrier(const XcdBarrier& b) {
    asm volatile("s_waitcnt vmcnt(0)" ::: "memory");
    __syncthreads();
    if (threadIdx.x == 0) {
        unsigned* bar = b.bar;
        __builtin_amdgcn_s_waitcnt(0);
        unsigned nloc = b.st[0], nx = b.st[1];
        if (nloc == 0u) { xcd_barrier_complete(bar, b.x, nloc, nx); b.st[0] = nloc; b.st[1] = nx; }
        const unsigned old = xb_add(&bar[XB_XSUB(b.x)], 1u);
        const unsigned gen = old / nloc;
        if (old + 1u == (gen + 1u) * nloc) {
            __builtin_amdgcn_fence(__ATOMIC_RELEASE, "agent");
            asm volatile("s_waitcnt vmcnt(0)" ::: "memory");
            const unsigned og = xb_add(&bar[XB_TOP], 1u);
            const unsigned tg = og / nx;
            if (og + 1u == (tg + 1u) * nx) xb_add(&bar[XB_TOPGEN], 1u);
            else XB_SPIN(xb_ld(&bar[XB_TOPGEN]) == tg, bar);
            __builtin_amdgcn_fence(__ATOMIC_ACQUIRE, "agent");
            xb_add(&bar[XB_XGEN(b.x)], 1u);
            asm volatile("s_waitcnt vmcnt(0)" ::: "memory");
        } else {
            XB_SPIN(xb_ld(&bar[XB_XGEN(b.x)]) == gen, bar);
            __builtin_amdgcn_fence(__ATOMIC_ACQUIRE, "agent");
            asm volatile("s_waitcnt vmcnt(0)" ::: "memory");
        }
    }
    __syncthreads();
}

#define KIN(i) (kparams()->in[i])
#define WS_ (kparams()->ws)
#define HOUT (kparams()->out)
#define Wb ((bf16_t*)(WS_ + WS_W))
#define XN ((bf16_t*)(WS_ + WS_XN))
#define R1 ((bf16_t*)(WS_ + WS_R1))
#define YA ((bf16_t*)(WS_ + WS_Y))
#define MG ((bf16_t*)(WS_ + WS_MG))
#define CH ((bf16_t*)(WS_ + WS_CH))
#define KCMP ((bf16_t*)(WS_ + WS_KCMP))
#define VCMP ((bf16_t*)(WS_ + WS_VCMP))
#define CB ((float*)(WS_ + WS_CB))
#define XN2 ((bf16_t*)(WS_ + WS_XN2))
#define PBF ((bf16_t*)(WS_ + WS_PBF))
#define SSQ ((float*)(WS_ + WS_SSQ))
#define SSQ2 ((float*)(WS_ + WS_SSQ2))
constexpr int LDS_BYTES = 147456;
#ifdef ONLY_EPI
#include <type_traits>
#define ONLY_OK(E) (std::is_same<E, ONLY_EPI>::value)
#else
#define ONLY_OK(E) true
#endif
#ifdef NO_GEMM
#define GEMM(EPI, e, A_, lda_, Bt_, M_, N_, K_, cshift) do { (void)(e); } while (0)
#else
#define GEMM(EPI, e, A_, lda_, Bt_, M_, N_, K_, cshift) do { pg8::Gemm g_{(const bf16_t*)(A_), (const bf16_t*)(Bt_), (M_), (N_), (K_), (lda_)}; pg8::StaticOrder S_; \
    int c_ = (int)((blk + (cshift)) % G), G_ = G; asm volatile("" : "+s"(c_), "+s"(G_)); S_.init((M_), (N_), G_, c_); if (ONLY_OK(EPI)) pg8::gemm_phase<EPI, pg8::StaticOrder, EPI::ALIGN, true>(lds, g_, S_, (e)); } while (0)
#endif
#ifdef NO_GEMM
#define GEMM_X(EPI, e, A_, lda_, Bt_, M_, N_, K_, cidx, gsz) do { (void)(e); } while (0)
#else
#define GEMM_X(EPI, e, A_, lda_, Bt_, M_, N_, K_, cidx, gsz) do { pg8::Gemm g_{(const bf16_t*)(A_), (const bf16_t*)(Bt_), (M_), (N_), (K_), (lda_)}; pg8::StaticOrder S_; \
    int c_ = (int)(cidx), G_ = (int)(gsz); asm volatile("" : "+s"(c_), "+s"(G_)); S_.init((M_), (N_), G_, c_); if (ONLY_OK(EPI)) pg8::gemm_phase<EPI, pg8::StaticOrder, EPI::ALIGN, true>(lds, g_, S_, (e)); } while (0)
#endif

__global__ void __launch_bounds__(NTHR, 2) fwd_kernel(Params P) {
    extern __shared__ __attribute__((aligned(16))) unsigned char lds_raw[];
    LAS uchar* lds = (LAS uchar*)lds_raw;
    cg::grid_group grid = cg::this_grid();
    volatile LAS unsigned* xst = (volatile LAS unsigned*)(lds + LDS_BYTES - 64);
    if (threadIdx.x < 2) xst[threadIdx.x] = 0u;
    __syncthreads();
    const XcdBarrier xbar = xcd_barrier_post((unsigned*)(kparams()->ws + WS_CTL), xst);
#ifndef PROBE_CLASS
#define PROBE_CLASS 0
#endif
#if PROBE_CLASS
    unsigned long long pr_acc = 0, pr_last = __builtin_amdgcn_s_memrealtime();
#define SYNC(cls) do { const unsigned long long t1_ = __builtin_amdgcn_s_memrealtime(); if ((cls) == PROBE_CLASS) pr_acc += t1_ - pr_last; if ((cls) == 6) grid.sync(); else xcd_barrier(xbar); \
    const unsigned long long t2_ = __builtin_amdgcn_s_memrealtime(); if (PROBE_CLASS == 2) pr_acc += t2_ - t1_; pr_last = t2_; } while (0)
#else
#define SYNC(cls) do { if ((cls) == 6) grid.sync(); else xcd_barrier(xbar); } while (0)
#endif
#define DEF_IDS \
    int tid_o = threadIdx.x, G_o = gridDim.x, blk_o = blockIdx.x; asm volatile("" : "+v"(tid_o), "+s"(G_o), "+s"(blk_o)); \
    const int tid = tid_o, lane = tid & 63, wave = __builtin_amdgcn_readfirstlane(tid >> 6); \
    const int G = G_o, blk = blk_o; \
    const int vcu = (G % 8 == 0) ? (blk % 8) * (G / 8) + blk / 8 : blk; \
    const int gw = blk * 8 + wave, ngw = G * 8; (void)vcu; (void)gw; (void)ngw; (void)lane;
    {
        DEF_IDS
        LAS float* scr = (LAS float*)lds;
        int base = 0;
        for (int L = 0; L < DEPTH; ++L) {
            bf16_t* wl = Wb + (size_t)L * W_LAYER;
            conv_matrix(KIN(3) + (size_t)L * 1024 * 5632, 1024, 5632, 5632, 1, wl + W_WI1, base, scr, tid, blk, G, KIN(2) + (size_t)(L * 4 + 0) * DM);
            conv_matrix(KIN(4) + (size_t)L * 2816 * 1024, 2816, 1024, 1024, 0, wl + W_WO1, base, scr, tid, blk, G);
            conv_matrix(KIN(5) + (size_t)L * 1024 * DIN, 1024, DIN, DINP, 2, wl + W_WIN, base, scr, tid, blk, G, KIN(2) + (size_t)(L * 4 + 1) * DM);
            for (int t = 0; t < 2; ++t) conv_matrix(KIN(9) + ((size_t)L * 2 + t) * 2048 * 256, 2048, 256, 256, 0, wl + W_CW1 + (size_t)t * 256 * 2048, base, scr, tid, blk, G);
            for (int t = 0; t < 2; ++t) conv_matrix(KIN(10) + ((size_t)L * 2 + t) * 256 * 64, 256, 64, 256, 3, wl + W_CW2 + (size_t)t * 256 * 256, base, scr, tid, blk, G);
            for (int t = 0; t < 3; ++t) conv_matrix(KIN(12) + ((size_t)L * 3 + t) * 512 * 1024, 512, 1024, 1024, 0, wl + W_WBR + (size_t)t * 1024 * 512, base, scr, tid, blk, G);
            conv_matrix(KIN(13) + (size_t)L * 1024 * 1024, 1024, 1024, 1024, 0, wl + W_WOUT, base, scr, tid, blk, G);
            conv_matrix(KIN(14) + (size_t)L * 1024 * 5632, 1024, 5632, 5632, 1, wl + W_WI2, base, scr, tid, blk, G, KIN(2) + (size_t)(L * 4 + 2) * DM);
            conv_matrix(KIN(15) + (size_t)L * 2816 * 1024, 2816, 1024, 1024, 0, wl + W_WO2, base, scr, tid, blk, G);
            conv_matrix(KIN(16) + (size_t)L * 256 * 1024, 256, 1024, 1024, 0, wl + W_WPE, base, scr, tid, blk, G);
            conv_matrix(KIN(17) + (size_t)L * 1024 * 1024, 1024, 1024, 1024, 0, wl + W_WPG, base, scr, tid, blk, G, KIN(2) + (size_t)(L * 4 + 3) * DM);
        }
        for (int pr = blk; pr < DEPTH * 2; pr += G) {
            const float* pos = KIN(8) + (size_t)pr * 2048; const float* w1 = KIN(9) + (size_t)pr * 2048 * 256;
            float a[4] = {0.f, 0.f, 0.f, 0.f};
            for (int k = wave * 256; k < wave * 256 + 256; ++k) { const float pv = pos[k];
#pragma unroll
                for (int j = 0; j < 4; ++j) a[j] += pv * w1[(size_t)k * 256 + lane + 64 * j]; }
#pragma unroll
            for (int j = 0; j < 4; ++j) scr[wave * 256 + lane + 64 * j] = a[j];
            __syncthreads();
            if (tid < 256) { float s = 0.f;
#pragma unroll
                for (int ww = 0; ww < 8; ++ww) s += scr[ww * 256 + tid];
                CB[pr * 256 + tid] = s; }
            __syncthreads();
        }
        phase_prep(KIN(0), XN2, SSQ2, gw, ngw, lane);
    }
    SYNC(6);

#pragma unroll 1
    for (int L = 0; L < DEPTH; ++L) {
        DEF_IDS
#define wl (Wb + (size_t)L * W_LAYER)
#define ng (KIN(2) + (size_t)L * 4 * DM)
        { EpiSwiglu e{R1, SSQ2}; GEMM(EpiSwiglu, e, XN2, 1024, wl + W_WI1, T, 5632, 1024, 0); }
        SYNC(3);
        { EpiResid e{0.5f, 0, L == 0 ? 0 : 1}; GEMM(EpiResid, e, R1, DFF, wl + W_WO1, T, 1024, DFF, 0); }
        SYNC(3);
        {
            const f32x4* src = (const f32x4*)(KIN(1) + (size_t)L * T * PLE); u32x2* dst = (u32x2*)PBF;
            const int tq = opq(tid);
            for (size_t idx = (size_t)blk * NTHR + tq; idx < (size_t)T * PLE / 4; idx += (size_t)G * NTHR) { const f32x4 v = src[idx]; u32x2 w; w.x = cvtpk(v[0], v[1]); w.y = cvtpk(v[2], v[3]); dst[idx] = w; }
        }
        { EpiZ e{R1, SSQ, 0}; GEMM(EpiZ, e, XN, 1024, wl + W_WIN, TC, DINP - 256, 1024, 0); }
        SYNC(3);
        for (int c = 0; c < NCHUNK; ++c) {
            {
                const bool offl = (G >= 64) && ((G & 1) == 0), has_cmp = blk < 16 || (blk >= G / 2 && blk < G / 2 + 16);
                EpiZ e{R1, SSQ + (size_t)c * TC * 16, 26};
                if (!offl) GEMM(EpiZ, e, XN + (size_t)c * TC * DM, 1024, wl + W_WIN + (size_t)(DINP - 256) * 1024, TC, 256, 1024, 0);
                else if (!has_cmp) GEMM_X(EpiZ, e, XN + (size_t)c * TC * DM, 1024, wl + W_WIN + (size_t)(DINP - 256) * 1024, TC, 256, 1024, blk < G / 2 ? blk - 16 : blk - 32, G - 32);
                EpiBf<0> ee{(bf16_t*)HOUT + (size_t)c * TC * DM, 1024, nullptr};
                if (!offl) GEMM(EpiBf<0>, ee, PBF + (size_t)c * TC * PLE, 256, wl + W_WPE, TC, 1024, 256, 0);
                else if (!has_cmp) GEMM_X(EpiBf<0>, ee, PBF + (size_t)c * TC * PLE, 256, wl + W_WPE, TC, 1024, 256, (G - 33) - (blk < G / 2 ? blk - 16 : blk - 32), G - 32);
            }
            { EpiBf<1> ek{CH, 256, CB + (L * 2 + 0) * 256}; GEMM(EpiBf<1>, ek, R1 + ZKCI, 1024, wl + W_CW1, NB * 512, 256, 2048, 0);
              EpiBf<1> ev{CH + (size_t)NB * 512 * 256, 256, CB + (L * 2 + 1) * 256}; GEMM(EpiBf<1>, ev, R1 + ZVCI, 1024, wl + W_CW1 + (size_t)256 * 2048, NB * 512, 256, 2048, G / 2); }
            __builtin_amdgcn_fence(__ATOMIC_RELEASE, "workgroup"); __syncthreads(); __builtin_amdgcn_fence(__ATOMIC_ACQUIRE, "workgroup");
            { EpiCmp2<false> ek{KCMP}; GEMM(EpiCmp2<false>, ek, CH, 256, wl + W_CW2, NB * 512, 256, 256, 0);
              EpiCmp2<true> ev{VCMP}; GEMM(EpiCmp2<true>, ev, CH + (size_t)NB * 512 * 256, 256, wl + W_CW2 + (size_t)256 * 256, NB * 512, 256, 256, G / 2); }
            SYNC(5);
            {
                AttnCtx C;
                C.zb = R1; C.park = (float*)MG; C.ya = YA; C.yb = YA + (size_t)TC * 512; C.yc = YA + (size_t)2 * TC * 512; C.kcmp = KCMP; C.vtcmp = VCMP;
                C.rel_bias = KIN(18); C.lamp = KIN(6) + (size_t)L * 256; C.subln = KIN(7) + (size_t)L * 128; C.sinks = KIN(11) + (size_t)L * 8;
                C.lam_init = 0.8f - 0.6f * __expf(-0.3f * (float)L);
                for (int u = vcu; u < NB * 32; u += G) {
                    const int bl = u >> 5;
#ifndef NO_A
#if PROBE_CLASS == 7
                    const unsigned long long ta0_ = __builtin_amdgcn_s_memrealtime();
#endif
                    { const int h = (u >> 3) & 3, qp = u & 7;
#pragma unroll 1
                      for (int k = 0; k < 2; ++k) attn_unit_A(lds, C, bl, h, k ? 15 - qp : qp, tid); }
#if PROBE_CLASS == 7
                    pr_acc += __builtin_amdgcn_s_memrealtime() - ta0_;
#endif
#endif
                    { const int g = (u >> 4) & 1, is = u & 15;
#ifndef NO_B
#pragma unroll 1
                      for (int k = 0; k < 4; ++k) attn_unit_B(lds, C, bl, g, (k & 1) ? (k == 1 ? 31 : 63) - is : (k == 0 ? 0 : 32) + is, tid);
#endif
#ifndef NO_C
#pragma unroll 1
                      for (int k = 0; k < 4; ++k) attn_unit_C(lds, C, bl, g, (k & 1) ? (k == 1 ? 31 : 63) - is : (k == 0 ? 0 : 32) + is, tid);
#endif
                    }
                }
            }
            SYNC(1);
            for (int mi = 0; mi < 3; ++mi) {
                EpiBranch e{MG, R1 + ZSG, mi}; GEMM(EpiBranch, e, YA + (size_t)mi * TC * 512, 512, wl + W_WBR + (size_t)mi * 1024 * 512, TC, 1024, 512, 0);
            }
            SYNC(3);
            { EpiResid e{1.0f, c * TC, 2}; GEMM(EpiResid, e, MG, 1024, wl + W_WOUT, TC, 1024, 1024, 0); }
            if (c + 1 < NCHUNK) { EpiZ e{R1, SSQ + (size_t)(c + 1) * TC * 16, 0}; GEMM(EpiZ, e, XN + (size_t)(c + 1) * TC * DM, 1024, wl + W_WIN, TC, DINP - 256, 1024, 0); }
            SYNC(3);
        }
        { EpiSwiglu e{R1, SSQ}; GEMM(EpiSwiglu, e, XN, 1024, wl + W_WI2, T, 5632, 1024, 0); }
        SYNC(3);
        { EpiResid e{0.5f, 0, 2}; GEMM(EpiResid, e, R1, DFF, wl + W_WO2, T, 1024, DFF, 0); }
        SYNC(3);
        { uchar* ws_ = WS_; EpiPle e{(const bf16_t*)(ws_ + WS_XN), (const bf16_t*)HOUT, (const float*)(ws_ + WS_SSQ), (bf16_t*)(ws_ + WS_XN2), (float*)(ws_ + WS_SSQ2)}; GEMM(EpiPle, e, XN, 1024, wl + W_WPG, T, 1024, 1024, 0); }
        SYNC(3);
    }
    { DEF_IDS const int lq = opq(lane); float* ho = HOUT; const float* fg = KIN(19); const bf16_t* hb = XN2; for (int m = gw; m < T; m += ngw) rms_row_bf16in_f32(hb + (size_t)m * DM, fg, ho + (size_t)m * DM, lq); }
#if PROBE_CLASS
    if (blockIdx.x == 0) { const unsigned long long t0_ = __builtin_amdgcn_s_memrealtime(); while (__builtin_amdgcn_s_memrealtime() - t0_ < pr_acc) __builtin_amdgcn_s_sleep(20); }
#endif
}

extern "C" void kernel_launch(void* const* d_in, const int* in_sizes, int n_in, void* d_out, int out_size, void* d_ws, size_t ws_size, hipStream_t stream) {
    static int grid = 0;
    if (grid == 0) {
        if (n_in != 20 || out_size != T * DM || ws_size < WS_END) { fprintf(stderr, "kernel_launch: unexpected shapes (n_in %d out %d ws %zu)\n", n_in, out_size, ws_size); grid = -1; return; }
        int dev = 0, cus = 0, per_cu = 0;
        hipGetDevice(&dev);
        hipDeviceGetAttribute(&cus, hipDeviceAttributeMultiprocessorCount, dev);
        if (hipFuncSetAttribute((const void*)fwd_kernel, hipFuncAttributeMaxDynamicSharedMemorySize, LDS_BYTES) != hipSuccess) { fprintf(stderr, "kernel_launch: hipFuncSetAttribute failed\n"); grid = -1; return; }
        if (hipOccupancyMaxActiveBlocksPerMultiprocessor(&per_cu, (const void*)fwd_kernel, NTHR, LDS_BYTES) != hipSuccess || per_cu < 1) { fprintf(stderr, "kernel_launch: occupancy query says %d\n", per_cu); per_cu = 1; }
        (void)hipGetLastError();
        grid = cus;
        if (grid > 256) grid = 256;
    }
    if (grid < 0) return;
    if (hipMemsetAsync((char*)d_ws + WS_CTL, 0, CTL_ZERO_BYTES, stream) != hipSuccess) { fprintf(stderr, "kernel_launch: memset failed\n"); return; }
    Params p{};
    for (int i = 0; i < 20; ++i) p.in[i] = (const float*)d_in[i];
    p.out = (float*)d_out; p.ws = (uchar*)d_ws;
    void* args[] = {&p};
    hipError_t e = hipLaunchCooperativeKernel((const void*)fwd_kernel, dim3(grid), dim3(NTHR), args, LDS_BYTES, stream);
    if (e != hipSuccess) fprintf(stderr, "cooperative launch failed: %s (grid %d)\n", hipGetErrorString(e), grid);
}
```
